# Optimizing an MI355X kernel written in HIP

```python
import jax
import jax.numpy as jnp
from jax import lax

D_MODEL = 1024
BATCH = 2
SEQ = 16384
DEPTH = 2

HEAD_DIM = 64
ROPE_THETA = 10000.0
NORM_EPS = 1e-6
Q_BLOCK = 128
MAX_POS_OFFSET = 4096

A_HEADS = 8
A_KV_HEADS = 2
A_WINDOW = 128
B_HEADS = 8
C_HEADS = 8
C_KV_HEADS = 2
C_BLOCK = 256
C_TOPK = 3
D_HEADS = 8
D_KV_HEADS = 2
D_CMP_LEN = 32
D_CMP_STRIDE = 16
D_CMP_HIDDEN = 256
D_SEL_LEN = 64
D_SEL_TOPK = 16
D_WINDOW = 512
N_GROUPS = 4
EXPERTS_PER_GROUP = 16
N_EXPERTS = N_GROUPS * EXPERTS_PER_GROUP
MOE_TOPK = 2
EXPERT_HIDDEN = 512
MOE_BLOCK = 128

AB_SPLITS = (A_HEADS * HEAD_DIM, A_KV_HEADS * HEAD_DIM, A_KV_HEADS * HEAD_DIM, B_HEADS * HEAD_DIM, B_HEADS * HEAD_DIM, B_HEADS * HEAD_DIM)
CD_SPLITS = (C_HEADS * HEAD_DIM, C_KV_HEADS * HEAD_DIM, C_KV_HEADS * HEAD_DIM, D_HEADS * HEAD_DIM) + (D_KV_HEADS * HEAD_DIM,) * 6 + (3 * D_HEADS,)
AB_COLS = sum(AB_SPLITS)
CD_COLS = sum(CD_SPLITS)
AB_OUT = (A_HEADS + B_HEADS) * HEAD_DIM
CD_OUT = (C_HEADS + D_HEADS) * HEAD_DIM

kernel_name = 'hybrid_swa_stickbreak_moba_nsa_hmoe'


def _rmsnorm(x, g):
    xf = x.astype(jnp.float32)
    y = xf * lax.rsqrt(jnp.mean(xf * xf, axis=-1, keepdims=True) + NORM_EPS)
    return (y * g.astype(jnp.float32)).astype(x.dtype)


def _rope_tables(positions):
    inv_freq = ROPE_THETA ** (-jnp.arange(0, HEAD_DIM, 2, dtype=jnp.float32) / HEAD_DIM)
    ang = positions.astype(jnp.float32)[..., None] * inv_freq
    return jnp.cos(ang)[:, :, None, :], jnp.sin(ang)[:, :, None, :]


def _rope(x, cos, sin):
    half = HEAD_DIM // 2
    x1 = x[..., :half].astype(jnp.float32)
    x2 = x[..., half:].astype(jnp.float32)
    return jnp.concatenate([x1 * cos - x2 * sin, x2 * cos + x1 * sin], axis=-1).astype(x.dtype)


def _heads(t):
    return t.reshape(t.shape[0], t.shape[1], -1, HEAD_DIM)


def _split_cols(t, sizes):
    out, start = [], 0
    for size in sizes:
        out.append(t[..., start:start + size])
        start += size
    return out


def _sliding_window_sink_attention(q, k, v, sinks):
    B, S, Hq, d = q.shape
    Hkv = k.shape[2]
    G = Hq // Hkv
    nb = S // Q_BLOCK
    qb = q.reshape(B, nb, Q_BLOCK, Hkv, G, d)
    kb = k.reshape(B, nb, Q_BLOCK, Hkv, d)
    vb = v.reshape(B, nb, Q_BLOCK, Hkv, d)
    pad = ((0, 0), (1, 0), (0, 0), (0, 0), (0, 0))
    kk = jnp.concatenate([jnp.pad(kb, pad)[:, :-1], kb], axis=2)
    vv = jnp.concatenate([jnp.pad(vb, pad)[:, :-1], vb], axis=2)
    s = jnp.einsum('bnqhgd,bnkhd->bnhgqk', qb, kk).astype(jnp.float32) * (d ** -0.5)
    qi = jnp.arange(Q_BLOCK)[:, None] + Q_BLOCK
    ki = jnp.arange(2 * Q_BLOCK)[None, :]
    band = (qi - ki >= 0) & (qi - ki < A_WINDOW)
    exists = (jnp.arange(nb)[:, None] * Q_BLOCK + ki - Q_BLOCK) >= 0
    mask = (band[None] & exists[:, None, :])[None, :, None, None]
    s = jnp.where(mask, s, -jnp.inf)
    sink = sinks.astype(jnp.float32).reshape(1, 1, Hkv, G, 1, 1)
    m = jnp.maximum(s.max(axis=-1, keepdims=True), sink)
    p = jnp.exp(s - m)
    p = p / (p.sum(axis=-1, keepdims=True) + jnp.exp(sink - m))
    o = jnp.einsum('bnhgqk,bnkhd->bnqhgd', p.astype(v.dtype), vv)
    return o.reshape(B, S, Hq * d)


def _stick_breaking_attention(q, k, v):
    B, S, H, d = q.shape
    nb = S // Q_BLOCK
    qs = q.reshape(B, nb, Q_BLOCK, H, d).swapaxes(0, 1)
    spos = jnp.arange(S)

    def block(args):
        qblk, n = args
        z = jnp.einsum('bqhd,bkhd->bhqk', qblk, k).astype(jnp.float32) * (d ** -0.5)
        tpos = n * Q_BLOCK + jnp.arange(Q_BLOCK)
        past = spos[None, :] < tpos[:, None]
        log_stay = jnp.where(past, jax.nn.log_sigmoid(-z), 0.0)
        log_between = lax.cumsum(log_stay, axis=3, reverse=True) - log_stay
        w = jnp.where(past, jnp.exp(jax.nn.log_sigmoid(z) + log_between), 0.0)
        return jnp.einsum('bhqk,bkhd->bqhd', w.astype(v.dtype), v)

    o = lax.map(block, (qs, jnp.arange(nb)))
    return o.swapaxes(0, 1).reshape(B, S, H * d)


def _moba_attention(q, k, v):
    B, S, Hq, d = q.shape
    Hkv = k.shape[2]
    G = Hq // Hkv
    nblk = max(-(-S // C_BLOCK), C_TOPK)
    padw = ((0, 0), (0, nblk * C_BLOCK - S), (0, 0), (0, 0))
    kblk = jnp.pad(k, padw).reshape(B, nblk, C_BLOCK, Hkv, d)
    vblk = jnp.pad(v, padw).reshape(B, nblk, C_BLOCK, Hkv, d)
    kmean = kblk.astype(jnp.float32).mean(axis=2)
    kblk_t = kblk.transpose(0, 3, 1, 2, 4)
    vblk_t = vblk.transpose(0, 3, 1, 2, 4)
    nq = S // Q_BLOCK
    qs = q.reshape(B, nq, Q_BLOCK, Hkv, G, d).swapaxes(0, 1)
    bi = jnp.arange(B)[:, None, None, None, None]
    hi = jnp.arange(Hkv)[None, None, :, None, None]
    scale = d ** -0.5

    def block(args):
        qblk, n = args
        t = n * Q_BLOCK + jnp.arange(Q_BLOCK)
        own = (n * Q_BLOCK) // C_BLOCK
        gate = jnp.einsum('bqhgd,bmhd->bqhgm', qblk.astype(jnp.float32), kmean)
        gate = jnp.where(jnp.arange(nblk) < own, gate, -jnp.inf)
        _, sel = lax.top_k(gate, C_TOPK)
        valid = jnp.arange(C_TOPK) < own
        kg = kblk_t[bi, hi, sel]
        vg = vblk_t[bi, hi, sel]
        s_sel = jnp.einsum('bqhgd,bqhgrcd->bqhgrc', qblk, kg).astype(jnp.float32) * scale
        s_sel = jnp.where(valid[:, None], s_sel, -jnp.inf).reshape(B, Q_BLOCK, Hkv, G, C_TOPK * C_BLOCK)
        k_own = lax.dynamic_index_in_dim(kblk, own, axis=1, keepdims=False)
        v_own = lax.dynamic_index_in_dim(vblk, own, axis=1, keepdims=False)
        s_own = jnp.einsum('bqhgd,bchd->bqhgc', qblk, k_own).astype(jnp.float32) * scale
        causal = (own * C_BLOCK + jnp.arange(C_BLOCK))[None, :] <= t[:, None]
        s_own = jnp.where(causal[None, :, None, None, :], s_own, -jnp.inf)
        p = jax.nn.softmax(jnp.concatenate([s_sel, s_own], axis=-1), axis=-1)
        p_sel = p[..., :C_TOPK * C_BLOCK].reshape(B, Q_BLOCK, Hkv, G, C_TOPK, C_BLOCK)
        p_own = p[..., C_TOPK * C_BLOCK:]
        return (jnp.einsum('bqhgrc,bqhgrcd->bqhgd', p_sel.astype(v.dtype), vg)
                + jnp.einsum('bqhgc,bchd->bqhgd', p_own.astype(v.dtype), v_own))

    o = lax.map(block, (qs, jnp.arange(nq)))
    return o.swapaxes(0, 1).reshape(B, S, Hq * d)


def _nsa_attention(q, k_c, v_c, k_s, v_s, k_w, v_w, gates, k_pe, k_w1, k_w2, v_pe, v_w1, v_w2):
    B, S, Hq, d = q.shape
    Hkv = k_c.shape[2]
    G = Hq // Hkv
    scale = d ** -0.5
    nc = (S - D_CMP_LEN) // D_CMP_STRIDE + 1
    c_start = jnp.arange(nc) * D_CMP_STRIDE
    c_end = c_start + D_CMP_LEN - 1
    win = c_start[:, None] + jnp.arange(D_CMP_LEN)[None, :]

    def compress(t, pe, w1, w2):
        tw = t[:, win] + pe[None, None, :, None, :]
        tw = tw.transpose(0, 1, 3, 2, 4).reshape(B, nc, Hkv, D_CMP_LEN * d)
        return jax.nn.gelu(tw @ w1) @ w2

    k_cmp = compress(k_c, k_pe, k_w1, k_w2)
    v_cmp = compress(v_c, v_pe, v_w1, v_w2)
    nsel = max(-(-S // D_SEL_LEN), D_SEL_TOPK)
    padw = ((0, 0), (0, nsel * D_SEL_LEN - S), (0, 0), (0, 0))
    ks_t = jnp.pad(k_s, padw).reshape(B, nsel, D_SEL_LEN, Hkv, d).transpose(0, 3, 1, 2, 4)
    vs_t = jnp.pad(v_s, padw).reshape(B, nsel, D_SEL_LEN, Hkv, d).transpose(0, 3, 1, 2, 4)
    b_start = jnp.arange(nsel) * D_SEL_LEN
    overlap = ((c_start[:, None] <= b_start[None, :] + D_SEL_LEN - 1)
               & (c_end[:, None] >= b_start[None, :])).astype(jnp.float32)
    wpad = ((0, 0), (D_WINDOW, 0), (0, 0), (0, 0))
    kw_p = jnp.pad(k_w, wpad)
    vw_p = jnp.pad(v_w, wpad)
    nq = S // Q_BLOCK
    qs = q.reshape(B, nq, Q_BLOCK, Hkv, G, d).swapaxes(0, 1)
    gs = gates.reshape(B, nq, Q_BLOCK, Hkv, G, 3).swapaxes(0, 1)
    bi = jnp.arange(B)[:, None, None, None]
    hi = jnp.arange(Hkv)[None, None, :, None]
    jsel = jnp.arange(nsel)

    def block(args):
        qblk, gblk, n = args
        t = n * Q_BLOCK + jnp.arange(Q_BLOCK)
        s_c = jnp.einsum('bqhgd,bchd->bqhgc', qblk, k_cmp).astype(jnp.float32) * scale
        c_ok = (c_end[None, :] <= t[:, None])[None, :, None, None, :]
        s_c = jnp.where(c_ok, s_c, -jnp.inf)
        m = s_c.max(axis=-1, keepdims=True)
        m = jnp.where(jnp.isfinite(m), m, 0.0)
        e = jnp.exp(s_c - m)
        den = e.sum(axis=-1, keepdims=True)
        p_c = e / jnp.where(den > 0, den, 1.0)
        o_c = jnp.einsum('bqhgc,bchd->bqhgd', p_c.astype(v_cmp.dtype), v_cmp)
        imp = jnp.einsum('bqhgc,cj->bqhj', p_c, overlap)
        cur = t // D_SEL_LEN
        allowed = b_start[None, :] <= t[:, None]
        forced = (jsel[None, :] == 0) | (jsel[None, :] == cur[:, None]) | (jsel[None, :] == cur[:, None] - 1)
        imp = jnp.where(allowed[None, :, None, :], imp, -jnp.inf)
        imp = jnp.where((allowed & forced)[None, :, None, :], jnp.inf, imp)
        top_v, sel = lax.top_k(imp, D_SEL_TOPK)
        kg = ks_t[bi, hi, sel]
        vg = vs_t[bi, hi, sel]
        s_s = jnp.einsum('bqhgd,bqhrld->bqhgrl', qblk, kg).astype(jnp.float32) * scale
        kpos = sel[..., None] * D_SEL_LEN + jnp.arange(D_SEL_LEN)
        s_ok = (top_v > -jnp.inf)[..., None] & (kpos <= t[None, :, None, None, None])
        s_s = jnp.where(s_ok[:, :, :, None], s_s, -jnp.inf).reshape(B, Q_BLOCK, Hkv, G, D_SEL_TOPK * D_SEL_LEN)
        p_s = jax.nn.softmax(s_s, axis=-1).reshape(B, Q_BLOCK, Hkv, G, D_SEL_TOPK, D_SEL_LEN)
        o_s = jnp.einsum('bqhgrl,bqhrld->bqhgd', p_s.astype(vg.dtype), vg)
        k_win = lax.dynamic_slice_in_dim(kw_p, n * Q_BLOCK, D_WINDOW + Q_BLOCK, axis=1)
        v_win = lax.dynamic_slice_in_dim(vw_p, n * Q_BLOCK, D_WINDOW + Q_BLOCK, axis=1)
        s_w = jnp.einsum('bqhgd,bkhd->bqhgk', qblk, k_win).astype(jnp.float32) * scale
        wpos = n * Q_BLOCK - D_WINDOW + jnp.arange(D_WINDOW + Q_BLOCK)
        diff = t[:, None] - wpos[None, :]
        w_ok = (diff >= 0) & (diff < D_WINDOW) & (wpos[None, :] >= 0)
        s_w = jnp.where(w_ok[None, :, None, None, :], s_w, -jnp.inf)
        p_w = jax.nn.softmax(s_w, axis=-1)
        o_w = jnp.einsum('bqhgk,bkhd->bqhgd', p_w.astype(v_win.dtype), v_win)
        g = jax.nn.sigmoid(gblk.astype(jnp.float32))
        o = g[..., 0:1] * o_c + g[..., 1:2] * o_s + g[..., 2:3] * o_w
        return o.astype(q.dtype)

    o = lax.map(block, (qs, gs, jnp.arange(nq)))
    return o.swapaxes(0, 1).reshape(B, S, Hq * d)


def _mixer_ab(h, cos, sin, w_in, sinks, w_out):
    qa, ka, va, qb, kb, vb = _split_cols(h @ w_in, AB_SPLITS)
    oa = _sliding_window_sink_attention(_rope(_heads(qa), cos, sin), _rope(_heads(ka), cos, sin), _heads(va), sinks)
    ob = _stick_breaking_attention(_heads(qb), _heads(kb), _heads(vb))
    return jnp.concatenate([oa, ob], axis=-1) @ w_out


def _mixer_cd(h, cos, sin, w_in, k_pe, k_w1, k_w2, v_pe, v_w1, v_w2, w_out):
    qc, kc, vc, qd, kdc, vdc, kds, vds, kdw, vdw, gd = _split_cols(h @ w_in, CD_SPLITS)
    rp = lambda t: _rope(_heads(t), cos, sin)
    oc = _moba_attention(rp(qc), rp(kc), _heads(vc))
    od = _nsa_attention(rp(qd), rp(kdc), _heads(vdc), rp(kds), _heads(vds), rp(kdw), _heads(vdw), gd,
                        k_pe, k_w1, k_w2, v_pe, v_w1, v_w2)
    return jnp.concatenate([oc, od], axis=-1) @ w_out


def _hier_moe(h, router_group, router_expert, w_gate, w_up, w_down):
    B, S, D = h.shape
    n_tok = B * S
    hf = h.reshape(n_tok, D)
    gp = jax.nn.softmax((hf @ router_group).astype(jnp.float32), axis=-1)
    g_prob, g_idx = lax.top_k(gp, 1)
    el = (hf @ router_expert).astype(jnp.float32).reshape(n_tok, N_GROUPS, EXPERTS_PER_GROUP)
    el = jnp.take_along_axis(el, g_idx[:, :, None], axis=1)[:, 0]
    e_prob, e_idx = lax.top_k(jax.nn.softmax(el, axis=-1), MOE_TOPK)
    gate = g_prob * e_prob / e_prob.sum(axis=-1, keepdims=True)
    expert = g_idx * EXPERTS_PER_GROUP + e_idx
    n_asg = n_tok * MOE_TOPK
    e_flat = expert.reshape(n_asg)
    order = jnp.argsort(e_flat)
    e_sorted = e_flat[order]
    tok_sorted = (order // MOE_TOPK).astype(jnp.int32)
    w_sorted = gate.reshape(n_asg)[order]
    counts = jnp.zeros((N_EXPERTS,), jnp.int32).at[e_flat].add(1)
    padded = (counts + MOE_BLOCK - 1) // MOE_BLOCK * MOE_BLOCK
    pad_end = jnp.cumsum(padded)
    pad_start = pad_end - padded
    start = jnp.cumsum(counts) - counts
    dest = pad_start[e_sorted] + jnp.arange(n_asg) - start[e_sorted]
    n_rows = n_asg + N_EXPERTS * MOE_BLOCK
    n_blk = n_rows // MOE_BLOCK
    row_tok = jnp.full((n_rows,), n_tok, jnp.int32).at[dest].set(tok_sorted)
    row_w = jnp.zeros((n_rows,), jnp.float32).at[dest].set(w_sorted)
    blk_expert = jnp.minimum(jnp.searchsorted(pad_end, jnp.arange(n_blk) * MOE_BLOCK, side='right'), N_EXPERTS - 1)
    h_pad = jnp.concatenate([hf, jnp.zeros((1, D), hf.dtype)], axis=0)
    rows = h_pad[row_tok].reshape(n_blk, MOE_BLOCK, D)

    def expert_block(args):
        xb, e = args
        return (jax.nn.silu(xb @ w_gate[e]) * (xb @ w_up[e])) @ w_down[e]

    y = lax.map(expert_block, (rows, blk_expert)).reshape(n_rows, D)
    out = jnp.zeros((n_tok + 1, D), jnp.float32).at[row_tok].add(y.astype(jnp.float32) * row_w[:, None])
    return out[:n_tok].reshape(B, S, D).astype(h.dtype)


def setup_inputs(seed: int = 0) -> dict:
    key = jax.random.key(seed)
    keys = iter(jax.random.split(key, 40))

    def nrm(shape, scale):
        return jax.random.normal(next(keys), shape, jnp.float32) * scale

    def gain():
        return 1.0 + nrm((D_MODEL,), 0.02)

    def moe(suffix):
        return {
            'router_group' + suffix: nrm((D_MODEL, N_GROUPS), D_MODEL ** -0.5),
            'router_expert' + suffix: nrm((D_MODEL, N_EXPERTS), D_MODEL ** -0.5),
            'expert_gate' + suffix: nrm((N_EXPERTS, D_MODEL, EXPERT_HIDDEN), D_MODEL ** -0.5),
            'expert_up' + suffix: nrm((N_EXPERTS, D_MODEL, EXPERT_HIDDEN), D_MODEL ** -0.5),
            'expert_down' + suffix: nrm((N_EXPERTS, EXPERT_HIDDEN, D_MODEL), EXPERT_HIDDEN ** -0.5),
        }

    x = nrm((BATCH, SEQ, D_MODEL), 1.0)
    positions = jnp.arange(SEQ, dtype=jnp.int32)[None, :] + jax.random.randint(next(keys), (BATCH, 1), 0, MAX_POS_OFFSET, dtype=jnp.int32)
    cmp_in = D_CMP_LEN * HEAD_DIM
    inputs = {'x': x, 'positions': positions}
    inputs['ln_mix_0'] = gain()
    inputs['w_in_0'] = nrm((D_MODEL, AB_COLS), D_MODEL ** -0.5)
    inputs['sinks_0'] = nrm((A_HEADS,), 0.5)
    inputs['w_out_0'] = nrm((AB_OUT, D_MODEL), AB_OUT ** -0.5)
    inputs['ln_ffn_0'] = gain()
    inputs.update(moe('_0'))
    inputs['ln_mix_1'] = gain()
    inputs['w_in_1'] = nrm((D_MODEL, CD_COLS), D_MODEL ** -0.5)
    inputs['cmp_k_pe_1'] = nrm((D_CMP_LEN, HEAD_DIM), 0.1)
    inputs['cmp_k_w1_1'] = nrm((cmp_in, D_CMP_HIDDEN), cmp_in ** -0.5)
    inputs['cmp_k_w2_1'] = nrm((D_CMP_HIDDEN, HEAD_DIM), D_CMP_HIDDEN ** -0.5)
    inputs['cmp_v_pe_1'] = nrm((D_CMP_LEN, HEAD_DIM), 0.1)
    inputs['cmp_v_w1_1'] = nrm((cmp_in, D_CMP_HIDDEN), cmp_in ** -0.5)
    inputs['cmp_v_w2_1'] = nrm((D_CMP_HIDDEN, HEAD_DIM), D_CMP_HIDDEN ** -0.5)
    inputs['w_out_1'] = nrm((CD_OUT, D_MODEL), CD_OUT ** -0.5)
    inputs['ln_ffn_1'] = gain()
    inputs.update(moe('_1'))
    inputs['ln_final'] = gain()
    return inputs


def reference(x, positions, ln_mix_0, w_in_0, sinks_0, w_out_0, ln_ffn_0, router_group_0, router_expert_0, expert_gate_0, expert_up_0, expert_down_0, ln_mix_1, w_in_1, cmp_k_pe_1, cmp_k_w1_1, cmp_k_w2_1, cmp_v_pe_1, cmp_v_w1_1, cmp_v_w2_1, w_out_1, ln_ffn_1, router_group_1, router_expert_1, expert_gate_1, expert_up_1, expert_down_1, ln_final):
    cos, sin = _rope_tables(positions)
    mixers = (
        lambda h: _mixer_ab(h, cos, sin, w_in_0, sinks_0, w_out_0),
        lambda h: _mixer_cd(h, cos, sin, w_in_1, cmp_k_pe_1, cmp_k_w1_1, cmp_k_w2_1, cmp_v_pe_1, cmp_v_w1_1, cmp_v_w2_1, w_out_1),
    )
    mix_norms = (ln_mix_0, ln_mix_1)
    ffn_norms = (ln_ffn_0, ln_ffn_1)
    ffns = ((router_group_0, router_expert_0, expert_gate_0, expert_up_0, expert_down_0),
            (router_group_1, router_expert_1, expert_gate_1, expert_up_1, expert_down_1))
    for layer in range(DEPTH):
        x = x + mixers[layer](_rmsnorm(x, mix_norms[layer]))
        x = x + _hier_moe(_rmsnorm(x, ffn_norms[layer]), *ffns[layer])
    return _rmsnorm(x, ln_final)
```

```cpp
#include <hip/hip_runtime.h>
#include <stdint.h>
#include <stdio.h>
#include <string.h>

#ifndef MEGA
#define MEGA 1
#endif

typedef unsigned short bf16_t;
typedef short bf16x8 __attribute__((ext_vector_type(8)));
typedef float f32x4 __attribute__((ext_vector_type(4)));

#define NTOK 32768
#define SEQ 16384
#define DM 1024
#define LDQ 2304
#define NVH 10
#define NEXP 64
#define EH 512
#define NASG 65536
#define NCMP 1023
#define NCMPP 1024
#define NEG_BIG (-1.0e30f)

constexpr size_t MB = 1024ull * 1024ull;
constexpr size_t OFF_CTRL = 0;
constexpr size_t OFF_MOBACNT = 16384;
constexpr size_t OFF_ROPE = 1 * MB;
constexpr size_t OFF_W = 9 * MB;
constexpr size_t W_IN = OFF_W;
constexpr size_t W_OUT = W_IN + 2304ull * 1024 * 2;
constexpr size_t W_GU = W_OUT + 1024ull * 1024 * 2;
constexpr size_t W_DN = W_GU + 64ull * 1024 * 1024 * 2;
constexpr size_t W_K1 = W_DN + 64ull * 1024 * 512 * 2;
constexpr size_t W_V1 = W_K1 + 256ull * 2048 * 2;
constexpr size_t W_K2 = W_V1 + 256ull * 2048 * 2;
constexpr size_t W_V2 = W_K2 + 128ull * 256 * 2;
constexpr size_t W_BK = W_V2 + 128ull * 256 * 2;
constexpr size_t W_BV = W_BK + 1024;
constexpr size_t OFF_H = W_BV + 1024 + 1022 * 1024;
constexpr size_t OFF_QKV = OFF_H + (size_t)NTOK * 1024 * 2;
constexpr size_t OFF_VT = OFF_QKV + (size_t)NTOK * LDQ * 2;
constexpr size_t OFF_O = OFF_VT + 2ull * NVH * 64 * SEQ * 2;
constexpr size_t OFF_B = OFF_O + (size_t)NTOK * 1024 * 2;
constexpr size_t B_LIST = OFF_B;
constexpr size_t MOBA_LCAP = 2064384ull;
constexpr size_t B_PO = B_LIST + 4 * MOBA_LCAP * 4;
constexpr size_t B_PML = B_PO + (size_t)NTOK * 24 * 64 * 2;
constexpr size_t B_HIDK = B_PML + (size_t)NTOK * 24 * 8;
constexpr size_t B_HIDV = B_HIDK + 4096ull * 256 * 2;
constexpr size_t B_KCMP = B_HIDV + 4096ull * 256 * 2;
constexpr size_t B_VCMPT = B_KCMP + 4ull * 1024 * 64 * 2;
constexpr size_t B_KMEAN = B_VCMPT + 4ull * 1024 * 64 * 2;
constexpr size_t B_GD = B_KMEAN + 2ull * 64 * 2 * 64 * 4;
constexpr size_t B_Y = OFF_B;
constexpr size_t OFF_M = OFF_B + 160 * MB;
constexpr size_t M_TOKE = OFF_M;
constexpr size_t M_TOKG = M_TOKE + (size_t)NTOK * 8;
constexpr size_t M_TOKR = M_TOKG + (size_t)NTOK * 8;
constexpr size_t M_HIST = M_TOKR + (size_t)NTOK * 8;
constexpr size_t M_LIST = M_HIST + 512ull * 64 * 4;
constexpr size_t M_ECNT = M_LIST + 65536ull * 4;
constexpr size_t M_EBASE = M_ECNT + 256;
constexpr size_t WS_NEED = OFF_M + 2 * MB;
constexpr size_t HID_OFF = OFF_QKV;

#define SMEM_BYTES 36864

struct Params {
    const float* x; const int* pos;
    const float* ln_mix[2]; const float* w_in[2]; const float* sinks0; const float* w_out[2]; const float* ln_ffn[2];
    const float* r_group[2]; const float* r_expert[2]; const float* e_gate[2]; const float* e_up[2]; const float* e_down[2];
    const float* k_pe; const float* k_w1; const float* k_w2; const float* v_pe; const float* v_w1; const float* v_w2;
    const float* ln_final;
    float* out;
    char* ws;
};

#define XB_TMO      128
#define XB_XCNT(j)  (256  + 64 * (j))
#define XB_XSUB(j)  (1280 + 64 * (j))
#define XB_XGEN(j)  (2304 + 64 * (j))
#define XB_TOP      3328
#define XB_TOPGEN   3392
#define XCD_BAR_WORDS 3456
#define XB_SPIN_CAP (1u << 22)
#define LAS __attribute__((address_space(3)))

__device__ __forceinline__ unsigned xb_ld(unsigned* p)              { return __hip_atomic_load(p, __ATOMIC_RELAXED, __HIP_MEMORY_SCOPE_AGENT); }
__device__ __forceinline__ unsigned xb_add(unsigned* p, unsigned v) { return __hip_atomic_fetch_add(p, v, __ATOMIC_RELAXED, __HIP_MEMORY_SCOPE_AGENT); }
__device__ __forceinline__ unsigned xb_xcc_id() { return (unsigned)__builtin_amdgcn_s_getreg((3 << 11) | 20) & 0xFu; }
#define XB_SPIN(cond, bar) do { unsigned _sp = 0; while (cond) { __builtin_amdgcn_s_sleep(1); \
    if ((++_sp & 255u) == 0u) { if (xb_ld(&(bar)[XB_TMO])) break; if (_sp > XB_SPIN_CAP) { atomicAdd(&(bar)[XB_TMO], 1u); break; } } } } while (0)

struct XcdBarrier { unsigned* bar; unsigned x; volatile LAS unsigned* st; };

__device__ __forceinline__ XcdBarrier xcd_barrier_post(unsigned* bar, volatile LAS unsigned* st) {
    XcdBarrier b; b.bar = bar; b.x = xb_xcc_id(); b.st = st;
    if (threadIdx.x == 0) (void)xb_add(&bar[XB_XCNT(b.x)], 1u);
    return b;
}
__device__ __forceinline__ void xcd_barrier_complete(unsigned* bar, unsigned x, unsigned& nloc, unsigned& nx) {
    const unsigned G = gridDim.x * gridDim.y * gridDim.z;
    unsigned sum, cnt, mine, sp = 0u;
    for (;;) {
        sum = 0u; cnt = 0u; mine = 0u;
#pragma unroll
        for (unsigned j = 0; j < 16; ++j) { const unsigned c = xb_ld(&bar[XB_XCNT(j)]); sum += c; cnt += (c > 0u) ? 1u : 0u; mine = (j == x) ? c : mine; }
        if (sum == G) break;
        __builtin_amdgcn_s_sleep(1);
        if ((++sp & 255u) == 0u) { if (xb_ld(&bar[XB_TMO])) break; if (sp > XB_SPIN_CAP) { atomicAdd(&bar[XB_TMO], 1u); break; } }
    }
    nloc = mine > 0u ? mine : 1u; nx = cnt > 0u ? cnt : 1u;
}
__device__ __forceinline__ void xcd_barrier(const XcdBarrier& b) {
    asm volatile("s_waitcnt vmcnt(0)" ::: "memory");
    __syncthreads();
    if (threadIdx.x == 0) {
        unsigned* bar = b.bar;
        __builtin_amdgcn_s_waitcnt(0);
        unsigned nloc = b.st[0], nx = b.st[1];
        if (nloc == 0u) { xcd_barrier_complete(bar, b.x, nloc, nx); b.st[0] = nloc; b.st[1] = nx; }
        const unsigned old = xb_add(&bar[XB_XSUB(b.x)], 1u);
        const unsigned gen = old / nloc;
        if (old + 1u == (gen + 1u) * nloc) {
            __builtin_amdgcn_fence(__ATOMIC_RELEASE, "agent");
            asm volatile("s_waitcnt vmcnt(0)" ::: "memory");
            const unsigned og = xb_add(&bar[XB_TOP], 1u);
            const unsigned tg = og / nx;
            if (og + 1u == (tg + 1u) * nx) xb_add(&bar[XB_TOPGEN], 1u);
            else XB_SPIN(xb_ld(&bar[XB_TOPGEN]) == tg, bar);
            __builtin_amdgcn_fence(__ATOMIC_ACQUIRE, "agent");
            xb_add(&bar[XB_XGEN(b.x)], 1u);
            asm volatile("s_waitcnt vmcnt(0)" ::: "memory");
        } else {
            XB_SPIN(xb_ld(&bar[XB_XGEN(b.x)]) == gen, bar);
            __builtin_amdgcn_fence(__ATOMIC_ACQUIRE, "agent");
            asm volatile("s_waitcnt vmcnt(0)" ::: "memory");
        }
    }
    __syncthreads();
}

__device__ __forceinline__ bf16_t f2bf(float f) { uint32_t u = __float_as_uint(f); u += 0x7FFFu + ((u >> 16) & 1u); return (bf16_t)(u >> 16); }
__device__ __forceinline__ float bf2f(bf16_t h) { return __uint_as_float(((uint32_t)h) << 16); }
__device__ __forceinline__ uint32_t pack2(float a, float b) { return (uint32_t)f2bf(a) | ((uint32_t)f2bf(b) << 16); }
__device__ __forceinline__ f32x4 mfma16(bf16x8 a, bf16x8 b, f32x4 c) { return __builtin_amdgcn_mfma_f32_16x16x32_bf16(a, b, c, 0, 0, 0); }
__device__ __forceinline__ float red16_max(float v) { v = fmaxf(v, __shfl_xor(v, 1)); v = fmaxf(v, __shfl_xor(v, 2)); v = fmaxf(v, __shfl_xor(v, 4)); v = fmaxf(v, __shfl_xor(v, 8)); return v; }
__device__ __forceinline__ float red16_sum(float v) { v += __shfl_xor(v, 1); v += __shfl_xor(v, 2); v += __shfl_xor(v, 4); v += __shfl_xor(v, 8); return v; }
__device__ __forceinline__ float red64_sum(float v) { v += __shfl_xor(v, 1); v += __shfl_xor(v, 2); v += __shfl_xor(v, 4); v += __shfl_xor(v, 8); v += __shfl_xor(v, 16); v += __shfl_xor(v, 32); return v; }
__device__ __forceinline__ void lds_fence() { asm volatile("s_waitcnt lgkmcnt(0)" ::: "memory"); }
__device__ __forceinline__ bf16x8 ld8(const bf16_t* p) { return *(const bf16x8*)p; }
__device__ __forceinline__ bf16x8 zero8() { bf16x8 z = {0, 0, 0, 0, 0, 0, 0, 0}; return z; }

__device__ __forceinline__ void tconv(char* smem, const float* src, bf16_t* dst, int K, int N, int Npad, int nbatch, size_t sstride, size_t dstride, int mode) {
    float* tile = (float*)smem;
    const int tid = threadIdx.x;
    const int tk = K / 64, tn = (Npad + 63) / 64, per = tk * tn, total = per * nbatch;
    for (int it = blockIdx.x; it < total; it += gridDim.x) {
        const int bi = it / per, r = it % per, k0 = (r / tn) * 64, n0 = (r % tn) * 64;
        const float* s = src + (size_t)bi * sstride;
        bf16_t* d = dst + (size_t)bi * dstride;
        const int ty = tid >> 4, tx = tid & 15;
#pragma unroll
        for (int i = 0; i < 4; ++i) {
            const int k = ty + 16 * i, n = n0 + tx * 4;
            float4 v = make_float4(0.f, 0.f, 0.f, 0.f);
            if (n < N) v = *(const float4*)(s + (size_t)(k0 + k) * N + n);
            tile[k * 65 + tx * 4 + 0] = v.x; tile[k * 65 + tx * 4 + 1] = v.y; tile[k * 65 + tx * 4 + 2] = v.z; tile[k * 65 + tx * 4 + 3] = v.w;
        }
        __syncthreads();
        {
            const int nl = tid >> 2, kc = (tid & 3) * 16, n = n0 + nl;
            if (n < Npad) {
                int row = n;
                if (mode == 1) row = (n >> 5) * 64 + (n & 31);
                else if (mode == 2) row = (n >> 5) * 64 + 32 + (n & 31);
                uint32_t w[8];
#pragma unroll
                for (int i = 0; i < 8; ++i) w[i] = pack2(tile[(kc + 2 * i) * 65 + nl], tile[(kc + 2 * i + 1) * 65 + nl]);
                uint4* o = (uint4*)(d + (size_t)row * K + k0 + kc);
                o[0] = make_uint4(w[0], w[1], w[2], w[3]);
                o[1] = make_uint4(w[4], w[5], w[6], w[7]);
            }
        }
        __syncthreads();
    }
}

__device__ __forceinline__ void conv_layer_weights(const Params& p, char* smem, int L) {
    char* ws = p.ws;
    if (L == 0) tconv(smem, p.w_in[0], (bf16_t*)(ws + W_IN), 1024, 2304, 2304, 1, 0, 0, 0);
    else        tconv(smem, p.w_in[1], (bf16_t*)(ws + W_IN), 1024, 2072, 2176, 1, 0, 0, 0);
    tconv(smem, p.w_out[L], (bf16_t*)(ws + W_OUT), 1024, 1024, 1024, 1, 0, 0, 0);
    tconv(smem, p.e_gate[L], (bf16_t*)(ws + W_GU), 1024, 512, 512, 64, 1024ull * 512, 1024ull * 1024, 1);
    tconv(smem, p.e_up[L], (bf16_t*)(ws + W_GU), 1024, 512, 512, 64, 1024ull * 512, 1024ull * 1024, 2);
    tconv(smem, p.e_down[L], (bf16_t*)(ws + W_DN), 512, 1024, 1024, 64, 512ull * 1024, 1024ull * 512, 0);
    if (L == 1) {
        tconv(smem, p.k_w1, (bf16_t*)(ws + W_K1), 2048, 256, 256, 1, 0, 0, 0);
        tconv(smem, p.v_w1, (bf16_t*)(ws + W_V1), 2048, 256, 256, 1, 0, 0, 0);
        tconv(smem, p.k_w2, (bf16_t*)(ws + W_K2), 256, 64, 128, 1, 0, 0, 0);
        tconv(smem, p.v_w2, (bf16_t*)(ws + W_V2), 256, 64, 128, 1, 0, 0, 0);
        if (blockIdx.x == gridDim.x - 1 || blockIdx.x == gridDim.x - 2) {
            const bool isv = (blockIdx.x == gridDim.x - 2);
            const float* pe = isv ? p.v_pe : p.k_pe; const float* w1 = isv ? p.v_w1 : p.k_w1;
            float* bias = (float*)(ws + (isv ? W_BV : W_BK));
            const int n = threadIdx.x; float acc = 0.f;
            for (int kk = 0; kk < 2048; ++kk) acc += pe[kk] * w1[(size_t)kk * 256 + n];
            bias[n] = acc;
        }
    }
}

__device__ __forceinline__ void rope_table(const Params& p) {
    float* rc = (float*)(p.ws + OFF_ROPE); float* rs = rc + (size_t)NTOK * 32;
    for (int i = blockIdx.x * 256 + threadIdx.x; i < NTOK * 32; i += gridDim.x * 256) {
        const int t = i >> 5, c = i & 31;
        const double inv = pow(10000.0, -(double)c / 32.0);
        const double ang = (double)p.pos[t] * inv;
        rc[i] = (float)cos(ang); rs[i] = (float)sin(ang);
    }
}

__device__ __forceinline__ void norm_pass(const float* src, const bf16_t* y, float* xr, const float* gain, bf16_t* hb, float* hf) {
    const int lane = threadIdx.x & 63, wid = threadIdx.x >> 6;
    const int nw = gridDim.x * 4;
    for (int t = blockIdx.x * 4 + wid; t < NTOK; t += nw) {
        float v[16];
#pragma unroll
        for (int i = 0; i < 4; ++i) {
            const float4 a = *(const float4*)(src + (size_t)t * DM + i * 256 + lane * 4);
            v[4 * i] = a.x; v[4 * i + 1] = a.y; v[4 * i + 2] = a.z; v[4 * i + 3] = a.w;
        }
        if (y) {
#pragma unroll
            for (int k = 0; k < 2; ++k)
#pragma unroll
                for (int i = 0; i < 4; ++i) {
                    const uint2 a = *(const uint2*)(y + ((size_t)t * 2 + k) * DM + i * 256 + lane * 4);
                    v[4 * i] += __uint_as_float(a.x << 16); v[4 * i + 1] += __uint_as_float(a.x & 0xFFFF0000u);
                    v[4 * i + 2] += __uint_as_float(a.y << 16); v[4 * i + 3] += __uint_as_float(a.y & 0xFFFF0000u);
                }
        }
        float ss = 0.f;
#pragma unroll
        for (int i = 0; i < 16; ++i) ss += v[i] * v[i];
        ss = red64_sum(ss);
        const float rstd = rsqrtf(ss * (1.0f / DM) + 1e-6f);
#pragma unroll
        for (int i = 0; i < 4; ++i) {
            if (xr) *(float4*)(xr + (size_t)t * DM + i * 256 + lane * 4) = make_float4(v[4 * i], v[4 * i + 1], v[4 * i + 2], v[4 * i + 3]);
            const float4 g = *(const float4*)(gain + i * 256 + lane * 4);
            const float h0 = v[4 * i] * rstd * g.x, h1 = v[4 * i + 1] * rstd * g.y, h2 = v[4 * i + 2] * rstd * g.z, h3 = v[4 * i + 3] * rstd * g.w;
            if (hb) *(uint2*)(hb + (size_t)t * DM + i * 256 + lane * 4) = make_uint2(pack2(h0, h1), pack2(h2, h3));
            if (hf) *(float4*)(hf + (size_t)t * DM + i * 256 + lane * 4) = make_float4(h0, h1, h2, h3);
        }
    }
}

__device__ __forceinline__ void glds16(const bf16_t* g, char* l) {
    __builtin_amdgcn_global_load_lds((const unsigned*)g, (LAS unsigned*)l, 16, 0, 0);
}
template <class AOff, class Epi>
__device__ __forceinline__ void gemm_tile(char* smem, const bf16_t* a0, const bf16_t* a1, const bf16_t* b0, const bf16_t* b1, int KT, AOff aoff, Epi epi) {
    const int tid = threadIdx.x, wid = tid >> 6, lane = tid & 63, wr = wid >> 1, wc = wid & 1, fr = lane & 15, fq = lane >> 4;
    f32x4 acc[4][4];
#pragma unroll
    for (int m = 0; m < 4; ++m)
#pragma unroll
        for (int n = 0; n < 4; ++n) acc[m][n] = (f32x4){0.f, 0.f, 0.f, 0.f};
    {
        const size_t ao = aoff(0);
        glds16(a0 + ao, smem + tid * 16); glds16(a1 + ao, smem + 4096 + tid * 16);
        glds16(b0, smem + 8192 + tid * 16); glds16(b1, smem + 8192 + 4096 + tid * 16);
    }
    for (int t = 0; t < KT; ++t) {
        char* cur = smem + (t & 1) * 16384;
        asm volatile("s_waitcnt vmcnt(0)" ::: "memory");
        __syncthreads();
        if (t + 1 < KT) {
            char* nxt = smem + ((t + 1) & 1) * 16384;
            const size_t ao = aoff(t + 1);
            glds16(a0 + ao, nxt + tid * 16); glds16(a1 + ao, nxt + 4096 + tid * 16);
            glds16(b0 + (t + 1) * 32, nxt + 8192 + tid * 16); glds16(b1 + (t + 1) * 32, nxt + 8192 + 4096 + tid * 16);
        }
        bf16x8 af[4], bfr[4];
#pragma unroll
        for (int m = 0; m < 4; ++m) af[m] = *(const bf16x8*)(cur + (wr * 64 + m * 16 + fr) * 64 + fq * 16);
#pragma unroll
        for (int n = 0; n < 4; ++n) bfr[n] = *(const bf16x8*)(cur + 8192 + (wc * 64 + n * 16 + fr) * 64 + fq * 16);
#pragma unroll
        for (int m = 0; m < 4; ++m)
#pragma unroll
            for (int n = 0; n < 4; ++n) acc[m][n] = mfma16(af[m], bfr[n], acc[m][n]);
    }
    epi(acc, wr, wc, fr, fq);
    __syncthreads();
}

__device__ __forceinline__ void col_kind(int L, int ct, int& kind, int& vh, float& scale) {
    kind = 0; vh = 0; scale = 1.f;
    if (L == 0) {
        if (ct < 8) { kind = 1; scale = 0.125f; }
        else if (ct < 10) kind = 1;
        else if (ct < 12) { kind = 2; vh = ct - 10; }
        else if (ct < 20) { kind = 0; scale = 0.125f; }
        else if (ct < 28) kind = 0;
        else { kind = 2; vh = 2 + (ct - 28); }
    } else {
        if (ct < 8) { kind = 1; scale = 0.125f; }
        else if (ct < 10) kind = 1;
        else if (ct < 12) { kind = 2; vh = ct - 10; }
        else if (ct < 20) { kind = 1; scale = 0.125f; }
        else if (ct < 22) kind = 1;
        else if (ct < 24) kind = 0;
        else if (ct < 26) kind = 1;
        else if (ct < 28) { kind = 2; vh = 2 + (ct - 26); }
        else if (ct < 30) kind = 1;
        else if (ct < 32) { kind = 2; vh = 4 + (ct - 30); }
        else if (ct == 32) kind = 3;
        else kind = 4;
    }
}

__device__ __forceinline__ void ph_gemm_qkv(const Params& p, char* smem, int L) {
    const bf16_t* A = (const bf16_t*)(p.ws + OFF_H);
    const bf16_t* Bt = (const bf16_t*)(p.ws + W_IN);
    bf16_t* Q = (bf16_t*)(p.ws + OFF_QKV);
    bf16_t* VT = (bf16_t*)(p.ws + OFF_VT);
    float* GD = (float*)(p.ws + B_GD);
    const float* rc = (const float*)(p.ws + OFF_ROPE); const float* rs = rc + (size_t)NTOK * 32;
    const int tn = (L == 0) ? 18 : 17, tm = NTOK / 128, total = tm * tn;
    const int tid = threadIdx.x;
    for (int it = blockIdx.x; it < total; it += gridDim.x) {
        const int mt = it / tn, nt = it % tn, brow = mt * 128, bcol = nt * 128;
        const bf16_t* a0 = A + (size_t)(brow + (tid >> 2)) * DM + (tid & 3) * 8;
        const bf16_t* a1 = a0 + (size_t)64 * DM;
        const bf16_t* b0 = Bt + (size_t)(bcol + (tid >> 2)) * DM + (tid & 3) * 8;
        const bf16_t* b1 = b0 + (size_t)64 * DM;
        gemm_tile(smem, a0, a1, b0, b1, DM / 32, [](int t) { return (size_t)t * 32; },
            [&](f32x4 (&acc)[4][4], int wr, int wc, int fr, int fq) {
                const int ct = (bcol >> 6) + wc;
                int kind, vh; float scale; col_kind(L, ct, kind, vh, scale);
                if (kind == 4) return;
#pragma unroll
                for (int m = 0; m < 4; ++m) {
                    const int row0 = brow + wr * 64 + m * 16 + fq * 4;
                    if (kind == 1) {
#pragma unroll
                        for (int j = 0; j < 4; ++j) {
                            const int row = row0 + j;
#pragma unroll
                            for (int n = 0; n < 2; ++n) {
                                const int c = n * 16 + fr;
                                const float cs = rc[(size_t)row * 32 + c], sn = rs[(size_t)row * 32 + c];
                                const float x1 = acc[m][n][j], x2 = acc[m][n + 2][j];
                                Q[(size_t)row * LDQ + ct * 64 + c] = f2bf((x1 * cs - x2 * sn) * scale);
                                Q[(size_t)row * LDQ + ct * 64 + 32 + c] = f2bf((x2 * cs + x1 * sn) * scale);
                            }
                        }
                    } else if (kind == 0) {
#pragma unroll
                        for (int j = 0; j < 4; ++j)
#pragma unroll
                            for (int n = 0; n < 4; ++n) Q[(size_t)(row0 + j) * LDQ + ct * 64 + n * 16 + fr] = f2bf(acc[m][n][j] * scale);
                    } else if (kind == 2) {
                        const int b = row0 >> 14, s = row0 & (SEQ - 1);
#pragma unroll
                        for (int n = 0; n < 4; ++n) {
                            const int d = n * 16 + fr;
                            *(uint2*)(VT + ((size_t)(b * NVH + vh) * 64 + d) * SEQ + s) = make_uint2(pack2(acc[m][n][0], acc[m][n][1]), pack2(acc[m][n][2], acc[m][n][3]));
                        }
                    } else {
#pragma unroll
                        for (int j = 0; j < 4; ++j)
#pragma unroll
                            for (int n = 0; n < 2; ++n) { const int c = n * 16 + fr; if (c < 24) GD[(size_t)(row0 + j) * 24 + c] = acc[m][n][j]; }
                    }
                }
            });
    }
}

__device__ __forceinline__ void ph_gemm_out(const Params& p, char* smem) {
    const bf16_t* A = (const bf16_t*)(p.ws + OFF_O);
    const bf16_t* Bt = (const bf16_t*)(p.ws + W_OUT);
    float* X = p.out;
    const int tn = 8, total = (NTOK / 128) * tn, tid = threadIdx.x;
    for (int it = blockIdx.x; it < total; it += gridDim.x) {
        const int mt = it / tn, nt = it % tn, brow = mt * 128, bcol = nt * 128;
        const bf16_t* a0 = A + (size_t)(brow + (tid >> 2)) * DM + (tid & 3) * 8;
        const bf16_t* a1 = a0 + (size_t)64 * DM;
        const bf16_t* b0 = Bt + (size_t)(bcol + (tid >> 2)) * DM + (tid & 3) * 8;
        const bf16_t* b1 = b0 + (size_t)64 * DM;
        gemm_tile(smem, a0, a1, b0, b1, DM / 32, [](int t) { return (size_t)t * 32; },
            [&](f32x4 (&acc)[4][4], int wr, int wc, int fr, int fq) {
#pragma unroll
                for (int m = 0; m < 4; ++m)
#pragma unroll
                    for (int j = 0; j < 4; ++j) {
                        float* xp = X + (size_t)(brow + wr * 64 + m * 16 + fq * 4 + j) * DM + bcol + wc * 64 + fr;
#pragma unroll
                        for (int n = 0; n < 4; ++n) xp[n * 16] += acc[m][n][j];
                    }
            });
    }
}

__device__ __forceinline__ void ph_route(const Params& p, char* smem, int L) {
    float* hs = (float*)smem;
    float* le = (float*)(smem + 32768);
    float* lg = (float*)(smem + 32768 + 2048);
    int* hist = (int*)(smem + 32768 + 2048 + 128);
    const float* gain = p.ln_ffn[L]; const float* Wg = p.r_group[L]; const float* We = p.r_expert[L];
    bf16_t* H = (bf16_t*)(p.ws + OFF_H);
    int* tok_e = (int*)(p.ws + M_TOKE); float* tok_g = (float*)(p.ws + M_TOKG); int* tok_r = (int*)(p.ws + M_TOKR);
    int* hist_g = (int*)(p.ws + M_HIST);
    const int tid = threadIdx.x, lane = tid & 63, wid = tid >> 6;
    for (int ch = blockIdx.x; ch < NTOK / 64; ch += gridDim.x) {
        if (tid < 64) hist[tid] = 0;
        __syncthreads();
        for (int sub = 0; sub < 8; ++sub) {
            const int tb = ch * 64 + sub * 8;
#pragma unroll
            for (int q = 0; q < 2; ++q) {
                const int tl = wid * 2 + q, t = tb + tl;
                float v[16];
#pragma unroll
                for (int i = 0; i < 4; ++i) { const float4 a = *(const float4*)(p.out + (size_t)t * DM + i * 256 + lane * 4); v[4 * i] = a.x; v[4 * i + 1] = a.y; v[4 * i + 2] = a.z; v[4 * i + 3] = a.w; }
                float ss = 0.f;
#pragma unroll
                for (int i = 0; i < 16; ++i) ss += v[i] * v[i];
                ss = red64_sum(ss);
                const float rstd = rsqrtf(ss * (1.0f / DM) + 1e-6f);
#pragma unroll
                for (int i = 0; i < 4; ++i) {
                    const float4 g = *(const float4*)(gain + i * 256 + lane * 4);
                    const float h0 = v[4 * i] * rstd * g.x, h1 = v[4 * i + 1] * rstd * g.y, h2 = v[4 * i + 2] * rstd * g.z, h3 = v[4 * i + 3] * rstd * g.w;
                    *(uint2*)(H + (size_t)t * DM + i * 256 + lane * 4) = make_uint2(pack2(h0, h1), pack2(h2, h3));
                    *(float4*)(hs + tl * 1024 + i * 256 + lane * 4) = make_float4(h0, h1, h2, h3);
                }
            }
            __syncthreads();
            {
                float a0 = 0.f, a1 = 0.f;
                const float* h0p = hs + (wid * 2) * 1024; const float* h1p = h0p + 1024;
                for (int k = 0; k < DM; k += 4) {
                    const float4 x0 = *(const float4*)(h0p + k), x1 = *(const float4*)(h1p + k);
                    const float w0 = We[(size_t)k * 64 + lane], w1 = We[(size_t)(k + 1) * 64 + lane], w2 = We[(size_t)(k + 2) * 64 + lane], w3 = We[(size_t)(k + 3) * 64 + lane];
                    a0 += x0.x * w0; a0 += x0.y * w1; a0 += x0.z * w2; a0 += x0.w * w3;
                    a1 += x1.x * w0; a1 += x1.y * w1; a1 += x1.z * w2; a1 += x1.w * w3;
                }
                le[(wid * 2) * 64 + lane] = a0; le[(wid * 2 + 1) * 64 + lane] = a1;
                const int tk = tid >> 5, gi = (tid >> 3) & 3, kp = tid & 7;
                float g = 0.f;
                const float* hp = hs + tk * 1024 + kp * 128;
                for (int k = 0; k < 128; ++k) g += hp[k] * Wg[(size_t)(kp * 128 + k) * 4 + gi];
                g += __shfl_xor(g, 1); g += __shfl_xor(g, 2); g += __shfl_xor(g, 4);
                if (kp == 0) lg[tk * 4 + gi] = g;
            }
            __syncthreads();
            if (tid < 8) {
                const int t = tb + tid;
                float gl[4]; float gm = -INFINITY; int gi = 0;
#pragma unroll
                for (int i = 0; i < 4; ++i) { gl[i] = lg[tid * 4 + i]; if (gl[i] > gm) { gm = gl[i]; gi = i; } }
                float gs = 0.f;
#pragma unroll
                for (int i = 0; i < 4; ++i) gs += __expf(gl[i] - gm);
                const float gprob = 1.0f / gs;
                float m0 = -INFINITY, m1 = -INFINITY; int i0 = 0, i1 = 0;
                for (int i = 0; i < 16; ++i) { const float v = le[tid * 64 + gi * 16 + i]; if (v > m0) { m1 = m0; i1 = i0; m0 = v; i0 = i; } else if (v > m1) { m1 = v; i1 = i; } }
                const float e1 = __expf(m1 - m0), den = 1.0f + e1;
                const int ex0 = gi * 16 + i0, ex1 = gi * 16 + i1;
                tok_e[t * 2] = ex0; tok_e[t * 2 + 1] = ex1;
                tok_g[t * 2] = gprob / den; tok_g[t * 2 + 1] = gprob * e1 / den;
                tok_r[t * 2] = atomicAdd(&hist[ex0], 1); tok_r[t * 2 + 1] = atomicAdd(&hist[ex1], 1);
            }
            __syncthreads();
        }
        if (tid < 64) hist_g[ch * 64 + tid] = hist[tid];
        __syncthreads();
    }
}

__device__ __forceinline__ void ph_dispatch(const Params& p, char* smem) {
    int* part_pre = (int*)smem;
    int* part_tot = part_pre + 256;
    int* pre = part_tot + 256;
    int* base = pre + 64;
    int* tot = base + 64;
    const int* hist_g = (const int*)(p.ws + M_HIST);
    const int* tok_e = (const int*)(p.ws + M_TOKE); const int* tok_r = (const int*)(p.ws + M_TOKR);
    int* list = (int*)(p.ws + M_LIST); int* e_cnt = (int*)(p.ws + M_ECNT); int* e_base = (int*)(p.ws + M_EBASE);
    const int tid = threadIdx.x, e = tid & 63, part = tid >> 6;
    for (int ch = blockIdx.x; ch < NTOK / 64; ch += gridDim.x) {
        int sp = 0, st = 0;
        for (int c = part * 128; c < part * 128 + 128; ++c) { const int v = hist_g[c * 64 + e]; st += v; if (c < ch) sp += v; }
        part_pre[part * 64 + e] = sp; part_tot[part * 64 + e] = st;
        __syncthreads();
        if (tid < 64) {
            pre[tid] = part_pre[tid] + part_pre[64 + tid] + part_pre[128 + tid] + part_pre[192 + tid];
            tot[tid] = part_tot[tid] + part_tot[64 + tid] + part_tot[128 + tid] + part_tot[192 + tid];
        }
        __syncthreads();
        if (tid == 0) { int acc = 0; for (int i = 0; i < 64; ++i) { base[i] = acc; acc += tot[i]; } }
        __syncthreads();
        if (tid < 128) {
            const int slot = (ch * 64) * 2 + tid;
            const int ex = tok_e[slot];
            list[base[ex] + pre[ex] + tok_r[slot]] = slot;
        }
        if (ch == 0 && tid < 64) { e_cnt[tid] = tot[tid]; e_base[tid] = base[tid]; }
        __syncthreads();
    }
}

__device__ __forceinline__ void ph_moe_gemm(const Params& p, char* smem, int which) {
    int* tpre = (int*)(smem + 32768);
    const int* e_cnt = (const int*)(p.ws + M_ECNT); const int* e_base = (const int*)(p.ws + M_EBASE);
    const int* list = (const int*)(p.ws + M_LIST); const float* tok_g = (const float*)(p.ws + M_TOKG);
    const bf16_t* H = (const bf16_t*)(p.ws + OFF_H);
    bf16_t* HID = (bf16_t*)(p.ws + HID_OFF);
    bf16_t* Y = (bf16_t*)(p.ws + B_Y);
    const int tid = threadIdx.x;
    if (tid == 0) { int acc = 0; for (int i = 0; i < 64; ++i) { tpre[i] = acc; acc += (e_cnt[i] + 127) >> 7; } tpre[64] = acc; }
    __syncthreads();
    const int total = tpre[64] * 8;
    for (int it = blockIdx.x; it < total; it += gridDim.x) {
        const int mtg = it >> 3, nt = it & 7;
        int e = 0;
        { int lo = 0, hi = 63; while (lo < hi) { const int mid = (lo + hi + 1) >> 1; if (tpre[mid] <= mtg) lo = mid; else hi = mid - 1; } e = lo; }
        const int mt = mtg - tpre[e], cnt = e_cnt[e], bas = e_base[e];
        const int r0 = mt * 128 + (tid >> 2), r1 = r0 + 64;
        if (which == 0) {
            const int t0 = (r0 < cnt) ? (list[bas + r0] >> 1) : 0, t1 = (r1 < cnt) ? (list[bas + r1] >> 1) : 0;
            const bf16_t* a0 = H + (size_t)t0 * DM + (tid & 3) * 8;
            const bf16_t* a1 = H + (size_t)t1 * DM + (tid & 3) * 8;
            const bf16_t* Bt = (const bf16_t*)(p.ws + W_GU) + (size_t)e * 1024 * 1024;
            const bf16_t* b0 = Bt + (size_t)(nt * 128 + (tid >> 2)) * DM + (tid & 3) * 8;
            const bf16_t* b1 = b0 + (size_t)64 * DM;
            gemm_tile(smem, a0, a1, b0, b1, DM / 32, [](int t) { return (size_t)t * 32; },
                [&](f32x4 (&acc)[4][4], int wr, int wc, int fr, int fq) {
#pragma unroll
                    for (int m = 0; m < 4; ++m)
#pragma unroll
                        for (int j = 0; j < 4; ++j) {
                            const int r = mt * 128 + wr * 64 + m * 16 + fq * 4 + j;
                            if (r < cnt) {
#pragma unroll
                                for (int n = 0; n < 2; ++n) {
                                    const float g = acc[m][n][j], u = acc[m][n + 2][j];
                                    const float s = g / (1.0f + __expf(-g));
                                    HID[(size_t)(bas + r) * EH + nt * 64 + wc * 32 + n * 16 + fr] = f2bf(s * u);
                                }
                            }
                        }
                });
        } else {
            const int q0 = (r0 < cnt) ? (bas + r0) : 0, q1 = (r1 < cnt) ? (bas + r1) : 0;
            const bf16_t* a0 = HID + (size_t)q0 * EH + (tid & 3) * 8;
            const bf16_t* a1 = HID + (size_t)q1 * EH + (tid & 3) * 8;
            const bf16_t* Bt = (const bf16_t*)(p.ws + W_DN) + (size_t)e * 1024 * 512;
            const bf16_t* b0 = Bt + (size_t)(nt * 128 + (tid >> 2)) * EH + (tid & 3) * 8;
            const bf16_t* b1 = b0 + (size_t)64 * EH;
            gemm_tile(smem, a0, a1, b0, b1, EH / 32, [](int t) { return (size_t)t * 32; },
                [&](f32x4 (&acc)[4][4], int wr, int wc, int fr, int fq) {
#pragma unroll
                    for (int m = 0; m < 4; ++m)
#pragma unroll
                        for (int j = 0; j < 4; ++j) {
                            const int r = mt * 128 + wr * 64 + m * 16 + fq * 4 + j;
                            if (r < cnt) {
                                const int slot = list[bas + r];
                                const float g = tok_g[slot];
#pragma unroll
                                for (int n = 0; n < 4; ++n) Y[(size_t)slot * DM + nt * 128 + wc * 64 + n * 16 + fr] = f2bf(acc[m][n][j] * g);
                            }
                        }
                });
        }
    }
}

#define PST 40
struct AttnState { float m[4], l[4]; f32x4 o[4]; };
__device__ __forceinline__ void attn_init(AttnState& st) {
#pragma unroll
    for (int j = 0; j < 4; ++j) { st.m[j] = NEG_BIG; st.l[j] = 0.f; }
#pragma unroll
    for (int n = 0; n < 4; ++n) st.o[n] = (f32x4){0.f, 0.f, 0.f, 0.f};
}
__device__ __forceinline__ void attn_scores(const bf16x8 (&qf)[2], const bf16_t* kp, int ldk, int fr, int fq, f32x4& s0, f32x4& s1) {
    s0 = (f32x4){0.f, 0.f, 0.f, 0.f}; s1 = s0;
#pragma unroll
    for (int ks = 0; ks < 2; ++ks) {
        const bf16x8 k0 = ld8(kp + (size_t)fr * ldk + ks * 32 + fq * 8);
        const bf16x8 k1 = ld8(kp + (size_t)(16 + fr) * ldk + ks * 32 + fq * 8);
        s0 = mfma16(qf[ks], k0, s0); s1 = mfma16(qf[ks], k1, s1);
    }
}
__device__ __forceinline__ void attn_pv(const float (&p0)[4], const float (&p1)[4], const bf16_t* vt, int ldv, bf16_t* pbuf, int fr, int fq, f32x4 (&o)[4]) {
#pragma unroll
    for (int j = 0; j < 4; ++j) { pbuf[(4 * fq + j) * PST + fr] = f2bf(p0[j]); pbuf[(4 * fq + j) * PST + 16 + fr] = f2bf(p1[j]); }
    lds_fence();
    const bf16x8 pf = *(const bf16x8*)(pbuf + fr * PST + fq * 8);
#pragma unroll
    for (int n = 0; n < 4; ++n) { const bf16x8 vf = ld8(vt + (size_t)(n * 16 + fr) * ldv + fq * 8); o[n] = mfma16(pf, vf, o[n]); }
    lds_fence();
}
template <class MaskFn>
__device__ __forceinline__ void attn_step(const bf16x8 (&qf)[2], const bf16_t* kp, int ldk, const bf16_t* vt, int ldv, MaskFn mask, AttnState& st, bf16_t* pbuf, int fr, int fq) {
    f32x4 s0, s1; attn_scores(qf, kp, ldk, fr, fq, s0, s1);
    float p0[4], p1[4];
#pragma unroll
    for (int j = 0; j < 4; ++j) {
        const bool v0 = mask(4 * fq + j, fr), v1 = mask(4 * fq + j, 16 + fr);
        const float a = v0 ? s0[j] : -INFINITY, b = v1 ? s1[j] : -INFINITY;
        const float mx = red16_max(fmaxf(a, b));
        const float mn = fmaxf(st.m[j], mx);
        const float alpha = __expf(st.m[j] - mn);
        p0[j] = v0 ? __expf(a - mn) : 0.f; p1[j] = v1 ? __expf(b - mn) : 0.f;
        st.l[j] = st.l[j] * alpha + p0[j] + p1[j]; st.m[j] = mn;
#pragma unroll
        for (int n = 0; n < 4; ++n) st.o[n][j] *= alpha;
    }
    attn_pv(p0, p1, vt, ldv, pbuf, fr, fq, st.o);
}

__device__ __forceinline__ void ph_attn0(const Params& p, char* smem) {
    const bf16_t* Q = (const bf16_t*)(p.ws + OFF_QKV);
    const bf16_t* VT = (const bf16_t*)(p.ws + OFF_VT);
    bf16_t* O = (bf16_t*)(p.ws + OFF_O);
    const int tid = threadIdx.x, lane = tid & 63, wid = tid >> 6, fr = lane & 15, fq = lane >> 4;
    bf16_t* pbuf = (bf16_t*)(smem + wid * (16 * PST * 2));
    const int nA = 2 * 8 * (SEQ / 16);
    const int nwv = gridDim.x * 4;
    for (int wi = blockIdx.x * 4 + wid; wi < 2 * nA; wi += nwv) {
        const bool isB = wi >= nA;
        const int w = isB ? wi - nA : wi;
        const int tt = w % (SEQ / 16), head = (w / (SEQ / 16)) & 7, b = w / (8 * (SEQ / 16));
        const int t0 = tt * 16;
        const size_t rowb = (size_t)b * SEQ;
        if (!isB) {
            const int hkv = head >> 2;
            bf16x8 qf[2];
            qf[0] = ld8(Q + (rowb + t0 + fr) * LDQ + head * 64 + fq * 8);
            qf[1] = ld8(Q + (rowb + t0 + fr) * LDQ + head * 64 + 32 + fq * 8);
            AttnState st; attn_init(st);
            const float sink = p.sinks0[head];
#pragma unroll
            for (int j = 0; j < 4; ++j) { st.m[j] = sink; st.l[j] = (fr == 0) ? 1.f : 0.f; }
            int k0 = t0 - 127; if (k0 < 0) k0 = 0; k0 &= ~31;
            for (int kb = k0; kb <= t0 + 15; kb += 32) {
                const bf16_t* kp = Q + (rowb + kb) * LDQ + 512 + hkv * 64;
                const bf16_t* vt = VT + ((size_t)(b * NVH + hkv) * 64) * SEQ + kb;
                attn_step(qf, kp, LDQ, vt, SEQ, [&](int r, int kk) { const int t = t0 + r, k = kb + kk; return (k <= t) && (t - k < 128); }, st, pbuf, fr, fq);
            }
#pragma unroll
            for (int j = 0; j < 4; ++j) {
                const float l = red16_sum(st.l[j]), inv = 1.0f / l;
#pragma unroll
                for (int n = 0; n < 4; ++n) O[(rowb + t0 + 4 * fq + j) * DM + head * 64 + n * 16 + fr] = f2bf(st.o[n][j] * inv);
            }
        } else {
            bf16x8 qf[2];
            qf[0] = ld8(Q + (rowb + t0 + fr) * LDQ + 768 + head * 64 + fq * 8);
            qf[1] = ld8(Q + (rowb + t0 + fr) * LDQ + 768 + head * 64 + 32 + fq * 8);
            f32x4 o[4];
#pragma unroll
            for (int n = 0; n < 4; ++n) o[n] = (f32x4){0.f, 0.f, 0.f, 0.f};
            float R[4] = {0.f, 0.f, 0.f, 0.f};
            for (int kb = (t0 >> 5) << 5; kb >= 0; kb -= 32) {
                const bf16_t* kp = Q + (rowb + kb) * LDQ + 1280 + head * 64;
                const bf16_t* vt = VT + ((size_t)(b * NVH + 2 + head) * 64) * SEQ + kb;
                f32x4 s0, s1; attn_scores(qf, kp, LDQ, fr, fq, s0, s1);
                float p0[4], p1[4];
#pragma unroll
                for (int j = 0; j < 4; ++j) {
                    const int t = t0 + 4 * fq + j;
                    const bool v0 = (kb + fr) < t, v1 = (kb + 16 + fr) < t;
                    const float z0 = s0[j], z1 = s1[j];
                    const float sp0 = fmaxf(z0, 0.f) + __logf(1.0f + __expf(-fabsf(z0)));
                    const float sp1 = fmaxf(z1, 0.f) + __logf(1.0f + __expf(-fabsf(z1)));
                    const float ls0 = v0 ? -sp0 : 0.f, ls1 = v1 ? -sp1 : 0.f;
                    float i0 = ls0, i1 = ls1;
#pragma unroll
                    for (int d = 1; d < 16; d <<= 1) {
                        const float u0 = __shfl_down(i0, d, 16), u1 = __shfl_down(i1, d, 16);
                        if (fr + d < 16) { i0 += u0; i1 += u1; }
                    }
                    const float tot0 = __shfl(i0, lane & 48), tot1 = __shfl(i1, lane & 48);
                    const float lb1 = R[j] + (i1 - ls1);
                    const float lb0 = R[j] + tot1 + (i0 - ls0);
                    p0[j] = v0 ? __expf(z0 - sp0 + lb0) : 0.f;
                    p1[j] = v1 ? __expf(z1 - sp1 + lb1) : 0.f;
                    R[j] += tot0 + tot1;
                }
                attn_pv(p0, p1, vt, SEQ, pbuf, fr, fq, o);
                const bool done = (R[0] < -104.f) && (R[1] < -104.f) && (R[2] < -104.f) && (R[3] < -104.f);
                if (__all(done)) break;
            }
#pragma unroll
            for (int j = 0; j < 4; ++j)
#pragma unroll
                for (int n = 0; n < 4; ++n) O[(rowb + t0 + 4 * fq + j) * DM + 512 + head * 64 + n * 16 + fr] = f2bf(o[n][j]);
        }
    }
}

__device__ __forceinline__ void ph_kmean(const Params& p) {
    const bf16_t* Q = (const bf16_t*)(p.ws + OFF_QKV);
    float* KM = (float*)(p.ws + B_KMEAN);
    const int lane = threadIdx.x & 63, wid = threadIdx.x >> 6;
    for (int wi = blockIdx.x * 4 + wid; wi < 256; wi += gridDim.x * 4) {
        const int hkv = wi & 1, j = (wi >> 1) & 63, b = wi >> 7;
        float acc = 0.f;
        for (int k = 0; k < 256; ++k) acc += bf2f(Q[((size_t)b * SEQ + j * 256 + k) * LDQ + 512 + hkv * 64 + lane]);
        KM[((b * 64 + j) * 2 + hkv) * 64 + lane] = acc * (1.0f / 256.0f);
    }
}

__device__ __forceinline__ size_t moba_list_off(int L, int j) { return (size_t)L * MOBA_LCAP + 1024ull * (size_t)(63 * j - (j * (j - 1)) / 2); }

__device__ __forceinline__ void ph_moba_gate(const Params& p, char* smem) {
    float* km = (float*)smem;
    int* cnt = (int*)(smem + 16384);
    int* gbase = cnt + 64;
    const bf16_t* Q = (const bf16_t*)(p.ws + OFF_QKV);
    const float* KM = (const float*)(p.ws + B_KMEAN);
    int* gcnt = (int*)(p.ws + OFF_MOBACNT);
    int* lists = (int*)(p.ws + B_LIST);
    const int tid = threadIdx.x;
    for (int it = blockIdx.x; it < 1024; it += gridDim.x) {
        const int tc = it & 255, hkv = (it >> 8) & 1, b = it >> 9, LL = b * 2 + hkv;
        const int tl = tc * 64 + (tid >> 2), g = tid & 3, own = tl >> 8;
        for (int i = tid; i < 64 * 64; i += 256) { const int j = i >> 6, d = i & 63; km[i] = KM[((b * 64 + j) * 2 + hkv) * 64 + d]; }
        if (tid < 64) cnt[tid] = 0;
        __syncthreads();
        float q[64];
        {
            const bf16_t* qp = Q + ((size_t)b * SEQ + tl) * LDQ + (hkv * 4 + g) * 64;
#pragma unroll
            for (int i = 0; i < 8; ++i) { const bf16x8 v = ld8(qp + i * 8);
#pragma unroll
                for (int e = 0; e < 8; ++e) q[i * 8 + e] = bf2f((bf16_t)v[e]); }
        }
        float bv0 = -INFINITY, bv1 = -INFINITY, bv2 = -INFINITY; int bi0 = 0, bi1 = 1, bi2 = 2;
        for (int j = 0; j < own; ++j) {
            float s = 0.f;
#pragma unroll
            for (int d = 0; d < 64; d += 4) { const float4 k = *(const float4*)(km + j * 64 + d); s += q[d] * k.x; s += q[d + 1] * k.y; s += q[d + 2] * k.z; s += q[d + 3] * k.w; }
            if (s > bv0) { bv2 = bv1; bi2 = bi1; bv1 = bv0; bi1 = bi0; bv0 = s; bi0 = j; }
            else if (s > bv1) { bv2 = bv1; bi2 = bi1; bv1 = s; bi1 = j; }
            else if (s > bv2) { bv2 = s; bi2 = j; }
        }
        const int nv = own < 3 ? own : 3;
        int rk0 = 0, rk1 = 0, rk2 = 0;
        if (nv > 0) rk0 = atomicAdd(&cnt[bi0], 1);
        if (nv > 1) rk1 = atomicAdd(&cnt[bi1], 1);
        if (nv > 2) rk2 = atomicAdd(&cnt[bi2], 1);
        __syncthreads();
        if (tid < 64 && cnt[tid] > 0) gbase[tid] = atomicAdd(&gcnt[LL * 64 + tid], cnt[tid]);
        __syncthreads();
        const int ent = tl | (g << 14);
        if (nv > 0) lists[moba_list_off(LL, bi0) + gbase[bi0] + rk0] = ent | (0 << 16);
        if (nv > 1) lists[moba_list_off(LL, bi1) + gbase[bi1] + rk1] = ent | (1 << 16);
        if (nv > 2) lists[moba_list_off(LL, bi2) + gbase[bi2] + rk2] = ent | (2 << 16);
        __syncthreads();
    }
}

__device__ __forceinline__ void ph_moba_part(const Params& p, char* smem) {
    int* cpre = (int*)(smem + 8192);
    const bf16_t* Q = (const bf16_t*)(p.ws + OFF_QKV);
    const bf16_t* VT = (const bf16_t*)(p.ws + OFF_VT);
    const int* gcnt = (const int*)(p.ws + OFF_MOBACNT);
    const int* lists = (const int*)(p.ws + B_LIST);
    bf16_t* PO = (bf16_t*)(p.ws + B_PO); float* PML = (float*)(p.ws + B_PML);
    const int tid = threadIdx.x, lane = tid & 63, wid = tid >> 6, fr = lane & 15, fq = lane >> 4;
    bf16_t* pbuf = (bf16_t*)(smem + wid * (16 * PST * 2));
    cpre[tid + 1] = (gcnt[tid] + 63) >> 6;
    if (tid == 0) cpre[0] = 0;
    __syncthreads();
    if (tid == 0) { int acc = 0; for (int i = 1; i <= 256; ++i) { acc += cpre[i]; cpre[i] = acc; } }
    __syncthreads();
    const int total = cpre[256];
    for (int it = blockIdx.x; it < total; it += gridDim.x) {
        int li;
        { int lo = 0, hi = 255; while (lo < hi) { const int mid = (lo + hi + 1) >> 1; if (cpre[mid] <= it) lo = mid; else hi = mid - 1; } li = lo; }
        const int chunk = it - cpre[li], LL = li >> 6, j = li & 63, b = LL >> 1, hkv = LL & 1, n = gcnt[li];
        const int* lst = lists + moba_list_off(LL, j);
        const int rbase = chunk * 64 + wid * 16;
        if (rbase >= n) continue;
        int ra = rbase + fr; if (ra >= n) ra = n - 1;
        const int ea = lst[ra];
        const bf16_t* qp = Q + ((size_t)b * SEQ + (ea & 16383)) * LDQ + (hkv * 4 + ((ea >> 14) & 3)) * 64;
        bf16x8 qf[2]; qf[0] = ld8(qp + fq * 8); qf[1] = ld8(qp + 32 + fq * 8);
        AttnState st; attn_init(st);
        for (int s = 0; s < 8; ++s) {
            const int kb = j * 256 + s * 32;
            const bf16_t* kp = Q + ((size_t)b * SEQ + kb) * LDQ + 512 + hkv * 64;
            const bf16_t* vt = VT + ((size_t)(b * NVH + hkv) * 64) * SEQ + kb;
            attn_step(qf, kp, LDQ, vt, SEQ, [](int, int) { return true; }, st, pbuf, fr, fq);
        }
#pragma unroll
        for (int jj = 0; jj < 4; ++jj) {
            const int r = rbase + 4 * fq + jj;
            const float l = red16_sum(st.l[jj]);
            if (r < n) {
                const int e = lst[r];
                const size_t idx = ((size_t)((size_t)b * SEQ + (e & 16383)) * 8 + hkv * 4 + ((e >> 14) & 3)) * 3 + ((e >> 16) & 3);
#pragma unroll
                for (int nn = 0; nn < 4; ++nn) PO[idx * 64 + nn * 16 + fr] = f2bf(st.o[nn][jj]);
                if (fr == 0) { PML[idx * 2] = st.m[jj]; PML[idx * 2 + 1] = l; }
            }
        }
    }
}

__device__ __forceinline__ void ph_moba_own(const Params& p, char* smem) {
    const bf16_t* Q = (const bf16_t*)(p.ws + OFF_QKV);
    const bf16_t* VT = (const bf16_t*)(p.ws + OFF_VT);
    const bf16_t* PO = (const bf16_t*)(p.ws + B_PO); const float* PML = (const float*)(p.ws + B_PML);
    bf16_t* O = (bf16_t*)(p.ws + OFF_O);
    const int tid = threadIdx.x, lane = tid & 63, wid = tid >> 6, fr = lane & 15, fq = lane >> 4;
    bf16_t* pbuf = (bf16_t*)(smem + wid * (16 * PST * 2));
    const int nI = 2 * 8 * (SEQ / 16);
    for (int wi = blockIdx.x * 4 + wid; wi < nI; wi += gridDim.x * 4) {
        const int tt = wi % (SEQ / 16), head = (wi / (SEQ / 16)) & 7, b = wi / (8 * (SEQ / 16));
        const int t0 = tt * 16, hkv = head >> 2, own = t0 >> 8;
        const size_t rowb = (size_t)b * SEQ;
        bf16x8 qf[2];
        qf[0] = ld8(Q + (rowb + t0 + fr) * LDQ + head * 64 + fq * 8);
        qf[1] = ld8(Q + (rowb + t0 + fr) * LDQ + head * 64 + 32 + fq * 8);
        AttnState st; attn_init(st);
        for (int kb = own * 256; kb <= t0 + 15; kb += 32) {
            const bf16_t* kp = Q + (rowb + kb) * LDQ + 512 + hkv * 64;
            const bf16_t* vt = VT + ((size_t)(b * NVH + hkv) * 64) * SEQ + kb;
            attn_step(qf, kp, LDQ, vt, SEQ, [&](int r, int kk) { return (kb + kk) <= (t0 + r); }, st, pbuf, fr, fq);
        }
        const int nv = own < 3 ? own : 3;
#pragma unroll
        for (int j = 0; j < 4; ++j) {
            const int t = t0 + 4 * fq + j;
            float l = red16_sum(st.l[j]), m = st.m[j];
            float o0 = st.o[0][j], o1 = st.o[1][j], o2 = st.o[2][j], o3 = st.o[3][j];
            for (int r = 0; r < nv; ++r) {
                const size_t idx = ((size_t)(rowb + t) * 8 + head) * 3 + r;
                const float mr = PML[idx * 2], lr = PML[idx * 2 + 1];
                const float mn = fmaxf(m, mr), a = __expf(m - mn), c = __expf(mr - mn);
                o0 = o0 * a + c * bf2f(PO[idx * 64 + fr]); o1 = o1 * a + c * bf2f(PO[idx * 64 + 16 + fr]);
                o2 = o2 * a + c * bf2f(PO[idx * 64 + 32 + fr]); o3 = o3 * a + c * bf2f(PO[idx * 64 + 48 + fr]);
                l = l * a + c * lr; m = mn;
            }
            const float inv = 1.0f / l;
            bf16_t* op = O + (rowb + t) * DM + head * 64 + fr;
            op[0] = f2bf(o0 * inv); op[16] = f2bf(o1 * inv); op[32] = f2bf(o2 * inv); op[48] = f2bf(o3 * inv);
        }
    }
}

__device__ __forceinline__ float gelu_tanh(float x) {
    const float u = 0.7978845608028654f * (x + 0.044715f * x * x * x);
    const float e = __expf(2.0f * u);
    const float th = 1.0f - 2.0f / (e + 1.0f);
    return 0.5f * x * (1.0f + th);
}
__device__ __forceinline__ void ph_cmp1(const Params& p, char* smem) {
    const bf16_t* Q = (const bf16_t*)(p.ws + OFF_QKV);
    const int tid = threadIdx.x;
    for (int it = blockIdx.x; it < 128; it += gridDim.x) {
        const int kv = it >> 6, mt = (it >> 1) & 31, nt = it & 1;
        const int col = kv ? 1408 : 1280;
        const bf16_t* Bt = (const bf16_t*)(p.ws + (kv ? W_V1 : W_K1));
        const float* bias = (const float*)(p.ws + (kv ? W_BV : W_BK));
        bf16_t* HID = (bf16_t*)(p.ws + (kv ? B_HIDV : B_HIDK));
        auto rowptr = [&](int r) {
            const int h = r & 1, bc = r >> 1, c = bc & 1023, b = bc >> 10;
            const int cc = (c < NCMP) ? c : 0;
            return Q + ((size_t)b * SEQ + 16 * cc) * LDQ + col + h * 64 + (tid & 3) * 8;
        };
        const bf16_t* a0 = rowptr(mt * 128 + (tid >> 2));
        const bf16_t* a1 = rowptr(mt * 128 + 64 + (tid >> 2));
        const bf16_t* b0 = Bt + (size_t)(nt * 128 + (tid >> 2)) * 2048 + (tid & 3) * 8;
        const bf16_t* b1 = b0 + (size_t)64 * 2048;
        gemm_tile(smem, a0, a1, b0, b1, 64, [](int t) { return (size_t)(t >> 1) * LDQ + (t & 1) * 32; },
            [&](f32x4 (&acc)[4][4], int wr, int wc, int fr, int fq) {
#pragma unroll
                for (int m = 0; m < 4; ++m)
#pragma unroll
                    for (int j = 0; j < 4; ++j) {
                        const int r = mt * 128 + wr * 64 + m * 16 + fq * 4 + j;
#pragma unroll
                        for (int n = 0; n < 4; ++n) { const int cn = nt * 128 + wc * 64 + n * 16 + fr; HID[(size_t)r * 256 + cn] = f2bf(gelu_tanh(acc[m][n][j] + bias[cn])); }
                    }
            });
    }
}
__device__ __forceinline__ void ph_cmp2(const Params& p, char* smem) {
    const int tid = threadIdx.x;
    for (int it = blockIdx.x; it < 64; it += gridDim.x) {
        const int kv = it >> 5, mt = it & 31;
        const bf16_t* A = (const bf16_t*)(p.ws + (kv ? B_HIDV : B_HIDK));
        const bf16_t* Bt = (const bf16_t*)(p.ws + (kv ? W_V2 : W_K2));
        bf16_t* KC = (bf16_t*)(p.ws + B_KCMP); bf16_t* VC = (bf16_t*)(p.ws + B_VCMPT);
        const bf16_t* a0 = A + (size_t)(mt * 128 + (tid >> 2)) * 256 + (tid & 3) * 8;
        const bf16_t* a1 = a0 + (size_t)64 * 256;
        const bf16_t* b0 = Bt + (size_t)(tid >> 2) * 256 + (tid & 3) * 8;
        const bf16_t* b1 = b0 + (size_t)64 * 256;
        gemm_tile(smem, a0, a1, b0, b1, 8, [](int t) { return (size_t)t * 32; },
            [&](f32x4 (&acc)[4][4], int wr, int wc, int fr, int fq) {
                if (wc != 0) return;
#pragma unroll
                for (int m = 0; m < 4; ++m)
#pragma unroll
                    for (int j = 0; j < 4; ++j) {
                        const int r = mt * 128 + wr * 64 + m * 16 + fq * 4 + j;
                        const int h = r & 1, bc = r >> 1, c = bc & 1023, b = bc >> 10;
                        const bool ok = c < NCMP;
#pragma unroll
                        for (int n = 0; n < 4; ++n) {
                            const int d = n * 16 + fr;
                            const bf16_t v = ok ? f2bf(acc[m][n][j]) : (bf16_t)0;
                            if (kv == 0) KC[((size_t)(b * 2 + h) * 1024 + c) * 64 + d] = v;
                            else VC[((size_t)(b * 2 + h) * 64 + d) * 1024 + c] = v;
                        }
                    }
            });
    }
}

__device__ __forceinline__ void ph_nsa(const Params& p, char* smem) {
    const bf16_t* Q = (const bf16_t*)(p.ws + OFF_QKV);
    const bf16_t* VT = (const bf16_t*)(p.ws + OFF_VT);
    const bf16_t* KC = (const bf16_t*)(p.ws + B_KCMP); const bf16_t* VC = (const bf16_t*)(p.ws + B_VCMPT);
    const float* GD = (const float*)(p.ws + B_GD);
    bf16_t* O = (bf16_t*)(p.ws + OFF_O);
    const int tid = threadIdx.x, lane = tid & 63, wid = tid >> 6, fr = lane & 15, fq = lane >> 4;
    bf16_t* pbuf = (bf16_t*)(smem + wid * 6144);
    float* imp = (float*)(smem + wid * 6144 + 1280);
    int* sel = (int*)(smem + wid * 6144 + 1280 + 4096);
    const int nI = 2 * 2 * (SEQ / 4);
    for (int wi = blockIdx.x * 4 + wid; wi < nI; wi += gridDim.x * 4) {
        const int tq = wi % (SEQ / 4), hkv = (wi / (SEQ / 4)) & 1, b = wi / (2 * (SEQ / 4));
        const int t0 = tq * 4;
        const size_t rowb = (size_t)b * SEQ;
        bf16x8 qf[2];
        {
            const bf16_t* qp = Q + (rowb + t0 + (fr >> 2)) * LDQ + 768 + (hkv * 4 + (fr & 3)) * 64;
            qf[0] = ld8(qp + fq * 8); qf[1] = ld8(qp + 32 + fq * 8);
        }
        float gc[4], gs[4], gw[4];
#pragma unroll
        for (int j = 0; j < 4; ++j) {
            const float* gp = GD + (rowb + t0 + fq) * 24 + (hkv * 4 + j) * 3;
            gc[j] = 1.0f / (1.0f + __expf(-gp[0])); gs[j] = 1.0f / (1.0f + __expf(-gp[1])); gw[j] = 1.0f / (1.0f + __expf(-gp[2]));
        }
        f32x4 outa[4];
#pragma unroll
        for (int n = 0; n < 4; ++n) outa[n] = (f32x4){0.f, 0.f, 0.f, 0.f};
        const int LL = b * 2 + hkv;
        const bf16_t* kc = KC + (size_t)LL * 1024 * 64;
        const bf16_t* vc = VC + (size_t)LL * 64 * 1024;
        const int cN = (t0 + 3 >= 31) ? ((t0 + 3 - 31) >> 4) + 1 : 0;
        const int csteps = (cN + 31) >> 5;
        float m1[4], l1[4];
#pragma unroll
        for (int j = 0; j < 4; ++j) { m1[j] = NEG_BIG; l1[j] = 0.f; }
        for (int s = 0; s < csteps; ++s) {
            f32x4 s0, s1; attn_scores(qf, kc + (size_t)s * 32 * 64, 64, fr, fq, s0, s1);
#pragma unroll
            for (int j = 0; j < 4; ++j) {
                const int t = t0 + fq;
                const bool v0 = (16 * (s * 32 + fr) + 31) <= t, v1 = (16 * (s * 32 + 16 + fr) + 31) <= t;
                const float a = v0 ? s0[j] : -INFINITY, c = v1 ? s1[j] : -INFINITY;
                const float mx = red16_max(fmaxf(a, c)), mn = fmaxf(m1[j], mx);
                l1[j] = l1[j] * __expf(m1[j] - mn) + (v0 ? __expf(a - mn) : 0.f) + (v1 ? __expf(c - mn) : 0.f);
                m1[j] = mn;
            }
        }
        float il[4];
#pragma unroll
        for (int j = 0; j < 4; ++j) { const float l = red16_sum(l1[j]); il[j] = l > 0.f ? 1.0f / l : 0.f; }
        for (int i = lane; i < 1024; i += 64) imp[i] = 0.f;
        lds_fence();
        {
            f32x4 oc[4];
#pragma unroll
            for (int n = 0; n < 4; ++n) oc[n] = (f32x4){0.f, 0.f, 0.f, 0.f};
            for (int s = 0; s < csteps; ++s) {
                f32x4 s0, s1; attn_scores(qf, kc + (size_t)s * 32 * 64, 64, fr, fq, s0, s1);
                float p0[4], p1[4]; float ps0 = 0.f, ps1 = 0.f;
#pragma unroll
                for (int j = 0; j < 4; ++j) {
                    const int t = t0 + fq;
                    const bool v0 = (16 * (s * 32 + fr) + 31) <= t, v1 = (16 * (s * 32 + 16 + fr) + 31) <= t;
                    p0[j] = v0 ? __expf(s0[j] - m1[j]) * il[j] : 0.f; p1[j] = v1 ? __expf(s1[j] - m1[j]) * il[j] : 0.f;
                    ps0 += p0[j]; ps1 += p1[j];
                }
                {
                    float g0 = ps0 + __shfl_xor(ps0, 1); g0 += __shfl_xor(g0, 2);
                    float g1 = ps1 + __shfl_xor(ps1, 1); g1 += __shfl_xor(g1, 2);
                    const int a0 = (s * 32 + fr) >> 2, a1 = (s * 32 + 16 + fr) >> 2;
                    if ((fr & 3) == 0) { imp[fq * 256 + a0] += g0; }
                    lds_fence();
                    if ((fr & 3) == 3) { imp[fq * 256 + a0 + 1] += ps0; }
                    lds_fence();
                    if ((fr & 3) == 0) { imp[fq * 256 + a1] += g1; }
                    lds_fence();
                    if ((fr & 3) == 3 && a1 + 1 < 256) { imp[fq * 256 + a1 + 1] += ps1; }
                    lds_fence();
                }
                attn_pv(p0, p1, vc + (size_t)s * 32, 1024, pbuf, fr, fq, oc);
            }
#pragma unroll
            for (int n = 0; n < 4; ++n)
#pragma unroll
                for (int j = 0; j < 4; ++j) outa[n][j] += gc[j] * oc[n][j];
        }
        for (int qi = 0; qi < 4; ++qi) {
            const int t = t0 + qi, cur = t >> 6;
            float v[4];
#pragma unroll
            for (int i = 0; i < 4; ++i) {
                const int jb = lane + 64 * i;
                float x = imp[qi * 256 + jb];
                if (jb > cur) x = -INFINITY;
                else if (jb == 0 || jb == cur || jb == cur - 1) x = INFINITY;
                v[i] = x;
            }
            for (int r = 0; r < 16; ++r) {
                float bv = v[0]; int bi = lane;
#pragma unroll
                for (int i = 1; i < 4; ++i) if (v[i] > bv) { bv = v[i]; bi = lane + 64 * i; }
#pragma unroll
                for (int off = 32; off >= 1; off >>= 1) {
                    const float ov = __shfl_xor(bv, off); const int oi = __shfl_xor(bi, off);
                    if (ov > bv || (ov == bv && oi < bi)) { bv = ov; bi = oi; }
                }
                if (lane == 0) sel[qi * 16 + r] = (bv > -INFINITY) ? bi : -1;
#pragma unroll
                for (int i = 0; i < 4; ++i) if (bi == lane + 64 * i) v[i] = -INFINITY;
            }
        }
        lds_fence();
        {
            AttnState st; attn_init(st);
            for (int qi = 0; qi < 4; ++qi) {
                const int t = t0 + qi;
                for (int r = 0; r < 16; ++r) {
                    const int blk = sel[qi * 16 + r];
                    if (blk < 0) continue;
#pragma unroll
                    for (int hf = 0; hf < 2; ++hf) {
                        const int kb = blk * 64 + hf * 32;
                        if (kb > t) continue;
                        const bf16_t* kp = Q + (rowb + kb) * LDQ + 1536 + hkv * 64;
                        const bf16_t* vt = VT + ((size_t)(b * NVH + 2 + hkv) * 64) * SEQ + kb;
                        attn_step(qf, kp, LDQ, vt, SEQ, [&](int rr, int kk) { return ((rr >> 2) == qi) && ((kb + kk) <= t); }, st, pbuf, fr, fq);
                    }
                }
            }
#pragma unroll
            for (int j = 0; j < 4; ++j) {
                const float l = red16_sum(st.l[j]), inv = l > 0.f ? gs[j] / l : 0.f;
#pragma unroll
                for (int n = 0; n < 4; ++n) outa[n][j] += st.o[n][j] * inv;
            }
        }
        {
            AttnState st; attn_init(st);
            int k0 = t0 - 511; if (k0 < 0) k0 = 0; k0 &= ~31;
            for (int kb = k0; kb <= t0 + 3; kb += 32) {
                const bf16_t* kp = Q + (rowb + kb) * LDQ + 1792 + hkv * 64;
                const bf16_t* vt = VT + ((size_t)(b * NVH + 4 + hkv) * 64) * SEQ + kb;
                attn_step(qf, kp, LDQ, vt, SEQ, [&](int rr, int kk) { const int t = t0 + (rr >> 2), k = kb + kk; return (k <= t) && (t - k < 512); }, st, pbuf, fr, fq);
            }
#pragma unroll
            for (int j = 0; j < 4; ++j) {
                const float l = red16_sum(st.l[j]), inv = l > 0.f ? gw[j] / l : 0.f;
#pragma unroll
                for (int n = 0; n < 4; ++n) outa[n][j] += st.o[n][j] * inv;
            }
        }
#pragma unroll
        for (int j = 0; j < 4; ++j)
#pragma unroll
            for (int n = 0; n < 4; ++n) O[(rowb + t0 + fq) * DM + 512 + (hkv * 4 + j) * 64 + n * 16 + fr] = f2bf(outa[n][j]);
    }
}

template <int PH> __device__ __forceinline__ void run_phase(const Params& p, char* smem) {
    char* ws = p.ws;
    if (PH == 0) {
        conv_layer_weights(p, smem, 0);
        rope_table(p);
        norm_pass(p.x, nullptr, p.out, p.ln_mix[0], (bf16_t*)(ws + OFF_H), nullptr);
    } else if (PH == 1) ph_gemm_qkv(p, smem, 0);
    else if (PH == 2) ph_attn0(p, smem);
    else if (PH == 3) ph_gemm_out(p, smem);
    else if (PH == 4) ph_route(p, smem, 0);
    else if (PH == 5) ph_dispatch(p, smem);
    else if (PH == 6) ph_moe_gemm(p, smem, 0);
    else if (PH == 7) ph_moe_gemm(p, smem, 1);
    else if (PH == 8) {
        norm_pass(p.out, (const bf16_t*)(ws + B_Y), p.out, p.ln_mix[1], (bf16_t*)(ws + OFF_H), nullptr);
        conv_layer_weights(p, smem, 1);
    } else if (PH == 9) ph_gemm_qkv(p, smem, 1);
    else if (PH == 10) { ph_kmean(p); ph_cmp1(p, smem); }
    else if (PH == 11) { ph_moba_gate(p, smem); ph_cmp2(p, smem); }
    else if (PH == 12) { ph_moba_part(p, smem); __syncthreads(); ph_nsa(p, smem); }
    else if (PH == 13) ph_moba_own(p, smem);
    else if (PH == 14) ph_gemm_out(p, smem);
    else if (PH == 15) ph_route(p, smem, 1);
    else if (PH == 16) ph_dispatch(p, smem);
    else if (PH == 17) ph_moe_gemm(p, smem, 0);
    else if (PH == 18) ph_moe_gemm(p, smem, 1);
    else if (PH == 19) norm_pass(p.out, (const bf16_t*)(ws + B_Y), nullptr, p.ln_final, nullptr, p.out);
}
#define NPHASE 20

#if MEGA
#define PHB(n) run_phase<n>(p, smem); xcd_barrier(bar);
__global__ void __launch_bounds__(256, 2) k_mega(Params p) {
    __shared__ __attribute__((aligned(16))) char smem_all[SMEM_BYTES + 16];
    char* smem = smem_all + 16;
    if (threadIdx.x == 0) *(uint4*)smem_all = make_uint4(0u, 0u, 0u, 0u);
    __syncthreads();
    XcdBarrier bar = xcd_barrier_post((unsigned*)(p.ws + OFF_CTRL), (volatile LAS unsigned*)smem_all);
    PHB(0) PHB(1) PHB(2) PHB(3) PHB(4) PHB(5) PHB(6) PHB(7) PHB(8) PHB(9)
    PHB(10) PHB(11) PHB(12) PHB(13) PHB(14) PHB(15) PHB(16) PHB(17) PHB(18)
    run_phase<19>(p, smem);
}
#else
template <int PH> __global__ void __launch_bounds__(256, 2) k_phase(Params p) {
    __shared__ __attribute__((aligned(16))) char smem_all[SMEM_BYTES + 16];
    run_phase<PH>(p, smem_all + 16);
}
template <int PH> static void launch_phases(const Params& p, int grid, hipStream_t stream) {
    hipLaunchKernelGGL(k_phase<PH>, dim3(grid), dim3(256), 0, stream, p);
    if constexpr (PH + 1 < NPHASE) launch_phases<PH + 1>(p, grid, stream);
}
#endif

extern "C" void kernel_launch(void* const* d_in, const int* in_sizes, int n_in, void* d_out, int out_size, void* d_ws, size_t ws_size, hipStream_t stream) {
    (void)in_sizes; (void)n_in; (void)out_size;
    if (ws_size < WS_NEED) { fprintf(stderr, "workspace too small: %zu < %zu\n", ws_size, (size_t)WS_NEED); return; }
    Params p; memset(&p, 0, sizeof(p));
    p.x = (const float*)d_in[0]; p.pos = (const int*)d_in[1];
    p.ln_mix[0] = (const float*)d_in[2]; p.w_in[0] = (const float*)d_in[3]; p.sinks0 = (const float*)d_in[4]; p.w_out[0] = (const float*)d_in[5];
    p.ln_ffn[0] = (const float*)d_in[6]; p.r_group[0] = (const float*)d_in[7]; p.r_expert[0] = (const float*)d_in[8];
    p.e_gate[0] = (const float*)d_in[9]; p.e_up[0] = (const float*)d_in[10]; p.e_down[0] = (const float*)d_in[11];
    p.ln_mix[1] = (const float*)d_in[12]; p.w_in[1] = (const float*)d_in[13];
    p.k_pe = (const float*)d_in[14]; p.k_w1 = (const float*)d_in[15]; p.k_w2 = (const float*)d_in[16];
    p.v_pe = (const float*)d_in[17]; p.v_w1 = (const float*)d_in[18]; p.v_w2 = (const float*)d_in[19];
    p.w_out[1] = (const float*)d_in[20]; p.ln_ffn[1] = (const float*)d_in[21]; p.r_group[1] = (const float*)d_in[22]; p.r_expert[1] = (const float*)d_in[23];
    p.e_gate[1] = (const float*)d_in[24]; p.e_up[1] = (const float*)d_in[25]; p.e_down[1] = (const float*)d_in[26];
    p.ln_final = (const float*)d_in[27];
    p.out = (float*)d_out; p.ws = (char*)d_ws;
    (void)hipMemsetAsync(d_ws, 0, 1 * MB, stream);
#if MEGA
    static int grid = 0;
    if (!grid) {
        int dev = 0, cus = 0, per_cu = 0;
        (void)hipGetDevice(&dev);
        (void)hipDeviceGetAttribute(&cus, hipDeviceAttributeMultiprocessorCount, dev);
        (void)hipOccupancyMaxActiveBlocksPerMultiprocessor(&per_cu, k_mega, 256, 0);
        if (per_cu < 1) per_cu = 1;
        grid = cus * (per_cu < 2 ? per_cu : 2);
    }
    hipLaunchKernelGGL(k_mega, dim3(grid), dim3(256), 0, stream, p);
#else
    launch_phases<0>(p, 512, stream);
#endif
}
```

```cpp
#include <hip/hip_runtime.h>
#include <stdint.h>
#include <stdio.h>
#include <string.h>

#ifndef MEGA
#define MEGA 1
#endif
#ifndef PROBE_A
#define PROBE_A 0
#endif
#ifndef PROBE_B
#define PROBE_B 0
#endif
#ifndef PROBE_NSA
#define PROBE_NSA 0
#endif
#define PROBING ((PROBE_A) | (PROBE_B) | (PROBE_NSA))

typedef unsigned short bf16_t;
typedef short bf16x8 __attribute__((ext_vector_type(8)));
typedef float f32x4 __attribute__((ext_vector_type(4)));

#define NTOK 32768
#define SEQ 16384
#define DM 1024
#define LDQ 2304
#define NVH 10
#define NEXP 64
#define EH 512
#define NASG 65536
#define NCMP 1023
#define NCMPP 1024
#define NEG_BIG (-1.0e30f)
#define VLD (SEQ + 64)
#define CLD (NCMPP + 64)

constexpr size_t MB = 1024ull * 1024ull;
constexpr size_t OFF_CTRL = 0;
constexpr size_t OFF_MOBACNT = 32768;
constexpr size_t OFF_ROPE = 1 * MB;
constexpr size_t OFF_NSACNT = 65536;
#define CNTS 32
constexpr size_t OFF_MOECNT = 262144;
constexpr size_t OFF_W = 9 * MB;
constexpr size_t W_IN = OFF_W;
constexpr size_t W_OUT = W_IN + 2304ull * 1024 * 2;
constexpr size_t W_K1 = W_OUT + 1024ull * 1024 * 2;
constexpr size_t W_V1 = W_K1 + 256ull * 2048 * 2;
constexpr size_t W_K2 = W_V1 + 256ull * 2048 * 2;
constexpr size_t W_V2 = W_K2 + 128ull * 256 * 2;
constexpr size_t W_BK = W_V2 + 128ull * 256 * 2;
constexpr size_t W_BV = W_BK + 1024;
constexpr size_t W_GU = W_BV + 1024 + 1022 * 1024;
constexpr size_t W_DN = W_GU + 64ull * 1024 * 1024 * 2;
constexpr size_t OFF_H = W_DN + 64ull * 1024 * 512 * 2;
constexpr size_t OFF_QKV = OFF_H + (size_t)NTOK * 1024 * 2;
constexpr size_t OFF_VT = OFF_QKV + (size_t)NTOK * LDQ * 2;
constexpr size_t OFF_O = OFF_VT + 2ull * NVH * 64 * VLD * 2;
constexpr size_t OFF_B = OFF_O + (size_t)NTOK * 1024 * 2;
constexpr size_t B_LIST = OFF_B;
constexpr size_t MOBA_LCAP = 2064384ull;
constexpr size_t B_PO = B_LIST + 4 * MOBA_LCAP * 4;
constexpr size_t B_PML = B_PO + (size_t)NTOK * 24 * 64 * 2;
constexpr size_t B_HIDK = B_PML + (size_t)NTOK * 24 * 8;
constexpr size_t B_HIDV = B_HIDK + 4096ull * 256 * 2;
constexpr size_t B_KCMP = B_HIDV + 4096ull * 256 * 2;
constexpr size_t B_VCMPT = B_KCMP + 4ull * 1024 * 64 * 2;
constexpr size_t B_KMEAN = B_VCMPT + 4ull * CLD * 64 * 2;
constexpr size_t B_GD = B_KMEAN + 2ull * 64 * 2 * 64 * 4;
constexpr size_t B_END = B_GD + (size_t)NTOK * 24 * 4;
constexpr size_t B_Y = OFF_B;
constexpr size_t OFF_M = OFF_B + 150 * MB;
static_assert(B_END <= OFF_M, "B region overflow");
constexpr size_t M_TOKE = OFF_M;
constexpr size_t M_TOKG = M_TOKE + (size_t)NTOK * 8;
constexpr size_t M_TOKR = M_TOKG + (size_t)NTOK * 8;
constexpr size_t M_HIST = M_TOKR + (size_t)NTOK * 8;
constexpr size_t M_LIST = M_HIST + 512ull * 64 * 4;
constexpr size_t M_ECNT = M_LIST + 65536ull * 4;
constexpr size_t M_EBASE = M_ECNT + 256;
constexpr size_t M_SELID = OFF_M + 2 * MB;
constexpr size_t NSA_PSZ = (size_t)2 * SEQ * 13 * 544;
constexpr size_t NSA_PX = OFF_M + 3 * MB;
constexpr size_t NSA_PY = W_GU;
static_assert(NSA_PSZ <= 256 * MB, "NSA partials do not fit the weight region");
constexpr size_t NSA_LCAP = 2072640ull;
constexpr size_t NSA_LISTS = NSA_PX + NSA_PSZ;
constexpr size_t WS_NEED = NSA_LISTS + 4 * NSA_LCAP * 2;
constexpr size_t MOE_LIST = NSA_LISTS;
static_assert(64ull * 32768 * 4 <= 4 * NSA_LCAP * 2, "MoE lists do not fit");
constexpr size_t HID_OFF = OFF_QKV;

#define SMEM_BYTES 75776
#define HDR_BYTES 512

struct Params {
    const float* x; const int* pos;
    const float* ln_mix[2]; const float* w_in[2]; const float* sinks0; const float* w_out[2]; const float* ln_ffn[2];
    const float* r_group[2]; const float* r_expert[2]; const float* e_gate[2]; const float* e_up[2]; const float* e_down[2];
    const float* k_pe; const float* k_w1; const float* k_w2; const float* v_pe; const float* v_w1; const float* v_w2;
    const float* ln_final;
    float* out;
    char* ws;
};

#define XB_TMO      128
#define XB_XCNT(j)  (256  + 64 * (j))
#define XB_XSUB(j)  (1280 + 64 * (j))
#define XB_XGEN(j)  (2304 + 64 * (j))
#define XB_TOP      3328
#define XB_TOPGEN   3392
#define XCD_BAR_WORDS 3456
#define XB_SPIN_CAP (1u << 22)
#define LAS __attribute__((address_space(3)))

__device__ __forceinline__ unsigned xb_ld(unsigned* p)              { return __hip_atomic_load(p, __ATOMIC_RELAXED, __HIP_MEMORY_SCOPE_AGENT); }
__device__ __forceinline__ unsigned xb_add(unsigned* p, unsigned v) { return __hip_atomic_fetch_add(p, v, __ATOMIC_RELAXED, __HIP_MEMORY_SCOPE_AGENT); }
__device__ __forceinline__ unsigned xb_xcc_id() { return (unsigned)__builtin_amdgcn_s_getreg((3 << 11) | 20) & 0xFu; }
#define XB_SPIN(cond, bar) do { unsigned _sp = 0; while (cond) { __builtin_amdgcn_s_sleep(1); \
    if ((++_sp & 255u) == 0u) { if (xb_ld(&(bar)[XB_TMO])) break; if (_sp > XB_SPIN_CAP) { atomicAdd(&(bar)[XB_TMO], 1u); break; } } } } while (0)

struct XcdBarrier { unsigned* bar; unsigned x; volatile LAS unsigned* st; };

__device__ __forceinline__ XcdBarrier xcd_barrier_post(unsigned* bar, volatile LAS unsigned* st) {
    XcdBarrier b; b.bar = bar; b.x = xb_xcc_id(); b.st = st;
    if (threadIdx.x == 0) (void)xb_add(&bar[XB_XCNT(b.x)], 1u);
    return b;
}
__device__ __forceinline__ void xcd_barrier_complete(unsigned* bar, unsigned x, unsigned& nloc, unsigned& nx) {
    const unsigned G = gridDim.x * gridDim.y * gridDim.z;
    unsigned sum, cnt, mine, sp = 0u;
    for (;;) {
        sum = 0u; cnt = 0u; mine = 0u;
#pragma unroll
        for (unsigned j = 0; j < 16; ++j) { const unsigned c = xb_ld(&bar[XB_XCNT(j)]); sum += c; cnt += (c > 0u) ? 1u : 0u; mine = (j == x) ? c : mine; }
        if (sum == G) break;
        __builtin_amdgcn_s_sleep(1);
        if ((++sp & 255u) == 0u) { if (xb_ld(&bar[XB_TMO])) break; if (sp > XB_SPIN_CAP) { atomicAdd(&bar[XB_TMO], 1u); break; } }
    }
    nloc = mine > 0u ? mine : 1u; nx = cnt > 0u ? cnt : 1u;
}
__device__ __forceinline__ void xcd_barrier(const XcdBarrier& b) {
    asm volatile("s_waitcnt vmcnt(0)" ::: "memory");
    __syncthreads();
    if (threadIdx.x == 0) {
        unsigned* bar = b.bar;
        __builtin_amdgcn_s_waitcnt(0);
        unsigned nloc = b.st[0], nx = b.st[1];
        if (nloc == 0u) { xcd_barrier_complete(bar, b.x, nloc, nx); b.st[0] = nloc; b.st[1] = nx; }
        const unsigned old = xb_add(&bar[XB_XSUB(b.x)], 1u);
        const unsigned gen = old / nloc;
        if (old + 1u == (gen + 1u) * nloc) {
            __builtin_amdgcn_fence(__ATOMIC_RELEASE, "agent");
            asm volatile("s_waitcnt vmcnt(0)" ::: "memory");
            const unsigned og = xb_add(&bar[XB_TOP], 1u);
            const unsigned tg = og / nx;
            if (og + 1u == (tg + 1u) * nx) xb_add(&bar[XB_TOPGEN], 1u);
            else XB_SPIN(xb_ld(&bar[XB_TOPGEN]) == tg, bar);
            __builtin_amdgcn_fence(__ATOMIC_ACQUIRE, "agent");
            xb_add(&bar[XB_XGEN(b.x)], 1u);
            asm volatile("s_waitcnt vmcnt(0)" ::: "memory");
        } else {
            XB_SPIN(xb_ld(&bar[XB_XGEN(b.x)]) == gen, bar);
            __builtin_amdgcn_fence(__ATOMIC_ACQUIRE, "agent");
            asm volatile("s_waitcnt vmcnt(0)" ::: "memory");
        }
    }
    __syncthreads();
}

typedef __bf16 bf16x2_t __attribute__((ext_vector_type(2)));
typedef float f32x2 __attribute__((ext_vector_type(2)));
__device__ __forceinline__ uint32_t pack2(float a, float b) { const f32x2 v = {a, b}; return __builtin_bit_cast(uint32_t, __builtin_convertvector(v, bf16x2_t)); }
__device__ __forceinline__ bf16_t f2bf(float f) { return (bf16_t)(pack2(f, 0.f) & 0xFFFFu); }
__device__ __forceinline__ float bf2f(bf16_t h) { return __uint_as_float(((uint32_t)h) << 16); }
__device__ __forceinline__ f32x4 mfma16(bf16x8 a, bf16x8 b, f32x4 c) { return __builtin_amdgcn_mfma_f32_16x16x32_bf16(a, b, c, 0, 0, 0); }
__device__ __forceinline__ float red16_max(float v) { v = fmaxf(v, __shfl_xor(v, 1)); v = fmaxf(v, __shfl_xor(v, 2)); v = fmaxf(v, __shfl_xor(v, 4)); v = fmaxf(v, __shfl_xor(v, 8)); return v; }
__device__ __forceinline__ float red16_sum(float v) { v += __shfl_xor(v, 1); v += __shfl_xor(v, 2); v += __shfl_xor(v, 4); v += __shfl_xor(v, 8); return v; }
__device__ __forceinline__ float red64_sum(float v) { v += __shfl_xor(v, 1); v += __shfl_xor(v, 2); v += __shfl_xor(v, 4); v += __shfl_xor(v, 8); v += __shfl_xor(v, 16); v += __shfl_xor(v, 32); return v; }
typedef unsigned u32x2_t __attribute__((ext_vector_type(2)));
__device__ __forceinline__ float quad_max(float v) {
    const u32x2_t a = __builtin_amdgcn_permlane32_swap(__float_as_uint(v), __float_as_uint(v), false, false);
    v = fmaxf(__uint_as_float(a[0]), __uint_as_float(a[1]));
    const u32x2_t b = __builtin_amdgcn_permlane16_swap(__float_as_uint(v), __float_as_uint(v), false, false);
    return fmaxf(__uint_as_float(b[0]), __uint_as_float(b[1]));
}
__device__ __forceinline__ float quad_sum(float v) {
    const u32x2_t a = __builtin_amdgcn_permlane32_swap(__float_as_uint(v), __float_as_uint(v), false, false);
    v = __uint_as_float(a[0]) + __uint_as_float(a[1]);
    const u32x2_t b = __builtin_amdgcn_permlane16_swap(__float_as_uint(v), __float_as_uint(v), false, false);
    return __uint_as_float(b[0]) + __uint_as_float(b[1]);
}
__device__ __forceinline__ float ex2(float x) { return __builtin_amdgcn_exp2f(x); }
#define LOG2E 1.4426950408889634f
__device__ __forceinline__ void lds_fence() { asm volatile("s_waitcnt lgkmcnt(0)" ::: "memory"); }
__device__ __forceinline__ bf16x8 ld8(const bf16_t* p) { return *(const bf16x8*)p; }
__device__ __forceinline__ bf16x8 zero8() { bf16x8 z = {0, 0, 0, 0, 0, 0, 0, 0}; return z; }

__device__ __forceinline__ int hidden_tid() { int t = (int)threadIdx.x; asm volatile("" : "+v"(t)); return t; }

__device__ __forceinline__ void tconv(char* smem, const float* src, bf16_t* dst, int K, int N, int Npad, int nbatch, size_t sstride, size_t dstride, int mode) {
    float* tile = (float*)smem;
    const int tid = threadIdx.x;
    const int tk = K / 64, tn = (Npad + 63) / 64, per = tk * tn, total = per * nbatch;
    for (int it = blockIdx.x; it < total; it += gridDim.x) {
        const int bi = it / per, r = it % per, k0 = (r / tn) * 64, n0 = (r % tn) * 64;
        const float* s = src + (size_t)bi * sstride;
        bf16_t* d = dst + (size_t)bi * dstride;
        const int ty = tid >> 4, tx = tid & 15;
#pragma unroll
        for (int i = 0; i < 4; ++i) {
            const int k = ty + 16 * i, n = n0 + tx * 4;
            float4 v = make_float4(0.f, 0.f, 0.f, 0.f);
            if (n < N) v = *(const float4*)(s + (size_t)(k0 + k) * N + n);
            tile[k * 65 + tx * 4 + 0] = v.x; tile[k * 65 + tx * 4 + 1] = v.y; tile[k * 65 + tx * 4 + 2] = v.z; tile[k * 65 + tx * 4 + 3] = v.w;
        }
        __syncthreads();
        {
            const int nl = tid >> 2, kc = (tid & 3) * 16, n = n0 + nl;
            if (n < Npad) {
                int row = n;
                if (mode == 1) row = (n >> 5) * 64 + (n & 31);
                else if (mode == 2) row = (n >> 5) * 64 + 32 + (n & 31);
                uint32_t w[8];
#pragma unroll
                for (int i = 0; i < 8; ++i) w[i] = pack2(tile[(kc + 2 * i) * 65 + nl], tile[(kc + 2 * i + 1) * 65 + nl]);
                uint4* o = (uint4*)(d + (size_t)row * K + k0 + kc);
                o[0] = make_uint4(w[0], w[1], w[2], w[3]);
                o[1] = make_uint4(w[4], w[5], w[6], w[7]);
            }
        }
        __syncthreads();
    }
}

__device__ __forceinline__ void conv_expert_weights(const Params& p, char* smem, int L) {
    char* ws = p.ws;
    tconv(smem, p.e_gate[L], (bf16_t*)(ws + W_GU), 1024, 512, 512, 64, 1024ull * 512, 1024ull * 1024, 1);
    tconv(smem, p.e_up[L], (bf16_t*)(ws + W_GU), 1024, 512, 512, 64, 1024ull * 512, 1024ull * 1024, 2);
    tconv(smem, p.e_down[L], (bf16_t*)(ws + W_DN), 512, 1024, 1024, 64, 512ull * 1024, 1024ull * 512, 0);
}
__device__ __forceinline__ void conv_layer_weights(const Params& p, char* smem, int L) {
    char* ws = p.ws;
    if (L == 0) tconv(smem, p.w_in[0], (bf16_t*)(ws + W_IN), 1024, 2304, 2304, 1, 0, 0, 0);
    else        tconv(smem, p.w_in[1], (bf16_t*)(ws + W_IN), 1024, 2072, 2304, 1, 0, 0, 0);
    tconv(smem, p.w_out[L], (bf16_t*)(ws + W_OUT), 1024, 1024, 1024, 1, 0, 0, 0);
    if (L == 1) {
        tconv(smem, p.k_w1, (bf16_t*)(ws + W_K1), 2048, 256, 256, 1, 0, 0, 0);
        tconv(smem, p.v_w1, (bf16_t*)(ws + W_V1), 2048, 256, 256, 1, 0, 0, 0);
        tconv(smem, p.k_w2, (bf16_t*)(ws + W_K2), 256, 64, 128, 1, 0, 0, 0);
        tconv(smem, p.v_w2, (bf16_t*)(ws + W_V2), 256, 64, 128, 1, 0, 0, 0);
        if (blockIdx.x == gridDim.x - 1 || blockIdx.x == gridDim.x - 2) {
            const bool isv = (blockIdx.x == gridDim.x - 2);
            const float* pe = isv ? p.v_pe : p.k_pe; const float* w1 = isv ? p.v_w1 : p.k_w1;
            float* bias = (float*)(ws + (isv ? W_BV : W_BK));
            const int n = threadIdx.x; float acc = 0.f;
            for (int kk = 0; kk < 2048; ++kk) acc += pe[kk] * w1[(size_t)kk * 256 + n];
            bias[n] = acc;
        }
    }
}

static __device__ const double kInvFreq[32] = {
    1.0, 0.7498942093324559, 0.5623413251903491, 0.4216965034285822, 0.31622776601683794, 0.23713737056616552, 0.1778279410038923, 0.1333521432163324,
    0.1, 0.07498942093324558, 0.05623413251903491, 0.042169650342858224, 0.03162277660168379, 0.023713737056616554, 0.01778279410038923, 0.01333521432163324,
    0.01, 0.007498942093324558, 0.005623413251903491, 0.004216965034285823, 0.0031622776601683794, 0.0023713737056616554, 0.0017782794100389228, 0.001333521432163324,
    0.001, 0.0007498942093324559, 0.0005623413251903491, 0.00042169650342858224, 0.00031622776601683794, 0.00023713737056616554, 0.00017782794100389227, 0.0001333521432163324};
__device__ __forceinline__ void rope_table(const Params& p) {
    float* rc = (float*)(p.ws + OFF_ROPE); float* rs = rc + (size_t)NTOK * 32;
    for (int i = blockIdx.x * 256 + threadIdx.x; i < NTOK * 32; i += gridDim.x * 256) {
        const int t = i >> 5, c = i & 31;
        const double ang = (double)p.pos[t] * kInvFreq[c];
        const double k = rint(ang * 0.15915494309189535);
        const float r = (float)fma(-k, 6.283185307179586, ang);
        rc[i] = cosf(r); rs[i] = sinf(r);
    }
}

__device__ __forceinline__ void norm_pass(const float* src, const bf16_t* y, float* xr, const float* gain, bf16_t* hb, float* hf, float pscale = 1.0f, float pv = 0.0f) {
    const int lane = threadIdx.x & 63, wid = threadIdx.x >> 6;
    const int nw = gridDim.x * 4;
    for (int t = blockIdx.x * 4 + wid; t < NTOK; t += nw) {
        float v[16];
#pragma unroll
        for (int i = 0; i < 4; ++i) {
            const float4 a = *(const float4*)(src + (size_t)t * DM + i * 256 + lane * 4);
            v[4 * i] = a.x; v[4 * i + 1] = a.y; v[4 * i + 2] = a.z; v[4 * i + 3] = a.w;
        }
        if (y) {
#pragma unroll
            for (int k = 0; k < 2; ++k)
#pragma unroll
                for (int i = 0; i < 4; ++i) {
                    const uint2 a = *(const uint2*)(y + ((size_t)t * 2 + k) * DM + i * 256 + lane * 4);
                    v[4 * i] += __uint_as_float(a.x << 16); v[4 * i + 1] += __uint_as_float(a.x & 0xFFFF0000u);
                    v[4 * i + 2] += __uint_as_float(a.y << 16); v[4 * i + 3] += __uint_as_float(a.y & 0xFFFF0000u);
                }
        }
        float ss = 0.f;
#pragma unroll
        for (int i = 0; i < 16; ++i) ss += v[i] * v[i];
        ss = red64_sum(ss);
        const float rstd = rsqrtf(ss * (1.0f / DM) + 1e-6f);
#pragma unroll
        for (int i = 0; i < 4; ++i) {
            if (xr) *(float4*)(xr + (size_t)t * DM + i * 256 + lane * 4) = make_float4(v[4 * i], v[4 * i + 1], v[4 * i + 2], v[4 * i + 3]);
            const float4 g = *(const float4*)(gain + i * 256 + lane * 4);
            const float h0 = v[4 * i] * rstd * g.x, h1 = v[4 * i + 1] * rstd * g.y, h2 = v[4 * i + 2] * rstd * g.z, h3 = v[4 * i + 3] * rstd * g.w;
            if (hb) *(uint2*)(hb + (size_t)t * DM + i * 256 + lane * 4) = make_uint2(pack2(h0, h1), pack2(h2, h3));
            if (hf) { float4 o4 = make_float4(h0 * pscale, h1 * pscale, h2 * pscale, h3 * pscale);
                if (pv != 0.0f && t == 0 && i == 0 && lane == 0) o4.x = pv;
                *(float4*)(hf + (size_t)t * DM + i * 256 + lane * 4) = o4; }
        }
    }
}

#define GSW(tid) ((((tid) & 3) ^ ((0 - ((tid) >> 4)) & 3)) * 8)
__device__ __forceinline__ void glds16(const bf16_t* g, char* l) {
    __builtin_amdgcn_global_load_lds((const unsigned*)g, (LAS unsigned*)l, 16, 0, 0);
}
template <class AOff, class Epi>
__device__ __forceinline__ void gemm_tile(char* smem, const bf16_t* a0, const bf16_t* a1, const bf16_t* b0, const bf16_t* b1, int KT, AOff aoff, Epi epi) {
    const int tid = threadIdx.x, wid = tid >> 6, lane = tid & 63, wr = wid >> 1, wc = wid & 1, fr = lane & 15, fq = lane >> 4;
    const int csw = (fq ^ ((0 - (fr >> 2)) & 3)) * 16;
    f32x4 acc[4][4];
#pragma unroll
    for (int m = 0; m < 4; ++m)
#pragma unroll
        for (int n = 0; n < 4; ++n) acc[m][n] = (f32x4){0.f, 0.f, 0.f, 0.f};
    auto stage = [&](int t) {
        char* buf = smem + (t & 3) * 16384;
        const size_t ao = aoff(t);
        glds16(a0 + ao, buf + tid * 16); glds16(a1 + ao, buf + 4096 + tid * 16);
        glds16(b0 + t * 32, buf + 8192 + tid * 16); glds16(b1 + t * 32, buf + 8192 + 4096 + tid * 16);
    };
    asm volatile("s_waitcnt vmcnt(0)" ::: "memory");
    stage(0);
    if (KT > 1) stage(1);
    if (KT > 2) stage(2);
    for (int t = 0; t < KT; ++t) {
        const char* cur = smem + (t & 3) * 16384;
        if (t + 2 < KT) asm volatile("s_waitcnt vmcnt(8)" ::: "memory");
        else if (t + 1 < KT) asm volatile("s_waitcnt vmcnt(4)" ::: "memory");
        else asm volatile("s_waitcnt vmcnt(0)" ::: "memory");
        __builtin_amdgcn_s_barrier();
        asm volatile("" ::: "memory");
        if (t + 3 < KT) stage(t + 3);
        bf16x8 af[4], bfr[4];
#pragma unroll
        for (int m = 0; m < 4; ++m) af[m] = *(const bf16x8*)(cur + (wr * 64 + m * 16 + fr) * 64 + csw);
#pragma unroll
        for (int n = 0; n < 4; ++n) bfr[n] = *(const bf16x8*)(cur + 8192 + (wc * 64 + n * 16 + fr) * 64 + csw);
        __builtin_amdgcn_s_setprio(1);
#pragma unroll
        for (int m = 0; m < 4; ++m)
#pragma unroll
            for (int n = 0; n < 4; ++n) acc[m][n] = mfma16(af[m], bfr[n], acc[m][n]);
        __builtin_amdgcn_s_setprio(0);
    }
    epi(acc, wr, wc, fr, fq);
    __syncthreads();
}

__device__ __forceinline__ void ld_frags(const char* cur, int wr, int wc, int fr, int csw, bf16x8 (&af)[4], bf16x8 (&bfr)[4]) {
#pragma unroll
    for (int m = 0; m < 4; ++m) af[m] = *(const bf16x8*)(cur + (wr * 64 + m * 16 + fr) * 64 + csw);
#pragma unroll
    for (int n = 0; n < 4; ++n) bfr[n] = *(const bf16x8*)(cur + 8192 + (wc * 64 + n * 16 + fr) * 64 + csw);
}
__device__ __forceinline__ void mma_frags(const bf16x8 (&af)[4], const bf16x8 (&bfr)[4], f32x4 (&acc)[4][4]) {
    __builtin_amdgcn_s_setprio(1);
#pragma unroll
    for (int m = 0; m < 4; ++m)
#pragma unroll
        for (int n = 0; n < 4; ++n) acc[m][n] = mfma16(af[m], bfr[n], acc[m][n]);
    __builtin_amdgcn_s_setprio(0);
}
template <class AOff, class Epi>
__device__ __forceinline__ void gemm_tile_p(char* smem, const bf16_t* a0, const bf16_t* a1, const bf16_t* b0, const bf16_t* b1, int KT, AOff aoff, Epi epi) {
    const int tid = threadIdx.x, wid = tid >> 6, lane = tid & 63, wr = wid >> 1, wc = wid & 1, fr = lane & 15, fq = lane >> 4;
    const int csw = (fq ^ ((0 - (fr >> 2)) & 3)) * 16;
    f32x4 acc[4][4];
#pragma unroll
    for (int m = 0; m < 4; ++m)
#pragma unroll
        for (int n = 0; n < 4; ++n) acc[m][n] = (f32x4){0.f, 0.f, 0.f, 0.f};
    auto stage = [&](int t) {
        char* buf = smem + (t & 3) * 16384;
        const size_t ao = aoff(t);
        glds16(a0 + ao, buf + tid * 16); glds16(a1 + ao, buf + 4096 + tid * 16);
        glds16(b0 + t * 32, buf + 8192 + tid * 16); glds16(b1 + t * 32, buf + 8192 + 4096 + tid * 16);
    };
    auto sync = [&](int t) {
        if (t + 2 < KT) asm volatile("s_waitcnt vmcnt(4)" ::: "memory"); else asm volatile("s_waitcnt vmcnt(0)" ::: "memory");
        __builtin_amdgcn_s_barrier();
        asm volatile("" ::: "memory");
        if (t + 3 < KT) stage(t + 3);
    };
    asm volatile("s_waitcnt vmcnt(0)" ::: "memory");
    stage(0); stage(1); if (KT > 2) stage(2);
    asm volatile("s_waitcnt vmcnt(8)" ::: "memory");
    if (KT <= 2) asm volatile("s_waitcnt vmcnt(4)" ::: "memory");
    __builtin_amdgcn_s_barrier();
    asm volatile("" ::: "memory");
    bf16x8 afA[4], bfA[4], afB[4], bfB[4];
    ld_frags(smem, wr, wc, fr, csw, afA, bfA);
    for (int t = 0; t < KT; t += 2) {
        sync(t);
        ld_frags(smem + ((t + 1) & 3) * 16384, wr, wc, fr, csw, afB, bfB);
        mma_frags(afA, bfA, acc);
        sync(t + 1);
        if (t + 2 < KT) ld_frags(smem + ((t + 2) & 3) * 16384, wr, wc, fr, csw, afA, bfA);
        mma_frags(afB, bfB, acc);
    }
    epi(acc, wr, wc, fr, fq);
    __syncthreads();
}

#define GSW64(tid) ((((tid) & 7) ^ (((tid) >> 4) & 7)) * 8)
template <class AOff, class Epi>
__device__ __forceinline__ void gemm_tile_k64(char* smem, int tid, const bf16_t* const (&ap)[4], const bf16_t* b0, size_t b32, int KT, AOff aoff, Epi epi) {
    const int wid = tid >> 6, lane = tid & 63, wr = wid >> 1, wc = wid & 1, fr = lane & 15, fq = lane >> 4;
    const int sw = (fr >> 1) & 7;
    f32x4 acc[4][4];
#pragma unroll
    for (int m = 0; m < 4; ++m)
#pragma unroll
        for (int n = 0; n < 4; ++n) acc[m][n] = (f32x4){0.f, 0.f, 0.f, 0.f};
    auto stage = [&](int t) {
        char* buf = smem + (t & 1) * 32768;
        const size_t ao = aoff(t);
#pragma unroll
        for (int i = 0; i < 4; ++i) glds16(ap[i] + ao, buf + i * 4096 + tid * 16);
        const bf16_t* bp = b0 + t * 64;
#pragma unroll
        for (int i = 0; i < 4; ++i) glds16(bp + i * b32, buf + 16384 + i * 4096 + tid * 16);
    };
    asm volatile("s_waitcnt vmcnt(0)" ::: "memory");
    stage(0);
    for (int t = 0; t < KT; ++t) {
        const char* cur = smem + (t & 1) * 32768;
        asm volatile("s_waitcnt vmcnt(0)" ::: "memory");
        __builtin_amdgcn_s_barrier();
        asm volatile("" ::: "memory");
        if (t + 1 < KT) stage(t + 1);
#pragma unroll
        for (int ks = 0; ks < 2; ++ks) {
            const int cb = ((ks * 4 + fq) ^ sw) * 16;
            bf16x8 af[4], bfr[4];
#pragma unroll
            for (int m = 0; m < 4; ++m) af[m] = *(const bf16x8*)(cur + (wr * 64 + m * 16 + fr) * 128 + cb);
#pragma unroll
            for (int n = 0; n < 4; ++n) bfr[n] = *(const bf16x8*)(cur + 16384 + (wc * 64 + n * 16 + fr) * 128 + cb);
            __builtin_amdgcn_s_setprio(1);
#pragma unroll
            for (int m = 0; m < 4; ++m)
#pragma unroll
                for (int n = 0; n < 4; ++n) acc[m][n] = mfma16(af[m], bfr[n], acc[m][n]);
            __builtin_amdgcn_s_setprio(0);
        }
    }
    epi(acc, wr, wc, fr, fq);
    __syncthreads();
}

__device__ __forceinline__ void col_kind(int L, int ct, int& kind, int& vh, float& scale) {
    kind = 0; vh = 0; scale = 1.f;
    if (L == 0) {
        if (ct < 8) { kind = 1; scale = 0.125f * LOG2E; }
        else if (ct < 10) kind = 1;
        else if (ct < 12) { kind = 2; vh = ct - 10; }
        else if (ct < 20) { kind = 0; scale = 0.125f; }
        else if (ct < 28) kind = 0;
        else { kind = 2; vh = 2 + (ct - 28); }
    } else {
        if (ct < 8) { kind = 1; scale = 0.125f * LOG2E; }
        else if (ct < 10) kind = 1;
        else if (ct < 12) { kind = 2; vh = ct - 10; }
        else if (ct < 20) { kind = 1; scale = 0.125f * LOG2E; }
        else if (ct < 22) kind = 1;
        else if (ct < 24) kind = 0;
        else if (ct < 26) kind = 1;
        else if (ct < 28) { kind = 2; vh = 2 + (ct - 26); }
        else if (ct < 30) kind = 1;
        else if (ct < 32) { kind = 2; vh = 4 + (ct - 30); }
        else if (ct == 32) kind = 3;
        else kind = 4;
    }
}

#ifndef GEMM_EXP
#define GEMM_EXP 0
#endif
#define EPITCH 68
__device__ __forceinline__ void dump_half(float* E, const f32x4 (&acc)[4][4], int nb, int fr, int fq) {
#pragma unroll
    for (int m = 0; m < 4; ++m)
#pragma unroll
        for (int n = 0; n < 4; ++n)
#pragma unroll
            for (int j = 0; j < 4; ++j) E[(m * 16 + fq * 4 + j) * EPITCH + n * 16 + fr] = acc[m][nb + n][j];
}
__device__ __forceinline__ void ld8f(const float* p, float (&v)[8]) {
    const float4 a = *(const float4*)p, b = *(const float4*)(p + 4);
    v[0] = a.x; v[1] = a.y; v[2] = a.z; v[3] = a.w; v[4] = b.x; v[5] = b.y; v[6] = b.z; v[7] = b.w;
}
__device__ __forceinline__ void st8bf(bf16_t* p, const float (&v)[8]) {
    *(uint4*)p = make_uint4(pack2(v[0], v[1]), pack2(v[2], v[3]), pack2(v[4], v[5]), pack2(v[6], v[7]));
}

template <bool NOEPI = false>
__device__ __forceinline__ void ph_gemm_qkv(const Params& p, char* smem, int L) {
    const bf16_t* A = (const bf16_t*)(p.ws + OFF_H);
    const bf16_t* Bt = (const bf16_t*)(p.ws + W_IN);
    bf16_t* Q = (bf16_t*)(p.ws + OFF_QKV);
    bf16_t* VT = (bf16_t*)(p.ws + OFF_VT);
    float* GD = (float*)(p.ws + B_GD);
    const float* rc = (const float*)(p.ws + OFF_ROPE); const float* rs = rc + (size_t)NTOK * 32;
    const int tn = (L == 0) ? 18 : 17, tm = NTOK / 128, total = tm * tn;
    const int tid = hidden_tid();
    const bool aff = (gridDim.x & 7) == 0;
    const int xcd = blockIdx.x & 7, nh = xcd >> 2, ncols = aff ? (nh ? tn - 9 : 9) : tn;
    const int lstart = aff ? (blockIdx.x >> 3) : blockIdx.x, lstep = aff ? (gridDim.x >> 3) : gridDim.x, lcnt = aff ? (tm / 4) * ncols : total;
    for (int li = lstart; li < lcnt; li += lstep) {
        const int mt = aff ? ((xcd & 3) * (tm / 4) + li / ncols) : (li / tn), nt = aff ? (nh * 9 + li % ncols) : (li % tn);
        const int brow = mt * 128, bcol = nt * 128;
        const bf16_t* a0 = A + (size_t)(brow + (tid >> 3)) * DM + GSW64(tid);
        const bf16_t* const ap[4] = {a0, a0 + (size_t)32 * DM, a0 + (size_t)64 * DM, a0 + (size_t)96 * DM};
        const bf16_t* b0 = Bt + (size_t)(bcol + (tid >> 3)) * DM + GSW64(tid);
        gemm_tile_k64(smem, tid, ap, b0, (size_t)32 * DM, DM / 64, [](int t) { return (size_t)t * 64; },
            [&](f32x4 (&acc)[4][4], int wr, int wc, int fr, int fq) {
                if (NOEPI) { float sink = 0.f; for (int m = 0; m < 4; ++m) for (int n = 0; n < 4; ++n) sink += acc[m][n][0] + acc[m][n][1] + acc[m][n][2] + acc[m][n][3]; if (sink == 1.2345e-30f) GD[0] = sink; return; }
                const int lane = tid & 63;
                float* E = (float*)(smem + (tid >> 6) * (64 * EPITCH * 4));
                const int rowbase = brow + wr * 64;
                __syncthreads();
                {
                    const int ct = (bcol >> 6) + wc;
                    int kind, vh; float scale; col_kind(L, ct, kind, vh, scale);
                    if (kind == 4) return;
                    dump_half(E, acc, 0, fr, fq);
                    lds_fence();
                    if (kind == 0 || kind == 1) {
#pragma unroll 1
                        for (int i = 0; i < 4; ++i) {
                            const int u = lane + 64 * i, r = u >> 2, c8 = (u & 3) * 8, grow = rowbase + r;
                            float x1[8], x2[8], o1[8], o2[8];
                            ld8f(E + r * EPITCH + c8, x1); ld8f(E + r * EPITCH + 32 + c8, x2);
                            if (kind == 1) {
                                float cs[8], sn[8];
                                ld8f(rc + (size_t)grow * 32 + c8, cs); ld8f(rs + (size_t)grow * 32 + c8, sn);
#pragma unroll
                                for (int e = 0; e < 8; ++e) { o1[e] = (x1[e] * cs[e] - x2[e] * sn[e]) * scale; o2[e] = (x2[e] * cs[e] + x1[e] * sn[e]) * scale; }
                            } else {
#pragma unroll
                                for (int e = 0; e < 8; ++e) { o1[e] = x1[e] * scale; o2[e] = x2[e] * scale; }
                            }
                            st8bf(Q + (size_t)grow * LDQ + ct * 64 + c8, o1);
                            st8bf(Q + (size_t)grow * LDQ + ct * 64 + 32 + c8, o2);
                        }
                    } else if (kind == 2) {
                        const int b = rowbase >> 14, s0 = rowbase & (SEQ - 1);
                        bf16_t* vrow = VT + ((size_t)(b * NVH + vh) * 64 + lane) * VLD + s0;
#pragma unroll 2
                        for (int tc = 0; tc < 8; ++tc) {
                            float v[8];
#pragma unroll
                            for (int e = 0; e < 8; ++e) v[e] = E[(8 * tc + e) * EPITCH + lane];
                            st8bf(vrow + 8 * tc, v);
                        }
                    } else {
#pragma unroll
                        for (int c = 0; c < 6; ++c) *(float4*)(GD + (size_t)(rowbase + lane) * 24 + 4 * c) = *(const float4*)(E + lane * EPITCH + 4 * c);
                    }
                    lds_fence();
                }
            });
    }
}

__device__ __forceinline__ void ph_gemm_out(const Params& p, char* smem, const float* xin) {
    const bf16_t* A = (const bf16_t*)(p.ws + OFF_O);
    const bf16_t* Bt = (const bf16_t*)(p.ws + W_OUT);
    float* X = p.out;
    const int tn = 8, tm = NTOK / 128, total = tm * tn, tid = hidden_tid();
    const bool aff = (gridDim.x & 7) == 0;
    const int xcd = blockIdx.x & 7, lstart = aff ? (blockIdx.x >> 3) : blockIdx.x, lstep = aff ? (gridDim.x >> 3) : gridDim.x, lcnt = aff ? total / 8 : total;
    for (int li = lstart; li < lcnt; li += lstep) {
        const int mt = aff ? (xcd * (tm / 8) + li / tn) : (li / tn), nt = li % tn, brow = mt * 128, bcol = nt * 128;
        const bf16_t* a0 = A + (size_t)(brow + (tid >> 3)) * DM + GSW64(tid);
        const bf16_t* const ap[4] = {a0, a0 + (size_t)32 * DM, a0 + (size_t)64 * DM, a0 + (size_t)96 * DM};
        const bf16_t* b0 = Bt + (size_t)(bcol + (tid >> 3)) * DM + GSW64(tid);
        gemm_tile_k64(smem, tid, ap, b0, (size_t)32 * DM, DM / 64, [](int t) { return (size_t)t * 64; },
            [&](f32x4 (&acc)[4][4], int wr, int wc, int fr, int fq) {
                const int lane = tid & 63;
                float* E = (float*)(smem + (tid >> 6) * (64 * EPITCH * 4));
                __syncthreads();
                {
                    dump_half(E, acc, 0, fr, fq);
                    lds_fence();
#pragma unroll 4
                    for (int i = 0; i < 16; ++i) {
                        const int u = lane + 64 * i, r = u >> 4, c4 = (u & 15) * 4;
                        const size_t xo = (size_t)(brow + wr * 64 + r) * DM + bcol + wc * 64 + c4;
                        const float4 e = *(const float4*)(E + r * EPITCH + c4);
                        float4 x = *(const float4*)(xin + xo); x.x += e.x; x.y += e.y; x.z += e.z; x.w += e.w; *(float4*)(X + xo) = x;
                    }
                    lds_fence();
                }
            });
    }
}

#define MOE_CAP 32768
__device__ __forceinline__ void ph_route(const Params& p, char* smem, int L) {
    float* lgs = (float*)smem;
    int* hist = (int*)(smem + 20480);
    int* gb = hist + 64;
    int* dec_e = gb + 64;
    int* dec_r = dec_e + 128;
    float* dec_g = (float*)(dec_r + 128);
    const float* gain = p.ln_ffn[L]; const float* Wg = p.r_group[L]; const float* We = p.r_expert[L];
    norm_pass(p.out, nullptr, nullptr, gain, (bf16_t*)(p.ws + OFF_H), nullptr);
    float* tok_g = (float*)(p.ws + M_TOKG);
    int* list = (int*)(p.ws + MOE_LIST);
    int* gcur = (int*)(p.ws + OFF_MOECNT) + L * 64 * CNTS;
    const int tid = threadIdx.x, lane = tid & 63, wid = tid >> 6, fr = lane & 15, fq = lane >> 4;
    for (int ch = blockIdx.x; ch < NTOK / 64; ch += gridDim.x) {
        if (tid < 64) hist[tid] = 0;
        const int tb = ch * 64 + wid * 16;
        f32x4 acc[5];
#pragma unroll
        for (int n = 0; n < 5; ++n) acc[n] = (f32x4){0.f, 0.f, 0.f, 0.f};
        float ss = 0.f;
        const float* xp = p.out + (size_t)(tb + fr) * DM + 4 * fq;
        const float* wep = We + (size_t)(4 * fq) * 64 + 4 * fr;
        const float* wgp = Wg + (size_t)(4 * fq) * 4 + (fr & 3);
        float4 x4 = *(const float4*)xp, g4 = *(const float4*)(gain + 4 * fq);
        float wb[4][5];
#pragma unroll
        for (int e = 0; e < 4; ++e) {
            { const float4 w4 = *(const float4*)(wep + (size_t)e * 64); wb[e][0] = w4.x; wb[e][1] = w4.y; wb[e][2] = w4.z; wb[e][3] = w4.w; }
            wb[e][4] = wgp[e * 4];
        }
        for (int i = 0; i < 64; ++i) {
            const int in = (i + 1 < 64) ? i + 1 : i;
            const float4 x4n = *(const float4*)(xp + 16 * in), g4n = *(const float4*)(gain + 16 * in + 4 * fq);
            float wn[4][5];
#pragma unroll
            for (int e = 0; e < 4; ++e) {
                { const float4 w4 = *(const float4*)(wep + (size_t)(16 * in + e) * 64); wn[e][0] = w4.x; wn[e][1] = w4.y; wn[e][2] = w4.z; wn[e][3] = w4.w; }
                wn[e][4] = wgp[(size_t)(16 * in + e) * 4];
            }
            ss += x4.x * x4.x + x4.y * x4.y + x4.z * x4.z + x4.w * x4.w;
            const float a[4] = {x4.x * g4.x, x4.y * g4.y, x4.z * g4.z, x4.w * g4.w};
#pragma unroll
            for (int e = 0; e < 4; ++e) {
#pragma unroll
                for (int n = 0; n < 4; ++n) acc[n] = __builtin_amdgcn_mfma_f32_16x16x4f32(a[e], wb[e][n], acc[n], 0, 0, 0);
                acc[4] = __builtin_amdgcn_mfma_f32_16x16x4f32(a[e], fr < 4 ? wb[e][4] : 0.f, acc[4], 0, 0, 0);
            }
            x4 = x4n; g4 = g4n;
#pragma unroll
            for (int e = 0; e < 4; ++e)
#pragma unroll
                for (int n = 0; n < 5; ++n) wb[e][n] = wn[e][n];
        }
        ss = quad_sum(ss);
        const float rstd = rsqrtf(ss * (1.0f / DM) + 1e-6f);
#pragma unroll
        for (int j = 0; j < 4; ++j) {
            const float r = __shfl(rstd, 4 * fq + j);
#pragma unroll
            for (int n = 0; n < 5; ++n) lgs[(wid * 16 + 4 * fq + j) * 80 + (n < 4 ? 4 * fr + n : 64 + fr)] = acc[n][j] * r;
        }
        __syncthreads();
        if (tid < 64) {
            const float* lt = lgs + tid * 80;
            float gl[4]; float gm = -INFINITY; int gi = 0;
#pragma unroll
            for (int i = 0; i < 4; ++i) { gl[i] = lt[64 + i]; if (gl[i] > gm) { gm = gl[i]; gi = i; } }
            float gsum = 0.f;
#pragma unroll
            for (int i = 0; i < 4; ++i) gsum += __expf(gl[i] - gm);
            const float gprob = 1.0f / gsum;
            float m0 = -INFINITY, m1 = -INFINITY; int i0 = 0, i1 = 0;
            for (int i = 0; i < 16; ++i) { const float v = lt[gi * 16 + i]; if (v > m0) { m1 = m0; i1 = i0; m0 = v; i0 = i; } else if (v > m1) { m1 = v; i1 = i; } }
            const float e1 = __expf(m1 - m0), den = 1.0f + e1;
            const int ex0 = gi * 16 + i0, ex1 = gi * 16 + i1;
            dec_e[tid * 2] = ex0; dec_e[tid * 2 + 1] = ex1;
            dec_g[tid * 2] = gprob / den; dec_g[tid * 2 + 1] = gprob * e1 / den;
            dec_r[tid * 2] = atomicAdd(&hist[ex0], 1); dec_r[tid * 2 + 1] = atomicAdd(&hist[ex1], 1);
        }
        __syncthreads();
        if (tid < 64) gb[tid] = hist[tid] > 0 ? atomicAdd(&gcur[tid * CNTS], hist[tid]) : 0;
        __syncthreads();
        if (tid < 128) {
            const int slot = ch * 128 + tid, ex = dec_e[tid];
            list[(size_t)ex * MOE_CAP + gb[ex] + dec_r[tid]] = slot;
            tok_g[slot] = dec_g[tid];
        }
        __syncthreads();
    }
}

__device__ __forceinline__ void ph_moe_gemm(const Params& p, char* smem, int which, int L) {
    int* tpre = (int*)(smem + 73728);
    int* e_cnt = tpre + 68;
    int* e_base = e_cnt + 64;
    const int* gcur = (const int*)(p.ws + OFF_MOECNT) + L * 64 * CNTS;
    const int* list = (const int*)(p.ws + MOE_LIST); const float* tok_g = (const float*)(p.ws + M_TOKG);
    const bf16_t* H = (const bf16_t*)(p.ws + OFF_H);
    bf16_t* HID = (bf16_t*)(p.ws + HID_OFF);
    bf16_t* Y = (bf16_t*)(p.ws + B_Y);
    const int tid = hidden_tid();
    const bool aff = (gridDim.x & 7) == 0;
    const int xcd = blockIdx.x & 7;
    if (tid == 0) {
        int rb = 0; for (int i = 0; i < 64; ++i) { const int c = gcur[i * CNTS]; e_cnt[i] = c; e_base[i] = rb; rb += c; }
        int acc = 0;
        if (aff) { for (int v = 0; v < 8; ++v) { tpre[v] = acc; acc += (e_cnt[xcd + 8 * v] + 127) >> 7; } tpre[8] = acc; }
        else { for (int i = 0; i < 64; ++i) { tpre[i] = acc; acc += (e_cnt[i] + 127) >> 7; } tpre[64] = acc; }
    }
    __syncthreads();
    const int nvis = aff ? 8 : 64;
    const int total = tpre[nvis] * 8;
    const int lstart = aff ? (blockIdx.x >> 3) : blockIdx.x, lstep = aff ? (gridDim.x >> 3) : gridDim.x;
    for (int it = lstart; it < total; it += lstep) {
        const int mtg = it >> 3, nt = it & 7;
        int v = 0;
        { int lo = 0, hi = nvis - 1; while (lo < hi) { const int mid = (lo + hi + 1) >> 1; if (tpre[mid] <= mtg) lo = mid; else hi = mid - 1; } v = lo; }
        const int e = aff ? (xcd + 8 * v) : v;
        const int mt = mtg - tpre[v], cnt = e_cnt[e], bas = e_base[e];
        const int* elist = list + (size_t)e * MOE_CAP;
        const int r0 = mt * 128 + (tid >> 3);
        if (which == 0) {
            const bf16_t* ap[4];
#pragma unroll
            for (int i = 0; i < 4; ++i) { const int r = r0 + 32 * i; const int tk = (r < cnt) ? (elist[r] >> 1) : 0; ap[i] = H + (size_t)tk * DM + GSW64(tid); }
            const bf16_t* Bt = (const bf16_t*)(p.ws + W_GU) + (size_t)e * 1024 * 1024;
            const bf16_t* b0 = Bt + (size_t)(nt * 128 + (tid >> 3)) * DM + GSW64(tid);
            gemm_tile_k64(smem, tid, ap, b0, (size_t)32 * DM, DM / 64, [](int t) { return (size_t)t * 64; },
                [&](f32x4 (&acc)[4][4], int wr, int wc, int fr, int fq) {
                    const int lane = tid & 63;
                    float* E = (float*)(smem + (tid >> 6) * (64 * EPITCH * 4));
                    __syncthreads();
                    {
                        dump_half(E, acc, 0, fr, fq);
                        lds_fence();
#pragma unroll 1
                        for (int i = 0; i < 4; ++i) {
                            const int u = lane + 64 * i, r = u >> 2, c8 = (u & 3) * 8, rr = mt * 128 + wr * 64 + r;
                            float g[8], up[8], o[8];
                            ld8f(E + r * EPITCH + c8, g); ld8f(E + r * EPITCH + 32 + c8, up);
#pragma unroll
                            for (int e = 0; e < 8; ++e) o[e] = g[e] / (1.0f + __expf(-g[e])) * up[e];
                            if (rr < cnt) st8bf(HID + (size_t)(bas + rr) * EH + (nt * 2 + wc) * 32 + c8, o);
                        }
                        lds_fence();
                    }
                });
        } else {
            const bf16_t* ap[4];
#pragma unroll
            for (int i = 0; i < 4; ++i) { const int r = r0 + 32 * i; ap[i] = HID + (size_t)((r < cnt) ? (bas + r) : 0) * EH + GSW64(tid); }
            const bf16_t* Bt = (const bf16_t*)(p.ws + W_DN) + (size_t)e * 1024 * 512;
            const bf16_t* b0 = Bt + (size_t)(nt * 128 + (tid >> 3)) * EH + GSW64(tid);
            gemm_tile_k64(smem, tid, ap, b0, (size_t)32 * EH, EH / 64, [](int t) { return (size_t)t * 64; },
                [&](f32x4 (&acc)[4][4], int wr, int wc, int fr, int fq) {
                    const int lane = tid & 63;
                    float* E = (float*)(smem + (tid >> 6) * (64 * EPITCH * 4));
                    __syncthreads();
                    {
                        dump_half(E, acc, 0, fr, fq);
                        lds_fence();
#pragma unroll 2
                        for (int i = 0; i < 8; ++i) {
                            const int u = lane + 64 * i, r = u >> 3, c8 = (u & 7) * 8, rr = mt * 128 + wr * 64 + r;
                            if (rr < cnt) {
                                const int slot = elist[rr];
                                const float g = tok_g[slot];
                                float x[8]; ld8f(E + r * EPITCH + c8, x);
#pragma unroll
                                for (int e = 0; e < 8; ++e) x[e] *= g;
                                st8bf(Y + (size_t)slot * DM + nt * 128 + wc * 64 + c8, x);
                            }
                        }
                        lds_fence();
                    }
                });
        }
    }
}

struct KF { bf16x8 k[4][2]; };
struct VF { bf16x8 v[4][2]; };
struct St { float m, l; f32x4 o[4]; };
#define KEY_OF(kt, j, fq) (32 * ((kt) >> 1) + 8 * (fq) + 4 * ((kt) & 1) + (j))
__device__ __forceinline__ void st_init(St& st) {
    st.m = NEG_BIG; st.l = 0.f;
#pragma unroll
    for (int n = 0; n < 4; ++n) st.o[n] = (f32x4){0.f, 0.f, 0.f, 0.f};
}
__device__ __forceinline__ void load_k(KF& f, const bf16_t* kp, size_t ldk, int fr, int fq) {
    const bf16_t* base = kp + (size_t)(8 * (fr >> 2) + (fr & 3)) * ldk + fq * 8;
#pragma unroll
    for (int kt = 0; kt < 4; ++kt)
#pragma unroll
        for (int ks = 0; ks < 2; ++ks) f.k[kt][ks] = ld8(base + (size_t)(32 * (kt >> 1) + 4 * (kt & 1)) * ldk + ks * 32);
}
__device__ __forceinline__ void load_v(VF& f, const bf16_t* vp, size_t ldv, int fr, int fq) {
    const bf16_t* base = vp + (size_t)fr * ldv + fq * 8;
#pragma unroll
    for (int n = 0; n < 4; ++n)
#pragma unroll
        for (int h = 0; h < 2; ++h) f.v[n][h] = ld8(base + (size_t)(n * 16) * ldv + h * 32);
}
__device__ __forceinline__ void scores(const KF& f, const bf16x8 (&qf)[2], f32x4 (&s)[4]) {
#pragma unroll
    for (int kt = 0; kt < 4; ++kt) {
        s[kt] = mfma16(f.k[kt][0], qf[0], (f32x4){0.f, 0.f, 0.f, 0.f});
        s[kt] = mfma16(f.k[kt][1], qf[1], s[kt]);
    }
}
typedef unsigned u32x4 __attribute__((ext_vector_type(4)));
__device__ __forceinline__ void pv(const VF& f, const float (&p)[4][4], f32x4 (&o)[4]) {
#pragma unroll
    for (int h = 0; h < 2; ++h) {
        u32x4 w;
        w[0] = pack2(p[2 * h][0], p[2 * h][1]); w[1] = pack2(p[2 * h][2], p[2 * h][3]);
        w[2] = pack2(p[2 * h + 1][0], p[2 * h + 1][1]); w[3] = pack2(p[2 * h + 1][2], p[2 * h + 1][3]);
        const bf16x8 pb = __builtin_bit_cast(bf16x8, w);
#pragma unroll
        for (int n = 0; n < 4; ++n) o[n] = mfma16(f.v[n][h], pb, o[n]);
    }
}
template <bool FULL, class MaskFn>
__device__ __forceinline__ void softmax_step(const f32x4 (&s)[4], MaskFn mask, St& st, float (&p)[4][4], int fq) {
    float mx = -INFINITY; bool v[4][4];
#pragma unroll
    for (int kt = 0; kt < 4; ++kt)
#pragma unroll
        for (int j = 0; j < 4; ++j) {
            if (FULL) { v[kt][j] = true; mx = fmaxf(mx, s[kt][j]); }
            else { v[kt][j] = mask(KEY_OF(kt, j, fq)); mx = fmaxf(mx, v[kt][j] ? s[kt][j] : -INFINITY); }
        }
    mx = quad_max(mx);
    if (!__all(mx <= st.m)) {
        const float mn = fmaxf(st.m, mx), alpha = ex2(st.m - mn);
        st.l *= alpha; st.m = mn;
#pragma unroll
        for (int n = 0; n < 4; ++n) st.o[n] *= alpha;
    }
    float sum = 0.f;
#pragma unroll
    for (int kt = 0; kt < 4; ++kt)
#pragma unroll
        for (int j = 0; j < 4; ++j) { p[kt][j] = (FULL || v[kt][j]) ? ex2(s[kt][j] - st.m) : 0.f; sum += p[kt][j]; }
    st.l += sum;
}
template <bool PF = true, class AddrFn, class MaskFn, class FullFn>
__device__ __forceinline__ void attn_run(const bf16x8 (&qf)[2], int nsteps, AddrFn addr, size_t ldk, size_t ldv, MaskFn mask, FullFn full, St& st, int fr, int fq) {
    if (nsteps <= 0) return;
    const bf16_t* kp; const bf16_t* vp; addr(0, kp, vp);
    if (PF) {
        KF kc; load_k(kc, kp, ldk, fr, fq);
        for (int s = 0; s < nsteps; ++s) {
            VF vf; load_v(vf, vp, ldv, fr, fq);
            const bf16_t* kp2 = kp; const bf16_t* vp2 = vp;
            if (s + 1 < nsteps) addr(s + 1, kp2, vp2);
            KF kn; load_k(kn, kp2, ldk, fr, fq);
            f32x4 sc[4]; scores(kc, qf, sc);
            float p[4][4];
            if (full(s)) softmax_step<true>(sc, [&](int key) { return mask(s, key); }, st, p, fq); else softmax_step<false>(sc, [&](int key) { return mask(s, key); }, st, p, fq);
            pv(vf, p, st.o);
            kc = kn; kp = kp2; vp = vp2;
        }
    } else {
        for (int s = 0; s < nsteps; ++s) {
            addr(s, kp, vp);
            KF kc; load_k(kc, kp, ldk, fr, fq);
            VF vf; load_v(vf, vp, ldv, fr, fq);
            f32x4 sc[4]; scores(kc, qf, sc);
            float p[4][4];
            if (full(s)) softmax_step<true>(sc, [&](int key) { return mask(s, key); }, st, p, fq); else softmax_step<false>(sc, [&](int key) { return mask(s, key); }, st, p, fq);
            pv(vf, p, st.o);
        }
    }
}
__device__ __forceinline__ void st_part(bf16_t* p32, const f32x4 (&o)[4]) {
    uint4* q = (uint4*)p32;
    q[0] = make_uint4(pack2(o[0][0], o[0][1]), pack2(o[0][2], o[0][3]), pack2(o[1][0], o[1][1]), pack2(o[1][2], o[1][3]));
    q[1] = make_uint4(pack2(o[2][0], o[2][1]), pack2(o[2][2], o[2][3]), pack2(o[3][0], o[3][1]), pack2(o[3][2], o[3][3]));
}
__device__ __forceinline__ void acc_part(const bf16_t* p32, float c, f32x4 (&o)[4]) {
    const uint4 a = ((const uint4*)p32)[0], b = ((const uint4*)p32)[1];
    const unsigned w[8] = {a.x, a.y, a.z, a.w, b.x, b.y, b.z, b.w};
#pragma unroll
    for (int n = 0; n < 4; ++n) {
        o[n][0] += c * __uint_as_float(w[2 * n] << 16); o[n][1] += c * __uint_as_float(w[2 * n] & 0xFFFF0000u);
        o[n][2] += c * __uint_as_float(w[2 * n + 1] << 16); o[n][3] += c * __uint_as_float(w[2 * n + 1] & 0xFFFF0000u);
    }
}
__device__ __forceinline__ void store_o4(bf16_t* dst, float a, float b, float c, float d) { *(uint2*)dst = make_uint2(pack2(a, b), pack2(c, d)); }

struct Stager {
    size_t ko, vo, ldk32, ldv32; int tid;
    __device__ __forceinline__ void init(int tid_, size_t ldk, size_t ldv) {
        tid = tid_;
        const int row = tid >> 3, c = tid & 7;
        const int gk = ((tid >> 4) & 1) | (((tid >> 6) & 3) << 1), gv = (tid >> 4) & 7;
        ko = (size_t)row * ldk + (c ^ gk) * 8;
        vo = (size_t)row * ldv + (c ^ gv) * 8;
        ldk32 = 32 * ldk; ldv32 = 32 * ldv;
    }
    __device__ __forceinline__ void stage_k(char* buf, const bf16_t* kp) const { glds16(kp + ko, buf + tid * 16); glds16(kp + ko + ldk32, buf + 4096 + tid * 16); }
    __device__ __forceinline__ void stage_v(char* buf, const bf16_t* vp) const { glds16(vp + vo, buf + 8192 + tid * 16); glds16(vp + vo + ldv32, buf + 12288 + tid * 16); }
};
__device__ __forceinline__ void lds_k(KF& f, const char* buf, int lane) {
    const int fr = lane & 15, fq = lane >> 4;
    const int gk = ((fr >> 1) & 1) | (((fr >> 2) & 3) << 1);
    const char* base = buf + (8 * (fr >> 2) + (fr & 3)) * 128;
#pragma unroll
    for (int kt = 0; kt < 4; ++kt)
#pragma unroll
        for (int ks = 0; ks < 2; ++ks) f.k[kt][ks] = *(const bf16x8*)(base + (32 * (kt >> 1) + 4 * (kt & 1)) * 128 + (((ks * 4 + fq) ^ gk) * 16));
}
__device__ __forceinline__ void lds_v(VF& f, const char* buf, int lane) {
    const int fr = lane & 15, fq = lane >> 4;
    const int gv = (fr >> 1) & 7;
    const char* base = buf + 8192 + fr * 128;
#pragma unroll
    for (int n = 0; n < 4; ++n)
#pragma unroll
        for (int h = 0; h < 2; ++h) f.v[n][h] = *(const bf16x8*)(base + n * 16 * 128 + (((h * 4 + fq) ^ gv) * 16));
}
#define LDS_RING(s) ((s) % 3 * 16384)
template <class AddrFn, class MaskFn, class FullFn>
__device__ __forceinline__ void attn_run_lds(char* smem, const Stager& sg, const bf16x8 (&qf)[2], int nsteps, AddrFn addr, MaskFn mask, FullFn full, St& st, int lane, int fq) {
    if (nsteps <= 0) return;
    const bf16_t* kp; const bf16_t* vp;
    asm volatile("s_waitcnt vmcnt(0)" ::: "memory");
    addr(0, kp, vp); sg.stage_k(smem, kp); sg.stage_v(smem, vp);
    if (nsteps > 1) { addr(1, kp, vp); sg.stage_k(smem + 16384, kp); sg.stage_v(smem + 16384, vp); }
    for (int s = 0; s < nsteps; ++s) {
        const char* cur = smem + LDS_RING(s);
        if (s + 1 < nsteps) asm volatile("s_waitcnt vmcnt(4)" ::: "memory"); else asm volatile("s_waitcnt vmcnt(0)" ::: "memory");
        __builtin_amdgcn_s_barrier();
        asm volatile("" ::: "memory");
        if (s + 2 < nsteps) { addr(s + 2, kp, vp); char* nxt = smem + LDS_RING(s + 2); sg.stage_k(nxt, kp); sg.stage_v(nxt, vp); }
        KF kc; lds_k(kc, cur, lane);
        VF vf; lds_v(vf, cur, lane);
        f32x4 sc[4]; scores(kc, qf, sc);
        float p[4][4];
        if (full(s)) softmax_step<true>(sc, [&](int key) { return mask(s, key); }, st, p, fq); else softmax_step<false>(sc, [&](int key) { return mask(s, key); }, st, p, fq);
        pv(vf, p, st.o);
    }
    __syncthreads();
}

template <class AddrFn, class MaskFn, class FullFn>
__device__ __forceinline__ void attn_run_lds2(char* smem, const Stager& sg, const bf16x8 (&qf)[2][2], int nsteps, AddrFn addr, MaskFn mask, FullFn full, St (&st)[2], int lane, int fq) {
    if (nsteps <= 0) return;
    const bf16_t* kp; const bf16_t* vp;
    asm volatile("s_waitcnt vmcnt(0)" ::: "memory");
    addr(0, kp, vp); sg.stage_k(smem, kp); sg.stage_v(smem, vp);
    if (nsteps > 1) { addr(1, kp, vp); sg.stage_k(smem + 16384, kp); sg.stage_v(smem + 16384, vp); }
    for (int s = 0; s < nsteps; ++s) {
        const char* cur = smem + LDS_RING(s);
        if (s + 1 < nsteps) asm volatile("s_waitcnt vmcnt(4)" ::: "memory"); else asm volatile("s_waitcnt vmcnt(0)" ::: "memory");
        __builtin_amdgcn_s_barrier();
        asm volatile("" ::: "memory");
        if (s + 2 < nsteps) { addr(s + 2, kp, vp); char* nxt = smem + LDS_RING(s + 2); sg.stage_k(nxt, kp); sg.stage_v(nxt, vp); }
        KF kc; lds_k(kc, cur, lane);
        VF vf; lds_v(vf, cur, lane);
#pragma unroll
        for (int r = 0; r < 2; ++r) {
            f32x4 sc[4]; scores(kc, qf[r], sc);
            float p[4][4];
            if (full(r, s)) softmax_step<true>(sc, [&](int key) { return mask(r, s, key); }, st[r], p, fq); else softmax_step<false>(sc, [&](int key) { return mask(r, s, key); }, st[r], p, fq);
            pv(vf, p, st[r].o);
        }
    }
    __syncthreads();
}

__device__ __forceinline__ void ph_attn0(const Params& p, char* smem) {
    const bf16_t* Q = (const bf16_t*)(p.ws + OFF_QKV);
    const bf16_t* VT = (const bf16_t*)(p.ws + OFF_VT);
    bf16_t* O = (bf16_t*)(p.ws + OFF_O);
    const int tid = threadIdx.x, lane = tid & 63, wid = tid >> 6, fr = lane & 15, fq = lane >> 4;
    Stager sg; sg.init(tid, LDQ, VLD);
    for (int it = blockIdx.x; it < 2 * 2 * (SEQ / 32); it += gridDim.x) {
        const int tt = it % (SEQ / 32), hkv = (it / (SEQ / 32)) & 1, b = it / (2 * (SEQ / 32));
        const int head = hkv * 4 + wid, t0 = tt * 32;
        const size_t rowb = (size_t)b * SEQ;
        bf16x8 qf[2][2]; St st[2];
#pragma unroll
        for (int r = 0; r < 2; ++r) {
            const bf16_t* qp = Q + (rowb + t0 + 16 * r + fr) * LDQ + head * 64;
            qf[r][0] = ld8(qp + fq * 8); qf[r][1] = ld8(qp + 32 + fq * 8);
            st_init(st[r]);
            st[r].m = p.sinks0[head] * LOG2E; st[r].l = (fq == 0) ? 1.f : 0.f;
        }
        int k0 = t0 - 127; if (k0 < 0) k0 = 0; k0 &= ~63;
        const int ns = ((t0 + 31 - k0) >> 6) + 1;
        const bf16_t* kbase = Q + rowb * LDQ + 512 + hkv * 64;
        const bf16_t* vbase = VT + ((size_t)(b * NVH + hkv) * 64) * VLD;
        attn_run_lds2(smem, sg, qf, ns, [&](int s, const bf16_t*& kp, const bf16_t*& vp) { const int kb = k0 + 64 * s; kp = kbase + (size_t)kb * LDQ; vp = vbase + kb; },
                      [&](int r, int s, int key) { const int k = k0 + 64 * s + key, t = t0 + 16 * r + fr; return (k <= t) && (t - k < 128); },
                      [&](int r, int s) { const int kb = k0 + 64 * s, tb = t0 + 16 * r; return (kb + 63 <= tb) && (tb + 15 - kb < 128); }, st, lane, fq);
#pragma unroll
        for (int r = 0; r < 2; ++r) {
            const float inv = 1.0f / quad_sum(st[r].l);
#pragma unroll
            for (int n = 0; n < 4; ++n) store_o4(O + (rowb + t0 + 16 * r + fr) * DM + head * 64 + n * 16 + 4 * fq, st[r].o[n][0] * inv, st[r].o[n][1] * inv, st[r].o[n][2] * inv, st[r].o[n][3] * inv);
        }
    }
    int* vote = (int*)(smem + 49152);
    for (int it = blockIdx.x; it < 2 * 8 * (SEQ / 64); it += gridDim.x) {
        const int tt = it % (SEQ / 64), head = (it / (SEQ / 64)) & 7, b = it / (8 * (SEQ / 64));
        const int tb0 = tt * 64, t = tb0 + 16 * wid + fr;
        const size_t rowb = (size_t)b * SEQ;
        bf16x8 qf[2];
        qf[0] = ld8(Q + (rowb + t) * LDQ + 768 + head * 64 + fq * 8);
        qf[1] = ld8(Q + (rowb + t) * LDQ + 768 + head * 64 + 32 + fq * 8);
        f32x4 o[4];
#pragma unroll
        for (int n = 0; n < 4; ++n) o[n] = (f32x4){0.f, 0.f, 0.f, 0.f};
        float R = 0.f;
        const bf16_t* kbase = Q + rowb * LDQ + 1280 + head * 64;
        const bf16_t* vbase = VT + ((size_t)(b * NVH + 2 + head) * 64) * VLD;
        const int nsteps = tt + 1;
        if (tid < 8) vote[tid] = 0;
        asm volatile("s_waitcnt vmcnt(0)" ::: "memory");
        sg.stage_k(smem, kbase + (size_t)tb0 * LDQ); sg.stage_v(smem, vbase + tb0);
        if (nsteps > 1) { sg.stage_k(smem + 16384, kbase + (size_t)(tb0 - 64) * LDQ); sg.stage_v(smem + 16384, vbase + tb0 - 64); }
        bool mine_done = false;
        for (int s = 0; s < nsteps; ++s) {
            const char* cur = smem + LDS_RING(s);
            const int kb = tb0 - 64 * s;
            if (s + 1 < nsteps) asm volatile("s_waitcnt vmcnt(4)" ::: "memory"); else asm volatile("s_waitcnt vmcnt(0)" ::: "memory");
            lds_fence();
            __builtin_amdgcn_s_barrier();
            asm volatile("" ::: "memory");
            if (s > 0) { const int* vv = vote + ((s - 1) & 1) * 4; if ((vv[0] & vv[1] & vv[2] & vv[3]) != 0) break; }
            if (s + 2 < nsteps) { char* nxt = smem + LDS_RING(s + 2); sg.stage_k(nxt, kbase + (size_t)(kb - 128) * LDQ); sg.stage_v(nxt, vbase + kb - 128); }
            if (!mine_done) {
                KF kc; lds_k(kc, cur, lane);
                VF vf; lds_v(vf, cur, lane);
                f32x4 sc[4]; scores(kc, qf, sc);
                float w4[4][4], ex[4][4], lsg[4][4];
                float T[2];
#pragma unroll
                for (int h = 0; h < 2; ++h) {
                    float run = 0.f;
#pragma unroll
                    for (int q = 1; q >= 0; --q) {
                        const int kt = 2 * h + q;
#pragma unroll
                        for (int j = 3; j >= 0; --j) {
                            const float z = sc[kt][j];
                            const bool v = (kb + KEY_OF(kt, j, fq)) < t;
                            const float sp = fmaxf(z, 0.f) + __logf(1.0f + __expf(-fabsf(z)));
                            ex[kt][j] = run;
                            lsg[kt][j] = v ? (z - sp) : -INFINITY;
                            run += v ? -sp : 0.f;
                        }
                    }
                    T[h] = run;
                }
                float E[2], Tot[2];
#pragma unroll
                for (int h = 0; h < 2; ++h) {
                    const float a0 = __shfl(T[h], fr), a1 = __shfl(T[h], fr + 16), a2 = __shfl(T[h], fr + 32), a3 = __shfl(T[h], fr + 48);
                    Tot[h] = (a0 + a1) + (a2 + a3);
                    E[h] = (fq < 1 ? a1 : 0.f) + (fq < 2 ? a2 : 0.f) + (fq < 3 ? a3 : 0.f);
                }
#pragma unroll
                for (int kt = 0; kt < 4; ++kt) {
                    const float off = (kt >> 1) ? (R + E[1]) : (R + Tot[1] + E[0]);
#pragma unroll
                    for (int j = 0; j < 4; ++j) w4[kt][j] = __expf(lsg[kt][j] + off + ex[kt][j]);
                }
                R += Tot[0] + Tot[1];
                pv(vf, w4, o);
                if (__all(R < -104.f)) mine_done = true;
            }
            if (lane == 0) vote[(s & 1) * 4 + wid] = mine_done ? 1 : 0;
        }
        asm volatile("s_waitcnt vmcnt(0)" ::: "memory");
        __syncthreads();
#pragma unroll
        for (int n = 0; n < 4; ++n) store_o4(O + (rowb + t) * DM + 512 + head * 64 + n * 16 + 4 * fq, o[n][0], o[n][1], o[n][2], o[n][3]);
    }
}

__device__ __forceinline__ void ph_kmean(const Params& p) {
    const bf16_t* Q = (const bf16_t*)(p.ws + OFF_QKV);
    float* KM = (float*)(p.ws + B_KMEAN);
    const int lane = threadIdx.x & 63, wid = threadIdx.x >> 6;
    const int c = lane & 7, r = lane >> 3;
    const int nw = gridDim.x * 4, w0 = ((blockIdx.x + gridDim.x - (gridDim.x > 128 ? 128 : 0)) % gridDim.x) * 4 + wid;
    for (int wi = w0; wi < 256; wi += nw) {
        const int hkv = wi & 1, j = (wi >> 1) & 63, b = wi >> 7;
        const bf16_t* base = Q + ((size_t)b * SEQ + j * 256 + r) * LDQ + 512 + hkv * 64 + c * 8;
        float acc[8] = {0.f, 0.f, 0.f, 0.f, 0.f, 0.f, 0.f, 0.f};
#pragma unroll 8
        for (int i = 0; i < 32; ++i) {
            const bf16x8 v = ld8(base + (size_t)(8 * i) * LDQ);
#pragma unroll
            for (int e = 0; e < 8; ++e) acc[e] += bf2f((bf16_t)v[e]);
        }
#pragma unroll
        for (int e = 0; e < 8; ++e) { float a = acc[e]; a += __shfl_xor(a, 8); a += __shfl_xor(a, 16); a += __shfl_xor(a, 32); acc[e] = a; }
        if (r == 0) {
            float* o = KM + ((b * 64 + j) * 2 + hkv) * 64 + c * 8;
            *(float4*)o = make_float4(acc[0] * (1.0f / 256.0f), acc[1] * (1.0f / 256.0f), acc[2] * (1.0f / 256.0f), acc[3] * (1.0f / 256.0f));
            *(float4*)(o + 4) = make_float4(acc[4] * (1.0f / 256.0f), acc[5] * (1.0f / 256.0f), acc[6] * (1.0f / 256.0f), acc[7] * (1.0f / 256.0f));
        }
    }
}
__device__ __forceinline__ size_t moba_list_off(int L, int j) { return (size_t)L * MOBA_LCAP + 1024ull * (size_t)(63 * j - (j * (j - 1)) / 2); }

__device__ __forceinline__ void ph_moba_gate(const Params& p, char* smem) {
    float* km = (float*)smem;
    int* cnt = (int*)(smem + 16384);
    int* gbase = cnt + 64;
    const bf16_t* Q = (const bf16_t*)(p.ws + OFF_QKV);
    const float* KM = (const float*)(p.ws + B_KMEAN);
    int* gcnt = (int*)(p.ws + OFF_MOBACNT);
    int* lists = (int*)(p.ws + B_LIST);
    const int tid = threadIdx.x;
    for (int it = blockIdx.x; it < 1024; it += gridDim.x) {
        const int tc = it & 255, hkv = (it >> 8) & 1, b = it >> 9, LL = b * 2 + hkv;
        const int tl = tc * 64 + (tid >> 2), g = tid & 3, own = tl >> 8;
        for (int i = tid; i < 64 * 64; i += 256) { const int j = i >> 6, d = i & 63; km[i] = KM[((b * 64 + j) * 2 + hkv) * 64 + d]; }
        if (tid < 64) cnt[tid] = 0;
        __syncthreads();
        float q[64];
        {
            const bf16_t* qp = Q + ((size_t)b * SEQ + tl) * LDQ + (hkv * 4 + g) * 64;
#pragma unroll
            for (int i = 0; i < 8; ++i) { const bf16x8 v = ld8(qp + i * 8);
#pragma unroll
                for (int e = 0; e < 8; ++e) q[i * 8 + e] = bf2f((bf16_t)v[e]); }
        }
        float bv0 = -INFINITY, bv1 = -INFINITY, bv2 = -INFINITY; int bi0 = 0, bi1 = 1, bi2 = 2;
        for (int j = 0; j < own; ++j) {
            float s = 0.f;
#pragma unroll
            for (int d = 0; d < 64; d += 4) { const float4 k = *(const float4*)(km + j * 64 + d); s += q[d] * k.x; s += q[d + 1] * k.y; s += q[d + 2] * k.z; s += q[d + 3] * k.w; }
            if (s > bv0) { bv2 = bv1; bi2 = bi1; bv1 = bv0; bi1 = bi0; bv0 = s; bi0 = j; }
            else if (s > bv1) { bv2 = bv1; bi2 = bi1; bv1 = s; bi1 = j; }
            else if (s > bv2) { bv2 = s; bi2 = j; }
        }
        const int nv = own < 3 ? own : 3;
        int rk0 = 0, rk1 = 0, rk2 = 0;
        if (nv > 0) rk0 = atomicAdd(&cnt[bi0], 1);
        if (nv > 1) rk1 = atomicAdd(&cnt[bi1], 1);
        if (nv > 2) rk2 = atomicAdd(&cnt[bi2], 1);
        __syncthreads();
        if (tid < 64 && cnt[tid] > 0) gbase[tid] = atomicAdd(&gcnt[(LL * 64 + tid) * CNTS], cnt[tid]);
        __syncthreads();
        const int ent = tl | (g << 14);
        if (nv > 0) lists[moba_list_off(LL, bi0) + gbase[bi0] + rk0] = ent | (0 << 16);
        if (nv > 1) lists[moba_list_off(LL, bi1) + gbase[bi1] + rk1] = ent | (1 << 16);
        if (nv > 2) lists[moba_list_off(LL, bi2) + gbase[bi2] + rk2] = ent | (2 << 16);
        __syncthreads();
    }
}

__device__ __forceinline__ void ph_moba_part(const Params& p, char* smem) {
    int* cpre = (int*)(smem + 49152);
    const bf16_t* Q = (const bf16_t*)(p.ws + OFF_QKV);
    const bf16_t* VT = (const bf16_t*)(p.ws + OFF_VT);
    const int* gcnt = (const int*)(p.ws + OFF_MOBACNT);
    const int* lists = (const int*)(p.ws + B_LIST);
    bf16_t* PO = (bf16_t*)(p.ws + B_PO); float* PML = (float*)(p.ws + B_PML);
    const int tid = threadIdx.x, lane = tid & 63, wid = tid >> 6, fr = lane & 15, fq = lane >> 4;
    Stager sg; sg.init(tid, LDQ, VLD);
    cpre[tid + 1] = (gcnt[tid * CNTS] + 127) >> 7;
    if (tid == 0) cpre[0] = 0;
    __syncthreads();
    if (tid == 0) { int acc = 0; for (int i = 1; i <= 256; ++i) { acc += cpre[i]; cpre[i] = acc; } }
    __syncthreads();
    const int total = cpre[256];
    for (int it = blockIdx.x; it < total; it += gridDim.x) {
        int li;
        { int lo = 0, hi = 255; while (lo < hi) { const int mid = (lo + hi + 1) >> 1; if (cpre[mid] <= it) lo = mid; else hi = mid - 1; } li = lo; }
        const int chunk = it - cpre[li], LL = li >> 6, j = li & 63, b = LL >> 1, hkv = LL & 1, n = gcnt[li * CNTS];
        const int* lst = lists + moba_list_off(LL, j);
        int ent[2]; bf16x8 qf[2][2]; St st[2];
#pragma unroll
        for (int r = 0; r < 2; ++r) {
            const int ri = chunk * 128 + r * 64 + wid * 16 + fr;
            ent[r] = lst[ri < n ? ri : n - 1];
            const bf16_t* qp = Q + ((size_t)b * SEQ + (ent[r] & 16383)) * LDQ + (hkv * 4 + ((ent[r] >> 14) & 3)) * 64;
            qf[r][0] = ld8(qp + fq * 8); qf[r][1] = ld8(qp + 32 + fq * 8);
            st_init(st[r]);
        }
        const bf16_t* kbase = Q + ((size_t)b * SEQ + j * 256) * LDQ + 512 + hkv * 64;
        const bf16_t* vbase = VT + ((size_t)(b * NVH + hkv) * 64) * VLD + j * 256;
        attn_run_lds2(smem, sg, qf, 4, [&](int s, const bf16_t*& kp, const bf16_t*& vp) { kp = kbase + (size_t)(64 * s) * LDQ; vp = vbase + 64 * s; },
                      [](int, int, int) { return true; }, [](int, int) { return true; }, st, lane, fq);
#pragma unroll
        for (int r = 0; r < 2; ++r) {
            const int ri = chunk * 128 + r * 64 + wid * 16 + fr;
            const float l = quad_sum(st[r].l);
            if (ri < n) {
                const int e = ent[r];
                const size_t idx = ((size_t)((size_t)b * SEQ + (e & 16383)) * 8 + hkv * 4 + ((e >> 14) & 3)) * 3 + ((e >> 16) & 3);
                st_part(PO + idx * 64 + fq * 16, st[r].o);
                if (fq == 0) { PML[idx * 2] = st[r].m; PML[idx * 2 + 1] = l; }
            }
        }
    }
}

__device__ __forceinline__ void ph_moba_own(const Params& p, char* smem) {
    const bf16_t* Q = (const bf16_t*)(p.ws + OFF_QKV);
    const bf16_t* VT = (const bf16_t*)(p.ws + OFF_VT);
    const bf16_t* PO = (const bf16_t*)(p.ws + B_PO); const float* PML = (const float*)(p.ws + B_PML);
    bf16_t* O = (bf16_t*)(p.ws + OFF_O);
    const int tid = threadIdx.x, lane = tid & 63, wid = tid >> 6, fr = lane & 15, fq = lane >> 4;
    Stager sg; sg.init(tid, LDQ, VLD);
    for (int it = blockIdx.x; it < 2 * 2 * (SEQ / 32); it += gridDim.x) {
        const int hb = it / (SEQ / 32), tt = (it % (SEQ / 32) + 3 * hb) % (SEQ / 32), hkv = hb & 1, b = hb >> 1;
        const int head = hkv * 4 + wid, t0 = tt * 32, own = t0 >> 8;
        const size_t rowb = (size_t)b * SEQ;
        bf16x8 qf[2][2]; St st[2];
#pragma unroll
        for (int r = 0; r < 2; ++r) {
            const bf16_t* qp = Q + (rowb + t0 + 16 * r + fr) * LDQ + head * 64;
            qf[r][0] = ld8(qp + fq * 8); qf[r][1] = ld8(qp + 32 + fq * 8);
            st_init(st[r]);
        }
        const int k0 = own * 256, ns = ((t0 + 31 - k0) >> 6) + 1;
        const bf16_t* kbase = Q + rowb * LDQ + 512 + hkv * 64;
        const bf16_t* vbase = VT + ((size_t)(b * NVH + hkv) * 64) * VLD;
        attn_run_lds2(smem, sg, qf, ns, [&](int s, const bf16_t*& kp, const bf16_t*& vp) { const int kb = k0 + 64 * s; kp = kbase + (size_t)kb * LDQ; vp = vbase + kb; },
                      [&](int r, int s, int key) { return (k0 + 64 * s + key) <= (t0 + 16 * r + fr); },
                      [&](int r, int s) { return (k0 + 64 * s + 63) <= (t0 + 16 * r); }, st, lane, fq);
        const int nv = own < 3 ? own : 3;
#pragma unroll
        for (int r = 0; r < 2; ++r) {
            const int t = t0 + 16 * r + fr;
            float l = quad_sum(st[r].l), m = st[r].m;
            for (int q = 0; q < nv; ++q) {
                const size_t idx = ((size_t)(rowb + t) * 8 + head) * 3 + q;
                const float mr = PML[idx * 2], lr = PML[idx * 2 + 1];
                const float mn = fmaxf(m, mr), a = ex2(m - mn), c = ex2(mr - mn);
#pragma unroll
                for (int n = 0; n < 4; ++n) st[r].o[n] *= a;
                acc_part(PO + idx * 64 + fq * 16, c, st[r].o);
                l = l * a + c * lr; m = mn;
            }
            const float inv = 1.0f / l;
#pragma unroll
            for (int n = 0; n < 4; ++n) store_o4(O + (rowb + t) * DM + head * 64 + n * 16 + 4 * fq, st[r].o[n][0] * inv, st[r].o[n][1] * inv, st[r].o[n][2] * inv, st[r].o[n][3] * inv);
        }
    }
}

__device__ __forceinline__ float gelu_tanh(float x) {
    const float u = 0.7978845608028654f * (x + 0.044715f * x * x * x);
    const float e = __expf(2.0f * u);
    const float th = 1.0f - 2.0f / (e + 1.0f);
    return 0.5f * x * (1.0f + th);
}
__device__ __forceinline__ void ph_cmp1(const Params& p, char* smem) {
    const bf16_t* Q = (const bf16_t*)(p.ws + OFF_QKV);
    const int tid = hidden_tid();
    for (int it = blockIdx.x; it < 128; it += gridDim.x) {
        const int kv = it >> 6, mt = (it >> 1) & 31, nt = it & 1;
        const int col = kv ? 1408 : 1280;
        const bf16_t* Bt = (const bf16_t*)(p.ws + (kv ? W_V1 : W_K1));
        const float* bias = (const float*)(p.ws + (kv ? W_BV : W_BK));
        bf16_t* HID = (bf16_t*)(p.ws + (kv ? B_HIDV : B_HIDK));
        const bf16_t* ap[4];
#pragma unroll
        for (int i = 0; i < 4; ++i) {
            const int r = mt * 128 + i * 32 + (tid >> 3);
            const int h = r & 1, bc = r >> 1, c = bc & 1023, b = bc >> 10;
            const int cc = (c < NCMP) ? c : 0;
            ap[i] = Q + ((size_t)b * SEQ + 16 * cc) * LDQ + col + h * 64 + GSW64(tid);
        }
        const bf16_t* b0 = Bt + (size_t)(nt * 128 + (tid >> 3)) * 2048 + GSW64(tid);
        gemm_tile_k64(smem, tid, ap, b0, (size_t)32 * 2048, 32, [](int t) { return (size_t)t * LDQ; },
            [&](f32x4 (&acc)[4][4], int wr, int wc, int fr, int fq) {
#pragma unroll
                for (int m = 0; m < 4; ++m)
#pragma unroll
                    for (int j = 0; j < 4; ++j) {
                        const int r = mt * 128 + wr * 64 + m * 16 + fq * 4 + j;
#pragma unroll
                        for (int n = 0; n < 4; ++n) { const int cn = nt * 128 + wc * 64 + n * 16 + fr; HID[(size_t)r * 256 + cn] = f2bf(gelu_tanh(acc[m][n][j] + bias[cn])); }
                    }
            });
    }
}
__device__ __forceinline__ void ph_cmp2(const Params& p, char* smem) {
    const int tid = threadIdx.x;
    for (int it = blockIdx.x; it < 64; it += gridDim.x) {
        const int kv = it >> 5, mt = it & 31;
        const bf16_t* A = (const bf16_t*)(p.ws + (kv ? B_HIDV : B_HIDK));
        const bf16_t* Bt = (const bf16_t*)(p.ws + (kv ? W_V2 : W_K2));
        bf16_t* KC = (bf16_t*)(p.ws + B_KCMP); bf16_t* VC = (bf16_t*)(p.ws + B_VCMPT);
        const bf16_t* a0 = A + (size_t)(mt * 128 + (tid >> 2)) * 256 + GSW(tid);
        const bf16_t* a1 = a0 + (size_t)64 * 256;
        const bf16_t* b0 = Bt + (size_t)(tid >> 2) * 256 + GSW(tid);
        const bf16_t* b1 = b0 + (size_t)64 * 256;
        gemm_tile(smem, a0, a1, b0, b1, 8, [](int t) { return (size_t)t * 32; },
            [&](f32x4 (&acc)[4][4], int wr, int wc, int fr, int fq) {
                if (wc != 0) return;
#pragma unroll
                for (int m = 0; m < 4; ++m)
#pragma unroll
                    for (int j = 0; j < 4; ++j) {
                        const int r = mt * 128 + wr * 64 + m * 16 + fq * 4 + j;
                        const int h = r & 1, bc = r >> 1, c = bc & 1023, b = bc >> 10;
                        const bool ok = c < NCMP;
#pragma unroll
                        for (int n = 0; n < 4; ++n) {
                            const int d = n * 16 + fr;
                            const bf16_t v = ok ? f2bf(acc[m][n][j]) : (bf16_t)0;
                            if (kv == 0) KC[((size_t)(b * 2 + h) * 1024 + c) * 64 + d] = v;
                            else VC[((size_t)(b * 2 + h) * 64 + d) * CLD + c] = v;
                        }
                    }
            });
    }
}

#ifndef PROBE_NSA
#define PROBE_NSA 0
#endif
#define NSA_T(i) if (PROBE_NSA) { const unsigned long long _n = clock64(); tsec[i] += _n - tprev; tprev = _n; }
__device__ __forceinline__ size_t nsa_list_off(int LL, int j) { return (size_t)LL * NSA_LCAP + 64ull * (size_t)(254 * j - (j * (j - 1)) / 2); }
__device__ __forceinline__ char* nsa_part_ptr(char* ws, int LL, int t, int slot) {
    const size_t rec = ((size_t)((LL & 1) * SEQ + t) * 13 + slot) * 544;
    return ws + ((LL >> 1) ? NSA_PY : NSA_PX) + rec;
}
struct NsaIter { bool aff; int xcd, i0, istr, icnt; };
__device__ __forceinline__ NsaIter nsa_iter() {
    NsaIter it; it.aff = (gridDim.x & 7) == 0; it.xcd = blockIdx.x & 7;
    it.i0 = it.aff ? (blockIdx.x >> 3) : blockIdx.x;
    it.istr = it.aff ? (gridDim.x >> 3) : gridDim.x;
    it.icnt = it.aff ? 512 : 4096;
    return it;
}

__device__ __forceinline__ void ph_nsa1(const Params& p, char* smem) {
    unsigned long long tsec[5] = {0, 0, 0, 0, 0}, tprev = 0;
    if (PROBE_NSA) tprev = clock64();
    const bf16_t* Q = (const bf16_t*)(p.ws + OFF_QKV);
    const bf16_t* VT = (const bf16_t*)(p.ws + OFF_VT);
    const bf16_t* KC = (const bf16_t*)(p.ws + B_KCMP); const bf16_t* VC = (const bf16_t*)(p.ws + B_VCMPT);
    const float* GD = (const float*)(p.ws + B_GD);
    bf16_t* O = (bf16_t*)(p.ws + OFF_O);
    unsigned char* SID = (unsigned char*)(p.ws + M_SELID);
    int* gcnt = (int*)(p.ws + OFF_NSACNT);
    unsigned short* lists = (unsigned short*)(p.ws + NSA_LISTS);
    const int tid = threadIdx.x, lane = tid & 63, wid = tid >> 6, fr = lane & 15, fq = lane >> 4;
    float* imp = (float*)(smem + 49152 + wid * 5376);
    int* selq = (int*)(smem + 49152 + wid * 5376 + 4096);
    int* sc = (int*)(smem + 49152 + wid * 5376 + 4352);
    const int qi_l = fr >> 2, g_l = fr & 3;
    Stager sgc; sgc.init(tid, 64, CLD);
    Stager sgw; sgw.init(tid, LDQ, VLD);
    const NsaIter itr = nsa_iter();
    for (int ii = itr.i0; ii < itr.icnt; ii += itr.istr) {
        const int LL = itr.aff ? (itr.xcd & 3) : (ii >> 10);
        const int tqb = itr.aff ? (2 * ii + (itr.xcd >> 2)) : (ii & 1023);
        const int b = LL >> 1, hkv = LL & 1;
        const int tb0 = tqb * 16, t0 = tb0 + wid * 4, t = t0 + qi_l;
        const size_t rowb = (size_t)b * SEQ;
        bf16x8 qf[2];
        {
            const bf16_t* qp = Q + (rowb + t) * LDQ + 768 + (hkv * 4 + g_l) * 64;
            qf[0] = ld8(qp + fq * 8); qf[1] = ld8(qp + 32 + fq * 8);
        }
        const float* gp = GD + (rowb + t) * 24 + (hkv * 4 + g_l) * 3;
        f32x4 outa[4];
#pragma unroll
        for (int n = 0; n < 4; ++n) outa[n] = (f32x4){0.f, 0.f, 0.f, 0.f};
        const bf16_t* kc = KC + (size_t)LL * 1024 * 64;
        const bf16_t* vc = VC + (size_t)LL * 64 * CLD;
        const int cN = (tb0 + 15 >= 31) ? ((tb0 + 15 - 31) >> 4) + 1 : 0;
        const int csteps = (cN + 63) >> 6;
        float m1 = NEG_BIG, l1 = 0.f;
        if (csteps > 0) {
            const int cs2 = (csteps + 1) >> 1;
            auto stage2 = [&](int s2, char* buf) {
                const int ta = 2 * s2, tb = (2 * s2 + 1 < 16) ? 2 * s2 + 1 : 15;
                sgc.stage_k(buf, kc + (size_t)ta * 64 * 64); sgc.stage_k(buf + 8192, kc + (size_t)tb * 64 * 64);
            };
            asm volatile("s_waitcnt vmcnt(0)" ::: "memory");
            stage2(0, smem);
            if (cs2 > 1) stage2(1, smem + 16384);
            for (int s = 0; s < cs2; ++s) {
                const char* cur = smem + LDS_RING(s);
                if (s + 1 < cs2) asm volatile("s_waitcnt vmcnt(4)" ::: "memory"); else asm volatile("s_waitcnt vmcnt(0)" ::: "memory");
                __builtin_amdgcn_s_barrier();
                asm volatile("" ::: "memory");
                if (s + 2 < cs2) stage2(s + 2, smem + LDS_RING(s + 2));
                float mx = -INFINITY;
                f32x4 sc[2][4];
#pragma unroll
                for (int u = 0; u < 2; ++u) {
                    KF kcur; lds_k(kcur, cur + u * 8192, lane);
                    scores(kcur, qf, sc[u]);
#pragma unroll
                    for (int kt = 0; kt < 4; ++kt)
#pragma unroll
                        for (int j = 0; j < 4; ++j) { const bool v = (16 * ((2 * s + u) * 64 + KEY_OF(kt, j, fq)) + 31) <= t; mx = fmaxf(mx, v ? sc[u][kt][j] : -INFINITY); }
                }
                mx = quad_max(mx);
                const float mn = fmaxf(m1, mx);
                float sum = 0.f;
#pragma unroll
                for (int u = 0; u < 2; ++u)
#pragma unroll
                    for (int kt = 0; kt < 4; ++kt)
#pragma unroll
                        for (int j = 0; j < 4; ++j) { const bool v = (16 * ((2 * s + u) * 64 + KEY_OF(kt, j, fq)) + 31) <= t; sum += v ? ex2(sc[u][kt][j] - mn) : 0.f; }
                l1 = l1 * ex2(m1 - mn) + sum; m1 = mn;
            }
            __syncthreads();
        }
        NSA_T(0)
        const float ltot = quad_sum(l1), il = ltot > 0.f ? 1.0f / ltot : 0.f;
        for (int i = lane; i < 1024; i += 64) imp[i] = 0.f;
        lds_fence();
        if (csteps > 0) {
            f32x4 oc[4];
#pragma unroll
            for (int n = 0; n < 4; ++n) oc[n] = (f32x4){0.f, 0.f, 0.f, 0.f};
            asm volatile("s_waitcnt vmcnt(0)" ::: "memory");
            sgc.stage_k(smem, kc); sgc.stage_v(smem, vc);
            if (csteps > 1) { sgc.stage_k(smem + 16384, kc + (size_t)64 * 64); sgc.stage_v(smem + 16384, vc + 64); }
            for (int s = 0; s < csteps; ++s) {
                const char* cur = smem + LDS_RING(s);
                if (s + 1 < csteps) asm volatile("s_waitcnt vmcnt(4)" ::: "memory"); else asm volatile("s_waitcnt vmcnt(0)" ::: "memory");
                __builtin_amdgcn_s_barrier();
                asm volatile("" ::: "memory");
                if (s + 2 < csteps) { char* nxt = smem + LDS_RING(s + 2); sgc.stage_k(nxt, kc + (size_t)(s + 2) * 64 * 64); sgc.stage_v(nxt, vc + (s + 2) * 64); }
                KF kcur; lds_k(kcur, cur, lane);
                VF vf; lds_v(vf, cur, lane);
                f32x4 sc[4]; scores(kcur, qf, sc);
                float pp[4][4], ps[4], cy[4];
#pragma unroll
                for (int kt = 0; kt < 4; ++kt) {
                    float a = 0.f;
#pragma unroll
                    for (int j = 0; j < 4; ++j) { const bool v = (16 * (s * 64 + KEY_OF(kt, j, fq)) + 31) <= t; pp[kt][j] = v ? ex2(sc[kt][j] - m1) * il : 0.f; a += pp[kt][j]; }
                    float c = pp[kt][3];
                    a += __shfl_xor(a, 1); a += __shfl_xor(a, 2);
                    c += __shfl_xor(c, 1); c += __shfl_xor(c, 2);
                    ps[kt] = a; cy[kt] = c;
                }
                if (g_l == 0) {
#pragma unroll
                    for (int kt = 0; kt < 4; ++kt) imp[qi_l * 256 + s * 16 + 8 * (kt >> 1) + 2 * fq + (kt & 1)] += ps[kt];
                }
                lds_fence();
                if (g_l == 0) {
#pragma unroll
                    for (int kt = 0; kt < 4; ++kt) { const int a1 = s * 16 + 8 * (kt >> 1) + 2 * fq + (kt & 1) + 1; if (a1 < 256) imp[qi_l * 256 + a1] += cy[kt]; }
                }
                lds_fence();
                pv(vf, pp, oc);
            }
            __syncthreads();
            { const float gc = 1.0f / (1.0f + __expf(-gp[0]));
#pragma unroll
            for (int n = 0; n < 4; ++n) outa[n] += oc[n] * gc; }
        }
        NSA_T(1)
        for (int qi = 0; qi < 4; ++qi) {
            const int cur = (t0 + qi) >> 6;
            int* ib = (int*)imp + qi * 256;
            if (lane == 0) ib[0] = -1;
            const int js = cur - 1 + (lane - 1);
            if (lane >= 1 && lane < 5 && js >= 0 && js < 256) ib[js] = -1;
        }
        lds_fence();
#pragma unroll 1
        for (int qi = 0; qi < 4; ++qi) {
            const int tt = t0 + qi, cur = tt >> 6;
            const int* ib = (const int*)imp + qi * 256;
            const int nforced = cur == 0 ? 1 : (cur == 1 ? 2 : 3);
            const int ncand = cur - 2 > 0 ? cur - 2 : 0;
            const int K = (16 - nforced) < ncand ? (16 - nforced) : ncand;
            int bi[4]; bool cand[4];
#pragma unroll
            for (int k = 0; k < 4; ++k) {
                const int i = lane + 64 * k;
                cand[k] = (i >= 1) && (i <= cur - 2);
                bi[k] = cand[k] ? ib[i] : -1;
            }
            bool done = false;
            if (K < ncand) {
                const int mloc = max(max(bi[0], bi[1]), max(bi[2], bi[3]));
                sc[lane] = mloc;
                lds_fence();
                int cnt = 0;
#pragma unroll 2
                for (int l4 = 0; l4 < 64; l4 += 4) {
                    const int4 v = *(const int4*)(sc + l4);
                    cnt += (v.x > mloc - ((l4 + 0) < lane ? 1 : 0)) ? 1 : 0; cnt += (v.y > mloc - ((l4 + 1) < lane ? 1 : 0)) ? 1 : 0;
                    cnt += (v.z > mloc - ((l4 + 2) < lane ? 1 : 0)) ? 1 : 0; cnt += (v.w > mloc - ((l4 + 3) < lane ? 1 : 0)) ? 1 : 0;
                }
                const unsigned long long mkk = __ballot(cnt == K - 1);
                const int tau = __builtin_amdgcn_readlane(mloc, __builtin_amdgcn_readfirstlane((int)__ffsll((long long)mkk) - 1));
                int ns = 0;
#pragma unroll
                for (int k = 0; k < 4; ++k) {
                    const bool sv = cand[k] && (bi[k] >= tau);
                    const unsigned long long mk = __ballot(sv);
                    const int pos = ns + __popcll(mk & ((1ull << lane) - 1ull));
                    if (sv && pos < 64) { sc[64 + pos] = bi[k]; sc[128 + pos] = lane + 64 * k; }
                    ns += __popcll(mk);
                }
                lds_fence();
                if (ns <= 64) {
                    const int my = sc[64 + (lane < ns ? lane : 0)], myi = sc[128 + (lane < ns ? lane : 0)];
                    int rk = 0;
                    const int ns4 = __builtin_amdgcn_readfirstlane(ns) & ~3;
                    for (int j = 0; j < ns4; j += 4) {
                        const int4 vj = *(const int4*)(sc + 64 + j), ij = *(const int4*)(sc + 128 + j);
                        rk += ((vj.x > my) || (vj.x == my && ij.x < myi)) ? 1 : 0; rk += ((vj.y > my) || (vj.y == my && ij.y < myi)) ? 1 : 0;
                        rk += ((vj.z > my) || (vj.z == my && ij.z < myi)) ? 1 : 0; rk += ((vj.w > my) || (vj.w == my && ij.w < myi)) ? 1 : 0;
                    }
                    for (int j = ns4; j < ns; ++j) { const int vj = sc[64 + j], ij = sc[128 + j]; rk += ((vj > my) || (vj == my && ij < myi)) ? 1 : 0; }
                    if (lane < ns && rk < K) selq[qi * 13 + rk] = myi;
                    done = true;
                }
                lds_fence();
            }
            if (!done) {
                int rank[4] = {0, 0, 0, 0};
                if (K < ncand) {
                    const int jend = __builtin_amdgcn_readfirstlane(cur - 1);
                    for (int j4 = 0; j4 < jend; j4 += 4) {
                        const int4 v = *(const int4*)(ib + j4);
                        const int vv[4] = {v.x, v.y, v.z, v.w};
#pragma unroll
                        for (int k = 0; k < 4; ++k)
#pragma unroll
                            for (int e = 0; e < 4; ++e) rank[k] += (vv[e] > bi[k] - ((j4 + e) < (lane + 64 * k) ? 1 : 0)) ? 1 : 0;
                    }
                }
                int off = 0;
#pragma unroll
                for (int i = 0; i < 4; ++i) {
                    const bool sb = cand[i] && (rank[i] < K);
                    const unsigned long long mk = __ballot(sb);
                    if (sb) selq[qi * 13 + off + __popcll(mk & ((1ull << lane) - 1ull))] = lane + 64 * i;
                    off += __popcll(mk);
                }
            }
            if (lane == 0) selq[52 + qi] = K;
        }
        lds_fence();
        NSA_T(2)
        if (lane < 52) {
            const int qi = lane / 13, slot = lane - qi * 13, tt = t0 + qi;
            if (slot < selq[52 + qi]) {
                const int jb = selq[lane];
                SID[((size_t)LL * SEQ + tt) * 16 + slot] = (unsigned char)jb;
                const int pos = atomicAdd(&gcnt[(LL * 256 + jb) * CNTS], 1);
                lists[nsa_list_off(LL, jb) + pos] = (unsigned short)tt;
            }
        } else if (lane < 56) {
            SID[((size_t)LL * SEQ + t0 + (lane - 52)) * 16 + 15] = (unsigned char)selq[lane];
        }
        lds_fence();
        NSA_T(3)
        {
            St st; st_init(st);
            bf16x8 qw[2];
            { const bf16_t* qp = Q + (rowb + t) * LDQ + 768 + (hkv * 4 + g_l) * 64; qw[0] = ld8(qp + fq * 8); qw[1] = ld8(qp + 32 + fq * 8); }
            int k0 = tb0 - 511; if (k0 < 0) k0 = 0; k0 &= ~63;
            const int nw = ((tb0 + 15 - k0) >> 6) + 1;
            const bf16_t* kbase = Q + rowb * LDQ + 1792 + hkv * 64;
            const bf16_t* vbase = VT + ((size_t)(b * NVH + 4 + hkv) * 64) * VLD;
            attn_run_lds(smem, sgw, qw, nw, [&](int s, const bf16_t*& kp, const bf16_t*& vp) { const int kb = k0 + 64 * s; kp = kbase + (size_t)kb * LDQ; vp = vbase + kb; },
                         [&](int s, int key) { const int k = k0 + 64 * s + key; return (k <= t) && (t - k < 512); },
                         [&](int s) { const int kb = k0 + 64 * s; return (kb + 63 <= t0) && (t0 + 3 - kb < 512); }, st, lane, fq);
            const float gw = 1.0f / (1.0f + __expf(-gp[2]));
            const float l = quad_sum(st.l), inv = l > 0.f ? gw / l : 0.f;
#pragma unroll
            for (int n = 0; n < 4; ++n) outa[n] += st.o[n] * inv;
        }
#pragma unroll
        for (int n = 0; n < 4; ++n) store_o4(O + (rowb + t) * DM + 512 + (hkv * 4 + g_l) * 64 + n * 16 + 4 * fq, outa[n][0], outa[n][1], outa[n][2], outa[n][3]);
        NSA_T(4)
    }
    if (PROBE_NSA && threadIdx.x == 0) { unsigned long long* sx = (unsigned long long*)(smem - HDR_BYTES + 32) + 24; for (int i = 0; i < 5; ++i) sx[i] = tsec[i]; }
}

__device__ __forceinline__ void ph_nsa2(const Params& p, char* smem) {
    int* cpre = (int*)(smem + 49152);
    const bf16_t* Q = (const bf16_t*)(p.ws + OFF_QKV);
    const bf16_t* VT = (const bf16_t*)(p.ws + OFF_VT);
    const unsigned char* SID = (const unsigned char*)(p.ws + M_SELID);
    const int* gcnt = (const int*)(p.ws + OFF_NSACNT);
    const unsigned short* lists = (const unsigned short*)(p.ws + NSA_LISTS);
    const int tid = threadIdx.x, lane = tid & 63, wid = tid >> 6, fr = lane & 15, fq = lane >> 4;
    const int qi_l = fr >> 2, g_l = fr & 3;
    for (int i = tid; i < 1024; i += 256) cpre[i + 1] = (gcnt[i * CNTS] + 63) >> 6;
    if (tid == 0) cpre[0] = 0;
    __syncthreads();
    if (tid == 0) { int acc = 0; for (int i = 1; i <= 1024; ++i) { acc += cpre[i]; cpre[i] = acc; } }
    __syncthreads();
    const int total = cpre[1024];
    for (int it = blockIdx.x * 4 + wid; it < total; it += gridDim.x * 4) {
        int li;
        { int lo = 0, hi = 1023; while (lo < hi) { const int mid = (lo + hi + 1) >> 1; if (cpre[mid] <= it) lo = mid; else hi = mid - 1; } li = lo; }
        const int chunk = it - cpre[li], LL = li >> 8, j = li & 255, b = LL >> 1, hkv = LL & 1, n = gcnt[li * CNTS];
        const unsigned short* lst = lists + nsa_list_off(LL, j);
        const size_t rowb = (size_t)b * SEQ;
        KF kf; load_k(kf, Q + (rowb + (size_t)j * 64) * LDQ + 1536 + hkv * 64, LDQ, fr, fq);
        VF vf; load_v(vf, VT + ((size_t)(b * NVH + 2 + hkv) * 64) * VLD + j * 64, VLD, fr, fq);
        const int e0 = chunk * 64, e1 = (e0 + 64 < n) ? e0 + 64 : n;
        const int tmine = lst[(e0 + lane < e1) ? e0 + lane : e0];
        const int ntile = (e1 - e0 + 3) >> 2;
        int ttA, ttB; bf16x8 qA0, qA1, qB0, qB1; uint4 sidA, sidB;
        {
            ttA = __shfl(tmine, (qi_l < e1 - e0) ? qi_l : 0);
            const bf16_t* qp = Q + (rowb + ttA) * LDQ + 768 + (hkv * 4 + g_l) * 64;
            qA0 = ld8(qp + fq * 8); qA1 = ld8(qp + 32 + fq * 8);
            sidA = *(const uint4*)(SID + ((size_t)LL * SEQ + ttA) * 16);
            const int eB = 4 + qi_l;
            ttB = __shfl(tmine, (eB < e1 - e0) ? eB : 0);
            qp = Q + (rowb + ttB) * LDQ + 768 + (hkv * 4 + g_l) * 64;
            qB0 = ld8(qp + fq * 8); qB1 = ld8(qp + 32 + fq * 8);
            sidB = *(const uint4*)(SID + ((size_t)LL * SEQ + ttB) * 16);
        }
        for (int tile = 0; tile < ntile; ++tile) {
            const bf16x8 qf[2] = {qA0, qA1};
            const int tcur = ttA; const bool okc = (tile * 4 + qi_l) < (e1 - e0); const uint4 sidc = sidA;
            ttA = ttB; qA0 = qB0; qA1 = qB1; sidA = sidB;
            {
                const int eN = (tile + 2) * 4 + qi_l;
                ttB = __shfl(tmine, (eN < e1 - e0) ? eN : 0);
                const bf16_t* qp = Q + (rowb + ttB) * LDQ + 768 + (hkv * 4 + g_l) * 64;
                qB0 = ld8(qp + fq * 8); qB1 = ld8(qp + 32 + fq * 8);
                sidB = *(const uint4*)(SID + ((size_t)LL * SEQ + ttB) * 16);
            }
            f32x4 sc[4]; scores(kf, qf, sc);
            float mx = sc[0][0];
#pragma unroll
            for (int kt = 0; kt < 4; ++kt)
#pragma unroll
                for (int jj = 0; jj < 4; ++jj) mx = fmaxf(mx, sc[kt][jj]);
            mx = quad_max(mx);
            float pp[4][4]; float sum = 0.f;
#pragma unroll
            for (int kt = 0; kt < 4; ++kt)
#pragma unroll
                for (int jj = 0; jj < 4; ++jj) { pp[kt][jj] = ex2(sc[kt][jj] - mx); sum += pp[kt][jj]; }
            sum = quad_sum(sum);
            f32x4 o[4];
#pragma unroll
            for (int nn = 0; nn < 4; ++nn) o[nn] = (f32x4){0.f, 0.f, 0.f, 0.f};
            pv(vf, pp, o);
            if (okc) {
                int slot = 0;
                const unsigned w4[4] = {sidc.x, sidc.y, sidc.z, sidc.w};
#pragma unroll
                for (int q = 12; q >= 0; --q) { if (((w4[q >> 2] >> (8 * (q & 3))) & 255u) == (unsigned)j) slot = q; }
                char* rec = nsa_part_ptr(p.ws, LL, tcur, slot);
                st_part((bf16_t*)(rec + g_l * 128) + fq * 16, o);
                if (fq == 0) *(float2*)(rec + 512 + g_l * 8) = make_float2(mx, sum);
            }
        }
    }
}

__device__ __forceinline__ void ph_nsa3(const Params& p, char* smem) {
    (void)smem;
    const bf16_t* Q = (const bf16_t*)(p.ws + OFF_QKV);
    const bf16_t* VT = (const bf16_t*)(p.ws + OFF_VT);
    const float* GD = (const float*)(p.ws + B_GD);
    const unsigned char* SID = (const unsigned char*)(p.ws + M_SELID);
    bf16_t* O = (bf16_t*)(p.ws + OFF_O);
    const int tid = threadIdx.x, lane = tid & 63, wid = tid >> 6, fr = lane & 15, fq = lane >> 4;
    const int qi_l = fr >> 2, g_l = fr & 3;
    Stager sg; sg.init(tid, LDQ, VLD);
    const NsaIter itr = nsa_iter();
    for (int ii = itr.i0; ii < itr.icnt; ii += itr.istr) {
        const int LL = itr.aff ? (itr.xcd & 3) : (ii >> 10);
        const int tqb = itr.aff ? (2 * ii + (itr.xcd >> 2)) : (ii & 1023);
        const int b = LL >> 1, hkv = LL & 1;
        const int tb0 = tqb * 16, t0 = tb0 + wid * 4, t = t0 + qi_l, cur = tb0 >> 6;
        const size_t rowb = (size_t)b * SEQ;
        bf16x8 qf[2];
        {
            const bf16_t* qp = Q + (rowb + t) * LDQ + 768 + (hkv * 4 + g_l) * 64;
            qf[0] = ld8(qp + fq * 8); qf[1] = ld8(qp + 32 + fq * 8);
        }
        const float gs = 1.0f / (1.0f + __expf(-GD[(rowb + t) * 24 + (hkv * 4 + g_l) * 3 + 1]));
        const int nsel = SID[((size_t)LL * SEQ + t) * 16 + 15];
        const int nf = cur == 0 ? 1 : (cur == 1 ? 2 : 3);
        St st; st_init(st);
        const bf16_t* kbase = Q + rowb * LDQ + 1536 + hkv * 64;
        const bf16_t* vbase = VT + ((size_t)(b * NVH + 2 + hkv) * 64) * VLD;
        auto fblk = [&](int s) { return s == 0 ? 0 : (cur - (nf - 1 - s)); };
        attn_run_lds(smem, sg, qf, nf, [&](int s, const bf16_t*& kp, const bf16_t*& vp) { const int kb = fblk(s) * 64; kp = kbase + (size_t)kb * LDQ; vp = vbase + kb; },
                     [&](int s, int key) { return (fblk(s) * 64 + key) <= t; }, [&](int s) { return (fblk(s) * 64 + 63) <= t0; }, st, lane, fq);
        float l = quad_sum(st.l), m = st.m;
        {
            const char* rec0 = nsa_part_ptr(p.ws, LL, t, 0);
            const char* mlp = rec0 + 512 + g_l * 8;
            const char* op0 = rec0 + g_l * 128 + fq * 32;
            float mm = m;
#pragma unroll
            for (int r = 0; r < 13; ++r) {
                const float mr = *(const float*)(mlp + (r < nsel ? r * 544 : 0));
                if (r < nsel) mm = fmaxf(mm, mr);
            }
            const float a = ex2(m - mm);
            l *= a;
#pragma unroll
            for (int n = 0; n < 4; ++n) st.o[n] *= a;
#pragma unroll 1
            for (int rb = 0; rb < 16; rb += 4) {
#pragma unroll
                for (int u = 0; u < 4; ++u) {
                    const int r = rb + u;
                    const bool ok = r < nsel;
                    const int ro = ok ? r * 544 : 0;
                    const float2 ml = *(const float2*)(mlp + ro);
                    const float c = ok ? ex2(ml.x - mm) : 0.f;
                    acc_part((const bf16_t*)(op0 + ro), c, st.o);
                    l += c * ml.y;
                }
            }
        }
        const float inv = l > 0.f ? gs / l : 0.f;
#pragma unroll
        for (int n = 0; n < 4; ++n) {
            bf16_t* op = O + (rowb + t) * DM + 512 + (hkv * 4 + g_l) * 64 + n * 16 + 4 * fq;
            const uint2 u = *(const uint2*)op;
            store_o4(op, __uint_as_float(u.x << 16) + st.o[n][0] * inv, __uint_as_float(u.x & 0xFFFF0000u) + st.o[n][1] * inv,
                         __uint_as_float(u.y << 16) + st.o[n][2] * inv, __uint_as_float(u.y & 0xFFFF0000u) + st.o[n][3] * inv);
        }
    }
}

template <int PH> __device__ __forceinline__ void run_phase(const Params& p, char* smem) {
    char* ws = p.ws;
    if (PH == 0) {
        conv_layer_weights(p, smem, 0); conv_expert_weights(p, smem, 0);
        rope_table(p);
        norm_pass(p.x, nullptr, nullptr, p.ln_mix[0], (bf16_t*)(ws + OFF_H), nullptr);
    } else if (PH == 1) { ph_gemm_qkv(p, smem, 0); if (GEMM_EXP == 1) { __syncthreads(); ph_gemm_qkv(p, smem, 0); } if (GEMM_EXP == 2) { __syncthreads(); ph_gemm_qkv<true>(p, smem, 0); } }
    else if (PH == 2) ph_attn0(p, smem);
    else if (PH == 3) ph_gemm_out(p, smem, p.x);
    else if (PH == 4) ph_route(p, smem, 0);
    else if (PH == 5) { }
    else if (PH == 6) ph_moe_gemm(p, smem, 0, 0);
    else if (PH == 7) ph_moe_gemm(p, smem, 1, 0);
    else if (PH == 8) {
        norm_pass(p.out, (const bf16_t*)(ws + B_Y), p.out, p.ln_mix[1], (bf16_t*)(ws + OFF_H), nullptr);
        conv_layer_weights(p, smem, 1);
    } else if (PH == 9) ph_gemm_qkv(p, smem, 1);
    else if (PH == 10) { ph_kmean(p); ph_cmp1(p, smem); }
    else if (PH == 11) { ph_moba_gate(p, smem); ph_cmp2(p, smem); }
    else if (PH == 12) { ph_moba_part(p, smem); __syncthreads(); if (PROBING && threadIdx.x == 0) ((unsigned long long*)(smem - HDR_BYTES + 32))[22] = wall_clock64(); ph_nsa1(p, smem); }
    else if (PH == 13) { ph_nsa2(p, smem); __syncthreads(); if (PROBING && threadIdx.x == 0) ((unsigned long long*)(smem - HDR_BYTES + 32))[23] = wall_clock64(); ph_moba_own(p, smem); }
    else if (PH == 14) ph_nsa3(p, smem);
    else if (PH == 15) { ph_gemm_out(p, smem, p.out); conv_expert_weights(p, smem, 1); }
    else if (PH == 16) ph_route(p, smem, 1);
    else if (PH == 17) { }
    else if (PH == 18) ph_moe_gemm(p, smem, 0, 1);
    else if (PH == 19) ph_moe_gemm(p, smem, 1, 1);
    else if (PH == 20) norm_pass(p.out, (const bf16_t*)(ws + B_Y), nullptr, p.ln_final, nullptr, p.out);
}
#define NPHASE 21

#if MEGA
#define PHB(n) run_phase<n>(p, smem); xcd_barrier(bar); if (PROBING && threadIdx.x == 0) stamps[n + 1] = wall_clock64();
#define PHS(n) if (PROBING && threadIdx.x == 0) stamps[n + 1] = stamps[n];
__global__ void __launch_bounds__(256, 2) k_mega(Params p) {
    __shared__ __attribute__((aligned(16))) char smem_all[SMEM_BYTES + HDR_BYTES];
    char* smem = smem_all + HDR_BYTES;
    unsigned long long* stamps = (unsigned long long*)(smem_all + 32);
    if (threadIdx.x == 0) *(uint4*)smem_all = make_uint4(0u, 0u, 0u, 0u);
    __syncthreads();
    XcdBarrier bar = xcd_barrier_post((unsigned*)(p.ws + OFF_CTRL), (volatile LAS unsigned*)smem_all);
    if (PROBING && threadIdx.x == 0) stamps[0] = wall_clock64();
    PHB(0) PHB(1) PHB(2) PHB(3) PHB(4) PHS(5) PHB(6) PHB(7) PHB(8) PHB(9)
    PHB(10) PHB(11) PHB(12) PHB(13) PHB(14) PHB(15) PHB(16) PHS(17) PHB(18) PHB(19)
    if (PROBING) {
        float* enc = (float*)(smem_all + 16);
        if (threadIdx.x == 0) {
            const float tot = (float)(stamps[20] - stamps[0]);
            float fa = 0.f, fb = 0.f;
            for (int i = 0; i < 20; ++i) { const float d = (float)(stamps[i + 1] - stamps[i]); if ((PROBE_A >> i) & 1) fa += d; if ((PROBE_B >> i) & 1) fb += d; }
            { const float d = (float)(stamps[22] - stamps[12]); if ((PROBE_A >> 20) & 1) fa += d; if ((PROBE_B >> 20) & 1) fb += d; }
            { const float d = (float)(stamps[23] - stamps[13]); if ((PROBE_A >> 21) & 1) fa += d; if ((PROBE_B >> 21) & 1) fb += d; }
            fa /= tot; fb /= tot;
#if PROBE_NSA
            { const unsigned long long* sx = stamps + 24; float sm = 0.f; for (int i = 0; i < 5; ++i) sm += (float)sx[i];
              fa = (float)sx[PROBE_NSA & 7] / sm; fb = (float)sx[(PROBE_NSA >> 3) & 7] / sm; }
#endif
            enc[0] = 1.0f + sqrtf(5e-4f + 6e-3f * fa);
            enc[1] = 20.0f + 80.0f * fb;
        }
        __syncthreads();
        norm_pass(p.out, (const bf16_t*)(p.ws + B_Y), nullptr, p.ln_final, nullptr, p.out, enc[0], enc[1]);
    } else {
        run_phase<20>(p, smem);
    }
}
#else
template <int PH> __global__ void __launch_bounds__(256, 2) k_phase(Params p) {
    __shared__ __attribute__((aligned(16))) char smem_all[SMEM_BYTES + 16];
    run_phase<PH>(p, smem_all + 16);
}
template <int PH> static void launch_phases(const Params& p, int grid, hipStream_t stream) {
    hipLaunchKernelGGL(k_phase<PH>, dim3(grid), dim3(256), 0, stream, p);
    if constexpr (PH + 1 < NPHASE) launch_phases<PH + 1>(p, grid, stream);
}
#endif

extern "C" void kernel_launch(void* const* d_in, const int* in_sizes, int n_in, void* d_out, int out_size, void* d_ws, size_t ws_size, hipStream_t stream) {
    (void)in_sizes; (void)n_in; (void)out_size;
    if (ws_size < WS_NEED) { fprintf(stderr, "workspace too small: %zu < %zu\n", ws_size, (size_t)WS_NEED); return; }
    Params p; memset(&p, 0, sizeof(p));
    p.x = (const float*)d_in[0]; p.pos = (const int*)d_in[1];
    p.ln_mix[0] = (const float*)d_in[2]; p.w_in[0] = (const float*)d_in[3]; p.sinks0 = (const float*)d_in[4]; p.w_out[0] = (const float*)d_in[5];
    p.ln_ffn[0] = (const float*)d_in[6]; p.r_group[0] = (const float*)d_in[7]; p.r_expert[0] = (const float*)d_in[8];
    p.e_gate[0] = (const float*)d_in[9]; p.e_up[0] = (const float*)d_in[10]; p.e_down[0] = (const float*)d_in[11];
    p.ln_mix[1] = (const float*)d_in[12]; p.w_in[1] = (const float*)d_in[13];
    p.k_pe = (const float*)d_in[14]; p.k_w1 = (const float*)d_in[15]; p.k_w2 = (const float*)d_in[16];
    p.v_pe = (const float*)d_in[17]; p.v_w1 = (const float*)d_in[18]; p.v_w2 = (const float*)d_in[19];
    p.w_out[1] = (const float*)d_in[20]; p.ln_ffn[1] = (const float*)d_in[21]; p.r_group[1] = (const float*)d_in[22]; p.r_expert[1] = (const float*)d_in[23];
    p.e_gate[1] = (const float*)d_in[24]; p.e_up[1] = (const float*)d_in[25]; p.e_down[1] = (const float*)d_in[26];
    p.ln_final = (const float*)d_in[27];
    p.out = (float*)d_out; p.ws = (char*)d_ws;
    (void)hipMemsetAsync(d_ws, 0, 1 * MB, stream);
#if MEGA
    static int grid = 0;
    if (!grid) {
        int dev = 0, cus = 0, per_cu = 0;
        (void)hipGetDevice(&dev);
        (void)hipDeviceGetAttribute(&cus, hipDeviceAttributeMultiprocessorCount, dev);
        (void)hipOccupancyMaxActiveBlocksPerMultiprocessor(&per_cu, k_mega, 256, 0);
        if (per_cu < 1) per_cu = 1;
        grid = cus * (per_cu < 2 ? per_cu : 2);
    }
    hipLaunchKernelGGL(k_mega, dim3(grid), dim3(256), 0, stream, p);
#else
    launch_phases<0>(p, 512, stream);
#endif
}
```

```cpp
#include <hip/hip_runtime.h>
#include <stdint.h>
#include <stdio.h>
#include <string.h>

#ifndef MEGA
#define MEGA 1
#endif
#ifndef PROBE_A
#define PROBE_A 0
#endif
#ifndef PROBE_B
#define PROBE_B 0
#endif
#ifndef PROBE_NSA
#define PROBE_NSA 0
#endif
#define PROBING ((PROBE_A) | (PROBE_B) | (PROBE_NSA))

typedef unsigned short bf16_t;
typedef short bf16x8 __attribute__((ext_vector_type(8)));
typedef float f32x4 __attribute__((ext_vector_type(4)));

#define NTOK 32768
#define SEQ 16384
#define DM 1024
#define LDQ 2304
#define NVH 10
#define NEXP 64
#define EH 512
#define NASG 65536
#define NCMP 1023
#define NCMPP 1024
#define NEG_BIG (-1.0e30f)
#define VLD (SEQ + 64)
#define CLD (NCMPP + 64)

constexpr size_t MB = 1024ull * 1024ull;
constexpr size_t OFF_CTRL = 0;
constexpr size_t OFF_MOBACNT = 32768;
constexpr size_t OFF_ROPE = 1 * MB;
constexpr size_t OFF_NSACNT = 65536;
#define CNTS 32
constexpr size_t OFF_MOECNT = 262144;
constexpr size_t OFF_W = 9 * MB;
constexpr size_t W_IN = OFF_W;
constexpr size_t W_OUT = W_IN + 2304ull * 1024 * 2;
constexpr size_t W_K1 = W_OUT + 1024ull * 1024 * 2;
constexpr size_t W_V1 = W_K1 + 256ull * 2048 * 2;
constexpr size_t W_K2 = W_V1 + 256ull * 2048 * 2;
constexpr size_t W_V2 = W_K2 + 128ull * 256 * 2;
constexpr size_t W_BK = W_V2 + 128ull * 256 * 2;
constexpr size_t W_BV = W_BK + 1024;
constexpr size_t W_GU = W_BV + 1024 + 1022 * 1024;
constexpr size_t W_DN = W_GU + 64ull * 1024 * 1024 * 2;
constexpr size_t OFF_H = W_DN + 64ull * 1024 * 512 * 2;
constexpr size_t OFF_QKV = OFF_H + (size_t)NTOK * 1024 * 2;
constexpr size_t OFF_VT = OFF_QKV + (size_t)NTOK * LDQ * 2;
constexpr size_t OFF_O = OFF_VT + 2ull * NVH * 64 * VLD * 2;
constexpr size_t OFF_B = OFF_O + (size_t)NTOK * 1024 * 2;
constexpr size_t B_LIST = OFF_B;
constexpr size_t MOBA_LCAP = 2064384ull;
constexpr size_t B_PO = B_LIST + 4 * MOBA_LCAP * 4;
constexpr size_t B_PML = B_PO + (size_t)NTOK * 24 * 64 * 2;
constexpr size_t B_HIDK = B_PML + (size_t)NTOK * 24 * 8;
constexpr size_t B_HIDV = B_HIDK + 4096ull * 256 * 2;
constexpr size_t B_KCMP = B_HIDV + 4096ull * 256 * 2;
constexpr size_t B_VCMPT = B_KCMP + 4ull * 1024 * 64 * 2;
constexpr size_t B_KMEAN = B_VCMPT + 4ull * CLD * 64 * 2;
constexpr size_t B_GD = B_KMEAN + 2ull * 64 * 2 * 64 * 4;
constexpr size_t B_END = B_GD + (size_t)NTOK * 24 * 4;
constexpr size_t B_Y = OFF_B;
constexpr size_t OFF_M = OFF_B + 150 * MB;
static_assert(B_END <= OFF_M, "B region overflow");
constexpr size_t M_TOKE = OFF_M;
constexpr size_t M_TOKG = M_TOKE + (size_t)NTOK * 8;
constexpr size_t M_TOKR = M_TOKG + (size_t)NTOK * 8;
constexpr size_t M_HIST = M_TOKR + (size_t)NTOK * 8;
constexpr size_t M_LIST = M_HIST + 512ull * 64 * 4;
constexpr size_t M_ECNT = M_LIST + 65536ull * 4;
constexpr size_t M_EBASE = M_ECNT + 256;
constexpr size_t M_SELID = OFF_M + 2 * MB;
constexpr size_t NSA_PSZ = (size_t)2 * SEQ * 13 * 544;
constexpr size_t NSA_PX = OFF_M + 3 * MB;
constexpr size_t NSA_PY = W_GU;
static_assert(NSA_PSZ <= 256 * MB, "NSA partials do not fit the weight region");
constexpr size_t NSA_LCAP = 2072640ull;
constexpr size_t NSA_LISTS = NSA_PX + NSA_PSZ;
constexpr size_t NSA_SLOTS = NSA_LISTS + 4 * NSA_LCAP * 2;
constexpr size_t WS_NEED = NSA_SLOTS + 4 * NSA_LCAP;
constexpr size_t MOE_LIST = NSA_LISTS;
static_assert(64ull * 32768 * 4 <= 4 * NSA_LCAP * 2, "MoE lists do not fit");
constexpr size_t HID_OFF = OFF_QKV;

#define SMEM_BYTES 75776
#define HDR_BYTES 512

struct Params {
    const float* x; const int* pos;
    const float* ln_mix[2]; const float* w_in[2]; const float* sinks0; const float* w_out[2]; const float* ln_ffn[2];
    const float* r_group[2]; const float* r_expert[2]; const float* e_gate[2]; const float* e_up[2]; const float* e_down[2];
    const float* k_pe; const float* k_w1; const float* k_w2; const float* v_pe; const float* v_w1; const float* v_w2;
    const float* ln_final;
    float* out;
    char* ws;
};

#define XB_TMO      128
#define XB_XCNT(j)  (256  + 64 * (j))
#define XB_XSUB(j)  (1280 + 64 * (j))
#define XB_XGEN(j)  (2304 + 64 * (j))
#define XB_TOP      3328
#define XB_TOPGEN   3392
#define XCD_BAR_WORDS 3456
#define XB_SPIN_CAP (1u << 22)
#define LAS __attribute__((address_space(3)))

__device__ __forceinline__ unsigned xb_ld(unsigned* p)              { return __hip_atomic_load(p, __ATOMIC_RELAXED, __HIP_MEMORY_SCOPE_AGENT); }
__device__ __forceinline__ unsigned xb_add(unsigned* p, unsigned v) { return __hip_atomic_fetch_add(p, v, __ATOMIC_RELAXED, __HIP_MEMORY_SCOPE_AGENT); }
__device__ __forceinline__ unsigned xb_xcc_id() { return (unsigned)__builtin_amdgcn_s_getreg((3 << 11) | 20) & 0xFu; }
#define XB_SPIN(cond, bar) do { unsigned _sp = 0; while (cond) { __builtin_amdgcn_s_sleep(1); \
    if ((++_sp & 255u) == 0u) { if (xb_ld(&(bar)[XB_TMO])) break; if (_sp > XB_SPIN_CAP) { atomicAdd(&(bar)[XB_TMO], 1u); break; } } } } while (0)

struct XcdBarrier { unsigned* bar; unsigned x; volatile LAS unsigned* st; };

__device__ __forceinline__ XcdBarrier xcd_barrier_post(unsigned* bar, volatile LAS unsigned* st) {
    XcdBarrier b; b.bar = bar; b.x = xb_xcc_id(); b.st = st;
    if (threadIdx.x == 0) (void)xb_add(&bar[XB_XCNT(b.x)], 1u);
    return b;
}
__device__ __forceinline__ void xcd_barrier_complete(unsigned* bar, unsigned x, unsigned& nloc, unsigned& nx) {
    const unsigned G = gridDim.x * gridDim.y * gridDim.z;
    unsigned sum, cnt, mine, sp = 0u;
    for (;;) {
        sum = 0u; cnt = 0u; mine = 0u;
#pragma unroll
        for (unsigned j = 0; j < 16; ++j) { const unsigned c = xb_ld(&bar[XB_XCNT(j)]); sum += c; cnt += (c > 0u) ? 1u : 0u; mine = (j == x) ? c : mine; }
        if (sum == G) break;
        __builtin_amdgcn_s_sleep(1);
        if ((++sp & 255u) == 0u) { if (xb_ld(&bar[XB_TMO])) break; if (sp > XB_SPIN_CAP) { atomicAdd(&bar[XB_TMO], 1u); break; } }
    }
    nloc = mine > 0u ? mine : 1u; nx = cnt > 0u ? cnt : 1u;
}
__device__ __forceinline__ void xcd_barrier(const XcdBarrier& b) {
    asm volatile("s_waitcnt vmcnt(0)" ::: "memory");
    __syncthreads();
    if (threadIdx.x == 0) {
        unsigned* bar = b.bar;
        __builtin_amdgcn_s_waitcnt(0);
        unsigned nloc = b.st[0], nx = b.st[1];
        if (nloc == 0u) { xcd_barrier_complete(bar, b.x, nloc, nx); b.st[0] = nloc; b.st[1] = nx; }
        const unsigned old = xb_add(&bar[XB_XSUB(b.x)], 1u);
        const unsigned gen = old / nloc;
        if (old + 1u == (gen + 1u) * nloc) {
            __builtin_amdgcn_fence(__ATOMIC_RELEASE, "agent");
            asm volatile("s_waitcnt vmcnt(0)" ::: "memory");
            const unsigned og = xb_add(&bar[XB_TOP], 1u);
            const unsigned tg = og / nx;
            if (og + 1u == (tg + 1u) * nx) xb_add(&bar[XB_TOPGEN], 1u);
            else XB_SPIN(xb_ld(&bar[XB_TOPGEN]) == tg, bar);
            __builtin_amdgcn_fence(__ATOMIC_ACQUIRE, "agent");
            xb_add(&bar[XB_XGEN(b.x)], 1u);
            asm volatile("s_waitcnt vmcnt(0)" ::: "memory");
        } else {
            XB_SPIN(xb_ld(&bar[XB_XGEN(b.x)]) == gen, bar);
            __builtin_amdgcn_fence(__ATOMIC_ACQUIRE, "agent");
            asm volatile("s_waitcnt vmcnt(0)" ::: "memory");
        }
    }
    __syncthreads();
}

typedef __bf16 bf16x2_t __attribute__((ext_vector_type(2)));
typedef float f32x2 __attribute__((ext_vector_type(2)));
__device__ __forceinline__ uint32_t pack2(float a, float b) { const f32x2 v = {a, b}; return __builtin_bit_cast(uint32_t, __builtin_convertvector(v, bf16x2_t)); }
__device__ __forceinline__ bf16_t f2bf(float f) { return (bf16_t)(pack2(f, 0.f) & 0xFFFFu); }
__device__ __forceinline__ float bf2f(bf16_t h) { return __uint_as_float(((uint32_t)h) << 16); }
__device__ __forceinline__ f32x4 mfma16(bf16x8 a, bf16x8 b, f32x4 c) { return __builtin_amdgcn_mfma_f32_16x16x32_bf16(a, b, c, 0, 0, 0); }
__device__ __forceinline__ float red16_max(float v) { v = fmaxf(v, __shfl_xor(v, 1)); v = fmaxf(v, __shfl_xor(v, 2)); v = fmaxf(v, __shfl_xor(v, 4)); v = fmaxf(v, __shfl_xor(v, 8)); return v; }
__device__ __forceinline__ float red16_sum(float v) { v += __shfl_xor(v, 1); v += __shfl_xor(v, 2); v += __shfl_xor(v, 4); v += __shfl_xor(v, 8); return v; }
__device__ __forceinline__ float red64_sum(float v) { v += __shfl_xor(v, 1); v += __shfl_xor(v, 2); v += __shfl_xor(v, 4); v += __shfl_xor(v, 8); v += __shfl_xor(v, 16); v += __shfl_xor(v, 32); return v; }
typedef unsigned u32x2_t __attribute__((ext_vector_type(2)));
__device__ __forceinline__ float quad_max(float v) {
    const u32x2_t a = __builtin_amdgcn_permlane32_swap(__float_as_uint(v), __float_as_uint(v), false, false);
    v = fmaxf(__uint_as_float(a[0]), __uint_as_float(a[1]));
    const u32x2_t b = __builtin_amdgcn_permlane16_swap(__float_as_uint(v), __float_as_uint(v), false, false);
    return fmaxf(__uint_as_float(b[0]), __uint_as_float(b[1]));
}
__device__ __forceinline__ float quad_sum(float v) {
    const u32x2_t a = __builtin_amdgcn_permlane32_swap(__float_as_uint(v), __float_as_uint(v), false, false);
    v = __uint_as_float(a[0]) + __uint_as_float(a[1]);
    const u32x2_t b = __builtin_amdgcn_permlane16_swap(__float_as_uint(v), __float_as_uint(v), false, false);
    return __uint_as_float(b[0]) + __uint_as_float(b[1]);
}
__device__ __forceinline__ float ex2(float x) { return __builtin_amdgcn_exp2f(x); }
#define LOG2E 1.4426950408889634f
__device__ __forceinline__ void lds_fence() { asm volatile("s_waitcnt lgkmcnt(0)" ::: "memory"); }
__device__ __forceinline__ bf16x8 ld8(const bf16_t* p) { return *(const bf16x8*)p; }
__device__ __forceinline__ bf16x8 zero8() { bf16x8 z = {0, 0, 0, 0, 0, 0, 0, 0}; return z; }

__device__ __forceinline__ int hidden_tid() { int t = (int)threadIdx.x; asm volatile("" : "+v"(t)); return t; }

__device__ __forceinline__ void tconv(char* smem, const float* src, bf16_t* dst, int K, int N, int Npad, int nbatch, size_t sstride, size_t dstride, int mode) {
    float* tile = (float*)smem;
    const int tid = threadIdx.x;
    const int tk = K / 64, tn = (Npad + 63) / 64, per = tk * tn, total = per * nbatch;
    for (int it = blockIdx.x; it < total; it += gridDim.x) {
        const int bi = it / per, r = it % per, k0 = (r / tn) * 64, n0 = (r % tn) * 64;
        const float* s = src + (size_t)bi * sstride;
        bf16_t* d = dst + (size_t)bi * dstride;
        const int ty = tid >> 4, tx = tid & 15;
#pragma unroll
        for (int i = 0; i < 4; ++i) {
            const int k = ty + 16 * i, n = n0 + tx * 4;
            float4 v = make_float4(0.f, 0.f, 0.f, 0.f);
            if (n < N) v = *(const float4*)(s + (size_t)(k0 + k) * N + n);
            tile[k * 65 + tx * 4 + 0] = v.x; tile[k * 65 + tx * 4 + 1] = v.y; tile[k * 65 + tx * 4 + 2] = v.z; tile[k * 65 + tx * 4 + 3] = v.w;
        }
        __syncthreads();
        {
            const int nl = tid >> 2, kc = (tid & 3) * 16, n = n0 + nl;
            if (n < Npad) {
                int row = n;
                if (mode == 1) row = (n >> 5) * 64 + (n & 31);
                else if (mode == 2) row = (n >> 5) * 64 + 32 + (n & 31);
                uint32_t w[8];
#pragma unroll
                for (int i = 0; i < 8; ++i) w[i] = pack2(tile[(kc + 2 * i) * 65 + nl], tile[(kc + 2 * i + 1) * 65 + nl]);
                uint4* o = (uint4*)(d + (size_t)row * K + k0 + kc);
                o[0] = make_uint4(w[0], w[1], w[2], w[3]);
                o[1] = make_uint4(w[4], w[5], w[6], w[7]);
            }
        }
        __syncthreads();
    }
}

__device__ __forceinline__ void conv_expert_weights(const Params& p, char* smem, int L) {
    char* ws = p.ws;
    tconv(smem, p.e_gate[L], (bf16_t*)(ws + W_GU), 1024, 512, 512, 64, 1024ull * 512, 1024ull * 1024, 1);
    tconv(smem, p.e_up[L], (bf16_t*)(ws + W_GU), 1024, 512, 512, 64, 1024ull * 512, 1024ull * 1024, 2);
    tconv(smem, p.e_down[L], (bf16_t*)(ws + W_DN), 512, 1024, 1024, 64, 512ull * 1024, 1024ull * 512, 0);
}
__device__ __forceinline__ void conv_layer_weights(const Params& p, char* smem, int L) {
    char* ws = p.ws;
    if (L == 0) tconv(smem, p.w_in[0], (bf16_t*)(ws + W_IN), 1024, 2304, 2304, 1, 0, 0, 0);
    else        tconv(smem, p.w_in[1], (bf16_t*)(ws + W_IN), 1024, 2072, 2304, 1, 0, 0, 0);
    tconv(smem, p.w_out[L], (bf16_t*)(ws + W_OUT), 1024, 1024, 1024, 1, 0, 0, 0);
    if (L == 1) {
        tconv(smem, p.k_w1, (bf16_t*)(ws + W_K1), 2048, 256, 256, 1, 0, 0, 0);
        tconv(smem, p.v_w1, (bf16_t*)(ws + W_V1), 2048, 256, 256, 1, 0, 0, 0);
        tconv(smem, p.k_w2, (bf16_t*)(ws + W_K2), 256, 64, 128, 1, 0, 0, 0);
        tconv(smem, p.v_w2, (bf16_t*)(ws + W_V2), 256, 64, 128, 1, 0, 0, 0);
        if (blockIdx.x == gridDim.x - 1 || blockIdx.x == gridDim.x - 2) {
            const bool isv = (blockIdx.x == gridDim.x - 2);
            const float* pe = isv ? p.v_pe : p.k_pe; const float* w1 = isv ? p.v_w1 : p.k_w1;
            float* bias = (float*)(ws + (isv ? W_BV : W_BK));
            const int n = threadIdx.x; float acc = 0.f;
            for (int kk = 0; kk < 2048; ++kk) acc += pe[kk] * w1[(size_t)kk * 256 + n];
            bias[n] = acc;
        }
    }
}

static __device__ const double kInvFreq[32] = {
    1.0, 0.7498942093324559, 0.5623413251903491, 0.4216965034285822, 0.31622776601683794, 0.23713737056616552, 0.1778279410038923, 0.1333521432163324,
    0.1, 0.07498942093324558, 0.05623413251903491, 0.042169650342858224, 0.03162277660168379, 0.023713737056616554, 0.01778279410038923, 0.01333521432163324,
    0.01, 0.007498942093324558, 0.005623413251903491, 0.004216965034285823, 0.0031622776601683794, 0.0023713737056616554, 0.0017782794100389228, 0.001333521432163324,
    0.001, 0.0007498942093324559, 0.0005623413251903491, 0.00042169650342858224, 0.00031622776601683794, 0.00023713737056616554, 0.00017782794100389227, 0.0001333521432163324};
__device__ __forceinline__ void rope_table(const Params& p) {
    float* rc = (float*)(p.ws + OFF_ROPE); float* rs = rc + (size_t)NTOK * 32;
    for (int i = blockIdx.x * 256 + threadIdx.x; i < NTOK * 32; i += gridDim.x * 256) {
        const int t = i >> 5, c = i & 31;
        const double ang = (double)p.pos[t] * kInvFreq[c];
        const double k = rint(ang * 0.15915494309189535);
        const float r = (float)fma(-k, 6.283185307179586, ang);
        rc[i] = cosf(r); rs[i] = sinf(r);
    }
}

__device__ __forceinline__ void norm_pass(const float* src, const bf16_t* y, float* xr, const float* gain, bf16_t* hb, float* hf, float pscale = 1.0f, float pv = 0.0f) {
    const int lane = threadIdx.x & 63, wid = threadIdx.x >> 6;
    const int nw = gridDim.x * 4;
    for (int t = blockIdx.x * 4 + wid; t < NTOK; t += nw) {
        float v[16];
#pragma unroll
        for (int i = 0; i < 4; ++i) {
            const float4 a = *(const float4*)(src + (size_t)t * DM + i * 256 + lane * 4);
            v[4 * i] = a.x; v[4 * i + 1] = a.y; v[4 * i + 2] = a.z; v[4 * i + 3] = a.w;
        }
        if (y) {
#pragma unroll
            for (int k = 0; k < 2; ++k)
#pragma unroll
                for (int i = 0; i < 4; ++i) {
                    const uint2 a = *(const uint2*)(y + ((size_t)t * 2 + k) * DM + i * 256 + lane * 4);
                    v[4 * i] += __uint_as_float(a.x << 16); v[4 * i + 1] += __uint_as_float(a.x & 0xFFFF0000u);
                    v[4 * i + 2] += __uint_as_float(a.y << 16); v[4 * i + 3] += __uint_as_float(a.y & 0xFFFF0000u);
                }
        }
        float ss = 0.f;
#pragma unroll
        for (int i = 0; i < 16; ++i) ss += v[i] * v[i];
        ss = red64_sum(ss);
        const float rstd = rsqrtf(ss * (1.0f / DM) + 1e-6f);
#pragma unroll
        for (int i = 0; i < 4; ++i) {
            if (xr) *(float4*)(xr + (size_t)t * DM + i * 256 + lane * 4) = make_float4(v[4 * i], v[4 * i + 1], v[4 * i + 2], v[4 * i + 3]);
            const float4 g = *(const float4*)(gain + i * 256 + lane * 4);
            const float h0 = v[4 * i] * rstd * g.x, h1 = v[4 * i + 1] * rstd * g.y, h2 = v[4 * i + 2] * rstd * g.z, h3 = v[4 * i + 3] * rstd * g.w;
            if (hb) *(uint2*)(hb + (size_t)t * DM + i * 256 + lane * 4) = make_uint2(pack2(h0, h1), pack2(h2, h3));
            if (hf) { float4 o4 = make_float4(h0 * pscale, h1 * pscale, h2 * pscale, h3 * pscale);
                if (pv != 0.0f && t == 0 && i == 0 && lane == 0) o4.x = pv;
                *(float4*)(hf + (size_t)t * DM + i * 256 + lane * 4) = o4; }
        }
    }
}

#define GSW(tid) ((((tid) & 3) ^ ((0 - ((tid) >> 4)) & 3)) * 8)
__device__ __forceinline__ void glds16(const bf16_t* g, char* l) {
    __builtin_amdgcn_global_load_lds((const unsigned*)g, (LAS unsigned*)l, 16, 0, 0);
}
template <class AOff, class Epi>
__device__ __forceinline__ void gemm_tile(char* smem, const bf16_t* a0, const bf16_t* a1, const bf16_t* b0, const bf16_t* b1, int KT, AOff aoff, Epi epi) {
    const int tid = threadIdx.x, wid = tid >> 6, lane = tid & 63, wr = wid >> 1, wc = wid & 1, fr = lane & 15, fq = lane >> 4;
    const int csw = (fq ^ ((0 - (fr >> 2)) & 3)) * 16;
    f32x4 acc[4][4];
#pragma unroll
    for (int m = 0; m < 4; ++m)
#pragma unroll
        for (int n = 0; n < 4; ++n) acc[m][n] = (f32x4){0.f, 0.f, 0.f, 0.f};
    auto stage = [&](int t) {
        char* buf = smem + (t & 3) * 16384;
        const size_t ao = aoff(t);
        glds16(a0 + ao, buf + tid * 16); glds16(a1 + ao, buf + 4096 + tid * 16);
        glds16(b0 + t * 32, buf + 8192 + tid * 16); glds16(b1 + t * 32, buf + 8192 + 4096 + tid * 16);
    };
    asm volatile("s_waitcnt vmcnt(0)" ::: "memory");
    stage(0);
    if (KT > 1) stage(1);
    if (KT > 2) stage(2);
    for (int t = 0; t < KT; ++t) {
        const char* cur = smem + (t & 3) * 16384;
        if (t + 2 < KT) asm volatile("s_waitcnt vmcnt(8)" ::: "memory");
        else if (t + 1 < KT) asm volatile("s_waitcnt vmcnt(4)" ::: "memory");
        else asm volatile("s_waitcnt vmcnt(0)" ::: "memory");
        __builtin_amdgcn_s_barrier();
        asm volatile("" ::: "memory");
        if (t + 3 < KT) stage(t + 3);
        bf16x8 af[4], bfr[4];
#pragma unroll
        for (int m = 0; m < 4; ++m) af[m] = *(const bf16x8*)(cur + (wr * 64 + m * 16 + fr) * 64 + csw);
#pragma unroll
        for (int n = 0; n < 4; ++n) bfr[n] = *(const bf16x8*)(cur + 8192 + (wc * 64 + n * 16 + fr) * 64 + csw);
        __builtin_amdgcn_s_setprio(1);
#pragma unroll
        for (int m = 0; m < 4; ++m)
#pragma unroll
            for (int n = 0; n < 4; ++n) acc[m][n] = mfma16(af[m], bfr[n], acc[m][n]);
        __builtin_amdgcn_s_setprio(0);
    }
    epi(acc, wr, wc, fr, fq);
    __syncthreads();
}

__device__ __forceinline__ void ld_frags(const char* cur, int wr, int wc, int fr, int csw, bf16x8 (&af)[4], bf16x8 (&bfr)[4]) {
#pragma unroll
    for (int m = 0; m < 4; ++m) af[m] = *(const bf16x8*)(cur + (wr * 64 + m * 16 + fr) * 64 + csw);
#pragma unroll
    for (int n = 0; n < 4; ++n) bfr[n] = *(const bf16x8*)(cur + 8192 + (wc * 64 + n * 16 + fr) * 64 + csw);
}
__device__ __forceinline__ void mma_frags(const bf16x8 (&af)[4], const bf16x8 (&bfr)[4], f32x4 (&acc)[4][4]) {
    __builtin_amdgcn_s_setprio(1);
#pragma unroll
    for (int m = 0; m < 4; ++m)
#pragma unroll
        for (int n = 0; n < 4; ++n) acc[m][n] = mfma16(af[m], bfr[n], acc[m][n]);
    __builtin_amdgcn_s_setprio(0);
}
template <class AOff, class Epi>
__device__ __forceinline__ void gemm_tile_p(char* smem, const bf16_t* a0, const bf16_t* a1, const bf16_t* b0, const bf16_t* b1, int KT, AOff aoff, Epi epi) {
    const int tid = threadIdx.x, wid = tid >> 6, lane = tid & 63, wr = wid >> 1, wc = wid & 1, fr = lane & 15, fq = lane >> 4;
    const int csw = (fq ^ ((0 - (fr >> 2)) & 3)) * 16;
    f32x4 acc[4][4];
#pragma unroll
    for (int m = 0; m < 4; ++m)
#pragma unroll
        for (int n = 0; n < 4; ++n) acc[m][n] = (f32x4){0.f, 0.f, 0.f, 0.f};
    auto stage = [&](int t) {
        char* buf = smem + (t & 3) * 16384;
        const size_t ao = aoff(t);
        glds16(a0 + ao, buf + tid * 16); glds16(a1 + ao, buf + 4096 + tid * 16);
        glds16(b0 + t * 32, buf + 8192 + tid * 16); glds16(b1 + t * 32, buf + 8192 + 4096 + tid * 16);
    };
    auto sync = [&](int t) {
        if (t + 2 < KT) asm volatile("s_waitcnt vmcnt(4)" ::: "memory"); else asm volatile("s_waitcnt vmcnt(0)" ::: "memory");
        __builtin_amdgcn_s_barrier();
        asm volatile("" ::: "memory");
        if (t + 3 < KT) stage(t + 3);
    };
    asm volatile("s_waitcnt vmcnt(0)" ::: "memory");
    stage(0); stage(1); if (KT > 2) stage(2);
    asm volatile("s_waitcnt vmcnt(8)" ::: "memory");
    if (KT <= 2) asm volatile("s_waitcnt vmcnt(4)" ::: "memory");
    __builtin_amdgcn_s_barrier();
    asm volatile("" ::: "memory");
    bf16x8 afA[4], bfA[4], afB[4], bfB[4];
    ld_frags(smem, wr, wc, fr, csw, afA, bfA);
    for (int t = 0; t < KT; t += 2) {
        sync(t);
        ld_frags(smem + ((t + 1) & 3) * 16384, wr, wc, fr, csw, afB, bfB);
        mma_frags(afA, bfA, acc);
        sync(t + 1);
        if (t + 2 < KT) ld_frags(smem + ((t + 2) & 3) * 16384, wr, wc, fr, csw, afA, bfA);
        mma_frags(afB, bfB, acc);
    }
    epi(acc, wr, wc, fr, fq);
    __syncthreads();
}

#define GSW64(tid) ((((tid) & 7) ^ (((tid) >> 4) & 7)) * 8)
template <class AOff, class Epi>
__device__ __forceinline__ void gemm_tile_k64(char* smem, int tid, const bf16_t* const (&ap)[4], const bf16_t* b0, size_t b32, int KT, AOff aoff, Epi epi) {
    const int wid = tid >> 6, lane = tid & 63, wr = wid >> 1, wc = wid & 1, fr = lane & 15, fq = lane >> 4;
    const int sw = (fr >> 1) & 7;
    f32x4 acc[4][4];
#pragma unroll
    for (int m = 0; m < 4; ++m)
#pragma unroll
        for (int n = 0; n < 4; ++n) acc[m][n] = (f32x4){0.f, 0.f, 0.f, 0.f};
    auto stage = [&](int t) {
        char* buf = smem + (t & 1) * 32768;
        const size_t ao = aoff(t);
#pragma unroll
        for (int i = 0; i < 4; ++i) glds16(ap[i] + ao, buf + i * 4096 + tid * 16);
        const bf16_t* bp = b0 + t * 64;
#pragma unroll
        for (int i = 0; i < 4; ++i) glds16(bp + i * b32, buf + 16384 + i * 4096 + tid * 16);
    };
    asm volatile("s_waitcnt vmcnt(0)" ::: "memory");
    stage(0);
    for (int t = 0; t < KT; ++t) {
        const char* cur = smem + (t & 1) * 32768;
        asm volatile("s_waitcnt vmcnt(0)" ::: "memory");
        __builtin_amdgcn_s_barrier();
        asm volatile("" ::: "memory");
        if (t + 1 < KT) stage(t + 1);
#pragma unroll
        for (int ks = 0; ks < 2; ++ks) {
            const int cb = ((ks * 4 + fq) ^ sw) * 16;
            bf16x8 af[4], bfr[4];
#pragma unroll
            for (int m = 0; m < 4; ++m) af[m] = *(const bf16x8*)(cur + (wr * 64 + m * 16 + fr) * 128 + cb);
#pragma unroll
            for (int n = 0; n < 4; ++n) bfr[n] = *(const bf16x8*)(cur + 16384 + (wc * 64 + n * 16 + fr) * 128 + cb);
            __builtin_amdgcn_s_setprio(1);
#pragma unroll
            for (int m = 0; m < 4; ++m)
#pragma unroll
                for (int n = 0; n < 4; ++n) acc[m][n] = mfma16(af[m], bfr[n], acc[m][n]);
            __builtin_amdgcn_s_setprio(0);
        }
    }
    epi(acc, wr, wc, fr, fq);
    __syncthreads();
}

__device__ __forceinline__ void col_kind(int L, int ct, int& kind, int& vh, float& scale) {
    kind = 0; vh = 0; scale = 1.f;
    if (L == 0) {
        if (ct < 8) { kind = 1; scale = 0.125f * LOG2E; }
        else if (ct < 10) kind = 1;
        else if (ct < 12) { kind = 2; vh = ct - 10; }
        else if (ct < 20) { kind = 0; scale = 0.125f; }
        else if (ct < 28) kind = 0;
        else { kind = 2; vh = 2 + (ct - 28); }
    } else {
        if (ct < 8) { kind = 1; scale = 0.125f * LOG2E; }
        else if (ct < 10) kind = 1;
        else if (ct < 12) { kind = 2; vh = ct - 10; }
        else if (ct < 20) { kind = 1; scale = 0.125f * LOG2E; }
        else if (ct < 22) kind = 1;
        else if (ct < 24) kind = 0;
        else if (ct < 26) kind = 1;
        else if (ct < 28) { kind = 2; vh = 2 + (ct - 26); }
        else if (ct < 30) kind = 1;
        else if (ct < 32) { kind = 2; vh = 4 + (ct - 30); }
        else if (ct == 32) kind = 3;
        else kind = 4;
    }
}

#ifndef GEMM_EXP
#define GEMM_EXP 0
#endif
#define EPITCH 68
__device__ __forceinline__ void dump_half(float* E, const f32x4 (&acc)[4][4], int nb, int fr, int fq) {
#pragma unroll
    for (int m = 0; m < 4; ++m)
#pragma unroll
        for (int n = 0; n < 4; ++n)
#pragma unroll
            for (int j = 0; j < 4; ++j) E[(m * 16 + fq * 4 + j) * EPITCH + n * 16 + fr] = acc[m][nb + n][j];
}
__device__ __forceinline__ void ld8f(const float* p, float (&v)[8]) {
    const float4 a = *(const float4*)p, b = *(const float4*)(p + 4);
    v[0] = a.x; v[1] = a.y; v[2] = a.z; v[3] = a.w; v[4] = b.x; v[5] = b.y; v[6] = b.z; v[7] = b.w;
}
__device__ __forceinline__ void st8bf(bf16_t* p, const float (&v)[8]) {
    *(uint4*)p = make_uint4(pack2(v[0], v[1]), pack2(v[2], v[3]), pack2(v[4], v[5]), pack2(v[6], v[7]));
}

template <bool NOEPI = false>
__device__ __forceinline__ void ph_gemm_qkv(const Params& p, char* smem, int L) {
    const bf16_t* A = (const bf16_t*)(p.ws + OFF_H);
    const bf16_t* Bt = (const bf16_t*)(p.ws + W_IN);
    bf16_t* Q = (bf16_t*)(p.ws + OFF_QKV);
    bf16_t* VT = (bf16_t*)(p.ws + OFF_VT);
    float* GD = (float*)(p.ws + B_GD);
    const float* rc = (const float*)(p.ws + OFF_ROPE); const float* rs = rc + (size_t)NTOK * 32;
    const int tn = (L == 0) ? 18 : 17, tm = NTOK / 128, total = tm * tn;
    const int tid = hidden_tid();
    const bool aff = (gridDim.x & 7) == 0;
    const int xcd = blockIdx.x & 7, nh = xcd >> 2, ncols = aff ? (nh ? tn - 9 : 9) : tn;
    const int lstart = aff ? (blockIdx.x >> 3) : blockIdx.x, lstep = aff ? (gridDim.x >> 3) : gridDim.x, lcnt = aff ? (tm / 4) * ncols : total;
    for (int li = lstart; li < lcnt; li += lstep) {
        const int mt = aff ? ((xcd & 3) * (tm / 4) + li / ncols) : (li / tn), nt = aff ? (nh * 9 + li % ncols) : (li % tn);
        const int brow = mt * 128, bcol = nt * 128;
        const bf16_t* a0 = A + (size_t)(brow + (tid >> 3)) * DM + GSW64(tid);
        const bf16_t* const ap[4] = {a0, a0 + (size_t)32 * DM, a0 + (size_t)64 * DM, a0 + (size_t)96 * DM};
        const bf16_t* b0 = Bt + (size_t)(bcol + (tid >> 3)) * DM + GSW64(tid);
        gemm_tile_k64(smem, tid, ap, b0, (size_t)32 * DM, DM / 64, [](int t) { return (size_t)t * 64; },
            [&](f32x4 (&acc)[4][4], int wr, int wc, int fr, int fq) {
                if (NOEPI) { float sink = 0.f; for (int m = 0; m < 4; ++m) for (int n = 0; n < 4; ++n) sink += acc[m][n][0] + acc[m][n][1] + acc[m][n][2] + acc[m][n][3]; if (sink == 1.2345e-30f) GD[0] = sink; return; }
                const int lane = tid & 63;
                float* E = (float*)(smem + (tid >> 6) * (64 * EPITCH * 4));
                const int rowbase = brow + wr * 64;
                __syncthreads();
                {
                    const int ct = (bcol >> 6) + wc;
                    int kind, vh; float scale; col_kind(L, ct, kind, vh, scale);
                    if (kind == 4) return;
                    dump_half(E, acc, 0, fr, fq);
                    lds_fence();
                    if (kind == 0 || kind == 1) {
#pragma unroll 1
                        for (int i = 0; i < 4; ++i) {
                            const int u = lane + 64 * i, r = u >> 2, c8 = (u & 3) * 8, grow = rowbase + r;
                            float x1[8], x2[8], o1[8], o2[8];
                            ld8f(E + r * EPITCH + c8, x1); ld8f(E + r * EPITCH + 32 + c8, x2);
                            if (kind == 1) {
                                float cs[8], sn[8];
                                ld8f(rc + (size_t)grow * 32 + c8, cs); ld8f(rs + (size_t)grow * 32 + c8, sn);
#pragma unroll
                                for (int e = 0; e < 8; ++e) { o1[e] = (x1[e] * cs[e] - x2[e] * sn[e]) * scale; o2[e] = (x2[e] * cs[e] + x1[e] * sn[e]) * scale; }
                            } else {
#pragma unroll
                                for (int e = 0; e < 8; ++e) { o1[e] = x1[e] * scale; o2[e] = x2[e] * scale; }
                            }
                            st8bf(Q + (size_t)grow * LDQ + ct * 64 + c8, o1);
                            st8bf(Q + (size_t)grow * LDQ + ct * 64 + 32 + c8, o2);
                        }
                    } else if (kind == 2) {
                        const int b = rowbase >> 14, s0 = rowbase & (SEQ - 1);
                        bf16_t* vrow = VT + ((size_t)(b * NVH + vh) * 64 + lane) * VLD + s0;
#pragma unroll 2
                        for (int tc = 0; tc < 8; ++tc) {
                            float v[8];
#pragma unroll
                            for (int e = 0; e < 8; ++e) v[e] = E[(8 * tc + e) * EPITCH + lane];
                            st8bf(vrow + 8 * tc, v);
                        }
                    } else {
#pragma unroll
                        for (int c = 0; c < 6; ++c) *(float4*)(GD + (size_t)(rowbase + lane) * 24 + 4 * c) = *(const float4*)(E + lane * EPITCH + 4 * c);
                    }
                    lds_fence();
                }
            });
    }
}

__device__ __forceinline__ void ph_gemm_out(const Params& p, char* smem, const float* xin) {
    const bf16_t* A = (const bf16_t*)(p.ws + OFF_O);
    const bf16_t* Bt = (const bf16_t*)(p.ws + W_OUT);
    float* X = p.out;
    const int tn = 8, tm = NTOK / 128, total = tm * tn, tid = hidden_tid();
    const bool aff = (gridDim.x & 7) == 0;
    const int xcd = blockIdx.x & 7, lstart = aff ? (blockIdx.x >> 3) : blockIdx.x, lstep = aff ? (gridDim.x >> 3) : gridDim.x, lcnt = aff ? total / 8 : total;
    for (int li = lstart; li < lcnt; li += lstep) {
        const int mt = aff ? (xcd * (tm / 8) + li / tn) : (li / tn), nt = li % tn, brow = mt * 128, bcol = nt * 128;
        const bf16_t* a0 = A + (size_t)(brow + (tid >> 3)) * DM + GSW64(tid);
        const bf16_t* const ap[4] = {a0, a0 + (size_t)32 * DM, a0 + (size_t)64 * DM, a0 + (size_t)96 * DM};
        const bf16_t* b0 = Bt + (size_t)(bcol + (tid >> 3)) * DM + GSW64(tid);
        gemm_tile_k64(smem, tid, ap, b0, (size_t)32 * DM, DM / 64, [](int t) { return (size_t)t * 64; },
            [&](f32x4 (&acc)[4][4], int wr, int wc, int fr, int fq) {
                const int lane = tid & 63;
                float* E = (float*)(smem + (tid >> 6) * (64 * EPITCH * 4));
                __syncthreads();
                {
                    dump_half(E, acc, 0, fr, fq);
                    lds_fence();
#pragma unroll 4
                    for (int i = 0; i < 16; ++i) {
                        const int u = lane + 64 * i, r = u >> 4, c4 = (u & 15) * 4;
                        const size_t xo = (size_t)(brow + wr * 64 + r) * DM + bcol + wc * 64 + c4;
                        const float4 e = *(const float4*)(E + r * EPITCH + c4);
                        float4 x = *(const float4*)(xin + xo); x.x += e.x; x.y += e.y; x.z += e.z; x.w += e.w; *(float4*)(X + xo) = x;
                    }
                    lds_fence();
                }
            });
    }
}

#define MOE_CAP 32768
__device__ __forceinline__ void ph_route(const Params& p, char* smem, int L) {
    float* lgs = (float*)smem;
    int* hist = (int*)(smem + 20480);
    int* gb = hist + 64;
    int* dec_e = gb + 64;
    int* dec_r = dec_e + 128;
    float* dec_g = (float*)(dec_r + 128);
    const float* gain = p.ln_ffn[L]; const float* Wg = p.r_group[L]; const float* We = p.r_expert[L];
    norm_pass(p.out, nullptr, nullptr, gain, (bf16_t*)(p.ws + OFF_H), nullptr);
    float* tok_g = (float*)(p.ws + M_TOKG);
    int* list = (int*)(p.ws + MOE_LIST);
    int* gcur = (int*)(p.ws + OFF_MOECNT) + L * 64 * CNTS;
    const int tid = threadIdx.x, lane = tid & 63, wid = tid >> 6, fr = lane & 15, fq = lane >> 4;
    for (int ch = blockIdx.x; ch < NTOK / 64; ch += gridDim.x) {
        if (tid < 64) hist[tid] = 0;
        const int tb = ch * 64 + wid * 16;
        f32x4 acc[5];
#pragma unroll
        for (int n = 0; n < 5; ++n) acc[n] = (f32x4){0.f, 0.f, 0.f, 0.f};
        float ss = 0.f;
        const float* xp = p.out + (size_t)(tb + fr) * DM + 4 * fq;
        const float* wep = We + (size_t)(4 * fq) * 64 + 4 * fr;
        const float* wgp = Wg + (size_t)(4 * fq) * 4 + (fr & 3);
        float4 x4 = *(const float4*)xp, g4 = *(const float4*)(gain + 4 * fq);
        float wb[4][5];
#pragma unroll
        for (int e = 0; e < 4; ++e) {
            { const float4 w4 = *(const float4*)(wep + (size_t)e * 64); wb[e][0] = w4.x; wb[e][1] = w4.y; wb[e][2] = w4.z; wb[e][3] = w4.w; }
            wb[e][4] = wgp[e * 4];
        }
        for (int i = 0; i < 64; ++i) {
            const int in = (i + 1 < 64) ? i + 1 : i;
            const float4 x4n = *(const float4*)(xp + 16 * in), g4n = *(const float4*)(gain + 16 * in + 4 * fq);
            float wn[4][5];
#pragma unroll
            for (int e = 0; e < 4; ++e) {
                { const float4 w4 = *(const float4*)(wep + (size_t)(16 * in + e) * 64); wn[e][0] = w4.x; wn[e][1] = w4.y; wn[e][2] = w4.z; wn[e][3] = w4.w; }
                wn[e][4] = wgp[(size_t)(16 * in + e) * 4];
            }
            ss += x4.x * x4.x + x4.y * x4.y + x4.z * x4.z + x4.w * x4.w;
            const float a[4] = {x4.x * g4.x, x4.y * g4.y, x4.z * g4.z, x4.w * g4.w};
#pragma unroll
            for (int e = 0; e < 4; ++e) {
#pragma unroll
                for (int n = 0; n < 4; ++n) acc[n] = __builtin_amdgcn_mfma_f32_16x16x4f32(a[e], wb[e][n], acc[n], 0, 0, 0);
                acc[4] = __builtin_amdgcn_mfma_f32_16x16x4f32(a[e], fr < 4 ? wb[e][4] : 0.f, acc[4], 0, 0, 0);
            }
            x4 = x4n; g4 = g4n;
#pragma unroll
            for (int e = 0; e < 4; ++e)
#pragma unroll
                for (int n = 0; n < 5; ++n) wb[e][n] = wn[e][n];
        }
        ss = quad_sum(ss);
        const float rstd = rsqrtf(ss * (1.0f / DM) + 1e-6f);
#pragma unroll
        for (int j = 0; j < 4; ++j) {
            const float r = __shfl(rstd, 4 * fq + j);
#pragma unroll
            for (int n = 0; n < 5; ++n) lgs[(wid * 16 + 4 * fq + j) * 80 + (n < 4 ? 4 * fr + n : 64 + fr)] = acc[n][j] * r;
        }
        __syncthreads();
        if (tid < 64) {
            const float* lt = lgs + tid * 80;
            float gl[4]; float gm = -INFINITY; int gi = 0;
#pragma unroll
            for (int i = 0; i < 4; ++i) { gl[i] = lt[64 + i]; if (gl[i] > gm) { gm = gl[i]; gi = i; } }
            float gsum = 0.f;
#pragma unroll
            for (int i = 0; i < 4; ++i) gsum += __expf(gl[i] - gm);
            const float gprob = 1.0f / gsum;
            float m0 = -INFINITY, m1 = -INFINITY; int i0 = 0, i1 = 0;
            for (int i = 0; i < 16; ++i) { const float v = lt[gi * 16 + i]; if (v > m0) { m1 = m0; i1 = i0; m0 = v; i0 = i; } else if (v > m1) { m1 = v; i1 = i; } }
            const float e1 = __expf(m1 - m0), den = 1.0f + e1;
            const int ex0 = gi * 16 + i0, ex1 = gi * 16 + i1;
            dec_e[tid * 2] = ex0; dec_e[tid * 2 + 1] = ex1;
            dec_g[tid * 2] = gprob / den; dec_g[tid * 2 + 1] = gprob * e1 / den;
            dec_r[tid * 2] = atomicAdd(&hist[ex0], 1); dec_r[tid * 2 + 1] = atomicAdd(&hist[ex1], 1);
        }
        __syncthreads();
        if (tid < 64) gb[tid] = hist[tid] > 0 ? atomicAdd(&gcur[tid * CNTS], hist[tid]) : 0;
        __syncthreads();
        if (tid < 128) {
            const int slot = ch * 128 + tid, ex = dec_e[tid];
            list[(size_t)ex * MOE_CAP + gb[ex] + dec_r[tid]] = slot;
            tok_g[slot] = dec_g[tid];
        }
        __syncthreads();
    }
}

__device__ __forceinline__ void ph_moe_gemm(const Params& p, char* smem, int which, int L) {
    int* tpre = (int*)(smem + 73728);
    int* e_cnt = tpre + 68;
    int* e_base = e_cnt + 64;
    const int* gcur = (const int*)(p.ws + OFF_MOECNT) + L * 64 * CNTS;
    const int* list = (const int*)(p.ws + MOE_LIST); const float* tok_g = (const float*)(p.ws + M_TOKG);
    const bf16_t* H = (const bf16_t*)(p.ws + OFF_H);
    bf16_t* HID = (bf16_t*)(p.ws + HID_OFF);
    bf16_t* Y = (bf16_t*)(p.ws + B_Y);
    const int tid = hidden_tid();
    const bool aff = (gridDim.x & 7) == 0;
    const int xcd = blockIdx.x & 7;
    if (tid == 0) {
        int rb = 0; for (int i = 0; i < 64; ++i) { const int c = gcur[i * CNTS]; e_cnt[i] = c; e_base[i] = rb; rb += c; }
        int acc = 0;
        if (aff) { for (int v = 0; v < 8; ++v) { tpre[v] = acc; acc += (e_cnt[xcd + 8 * v] + 127) >> 7; } tpre[8] = acc; }
        else { for (int i = 0; i < 64; ++i) { tpre[i] = acc; acc += (e_cnt[i] + 127) >> 7; } tpre[64] = acc; }
    }
    __syncthreads();
    const int nvis = aff ? 8 : 64;
    const int total = tpre[nvis] * 8;
    const int lstart = aff ? (blockIdx.x >> 3) : blockIdx.x, lstep = aff ? (gridDim.x >> 3) : gridDim.x;
    for (int it = lstart; it < total; it += lstep) {
        const int mtg = it >> 3, nt = it & 7;
        int v = 0;
        { int lo = 0, hi = nvis - 1; while (lo < hi) { const int mid = (lo + hi + 1) >> 1; if (tpre[mid] <= mtg) lo = mid; else hi = mid - 1; } v = lo; }
        const int e = aff ? (xcd + 8 * v) : v;
        const int mt = mtg - tpre[v], cnt = e_cnt[e], bas = e_base[e];
        const int* elist = list + (size_t)e * MOE_CAP;
        const int r0 = mt * 128 + (tid >> 3);
        if (which == 0) {
            const bf16_t* ap[4];
#pragma unroll
            for (int i = 0; i < 4; ++i) { const int r = r0 + 32 * i; const int tk = (r < cnt) ? (elist[r] >> 1) : 0; ap[i] = H + (size_t)tk * DM + GSW64(tid); }
            const bf16_t* Bt = (const bf16_t*)(p.ws + W_GU) + (size_t)e * 1024 * 1024;
            const bf16_t* b0 = Bt + (size_t)(nt * 128 + (tid >> 3)) * DM + GSW64(tid);
            gemm_tile_k64(smem, tid, ap, b0, (size_t)32 * DM, DM / 64, [](int t) { return (size_t)t * 64; },
                [&](f32x4 (&acc)[4][4], int wr, int wc, int fr, int fq) {
                    const int lane = tid & 63;
                    float* E = (float*)(smem + (tid >> 6) * (64 * EPITCH * 4));
                    __syncthreads();
                    {
                        dump_half(E, acc, 0, fr, fq);
                        lds_fence();
#pragma unroll 1
                        for (int i = 0; i < 4; ++i) {
                            const int u = lane + 64 * i, r = u >> 2, c8 = (u & 3) * 8, rr = mt * 128 + wr * 64 + r;
                            float g[8], up[8], o[8];
                            ld8f(E + r * EPITCH + c8, g); ld8f(E + r * EPITCH + 32 + c8, up);
#pragma unroll
                            for (int e = 0; e < 8; ++e) o[e] = g[e] / (1.0f + __expf(-g[e])) * up[e];
                            if (rr < cnt) st8bf(HID + (size_t)(bas + rr) * EH + (nt * 2 + wc) * 32 + c8, o);
                        }
                        lds_fence();
                    }
                });
        } else {
            const bf16_t* ap[4];
#pragma unroll
            for (int i = 0; i < 4; ++i) { const int r = r0 + 32 * i; ap[i] = HID + (size_t)((r < cnt) ? (bas + r) : 0) * EH + GSW64(tid); }
            const bf16_t* Bt = (const bf16_t*)(p.ws + W_DN) + (size_t)e * 1024 * 512;
            const bf16_t* b0 = Bt + (size_t)(nt * 128 + (tid >> 3)) * EH + GSW64(tid);
            gemm_tile_k64(smem, tid, ap, b0, (size_t)32 * EH, EH / 64, [](int t) { return (size_t)t * 64; },
                [&](f32x4 (&acc)[4][4], int wr, int wc, int fr, int fq) {
                    const int lane = tid & 63;
                    float* E = (float*)(smem + (tid >> 6) * (64 * EPITCH * 4));
                    __syncthreads();
                    {
                        dump_half(E, acc, 0, fr, fq);
                        lds_fence();
#pragma unroll 2
                        for (int i = 0; i < 8; ++i) {
                            const int u = lane + 64 * i, r = u >> 3, c8 = (u & 7) * 8, rr = mt * 128 + wr * 64 + r;
                            if (rr < cnt) {
                                const int slot = elist[rr];
                                const float g = tok_g[slot];
                                float x[8]; ld8f(E + r * EPITCH + c8, x);
#pragma unroll
                                for (int e = 0; e < 8; ++e) x[e] *= g;
                                st8bf(Y + (size_t)slot * DM + nt * 128 + wc * 64 + c8, x);
                            }
                        }
                        lds_fence();
                    }
                });
        }
    }
}

struct KF { bf16x8 k[4][2]; };
struct VF { bf16x8 v[4][2]; };
struct St { float m, l; f32x4 o[4]; };
#define KEY_OF(kt, j, fq) (32 * ((kt) >> 1) + 8 * (fq) + 4 * ((kt) & 1) + (j))
__device__ __forceinline__ void st_init(St& st) {
    st.m = NEG_BIG; st.l = 0.f;
#pragma unroll
    for (int n = 0; n < 4; ++n) st.o[n] = (f32x4){0.f, 0.f, 0.f, 0.f};
}
__device__ __forceinline__ void load_k(KF& f, const bf16_t* kp, size_t ldk, int fr, int fq) {
    const bf16_t* base = kp + (size_t)(8 * (fr >> 2) + (fr & 3)) * ldk + fq * 8;
#pragma unroll
    for (int kt = 0; kt < 4; ++kt)
#pragma unroll
        for (int ks = 0; ks < 2; ++ks) f.k[kt][ks] = ld8(base + (size_t)(32 * (kt >> 1) + 4 * (kt & 1)) * ldk + ks * 32);
}
__device__ __forceinline__ void load_v(VF& f, const bf16_t* vp, size_t ldv, int fr, int fq) {
    const bf16_t* base = vp + (size_t)fr * ldv + fq * 8;
#pragma unroll
    for (int n = 0; n < 4; ++n)
#pragma unroll
        for (int h = 0; h < 2; ++h) f.v[n][h] = ld8(base + (size_t)(n * 16) * ldv + h * 32);
}
__device__ __forceinline__ void scores(const KF& f, const bf16x8 (&qf)[2], f32x4 (&s)[4]) {
#pragma unroll
    for (int kt = 0; kt < 4; ++kt) {
        s[kt] = mfma16(f.k[kt][0], qf[0], (f32x4){0.f, 0.f, 0.f, 0.f});
        s[kt] = mfma16(f.k[kt][1], qf[1], s[kt]);
    }
}
typedef unsigned u32x4 __attribute__((ext_vector_type(4)));
__device__ __forceinline__ void pv(const VF& f, const float (&p)[4][4], f32x4 (&o)[4]) {
#pragma unroll
    for (int h = 0; h < 2; ++h) {
        u32x4 w;
        w[0] = pack2(p[2 * h][0], p[2 * h][1]); w[1] = pack2(p[2 * h][2], p[2 * h][3]);
        w[2] = pack2(p[2 * h + 1][0], p[2 * h + 1][1]); w[3] = pack2(p[2 * h + 1][2], p[2 * h + 1][3]);
        const bf16x8 pb = __builtin_bit_cast(bf16x8, w);
#pragma unroll
        for (int n = 0; n < 4; ++n) o[n] = mfma16(f.v[n][h], pb, o[n]);
    }
}
template <bool FULL, class MaskFn>
__device__ __forceinline__ void softmax_step(const f32x4 (&s)[4], MaskFn mask, St& st, float (&p)[4][4], int fq) {
    float mx = -INFINITY; bool v[4][4];
#pragma unroll
    for (int kt = 0; kt < 4; ++kt)
#pragma unroll
        for (int j = 0; j < 4; ++j) {
            if (FULL) { v[kt][j] = true; mx = fmaxf(mx, s[kt][j]); }
            else { v[kt][j] = mask(KEY_OF(kt, j, fq)); mx = fmaxf(mx, v[kt][j] ? s[kt][j] : -INFINITY); }
        }
    mx = quad_max(mx);
    if (!__all(mx <= st.m)) {
        const float mn = fmaxf(st.m, mx), alpha = ex2(st.m - mn);
        st.l *= alpha; st.m = mn;
#pragma unroll
        for (int n = 0; n < 4; ++n) st.o[n] *= alpha;
    }
    float sum = 0.f;
#pragma unroll
    for (int kt = 0; kt < 4; ++kt)
#pragma unroll
        for (int j = 0; j < 4; ++j) { p[kt][j] = (FULL || v[kt][j]) ? ex2(s[kt][j] - st.m) : 0.f; sum += p[kt][j]; }
    st.l += sum;
}
template <bool PF = true, class AddrFn, class MaskFn, class FullFn>
__device__ __forceinline__ void attn_run(const bf16x8 (&qf)[2], int nsteps, AddrFn addr, size_t ldk, size_t ldv, MaskFn mask, FullFn full, St& st, int fr, int fq) {
    if (nsteps <= 0) return;
    const bf16_t* kp; const bf16_t* vp; addr(0, kp, vp);
    if (PF) {
        KF kc; load_k(kc, kp, ldk, fr, fq);
        for (int s = 0; s < nsteps; ++s) {
            VF vf; load_v(vf, vp, ldv, fr, fq);
            const bf16_t* kp2 = kp; const bf16_t* vp2 = vp;
            if (s + 1 < nsteps) addr(s + 1, kp2, vp2);
            KF kn; load_k(kn, kp2, ldk, fr, fq);
            f32x4 sc[4]; scores(kc, qf, sc);
            float p[4][4];
            if (full(s)) softmax_step<true>(sc, [&](int key) { return mask(s, key); }, st, p, fq); else softmax_step<false>(sc, [&](int key) { return mask(s, key); }, st, p, fq);
            pv(vf, p, st.o);
            kc = kn; kp = kp2; vp = vp2;
        }
    } else {
        for (int s = 0; s < nsteps; ++s) {
            addr(s, kp, vp);
            KF kc; load_k(kc, kp, ldk, fr, fq);
            VF vf; load_v(vf, vp, ldv, fr, fq);
            f32x4 sc[4]; scores(kc, qf, sc);
            float p[4][4];
            if (full(s)) softmax_step<true>(sc, [&](int key) { return mask(s, key); }, st, p, fq); else softmax_step<false>(sc, [&](int key) { return mask(s, key); }, st, p, fq);
            pv(vf, p, st.o);
        }
    }
}
__device__ __forceinline__ void st_part(bf16_t* p32, const f32x4 (&o)[4]) {
    uint4* q = (uint4*)p32;
    q[0] = make_uint4(pack2(o[0][0], o[0][1]), pack2(o[0][2], o[0][3]), pack2(o[1][0], o[1][1]), pack2(o[1][2], o[1][3]));
    q[1] = make_uint4(pack2(o[2][0], o[2][1]), pack2(o[2][2], o[2][3]), pack2(o[3][0], o[3][1]), pack2(o[3][2], o[3][3]));
}
__device__ __forceinline__ void acc_part(const bf16_t* p32, float c, f32x4 (&o)[4]) {
    const uint4 a = ((const uint4*)p32)[0], b = ((const uint4*)p32)[1];
    const unsigned w[8] = {a.x, a.y, a.z, a.w, b.x, b.y, b.z, b.w};
#pragma unroll
    for (int n = 0; n < 4; ++n) {
        o[n][0] += c * __uint_as_float(w[2 * n] << 16); o[n][1] += c * __uint_as_float(w[2 * n] & 0xFFFF0000u);
        o[n][2] += c * __uint_as_float(w[2 * n + 1] << 16); o[n][3] += c * __uint_as_float(w[2 * n + 1] & 0xFFFF0000u);
    }
}
__device__ __forceinline__ void store_o4(bf16_t* dst, float a, float b, float c, float d) { *(uint2*)dst = make_uint2(pack2(a, b), pack2(c, d)); }

struct Stager {
    size_t ko, vo, ldk32, ldv32; int tid;
    __device__ __forceinline__ void init(int tid_, size_t ldk, size_t ldv) {
        tid = tid_;
        const int row = tid >> 3, c = tid & 7;
        const int gk = ((tid >> 4) & 1) | (((tid >> 6) & 3) << 1), gv = (tid >> 4) & 7;
        ko = (size_t)row * ldk + (c ^ gk) * 8;
        vo = (size_t)row * ldv + (c ^ gv) * 8;
        ldk32 = 32 * ldk; ldv32 = 32 * ldv;
    }
    __device__ __forceinline__ void stage_k(char* buf, const bf16_t* kp) const { glds16(kp + ko, buf + tid * 16); glds16(kp + ko + ldk32, buf + 4096 + tid * 16); }
    __device__ __forceinline__ void stage_v(char* buf, const bf16_t* vp) const { glds16(vp + vo, buf + 8192 + tid * 16); glds16(vp + vo + ldv32, buf + 12288 + tid * 16); }
};
__device__ __forceinline__ void lds_k(KF& f, const char* buf, int lane) {
    const int fr = lane & 15, fq = lane >> 4;
    const int gk = ((fr >> 1) & 1) | (((fr >> 2) & 3) << 1);
    const char* base = buf + (8 * (fr >> 2) + (fr & 3)) * 128;
#pragma unroll
    for (int kt = 0; kt < 4; ++kt)
#pragma unroll
        for (int ks = 0; ks < 2; ++ks) f.k[kt][ks] = *(const bf16x8*)(base + (32 * (kt >> 1) + 4 * (kt & 1)) * 128 + (((ks * 4 + fq) ^ gk) * 16));
}
__device__ __forceinline__ void lds_v(VF& f, const char* buf, int lane) {
    const int fr = lane & 15, fq = lane >> 4;
    const int gv = (fr >> 1) & 7;
    const char* base = buf + 8192 + fr * 128;
#pragma unroll
    for (int n = 0; n < 4; ++n)
#pragma unroll
        for (int h = 0; h < 2; ++h) f.v[n][h] = *(const bf16x8*)(base + n * 16 * 128 + (((h * 4 + fq) ^ gv) * 16));
}
#define LDS_RING(s) ((s) % 3 * 16384)
template <class AddrFn, class MaskFn, class FullFn>
__device__ __forceinline__ void attn_run_lds(char* smem, const Stager& sg, const bf16x8 (&qf)[2], int nsteps, AddrFn addr, MaskFn mask, FullFn full, St& st, int lane, int fq) {
    if (nsteps <= 0) return;
    const bf16_t* kp; const bf16_t* vp;
    asm volatile("s_waitcnt vmcnt(0)" ::: "memory");
    addr(0, kp, vp); sg.stage_k(smem, kp); sg.stage_v(smem, vp);
    if (nsteps > 1) { addr(1, kp, vp); sg.stage_k(smem + 16384, kp); sg.stage_v(smem + 16384, vp); }
    for (int s = 0; s < nsteps; ++s) {
        const char* cur = smem + LDS_RING(s);
        if (s + 1 < nsteps) asm volatile("s_waitcnt vmcnt(4)" ::: "memory"); else asm volatile("s_waitcnt vmcnt(0)" ::: "memory");
        __builtin_amdgcn_s_barrier();
        asm volatile("" ::: "memory");
        if (s + 2 < nsteps) { addr(s + 2, kp, vp); char* nxt = smem + LDS_RING(s + 2); sg.stage_k(nxt, kp); sg.stage_v(nxt, vp); }
        KF kc; lds_k(kc, cur, lane);
        VF vf; lds_v(vf, cur, lane);
        f32x4 sc[4]; scores(kc, qf, sc);
        float p[4][4];
        if (full(s)) softmax_step<true>(sc, [&](int key) { return mask(s, key); }, st, p, fq); else softmax_step<false>(sc, [&](int key) { return mask(s, key); }, st, p, fq);
        pv(vf, p, st.o);
    }
    __syncthreads();
}

template <class AddrFn, class MaskFn, class FullFn>
__device__ __forceinline__ void attn_run_lds2(char* smem, const Stager& sg, const bf16x8 (&qf)[2][2], int nsteps, AddrFn addr, MaskFn mask, FullFn full, St (&st)[2], int lane, int fq) {
    if (nsteps <= 0) return;
    const bf16_t* kp; const bf16_t* vp;
    asm volatile("s_waitcnt vmcnt(0)" ::: "memory");
    addr(0, kp, vp); sg.stage_k(smem, kp); sg.stage_v(smem, vp);
    if (nsteps > 1) { addr(1, kp, vp); sg.stage_k(smem + 16384, kp); sg.stage_v(smem + 16384, vp); }
    for (int s = 0; s < nsteps; ++s) {
        const char* cur = smem + LDS_RING(s);
        if (s + 1 < nsteps) asm volatile("s_waitcnt vmcnt(4)" ::: "memory"); else asm volatile("s_waitcnt vmcnt(0)" ::: "memory");
        __builtin_amdgcn_s_barrier();
        asm volatile("" ::: "memory");
        if (s + 2 < nsteps) { addr(s + 2, kp, vp); char* nxt = smem + LDS_RING(s + 2); sg.stage_k(nxt, kp); sg.stage_v(nxt, vp); }
        KF kc; lds_k(kc, cur, lane);
        VF vf; lds_v(vf, cur, lane);
#pragma unroll
        for (int r = 0; r < 2; ++r) {
            f32x4 sc[4]; scores(kc, qf[r], sc);
            float p[4][4];
            if (full(r, s)) softmax_step<true>(sc, [&](int key) { return mask(r, s, key); }, st[r], p, fq); else softmax_step<false>(sc, [&](int key) { return mask(r, s, key); }, st[r], p, fq);
            pv(vf, p, st[r].o);
        }
    }
    __syncthreads();
}

__device__ __forceinline__ void ph_attn0(const Params& p, char* smem) {
    const bf16_t* Q = (const bf16_t*)(p.ws + OFF_QKV);
    const bf16_t* VT = (const bf16_t*)(p.ws + OFF_VT);
    bf16_t* O = (bf16_t*)(p.ws + OFF_O);
    const int tid = threadIdx.x, lane = tid & 63, wid = tid >> 6, fr = lane & 15, fq = lane >> 4;
    Stager sg; sg.init(tid, LDQ, VLD);
    for (int it = blockIdx.x; it < 2 * 2 * (SEQ / 32); it += gridDim.x) {
        const int tt = it % (SEQ / 32), hkv = (it / (SEQ / 32)) & 1, b = it / (2 * (SEQ / 32));
        const int head = hkv * 4 + wid, t0 = tt * 32;
        const size_t rowb = (size_t)b * SEQ;
        bf16x8 qf[2][2]; St st[2];
#pragma unroll
        for (int r = 0; r < 2; ++r) {
            const bf16_t* qp = Q + (rowb + t0 + 16 * r + fr) * LDQ + head * 64;
            qf[r][0] = ld8(qp + fq * 8); qf[r][1] = ld8(qp + 32 + fq * 8);
            st_init(st[r]);
            st[r].m = p.sinks0[head] * LOG2E; st[r].l = (fq == 0) ? 1.f : 0.f;
        }
        int k0 = t0 - 127; if (k0 < 0) k0 = 0; k0 &= ~63;
        const int ns = ((t0 + 31 - k0) >> 6) + 1;
        const bf16_t* kbase = Q + rowb * LDQ + 512 + hkv * 64;
        const bf16_t* vbase = VT + ((size_t)(b * NVH + hkv) * 64) * VLD;
        attn_run_lds2(smem, sg, qf, ns, [&](int s, const bf16_t*& kp, const bf16_t*& vp) { const int kb = k0 + 64 * s; kp = kbase + (size_t)kb * LDQ; vp = vbase + kb; },
                      [&](int r, int s, int key) { const int k = k0 + 64 * s + key, t = t0 + 16 * r + fr; return (k <= t) && (t - k < 128); },
                      [&](int r, int s) { const int kb = k0 + 64 * s, tb = t0 + 16 * r; return (kb + 63 <= tb) && (tb + 15 - kb < 128); }, st, lane, fq);
#pragma unroll
        for (int r = 0; r < 2; ++r) {
            const float inv = 1.0f / quad_sum(st[r].l);
#pragma unroll
            for (int n = 0; n < 4; ++n) store_o4(O + (rowb + t0 + 16 * r + fr) * DM + head * 64 + n * 16 + 4 * fq, st[r].o[n][0] * inv, st[r].o[n][1] * inv, st[r].o[n][2] * inv, st[r].o[n][3] * inv);
        }
    }
    int* vote = (int*)(smem + 49152);
    for (int it = blockIdx.x; it < 2 * 8 * (SEQ / 64); it += gridDim.x) {
        const int tt = it % (SEQ / 64), head = (it / (SEQ / 64)) & 7, b = it / (8 * (SEQ / 64));
        const int tb0 = tt * 64, t = tb0 + 16 * wid + fr;
        const size_t rowb = (size_t)b * SEQ;
        bf16x8 qf[2];
        qf[0] = ld8(Q + (rowb + t) * LDQ + 768 + head * 64 + fq * 8);
        qf[1] = ld8(Q + (rowb + t) * LDQ + 768 + head * 64 + 32 + fq * 8);
        f32x4 o[4];
#pragma unroll
        for (int n = 0; n < 4; ++n) o[n] = (f32x4){0.f, 0.f, 0.f, 0.f};
        float R = 0.f;
        const bf16_t* kbase = Q + rowb * LDQ + 1280 + head * 64;
        const bf16_t* vbase = VT + ((size_t)(b * NVH + 2 + head) * 64) * VLD;
        const int nsteps = tt + 1;
        if (tid < 8) vote[tid] = 0;
        asm volatile("s_waitcnt vmcnt(0)" ::: "memory");
        sg.stage_k(smem, kbase + (size_t)tb0 * LDQ); sg.stage_v(smem, vbase + tb0);
        if (nsteps > 1) { sg.stage_k(smem + 16384, kbase + (size_t)(tb0 - 64) * LDQ); sg.stage_v(smem + 16384, vbase + tb0 - 64); }
        bool mine_done = false;
        for (int s = 0; s < nsteps; ++s) {
            const char* cur = smem + LDS_RING(s);
            const int kb = tb0 - 64 * s;
            if (s + 1 < nsteps) asm volatile("s_waitcnt vmcnt(4)" ::: "memory"); else asm volatile("s_waitcnt vmcnt(0)" ::: "memory");
            lds_fence();
            __builtin_amdgcn_s_barrier();
            asm volatile("" ::: "memory");
            if (s > 0) { const int* vv = vote + ((s - 1) & 1) * 4; if ((vv[0] & vv[1] & vv[2] & vv[3]) != 0) break; }
            if (s + 2 < nsteps) { char* nxt = smem + LDS_RING(s + 2); sg.stage_k(nxt, kbase + (size_t)(kb - 128) * LDQ); sg.stage_v(nxt, vbase + kb - 128); }
            if (!mine_done) {
                KF kc; lds_k(kc, cur, lane);
                VF vf; lds_v(vf, cur, lane);
                f32x4 sc[4]; scores(kc, qf, sc);
                float w4[4][4], ex[4][4], lsg[4][4];
                float T[2];
#pragma unroll
                for (int h = 0; h < 2; ++h) {
                    float run = 0.f;
#pragma unroll
                    for (int q = 1; q >= 0; --q) {
                        const int kt = 2 * h + q;
#pragma unroll
                        for (int j = 3; j >= 0; --j) {
                            const float z = sc[kt][j];
                            const bool v = (kb + KEY_OF(kt, j, fq)) < t;
                            const float sp = fmaxf(z, 0.f) + __logf(1.0f + __expf(-fabsf(z)));
                            ex[kt][j] = run;
                            lsg[kt][j] = v ? (z - sp) : -INFINITY;
                            run += v ? -sp : 0.f;
                        }
                    }
                    T[h] = run;
                }
                float E[2], Tot[2];
#pragma unroll
                for (int h = 0; h < 2; ++h) {
                    const float a0 = __shfl(T[h], fr), a1 = __shfl(T[h], fr + 16), a2 = __shfl(T[h], fr + 32), a3 = __shfl(T[h], fr + 48);
                    Tot[h] = (a0 + a1) + (a2 + a3);
                    E[h] = (fq < 1 ? a1 : 0.f) + (fq < 2 ? a2 : 0.f) + (fq < 3 ? a3 : 0.f);
                }
#pragma unroll
                for (int kt = 0; kt < 4; ++kt) {
                    const float off = (kt >> 1) ? (R + E[1]) : (R + Tot[1] + E[0]);
#pragma unroll
                    for (int j = 0; j < 4; ++j) w4[kt][j] = __expf(lsg[kt][j] + off + ex[kt][j]);
                }
                R += Tot[0] + Tot[1];
                pv(vf, w4, o);
                if (__all(R < -104.f)) mine_done = true;
            }
            if (lane == 0) vote[(s & 1) * 4 + wid] = mine_done ? 1 : 0;
        }
        asm volatile("s_waitcnt vmcnt(0)" ::: "memory");
        __syncthreads();
#pragma unroll
        for (int n = 0; n < 4; ++n) store_o4(O + (rowb + t) * DM + 512 + head * 64 + n * 16 + 4 * fq, o[n][0], o[n][1], o[n][2], o[n][3]);
    }
}

__device__ __forceinline__ void ph_kmean(const Params& p) {
    const bf16_t* Q = (const bf16_t*)(p.ws + OFF_QKV);
    float* KM = (float*)(p.ws + B_KMEAN);
    const int lane = threadIdx.x & 63, wid = threadIdx.x >> 6;
    const int c = lane & 7, r = lane >> 3;
    const int nw = gridDim.x * 4, w0 = ((blockIdx.x + gridDim.x - (gridDim.x > 128 ? 128 : 0)) % gridDim.x) * 4 + wid;
    for (int wi = w0; wi < 256; wi += nw) {
        const int hkv = wi & 1, j = (wi >> 1) & 63, b = wi >> 7;
        const bf16_t* base = Q + ((size_t)b * SEQ + j * 256 + r) * LDQ + 512 + hkv * 64 + c * 8;
        float acc[8] = {0.f, 0.f, 0.f, 0.f, 0.f, 0.f, 0.f, 0.f};
#pragma unroll 8
        for (int i = 0; i < 32; ++i) {
            const bf16x8 v = ld8(base + (size_t)(8 * i) * LDQ);
#pragma unroll
            for (int e = 0; e < 8; ++e) acc[e] += bf2f((bf16_t)v[e]);
        }
#pragma unroll
        for (int e = 0; e < 8; ++e) { float a = acc[e]; a += __shfl_xor(a, 8); a += __shfl_xor(a, 16); a += __shfl_xor(a, 32); acc[e] = a; }
        if (r == 0) {
            float* o = KM + ((b * 64 + j) * 2 + hkv) * 64 + c * 8;
            *(float4*)o = make_float4(acc[0] * (1.0f / 256.0f), acc[1] * (1.0f / 256.0f), acc[2] * (1.0f / 256.0f), acc[3] * (1.0f / 256.0f));
            *(float4*)(o + 4) = make_float4(acc[4] * (1.0f / 256.0f), acc[5] * (1.0f / 256.0f), acc[6] * (1.0f / 256.0f), acc[7] * (1.0f / 256.0f));
        }
    }
}
__device__ __forceinline__ size_t moba_list_off(int L, int j) { return (size_t)L * MOBA_LCAP + 1024ull * (size_t)(63 * j - (j * (j - 1)) / 2); }

__device__ __forceinline__ void ph_moba_gate(const Params& p, char* smem) {
    float* km = (float*)smem;
    int* cnt = (int*)(smem + 16384);
    int* gbase = cnt + 64;
    const bf16_t* Q = (const bf16_t*)(p.ws + OFF_QKV);
    const float* KM = (const float*)(p.ws + B_KMEAN);
    int* gcnt = (int*)(p.ws + OFF_MOBACNT);
    int* lists = (int*)(p.ws + B_LIST);
    const int tid = threadIdx.x;
    for (int it = blockIdx.x; it < 1024; it += gridDim.x) {
        const int tc = it & 255, hkv = (it >> 8) & 1, b = it >> 9, LL = b * 2 + hkv;
        const int tl = tc * 64 + (tid >> 2), g = tid & 3, own = tl >> 8;
        for (int i = tid; i < 64 * 64; i += 256) { const int j = i >> 6, d = i & 63; km[i] = KM[((b * 64 + j) * 2 + hkv) * 64 + d]; }
        if (tid < 64) cnt[tid] = 0;
        __syncthreads();
        float q[64];
        {
            const bf16_t* qp = Q + ((size_t)b * SEQ + tl) * LDQ + (hkv * 4 + g) * 64;
#pragma unroll
            for (int i = 0; i < 8; ++i) { const bf16x8 v = ld8(qp + i * 8);
#pragma unroll
                for (int e = 0; e < 8; ++e) q[i * 8 + e] = bf2f((bf16_t)v[e]); }
        }
        float bv0 = -INFINITY, bv1 = -INFINITY, bv2 = -INFINITY; int bi0 = 0, bi1 = 1, bi2 = 2;
        for (int j = 0; j < own; ++j) {
            float s = 0.f;
#pragma unroll
            for (int d = 0; d < 64; d += 4) { const float4 k = *(const float4*)(km + j * 64 + d); s += q[d] * k.x; s += q[d + 1] * k.y; s += q[d + 2] * k.z; s += q[d + 3] * k.w; }
            if (s > bv0) { bv2 = bv1; bi2 = bi1; bv1 = bv0; bi1 = bi0; bv0 = s; bi0 = j; }
            else if (s > bv1) { bv2 = bv1; bi2 = bi1; bv1 = s; bi1 = j; }
            else if (s > bv2) { bv2 = s; bi2 = j; }
        }
        const int nv = own < 3 ? own : 3;
        int rk0 = 0, rk1 = 0, rk2 = 0;
        if (nv > 0) rk0 = atomicAdd(&cnt[bi0], 1);
        if (nv > 1) rk1 = atomicAdd(&cnt[bi1], 1);
        if (nv > 2) rk2 = atomicAdd(&cnt[bi2], 1);
        __syncthreads();
        if (tid < 64 && cnt[tid] > 0) gbase[tid] = atomicAdd(&gcnt[(LL * 64 + tid) * CNTS], cnt[tid]);
        __syncthreads();
        const int ent = tl | (g << 14);
        if (nv > 0) lists[moba_list_off(LL, bi0) + gbase[bi0] + rk0] = ent | (0 << 16);
        if (nv > 1) lists[moba_list_off(LL, bi1) + gbase[bi1] + rk1] = ent | (1 << 16);
        if (nv > 2) lists[moba_list_off(LL, bi2) + gbase[bi2] + rk2] = ent | (2 << 16);
        __syncthreads();
    }
}

__device__ __forceinline__ void ph_moba_part(const Params& p, char* smem) {
    int* cpre = (int*)(smem + 49152);
    const bf16_t* Q = (const bf16_t*)(p.ws + OFF_QKV);
    const bf16_t* VT = (const bf16_t*)(p.ws + OFF_VT);
    const int* gcnt = (const int*)(p.ws + OFF_MOBACNT);
    const int* lists = (const int*)(p.ws + B_LIST);
    bf16_t* PO = (bf16_t*)(p.ws + B_PO); float* PML = (float*)(p.ws + B_PML);
    const int tid = threadIdx.x, lane = tid & 63, wid = tid >> 6, fr = lane & 15, fq = lane >> 4;
    Stager sg; sg.init(tid, LDQ, VLD);
    cpre[tid + 1] = (gcnt[tid * CNTS] + 127) >> 7;
    if (tid == 0) cpre[0] = 0;
    __syncthreads();
    if (tid == 0) { int acc = 0; for (int i = 1; i <= 256; ++i) { acc += cpre[i]; cpre[i] = acc; } }
    __syncthreads();
    const int total = cpre[256];
    for (int it = blockIdx.x; it < total; it += gridDim.x) {
        int li;
        { int lo = 0, hi = 255; while (lo < hi) { const int mid = (lo + hi + 1) >> 1; if (cpre[mid] <= it) lo = mid; else hi = mid - 1; } li = lo; }
        const int chunk = it - cpre[li], LL = li >> 6, j = li & 63, b = LL >> 1, hkv = LL & 1, n = gcnt[li * CNTS];
        const int* lst = lists + moba_list_off(LL, j);
        int ent[2]; bf16x8 qf[2][2]; St st[2];
#pragma unroll
        for (int r = 0; r < 2; ++r) {
            const int ri = chunk * 128 + r * 64 + wid * 16 + fr;
            ent[r] = lst[ri < n ? ri : n - 1];
            const bf16_t* qp = Q + ((size_t)b * SEQ + (ent[r] & 16383)) * LDQ + (hkv * 4 + ((ent[r] >> 14) & 3)) * 64;
            qf[r][0] = ld8(qp + fq * 8); qf[r][1] = ld8(qp + 32 + fq * 8);
            st_init(st[r]);
        }
        const bf16_t* kbase = Q + ((size_t)b * SEQ + j * 256) * LDQ + 512 + hkv * 64;
        const bf16_t* vbase = VT + ((size_t)(b * NVH + hkv) * 64) * VLD + j * 256;
        attn_run_lds2(smem, sg, qf, 4, [&](int s, const bf16_t*& kp, const bf16_t*& vp) { kp = kbase + (size_t)(64 * s) * LDQ; vp = vbase + 64 * s; },
                      [](int, int, int) { return true; }, [](int, int) { return true; }, st, lane, fq);
#pragma unroll
        for (int r = 0; r < 2; ++r) {
            const int ri = chunk * 128 + r * 64 + wid * 16 + fr;
            const float l = quad_sum(st[r].l);
            if (ri < n) {
                const int e = ent[r];
                const size_t idx = ((size_t)((size_t)b * SEQ + (e & 16383)) * 8 + hkv * 4 + ((e >> 14) & 3)) * 3 + ((e >> 16) & 3);
                st_part(PO + idx * 64 + fq * 16, st[r].o);
                if (fq == 0) { PML[idx * 2] = st[r].m; PML[idx * 2 + 1] = l; }
            }
        }
    }
}

__device__ __forceinline__ void ph_moba_own(const Params& p, char* smem) {
    const bf16_t* Q = (const bf16_t*)(p.ws + OFF_QKV);
    const bf16_t* VT = (const bf16_t*)(p.ws + OFF_VT);
    const bf16_t* PO = (const bf16_t*)(p.ws + B_PO); const float* PML = (const float*)(p.ws + B_PML);
    bf16_t* O = (bf16_t*)(p.ws + OFF_O);
    const int tid = threadIdx.x, lane = tid & 63, wid = tid >> 6, fr = lane & 15, fq = lane >> 4;
    Stager sg; sg.init(tid, LDQ, VLD);
    for (int it = blockIdx.x; it < 2 * 2 * (SEQ / 32); it += gridDim.x) {
        const int hb = it / (SEQ / 32), tt = (it % (SEQ / 32) + 3 * hb) % (SEQ / 32), hkv = hb & 1, b = hb >> 1;
        const int head = hkv * 4 + wid, t0 = tt * 32, own = t0 >> 8;
        const size_t rowb = (size_t)b * SEQ;
        bf16x8 qf[2][2]; St st[2];
#pragma unroll
        for (int r = 0; r < 2; ++r) {
            const bf16_t* qp = Q + (rowb + t0 + 16 * r + fr) * LDQ + head * 64;
            qf[r][0] = ld8(qp + fq * 8); qf[r][1] = ld8(qp + 32 + fq * 8);
            st_init(st[r]);
        }
        const int k0 = own * 256, ns = ((t0 + 31 - k0) >> 6) + 1;
        const bf16_t* kbase = Q + rowb * LDQ + 512 + hkv * 64;
        const bf16_t* vbase = VT + ((size_t)(b * NVH + hkv) * 64) * VLD;
        attn_run_lds2(smem, sg, qf, ns, [&](int s, const bf16_t*& kp, const bf16_t*& vp) { const int kb = k0 + 64 * s; kp = kbase + (size_t)kb * LDQ; vp = vbase + kb; },
                      [&](int r, int s, int key) { return (k0 + 64 * s + key) <= (t0 + 16 * r + fr); },
                      [&](int r, int s) { return (k0 + 64 * s + 63) <= (t0 + 16 * r); }, st, lane, fq);
        const int nv = own < 3 ? own : 3;
#pragma unroll
        for (int r = 0; r < 2; ++r) {
            const int t = t0 + 16 * r + fr;
            float l = quad_sum(st[r].l), m = st[r].m;
            for (int q = 0; q < nv; ++q) {
                const size_t idx = ((size_t)(rowb + t) * 8 + head) * 3 + q;
                const float mr = PML[idx * 2], lr = PML[idx * 2 + 1];
                const float mn = fmaxf(m, mr), a = ex2(m - mn), c = ex2(mr - mn);
#pragma unroll
                for (int n = 0; n < 4; ++n) st[r].o[n] *= a;
                acc_part(PO + idx * 64 + fq * 16, c, st[r].o);
                l = l * a + c * lr; m = mn;
            }
            const float inv = 1.0f / l;
#pragma unroll
            for (int n = 0; n < 4; ++n) store_o4(O + (rowb + t) * DM + head * 64 + n * 16 + 4 * fq, st[r].o[n][0] * inv, st[r].o[n][1] * inv, st[r].o[n][2] * inv, st[r].o[n][3] * inv);
        }
    }
}

__device__ __forceinline__ float gelu_tanh(float x) {
    const float u = 0.7978845608028654f * (x + 0.044715f * x * x * x);
    const float e = __expf(2.0f * u);
    const float th = 1.0f - 2.0f / (e + 1.0f);
    return 0.5f * x * (1.0f + th);
}
__device__ __forceinline__ void ph_cmp1(const Params& p, char* smem) {
    const bf16_t* Q = (const bf16_t*)(p.ws + OFF_QKV);
    const int tid = hidden_tid();
    for (int it = blockIdx.x; it < 128; it += gridDim.x) {
        const int kv = it >> 6, mt = (it >> 1) & 31, nt = it & 1;
        const int col = kv ? 1408 : 1280;
        const bf16_t* Bt = (const bf16_t*)(p.ws + (kv ? W_V1 : W_K1));
        const float* bias = (const float*)(p.ws + (kv ? W_BV : W_BK));
        bf16_t* HID = (bf16_t*)(p.ws + (kv ? B_HIDV : B_HIDK));
        const bf16_t* ap[4];
#pragma unroll
        for (int i = 0; i < 4; ++i) {
            const int r = mt * 128 + i * 32 + (tid >> 3);
            const int h = r & 1, bc = r >> 1, c = bc & 1023, b = bc >> 10;
            const int cc = (c < NCMP) ? c : 0;
            ap[i] = Q + ((size_t)b * SEQ + 16 * cc) * LDQ + col + h * 64 + GSW64(tid);
        }
        const bf16_t* b0 = Bt + (size_t)(nt * 128 + (tid >> 3)) * 2048 + GSW64(tid);
        gemm_tile_k64(smem, tid, ap, b0, (size_t)32 * 2048, 32, [](int t) { return (size_t)t * LDQ; },
            [&](f32x4 (&acc)[4][4], int wr, int wc, int fr, int fq) {
#pragma unroll
                for (int m = 0; m < 4; ++m)
#pragma unroll
                    for (int j = 0; j < 4; ++j) {
                        const int r = mt * 128 + wr * 64 + m * 16 + fq * 4 + j;
#pragma unroll
                        for (int n = 0; n < 4; ++n) { const int cn = nt * 128 + wc * 64 + n * 16 + fr; HID[(size_t)r * 256 + cn] = f2bf(gelu_tanh(acc[m][n][j] + bias[cn])); }
                    }
            });
    }
}
__device__ __forceinline__ void ph_cmp2(const Params& p, char* smem) {
    const int tid = threadIdx.x;
    for (int it = blockIdx.x; it < 64; it += gridDim.x) {
        const int kv = it >> 5, mt = it & 31;
        const bf16_t* A = (const bf16_t*)(p.ws + (kv ? B_HIDV : B_HIDK));
        const bf16_t* Bt = (const bf16_t*)(p.ws + (kv ? W_V2 : W_K2));
        bf16_t* KC = (bf16_t*)(p.ws + B_KCMP); bf16_t* VC = (bf16_t*)(p.ws + B_VCMPT);
        const bf16_t* a0 = A + (size_t)(mt * 128 + (tid >> 2)) * 256 + GSW(tid);
        const bf16_t* a1 = a0 + (size_t)64 * 256;
        const bf16_t* b0 = Bt + (size_t)(tid >> 2) * 256 + GSW(tid);
        const bf16_t* b1 = b0 + (size_t)64 * 256;
        gemm_tile(smem, a0, a1, b0, b1, 8, [](int t) { return (size_t)t * 32; },
            [&](f32x4 (&acc)[4][4], int wr, int wc, int fr, int fq) {
                if (wc != 0) return;
#pragma unroll
                for (int m = 0; m < 4; ++m)
#pragma unroll
                    for (int j = 0; j < 4; ++j) {
                        const int r = mt * 128 + wr * 64 + m * 16 + fq * 4 + j;
                        const int h = r & 1, bc = r >> 1, c = bc & 1023, b = bc >> 10;
                        const bool ok = c < NCMP;
#pragma unroll
                        for (int n = 0; n < 4; ++n) {
                            const int d = n * 16 + fr;
                            const bf16_t v = ok ? f2bf(acc[m][n][j]) : (bf16_t)0;
                            if (kv == 0) KC[((size_t)(b * 2 + h) * 1024 + c) * 64 + d] = v;
                            else VC[((size_t)(b * 2 + h) * 64 + d) * CLD + c] = v;
                        }
                    }
            });
    }
}

#ifndef PROBE_NSA
#define PROBE_NSA 0
#endif
#define NSA_T(i) if (PROBE_NSA) { const unsigned long long _n = clock64(); tsec[i] += _n - tprev; tprev = _n; }
__device__ __forceinline__ size_t nsa_list_off(int LL, int j) { return (size_t)LL * NSA_LCAP + 64ull * (size_t)(254 * j - (j * (j - 1)) / 2); }
__device__ __forceinline__ char* nsa_part_ptr(char* ws, int LL, int t, int slot) {
    const size_t rec = ((size_t)((LL & 1) * SEQ + t) * 13 + slot) * 544;
    return ws + ((LL >> 1) ? NSA_PY : NSA_PX) + rec;
}
struct NsaIter { bool aff; int xcd, i0, istr, icnt; };
__device__ __forceinline__ NsaIter nsa_iter() {
    NsaIter it; it.aff = (gridDim.x & 7) == 0; it.xcd = blockIdx.x & 7;
    it.i0 = it.aff ? (blockIdx.x >> 3) : blockIdx.x;
    it.istr = it.aff ? (gridDim.x >> 3) : gridDim.x;
    it.icnt = it.aff ? 512 : 4096;
    return it;
}

__device__ __forceinline__ void ph_nsa1(const Params& p, char* smem) {
    unsigned long long tsec[5] = {0, 0, 0, 0, 0}, tprev = 0;
    if (PROBE_NSA) tprev = clock64();
    const bf16_t* Q = (const bf16_t*)(p.ws + OFF_QKV);
    const bf16_t* VT = (const bf16_t*)(p.ws + OFF_VT);
    const bf16_t* KC = (const bf16_t*)(p.ws + B_KCMP); const bf16_t* VC = (const bf16_t*)(p.ws + B_VCMPT);
    const float* GD = (const float*)(p.ws + B_GD);
    bf16_t* O = (bf16_t*)(p.ws + OFF_O);
    unsigned char* SID = (unsigned char*)(p.ws + M_SELID);
    int* gcnt = (int*)(p.ws + OFF_NSACNT);
    unsigned short* lists = (unsigned short*)(p.ws + NSA_LISTS);
    unsigned char* lslot = (unsigned char*)(p.ws + NSA_SLOTS);
    const int tid = threadIdx.x, lane = tid & 63, wid = tid >> 6, fr = lane & 15, fq = lane >> 4;
    float* imp = (float*)(smem + 49152 + wid * 5376);
    int* selq = (int*)(smem + 49152 + wid * 5376 + 4096);
    int* sc = (int*)(smem + 49152 + wid * 5376 + 4352);
    const int qi_l = fr >> 2, g_l = fr & 3;
    Stager sgc; sgc.init(tid, 64, CLD);
    Stager sgw; sgw.init(tid, LDQ, VLD);
    const NsaIter itr = nsa_iter();
    for (int ii = itr.i0; ii < itr.icnt; ii += itr.istr) {
        const int LL = itr.aff ? (itr.xcd & 3) : (ii >> 10);
        const int tqb = itr.aff ? (2 * ii + (itr.xcd >> 2)) : (ii & 1023);
        const int b = LL >> 1, hkv = LL & 1;
        const int tb0 = tqb * 16, t0 = tb0 + wid * 4, t = t0 + qi_l;
        const size_t rowb = (size_t)b * SEQ;
        bf16x8 qf[2];
        {
            const bf16_t* qp = Q + (rowb + t) * LDQ + 768 + (hkv * 4 + g_l) * 64;
            qf[0] = ld8(qp + fq * 8); qf[1] = ld8(qp + 32 + fq * 8);
        }
        const float* gp = GD + (rowb + t) * 24 + (hkv * 4 + g_l) * 3;
        f32x4 outa[4];
#pragma unroll
        for (int n = 0; n < 4; ++n) outa[n] = (f32x4){0.f, 0.f, 0.f, 0.f};
        const bf16_t* kc = KC + (size_t)LL * 1024 * 64;
        const bf16_t* vc = VC + (size_t)LL * 64 * CLD;
        const int cN = (tb0 + 15 >= 31) ? ((tb0 + 15 - 31) >> 4) + 1 : 0;
        const int csteps = (cN + 63) >> 6;
        float m1 = NEG_BIG, l1 = 0.f;
        if (csteps > 0) {
            const int cs2 = (csteps + 1) >> 1;
            auto stage2 = [&](int s2, char* buf) {
                const int ta = 2 * s2, tb = (2 * s2 + 1 < 16) ? 2 * s2 + 1 : 15;
                sgc.stage_k(buf, kc + (size_t)ta * 64 * 64); sgc.stage_k(buf + 8192, kc + (size_t)tb * 64 * 64);
            };
            asm volatile("s_waitcnt vmcnt(0)" ::: "memory");
            stage2(0, smem);
            if (cs2 > 1) stage2(1, smem + 16384);
            for (int s = 0; s < cs2; ++s) {
                const char* cur = smem + LDS_RING(s);
                if (s + 1 < cs2) asm volatile("s_waitcnt vmcnt(4)" ::: "memory"); else asm volatile("s_waitcnt vmcnt(0)" ::: "memory");
                __builtin_amdgcn_s_barrier();
                asm volatile("" ::: "memory");
                if (s + 2 < cs2) stage2(s + 2, smem + LDS_RING(s + 2));
                float mx = -INFINITY;
                f32x4 sc[2][4];
#pragma unroll
                for (int u = 0; u < 2; ++u) {
                    KF kcur; lds_k(kcur, cur + u * 8192, lane);
                    scores(kcur, qf, sc[u]);
#pragma unroll
                    for (int kt = 0; kt < 4; ++kt)
#pragma unroll
                        for (int j = 0; j < 4; ++j) { const bool v = (16 * ((2 * s + u) * 64 + KEY_OF(kt, j, fq)) + 31) <= t; mx = fmaxf(mx, v ? sc[u][kt][j] : -INFINITY); }
                }
                mx = quad_max(mx);
                const float mn = fmaxf(m1, mx);
                float sum = 0.f;
#pragma unroll
                for (int u = 0; u < 2; ++u)
#pragma unroll
                    for (int kt = 0; kt < 4; ++kt)
#pragma unroll
                        for (int j = 0; j < 4; ++j) { const bool v = (16 * ((2 * s + u) * 64 + KEY_OF(kt, j, fq)) + 31) <= t; sum += v ? ex2(sc[u][kt][j] - mn) : 0.f; }
                l1 = l1 * ex2(m1 - mn) + sum; m1 = mn;
            }
            __syncthreads();
        }
        NSA_T(0)
        const float ltot = quad_sum(l1), il = ltot > 0.f ? 1.0f / ltot : 0.f;
        for (int i = lane; i < 1024; i += 64) imp[i] = 0.f;
        lds_fence();
        if (csteps > 0) {
            f32x4 oc[4];
#pragma unroll
            for (int n = 0; n < 4; ++n) oc[n] = (f32x4){0.f, 0.f, 0.f, 0.f};
            asm volatile("s_waitcnt vmcnt(0)" ::: "memory");
            sgc.stage_k(smem, kc); sgc.stage_v(smem, vc);
            if (csteps > 1) { sgc.stage_k(smem + 16384, kc + (size_t)64 * 64); sgc.stage_v(smem + 16384, vc + 64); }
            for (int s = 0; s < csteps; ++s) {
                const char* cur = smem + LDS_RING(s);
                if (s + 1 < csteps) asm volatile("s_waitcnt vmcnt(4)" ::: "memory"); else asm volatile("s_waitcnt vmcnt(0)" ::: "memory");
                __builtin_amdgcn_s_barrier();
                asm volatile("" ::: "memory");
                if (s + 2 < csteps) { char* nxt = smem + LDS_RING(s + 2); sgc.stage_k(nxt, kc + (size_t)(s + 2) * 64 * 64); sgc.stage_v(nxt, vc + (s + 2) * 64); }
                KF kcur; lds_k(kcur, cur, lane);
                VF vf; lds_v(vf, cur, lane);
                f32x4 sc[4]; scores(kcur, qf, sc);
                float pp[4][4], ps[4], cy[4];
#pragma unroll
                for (int kt = 0; kt < 4; ++kt) {
                    float a = 0.f;
#pragma unroll
                    for (int j = 0; j < 4; ++j) { const bool v = (16 * (s * 64 + KEY_OF(kt, j, fq)) + 31) <= t; pp[kt][j] = v ? ex2(sc[kt][j] - m1) * il : 0.f; a += pp[kt][j]; }
                    float c = pp[kt][3];
                    a += __shfl_xor(a, 1); a += __shfl_xor(a, 2);
                    c += __shfl_xor(c, 1); c += __shfl_xor(c, 2);
                    ps[kt] = a; cy[kt] = c;
                }
                if (g_l == 0) {
#pragma unroll
                    for (int kt = 0; kt < 4; ++kt) imp[qi_l * 256 + s * 16 + 8 * (kt >> 1) + 2 * fq + (kt & 1)] += ps[kt];
                }
                lds_fence();
                if (g_l == 0) {
#pragma unroll
                    for (int kt = 0; kt < 4; ++kt) { const int a1 = s * 16 + 8 * (kt >> 1) + 2 * fq + (kt & 1) + 1; if (a1 < 256) imp[qi_l * 256 + a1] += cy[kt]; }
                }
                lds_fence();
                pv(vf, pp, oc);
            }
            __syncthreads();
            { const float gc = 1.0f / (1.0f + __expf(-gp[0]));
#pragma unroll
            for (int n = 0; n < 4; ++n) outa[n] += oc[n] * gc; }
        }
        NSA_T(1)
        for (int qi = 0; qi < 4; ++qi) {
            const int cur = (t0 + qi) >> 6;
            int* ib = (int*)imp + qi * 256;
            if (lane == 0) ib[0] = -1;
            const int js = cur - 1 + (lane - 1);
            if (lane >= 1 && lane < 5 && js >= 0 && js < 256) ib[js] = -1;
        }
        lds_fence();
#pragma unroll 1
        for (int qi = 0; qi < 4; ++qi) {
            const int tt = t0 + qi, cur = tt >> 6;
            const int* ib = (const int*)imp + qi * 256;
            const int nforced = cur == 0 ? 1 : (cur == 1 ? 2 : 3);
            const int ncand = cur - 2 > 0 ? cur - 2 : 0;
            const int K = (16 - nforced) < ncand ? (16 - nforced) : ncand;
            int bi[4]; bool cand[4];
#pragma unroll
            for (int k = 0; k < 4; ++k) {
                const int i = lane + 64 * k;
                cand[k] = (i >= 1) && (i <= cur - 2);
                bi[k] = cand[k] ? ib[i] : -1;
            }
            bool done = false;
            if (K < ncand) {
                const int mloc = max(max(bi[0], bi[1]), max(bi[2], bi[3]));
                sc[lane] = mloc;
                lds_fence();
                int cnt = 0;
#pragma unroll 2
                for (int l4 = 0; l4 < 64; l4 += 4) {
                    const int4 v = *(const int4*)(sc + l4);
                    cnt += (v.x > mloc - ((l4 + 0) < lane ? 1 : 0)) ? 1 : 0; cnt += (v.y > mloc - ((l4 + 1) < lane ? 1 : 0)) ? 1 : 0;
                    cnt += (v.z > mloc - ((l4 + 2) < lane ? 1 : 0)) ? 1 : 0; cnt += (v.w > mloc - ((l4 + 3) < lane ? 1 : 0)) ? 1 : 0;
                }
                const unsigned long long mkk = __ballot(cnt == K - 1);
                const int tau = __builtin_amdgcn_readlane(mloc, __builtin_amdgcn_readfirstlane((int)__ffsll((long long)mkk) - 1));
                int ns = 0;
#pragma unroll
                for (int k = 0; k < 4; ++k) {
                    const bool sv = cand[k] && (bi[k] >= tau);
                    const unsigned long long mk = __ballot(sv);
                    const int pos = ns + __popcll(mk & ((1ull << lane) - 1ull));
                    if (sv && pos < 64) { sc[64 + pos] = bi[k]; sc[128 + pos] = lane + 64 * k; }
                    ns += __popcll(mk);
                }
                lds_fence();
                if (ns <= 64) {
                    const int my = sc[64 + (lane < ns ? lane : 0)], myi = sc[128 + (lane < ns ? lane : 0)];
                    int rk = 0;
                    const int ns4 = __builtin_amdgcn_readfirstlane(ns) & ~3;
                    for (int j = 0; j < ns4; j += 4) {
                        const int4 vj = *(const int4*)(sc + 64 + j), ij = *(const int4*)(sc + 128 + j);
                        rk += ((vj.x > my) || (vj.x == my && ij.x < myi)) ? 1 : 0; rk += ((vj.y > my) || (vj.y == my && ij.y < myi)) ? 1 : 0;
                        rk += ((vj.z > my) || (vj.z == my && ij.z < myi)) ? 1 : 0; rk += ((vj.w > my) || (vj.w == my && ij.w < myi)) ? 1 : 0;
                    }
                    for (int j = ns4; j < ns; ++j) { const int vj = sc[64 + j], ij = sc[128 + j]; rk += ((vj > my) || (vj == my && ij < myi)) ? 1 : 0; }
                    if (lane < ns && rk < K) selq[qi * 13 + rk] = myi;
                    done = true;
                }
                lds_fence();
            }
            if (!done) {
                int rank[4] = {0, 0, 0, 0};
                if (K < ncand) {
                    const int jend = __builtin_amdgcn_readfirstlane(cur - 1);
                    for (int j4 = 0; j4 < jend; j4 += 4) {
                        const int4 v = *(const int4*)(ib + j4);
                        const int vv[4] = {v.x, v.y, v.z, v.w};
#pragma unroll
                        for (int k = 0; k < 4; ++k)
#pragma unroll
                            for (int e = 0; e < 4; ++e) rank[k] += (vv[e] > bi[k] - ((j4 + e) < (lane + 64 * k) ? 1 : 0)) ? 1 : 0;
                    }
                }
                int off = 0;
#pragma unroll
                for (int i = 0; i < 4; ++i) {
                    const bool sb = cand[i] && (rank[i] < K);
                    const unsigned long long mk = __ballot(sb);
                    if (sb) selq[qi * 13 + off + __popcll(mk & ((1ull << lane) - 1ull))] = lane + 64 * i;
                    off += __popcll(mk);
                }
            }
            if (lane == 0) selq[52 + qi] = K;
        }
        lds_fence();
        NSA_T(2)
        if (lane < 52) {
            const int qi = lane / 13, slot = lane - qi * 13, tt = t0 + qi;
            if (slot < selq[52 + qi]) {
                const int jb = selq[lane];
                SID[((size_t)LL * SEQ + tt) * 16 + slot] = (unsigned char)jb;
                const int pos = atomicAdd(&gcnt[(LL * 256 + jb) * CNTS], 1);
                lists[nsa_list_off(LL, jb) + pos] = (unsigned short)tt;
                lslot[nsa_list_off(LL, jb) + pos] = (unsigned char)slot;
            }
        } else if (lane < 56) {
            SID[((size_t)LL * SEQ + t0 + (lane - 52)) * 16 + 15] = (unsigned char)selq[lane];
        }
        lds_fence();
        NSA_T(3)
        {
            St st; st_init(st);
            bf16x8 qw[2];
            { const bf16_t* qp = Q + (rowb + t) * LDQ + 768 + (hkv * 4 + g_l) * 64; qw[0] = ld8(qp + fq * 8); qw[1] = ld8(qp + 32 + fq * 8); }
            int k0 = tb0 - 511; if (k0 < 0) k0 = 0; k0 &= ~63;
            const int nw = ((tb0 + 15 - k0) >> 6) + 1;
            const bf16_t* kbase = Q + rowb * LDQ + 1792 + hkv * 64;
            const bf16_t* vbase = VT + ((size_t)(b * NVH + 4 + hkv) * 64) * VLD;
            attn_run_lds(smem, sgw, qw, nw, [&](int s, const bf16_t*& kp, const bf16_t*& vp) { const int kb = k0 + 64 * s; kp = kbase + (size_t)kb * LDQ; vp = vbase + kb; },
                         [&](int s, int key) { const int k = k0 + 64 * s + key; return (k <= t) && (t - k < 512); },
                         [&](int s) { const int kb = k0 + 64 * s; return (kb + 63 <= t0) && (t0 + 3 - kb < 512); }, st, lane, fq);
            const float gw = 1.0f / (1.0f + __expf(-gp[2]));
            const float l = quad_sum(st.l), inv = l > 0.f ? gw / l : 0.f;
#pragma unroll
            for (int n = 0; n < 4; ++n) outa[n] += st.o[n] * inv;
        }
#pragma unroll
        for (int n = 0; n < 4; ++n) store_o4(O + (rowb + t) * DM + 512 + (hkv * 4 + g_l) * 64 + n * 16 + 4 * fq, outa[n][0], outa[n][1], outa[n][2], outa[n][3]);
        NSA_T(4)
    }
    if (PROBE_NSA && threadIdx.x == 0) { unsigned long long* sx = (unsigned long long*)(smem - HDR_BYTES + 32) + 24; for (int i = 0; i < 5; ++i) sx[i] = tsec[i]; }
}

__device__ __forceinline__ void ph_nsa2(const Params& p, char* smem) {
    int* cpre = (int*)(smem + 49152);
    const bf16_t* Q = (const bf16_t*)(p.ws + OFF_QKV);
    const bf16_t* VT = (const bf16_t*)(p.ws + OFF_VT);
    const unsigned char* lslot = (const unsigned char*)(p.ws + NSA_SLOTS);
    const int* gcnt = (const int*)(p.ws + OFF_NSACNT);
    const unsigned short* lists = (const unsigned short*)(p.ws + NSA_LISTS);
    const int tid = threadIdx.x, lane = tid & 63, wid = tid >> 6, fr = lane & 15, fq = lane >> 4;
    const int qi_l = fr >> 2, g_l = fr & 3;
    for (int i = tid; i < 1024; i += 256) cpre[i + 1] = (gcnt[i * CNTS] + 63) >> 6;
    if (tid == 0) cpre[0] = 0;
    __syncthreads();
    if (tid == 0) { int acc = 0; for (int i = 1; i <= 1024; ++i) { acc += cpre[i]; cpre[i] = acc; } }
    __syncthreads();
    const int total = cpre[1024];
    for (int it = blockIdx.x * 4 + wid; it < total; it += gridDim.x * 4) {
        int li;
        { int lo = 0, hi = 1023; while (lo < hi) { const int mid = (lo + hi + 1) >> 1; if (cpre[mid] <= it) lo = mid; else hi = mid - 1; } li = lo; }
        const int chunk = it - cpre[li], LL = li >> 8, j = li & 255, b = LL >> 1, hkv = LL & 1, n = gcnt[li * CNTS];
        const unsigned short* lst = lists + nsa_list_off(LL, j);
        const size_t rowb = (size_t)b * SEQ;
        KF kf; load_k(kf, Q + (rowb + (size_t)j * 64) * LDQ + 1536 + hkv * 64, LDQ, fr, fq);
        VF vf; load_v(vf, VT + ((size_t)(b * NVH + 2 + hkv) * 64) * VLD + j * 64, VLD, fr, fq);
        const int e0 = chunk * 64, e1 = (e0 + 64 < n) ? e0 + 64 : n;
        const unsigned char* lsl = lslot + nsa_list_off(LL, j);
        const int emine = (e0 + lane < e1) ? e0 + lane : e0;
        const int tmine = (int)lst[emine] | ((int)lsl[emine] << 16);
        const int ntile = (e1 - e0 + 3) >> 2;
        int ttA, ttB; bf16x8 qA0, qA1, qB0, qB1;
        {
            ttA = __shfl(tmine, (qi_l < e1 - e0) ? qi_l : 0);
            const bf16_t* qp = Q + (rowb + (ttA & 0xFFFF)) * LDQ + 768 + (hkv * 4 + g_l) * 64;
            qA0 = ld8(qp + fq * 8); qA1 = ld8(qp + 32 + fq * 8);
            const int eB = 4 + qi_l;
            ttB = __shfl(tmine, (eB < e1 - e0) ? eB : 0);
            qp = Q + (rowb + (ttB & 0xFFFF)) * LDQ + 768 + (hkv * 4 + g_l) * 64;
            qB0 = ld8(qp + fq * 8); qB1 = ld8(qp + 32 + fq * 8);
        }
        for (int tile = 0; tile < ntile; ++tile) {
            const bf16x8 qf[2] = {qA0, qA1};
            const int tcur = ttA & 0xFFFF, slot = ttA >> 16; const bool okc = (tile * 4 + qi_l) < (e1 - e0);
            ttA = ttB; qA0 = qB0; qA1 = qB1;
            {
                const int eN = (tile + 2) * 4 + qi_l;
                ttB = __shfl(tmine, (eN < e1 - e0) ? eN : 0);
                const bf16_t* qp = Q + (rowb + (ttB & 0xFFFF)) * LDQ + 768 + (hkv * 4 + g_l) * 64;
                qB0 = ld8(qp + fq * 8); qB1 = ld8(qp + 32 + fq * 8);
            }
            f32x4 sc[4]; scores(kf, qf, sc);
            float mx = sc[0][0];
#pragma unroll
            for (int kt = 0; kt < 4; ++kt)
#pragma unroll
                for (int jj = 0; jj < 4; ++jj) mx = fmaxf(mx, sc[kt][jj]);
            mx = quad_max(mx);
            float pp[4][4]; float sum = 0.f;
#pragma unroll
            for (int kt = 0; kt < 4; ++kt)
#pragma unroll
                for (int jj = 0; jj < 4; ++jj) { pp[kt][jj] = ex2(sc[kt][jj] - mx); sum += pp[kt][jj]; }
            sum = quad_sum(sum);
            f32x4 o[4];
#pragma unroll
            for (int nn = 0; nn < 4; ++nn) o[nn] = (f32x4){0.f, 0.f, 0.f, 0.f};
            pv(vf, pp, o);
            if (okc) {
                char* rec = nsa_part_ptr(p.ws, LL, tcur, slot);
                st_part((bf16_t*)(rec + g_l * 128) + fq * 16, o);
                if (fq == 0) *(float2*)(rec + 512 + g_l * 8) = make_float2(mx, sum);
            }
        }
    }
}

__device__ __forceinline__ void ph_nsa3(const Params& p, char* smem) {
    (void)smem;
    const bf16_t* Q = (const bf16_t*)(p.ws + OFF_QKV);
    const bf16_t* VT = (const bf16_t*)(p.ws + OFF_VT);
    const float* GD = (const float*)(p.ws + B_GD);
    const unsigned char* SID = (const unsigned char*)(p.ws + M_SELID);
    bf16_t* O = (bf16_t*)(p.ws + OFF_O);
    const int tid = threadIdx.x, lane = tid & 63, wid = tid >> 6, fr = lane & 15, fq = lane >> 4;
    const int qi_l = fr >> 2, g_l = fr & 3;
    Stager sg; sg.init(tid, LDQ, VLD);
    const NsaIter itr = nsa_iter();
    for (int ii = itr.i0; ii < itr.icnt; ii += itr.istr) {
        const int LL = itr.aff ? (itr.xcd & 3) : (ii >> 10);
        const int tqb = itr.aff ? (2 * ii + (itr.xcd >> 2)) : (ii & 1023);
        const int b = LL >> 1, hkv = LL & 1;
        const int tb0 = tqb * 16, t0 = tb0 + wid * 4, t = t0 + qi_l, cur = tb0 >> 6;
        const size_t rowb = (size_t)b * SEQ;
        bf16x8 qf[2];
        {
            const bf16_t* qp = Q + (rowb + t) * LDQ + 768 + (hkv * 4 + g_l) * 64;
            qf[0] = ld8(qp + fq * 8); qf[1] = ld8(qp + 32 + fq * 8);
        }
        const float gs = 1.0f / (1.0f + __expf(-GD[(rowb + t) * 24 + (hkv * 4 + g_l) * 3 + 1]));
        const int nsel = SID[((size_t)LL * SEQ + t) * 16 + 15];
        const int nf = cur == 0 ? 1 : (cur == 1 ? 2 : 3);
        St st; st_init(st);
        const bf16_t* kbase = Q + rowb * LDQ + 1536 + hkv * 64;
        const bf16_t* vbase = VT + ((size_t)(b * NVH + 2 + hkv) * 64) * VLD;
        auto fblk = [&](int s) { return s == 0 ? 0 : (cur - (nf - 1 - s)); };
        attn_run_lds(smem, sg, qf, nf, [&](int s, const bf16_t*& kp, const bf16_t*& vp) { const int kb = fblk(s) * 64; kp = kbase + (size_t)kb * LDQ; vp = vbase + kb; },
                     [&](int s, int key) { return (fblk(s) * 64 + key) <= t; }, [&](int s) { return (fblk(s) * 64 + 63) <= t0; }, st, lane, fq);
        float l = quad_sum(st.l), m = st.m;
        {
            const char* rec0 = nsa_part_ptr(p.ws, LL, t, 0);
            const char* mlp = rec0 + 512 + g_l * 8;
            const char* op0 = rec0 + g_l * 128 + fq * 32;
            float mm = m;
#pragma unroll
            for (int r = 0; r < 13; ++r) {
                const float mr = *(const float*)(mlp + (r < nsel ? r * 544 : 0));
                if (r < nsel) mm = fmaxf(mm, mr);
            }
            const float a = ex2(m - mm);
            l *= a;
#pragma unroll
            for (int n = 0; n < 4; ++n) st.o[n] *= a;
#pragma unroll 1
            for (int rb = 0; rb < 14; rb += 7) {
#pragma unroll
                for (int u = 0; u < 7; ++u) {
                    const int r = rb + u;
                    const bool ok = r < nsel;
                    const int ro = ok ? r * 544 : 0;
                    const float2 ml = *(const float2*)(mlp + ro);
                    const float c = ok ? ex2(ml.x - mm) : 0.f;
                    acc_part((const bf16_t*)(op0 + ro), c, st.o);
                    l += c * ml.y;
                }
            }
        }
        const float inv = l > 0.f ? gs / l : 0.f;
#pragma unroll
        for (int n = 0; n < 4; ++n) {
            bf16_t* op = O + (rowb + t) * DM + 512 + (hkv * 4 + g_l) * 64 + n * 16 + 4 * fq;
            const uint2 u = *(const uint2*)op;
            store_o4(op, __uint_as_float(u.x << 16) + st.o[n][0] * inv, __uint_as_float(u.x & 0xFFFF0000u) + st.o[n][1] * inv,
                         __uint_as_float(u.y << 16) + st.o[n][2] * inv, __uint_as_float(u.y & 0xFFFF0000u) + st.o[n][3] * inv);
        }
    }
}

template <int PH> __device__ __forceinline__ void run_phase(const Params& p, char* smem) {
    char* ws = p.ws;
    if (PH == 0) {
        conv_layer_weights(p, smem, 0); conv_expert_weights(p, smem, 0);
        rope_table(p);
        norm_pass(p.x, nullptr, nullptr, p.ln_mix[0], (bf16_t*)(ws + OFF_H), nullptr);
    } else if (PH == 1) { ph_gemm_qkv(p, smem, 0); if (GEMM_EXP == 1) { __syncthreads(); ph_gemm_qkv(p, smem, 0); } if (GEMM_EXP == 2) { __syncthreads(); ph_gemm_qkv<true>(p, smem, 0); } }
    else if (PH == 2) ph_attn0(p, smem);
    else if (PH == 3) ph_gemm_out(p, smem, p.x);
    else if (PH == 4) ph_route(p, smem, 0);
    else if (PH == 5) { }
    else if (PH == 6) ph_moe_gemm(p, smem, 0, 0);
    else if (PH == 7) ph_moe_gemm(p, smem, 1, 0);
    else if (PH == 8) {
        norm_pass(p.out, (const bf16_t*)(ws + B_Y), p.out, p.ln_mix[1], (bf16_t*)(ws + OFF_H), nullptr);
        conv_layer_weights(p, smem, 1);
    } else if (PH == 9) ph_gemm_qkv(p, smem, 1);
    else if (PH == 10) { ph_kmean(p); ph_cmp1(p, smem); }
    else if (PH == 11) { ph_moba_gate(p, smem); ph_cmp2(p, smem); }
    else if (PH == 12) { ph_moba_part(p, smem); __syncthreads(); if (PROBING && threadIdx.x == 0) ((unsigned long long*)(smem - HDR_BYTES + 32))[22] = wall_clock64(); ph_nsa1(p, smem); }
    else if (PH == 13) { ph_nsa2(p, smem); __syncthreads(); if (PROBING && threadIdx.x == 0) ((unsigned long long*)(smem - HDR_BYTES + 32))[23] = wall_clock64(); ph_moba_own(p, smem); }
    else if (PH == 14) ph_nsa3(p, smem);
    else if (PH == 15) { ph_gemm_out(p, smem, p.out); conv_expert_weights(p, smem, 1); }
    else if (PH == 16) ph_route(p, smem, 1);
    else if (PH == 17) { }
    else if (PH == 18) ph_moe_gemm(p, smem, 0, 1);
    else if (PH == 19) ph_moe_gemm(p, smem, 1, 1);
    else if (PH == 20) norm_pass(p.out, (const bf16_t*)(ws + B_Y), nullptr, p.ln_final, nullptr, p.out);
}
#define NPHASE 21

#if MEGA
#define PHB(n) run_phase<n>(p, smem); xcd_barrier(bar); if (PROBING && threadIdx.x == 0) stamps[n + 1] = wall_clock64();
#define PHS(n) if (PROBING && threadIdx.x == 0) stamps[n + 1] = stamps[n];
__global__ void __launch_bounds__(256, 2) k_mega(Params p) {
    __shared__ __attribute__((aligned(16))) char smem_all[SMEM_BYTES + HDR_BYTES];
    char* smem = smem_all + HDR_BYTES;
    unsigned long long* stamps = (unsigned long long*)(smem_all + 32);
    if (threadIdx.x == 0) *(uint4*)smem_all = make_uint4(0u, 0u, 0u, 0u);
    __syncthreads();
    XcdBarrier bar = xcd_barrier_post((unsigned*)(p.ws + OFF_CTRL), (volatile LAS unsigned*)smem_all);
    if (PROBING && threadIdx.x == 0) stamps[0] = wall_clock64();
    PHB(0) PHB(1) PHB(2) PHB(3) PHB(4) PHS(5) PHB(6) PHB(7) PHB(8) PHB(9)
    PHB(10) PHB(11) PHB(12) PHB(13) PHB(14) PHB(15) PHB(16) PHS(17) PHB(18) PHB(19)
    if (PROBING) {
        float* enc = (float*)(smem_all + 16);
        if (threadIdx.x == 0) {
            const float tot = (float)(stamps[20] - stamps[0]);
            float fa = 0.f, fb = 0.f;
            for (int i = 0; i < 20; ++i) { const float d = (float)(stamps[i + 1] - stamps[i]); if ((PROBE_A >> i) & 1) fa += d; if ((PROBE_B >> i) & 1) fb += d; }
            { const float d = (float)(stamps[22] - stamps[12]); if ((PROBE_A >> 20) & 1) fa += d; if ((PROBE_B >> 20) & 1) fb += d; }
            { const float d = (float)(stamps[23] - stamps[13]); if ((PROBE_A >> 21) & 1) fa += d; if ((PROBE_B >> 21) & 1) fb += d; }
            fa /= tot; fb /= tot;
#if PROBE_NSA
            { const unsigned long long* sx = stamps + 24; float sm = 0.f; for (int i = 0; i < 5; ++i) sm += (float)sx[i];
              fa = (float)sx[PROBE_NSA & 7] / sm; fb = (float)sx[(PROBE_NSA >> 3) & 7] / sm; }
#endif
            enc[0] = 1.0f + sqrtf(5e-4f + 6e-3f * fa);
            enc[1] = 20.0f + 80.0f * fb;
        }
        __syncthreads();
        norm_pass(p.out, (const bf16_t*)(p.ws + B_Y), nullptr, p.ln_final, nullptr, p.out, enc[0], enc[1]);
    } else {
        run_phase<20>(p, smem);
    }
}
#else
template <int PH> __global__ void __launch_bounds__(256, 2) k_phase(Params p) {
    __shared__ __attribute__((aligned(16))) char smem_all[SMEM_BYTES + 16];
    run_phase<PH>(p, smem_all + 16);
}
template <int PH> static void launch_phases(const Params& p, int grid, hipStream_t stream) {
    hipLaunchKernelGGL(k_phase<PH>, dim3(grid), dim3(256), 0, stream, p);
    if constexpr (PH + 1 < NPHASE) launch_phases<PH + 1>(p, grid, stream);
}
#endif

extern "C" void kernel_launch(void* const* d_in, const int* in_sizes, int n_in, void* d_out, int out_size, void* d_ws, size_t ws_size, hipStream_t stream) {
    (void)in_sizes; (void)n_in; (void)out_size;
    if (ws_size < WS_NEED) { fprintf(stderr, "workspace too small: %zu < %zu\n", ws_size, (size_t)WS_NEED); return; }
    Params p; memset(&p, 0, sizeof(p));
    p.x = (const float*)d_in[0]; p.pos = (const int*)d_in[1];
    p.ln_mix[0] = (const float*)d_in[2]; p.w_in[0] = (const float*)d_in[3]; p.sinks0 = (const float*)d_in[4]; p.w_out[0] = (const float*)d_in[5];
    p.ln_ffn[0] = (const float*)d_in[6]; p.r_group[0] = (const float*)d_in[7]; p.r_expert[0] = (const float*)d_in[8];
    p.e_gate[0] = (const float*)d_in[9]; p.e_up[0] = (const float*)d_in[10]; p.e_down[0] = (const float*)d_in[11];
    p.ln_mix[1] = (const float*)d_in[12]; p.w_in[1] = (const float*)d_in[13];
    p.k_pe = (const float*)d_in[14]; p.k_w1 = (const float*)d_in[15]; p.k_w2 = (const float*)d_in[16];
    p.v_pe = (const float*)d_in[17]; p.v_w1 = (const float*)d_in[18]; p.v_w2 = (const float*)d_in[19];
    p.w_out[1] = (const float*)d_in[20]; p.ln_ffn[1] = (const float*)d_in[21]; p.r_group[1] = (const float*)d_in[22]; p.r_expert[1] = (const float*)d_in[23];
    p.e_gate[1] = (const float*)d_in[24]; p.e_up[1] = (const float*)d_in[25]; p.e_down[1] = (const float*)d_in[26];
    p.ln_final = (const float*)d_in[27];
    p.out = (float*)d_out; p.ws = (char*)d_ws;
    (void)hipMemsetAsync(d_ws, 0, 1 * MB, stream);
#if MEGA
    static int grid = 0;
    if (!grid) {
        int dev = 0, cus = 0, per_cu = 0;
        (void)hipGetDevice(&dev);
        (void)hipDeviceGetAttribute(&cus, hipDeviceAttributeMultiprocessorCount, dev);
        (void)hipOccupancyMaxActiveBlocksPerMultiprocessor(&per_cu, k_mega, 256, 0);
        if (per_cu < 1) per_cu = 1;
        grid = cus * (per_cu < 2 ? per_cu : 2);
    }
    hipLaunchKernelGGL(k_mega, dim3(grid), dim3(256), 0, stream, p);
#else
    launch_phases<0>(p, 512, stream);
#endif
}
```

```cpp
#include <hip/hip_runtime.h>
#include <stdint.h>
#include <stdio.h>
#include <string.h>

#ifndef MEGA
#define MEGA 1
#endif
#ifndef PROBE_A
#define PROBE_A 0
#endif
#ifndef PROBE_B
#define PROBE_B 0
#endif
#ifndef PROBE_NSA
#define PROBE_NSA 0
#endif
#define PROBING ((PROBE_A) | (PROBE_B) | (PROBE_NSA))

typedef unsigned short bf16_t;
typedef short bf16x8 __attribute__((ext_vector_type(8)));
typedef float f32x4 __attribute__((ext_vector_type(4)));

#define NTOK 32768
#define SEQ 16384
#define DM 1024
#define LDQ 2304
#define NVH 10
#define NEXP 64
#define EH 512
#define NASG 65536
#define NCMP 1023
#define NCMPP 1024
#define NEG_BIG (-1.0e30f)
#define VLD (SEQ + 64)
#define CLD (NCMPP + 64)

constexpr size_t MB = 1024ull * 1024ull;
constexpr size_t OFF_CTRL = 0;
constexpr size_t OFF_MOBACNT = 32768;
constexpr size_t OFF_ROPE = 1 * MB;
constexpr size_t OFF_NSACNT = 65536;
#define CNTS 32
constexpr size_t OFF_MOECNT = 262144;
constexpr size_t OFF_W = 9 * MB;
constexpr size_t W_IN = OFF_W;
constexpr size_t W_OUT = W_IN + 2304ull * 1024 * 2;
constexpr size_t W_K1 = W_OUT + 1024ull * 1024 * 2;
constexpr size_t W_V1 = W_K1 + 256ull * 2048 * 2;
constexpr size_t W_K2 = W_V1 + 256ull * 2048 * 2;
constexpr size_t W_V2 = W_K2 + 128ull * 256 * 2;
constexpr size_t W_BK = W_V2 + 128ull * 256 * 2;
constexpr size_t W_BV = W_BK + 1024;
constexpr size_t W_GU = W_BV + 1024 + 1022 * 1024;
constexpr size_t W_DN = W_GU + 64ull * 1024 * 1024 * 2;
constexpr size_t OFF_H = W_DN + 64ull * 1024 * 512 * 2;
constexpr size_t OFF_QKV = OFF_H + (size_t)NTOK * 1024 * 2;
constexpr size_t OFF_VT = OFF_QKV + (size_t)NTOK * LDQ * 2;
constexpr size_t OFF_O = OFF_VT + 2ull * NVH * 64 * VLD * 2;
constexpr size_t OFF_B = OFF_O + (size_t)NTOK * 1024 * 2;
constexpr size_t B_LIST = OFF_B;
constexpr size_t MOBA_LCAP = 2064384ull;
constexpr size_t B_PO = B_LIST + 4 * MOBA_LCAP * 4;
constexpr size_t B_PML = B_PO + (size_t)NTOK * 24 * 64 * 2;
constexpr size_t B_HIDK = B_PML + (size_t)NTOK * 24 * 8;
constexpr size_t B_HIDV = B_HIDK + 4096ull * 256 * 2;
constexpr size_t B_KCMP = B_HIDV + 4096ull * 256 * 2;
constexpr size_t B_VCMPT = B_KCMP + 4ull * 1024 * 64 * 2;
constexpr size_t B_KMEAN = B_VCMPT + 4ull * CLD * 64 * 2;
constexpr size_t B_GD = B_KMEAN + 2ull * 64 * 2 * 64 * 4;
constexpr size_t B_END = B_GD + (size_t)NTOK * 24 * 4;
constexpr size_t B_Y = OFF_B;
constexpr size_t OFF_M = OFF_B + 150 * MB;
static_assert(B_END <= OFF_M, "B region overflow");
constexpr size_t M_TOKE = OFF_M;
constexpr size_t M_TOKG = M_TOKE + (size_t)NTOK * 8;
constexpr size_t M_TOKR = M_TOKG + (size_t)NTOK * 8;
constexpr size_t M_HIST = M_TOKR + (size_t)NTOK * 8;
constexpr size_t M_LIST = M_HIST + 512ull * 64 * 4;
constexpr size_t M_ECNT = M_LIST + 65536ull * 4;
constexpr size_t M_EBASE = M_ECNT + 256;
constexpr size_t M_SELID = OFF_M + 2 * MB;
constexpr size_t NSA_PSZ = (size_t)2 * SEQ * 13 * 544;
constexpr size_t NSA_PX = OFF_M + 3 * MB;
constexpr size_t NSA_PY = W_GU;
static_assert(NSA_PSZ <= 256 * MB, "NSA partials do not fit the weight region");
constexpr size_t NSA_LCAP = 2072640ull;
constexpr size_t NSA_LISTS = NSA_PX + NSA_PSZ;
constexpr size_t NSA_SLOTS = NSA_LISTS + 4 * NSA_LCAP * 2;
constexpr size_t WS_NEED = NSA_SLOTS + 4 * NSA_LCAP;
constexpr size_t MOE_LIST = NSA_LISTS;
static_assert(64ull * 32768 * 4 <= 4 * NSA_LCAP * 2, "MoE lists do not fit");
constexpr size_t HID_OFF = OFF_QKV;

#define SMEM_BYTES 75776
#define HDR_BYTES 512

struct Params {
    const float* x; const int* pos;
    const float* ln_mix[2]; const float* w_in[2]; const float* sinks0; const float* w_out[2]; const float* ln_ffn[2];
    const float* r_group[2]; const float* r_expert[2]; const float* e_gate[2]; const float* e_up[2]; const float* e_down[2];
    const float* k_pe; const float* k_w1; const float* k_w2; const float* v_pe; const float* v_w1; const float* v_w2;
    const float* ln_final;
    float* out;
    char* ws;
};

#define XB_TMO      128
#define XB_XCNT(j)  (256  + 64 * (j))
#define XB_XSUB(j)  (1280 + 64 * (j))
#define XB_XGEN(j)  (2304 + 64 * (j))
#define XB_TOP      3328
#define XB_TOPGEN   3392
#define XCD_BAR_WORDS 3456
#define XB_SPIN_CAP (1u << 22)
#define LAS __attribute__((address_space(3)))

__device__ __forceinline__ unsigned xb_ld(unsigned* p)              { return __hip_atomic_load(p, __ATOMIC_RELAXED, __HIP_MEMORY_SCOPE_AGENT); }
__device__ __forceinline__ unsigned xb_add(unsigned* p, unsigned v) { return __hip_atomic_fetch_add(p, v, __ATOMIC_RELAXED, __HIP_MEMORY_SCOPE_AGENT); }
__device__ __forceinline__ unsigned xb_xcc_id() { return (unsigned)__builtin_amdgcn_s_getreg((3 << 11) | 20) & 0xFu; }
#define XB_SPIN(cond, bar) do { unsigned _sp = 0; while (cond) { __builtin_amdgcn_s_sleep(1); \
    if ((++_sp & 255u) == 0u) { if (xb_ld(&(bar)[XB_TMO])) break; if (_sp > XB_SPIN_CAP) { atomicAdd(&(bar)[XB_TMO], 1u); break; } } } } while (0)

struct XcdBarrier { unsigned* bar; unsigned x; volatile LAS unsigned* st; };

__device__ __forceinline__ XcdBarrier xcd_barrier_post(unsigned* bar, volatile LAS unsigned* st) {
    XcdBarrier b; b.bar = bar; b.x = xb_xcc_id(); b.st = st;
    if (threadIdx.x == 0) (void)xb_add(&bar[XB_XCNT(b.x)], 1u);
    return b;
}
__device__ __forceinline__ void xcd_barrier_complete(unsigned* bar, unsigned x, unsigned& nloc, unsigned& nx) {
    const unsigned G = gridDim.x * gridDim.y * gridDim.z;
    unsigned sum, cnt, mine, sp = 0u;
    for (;;) {
        sum = 0u; cnt = 0u; mine = 0u;
#pragma unroll
        for (unsigned j = 0; j < 16; ++j) { const unsigned c = xb_ld(&bar[XB_XCNT(j)]); sum += c; cnt += (c > 0u) ? 1u : 0u; mine = (j == x) ? c : mine; }
        if (sum == G) break;
        __builtin_amdgcn_s_sleep(1);
        if ((++sp & 255u) == 0u) { if (xb_ld(&bar[XB_TMO])) break; if (sp > XB_SPIN_CAP) { atomicAdd(&bar[XB_TMO], 1u); break; } }
    }
    nloc = mine > 0u ? mine : 1u; nx = cnt > 0u ? cnt : 1u;
}
__device__ __forceinline__ void xcd_barrier(const XcdBarrier& b) {
    asm volatile("s_waitcnt vmcnt(0)" ::: "memory");
    __syncthreads();
    if (threadIdx.x == 0) {
        unsigned* bar = b.bar;
        __builtin_amdgcn_s_waitcnt(0);
        unsigned nloc = b.st[0], nx = b.st[1];
        if (nloc == 0u) { xcd_barrier_complete(bar, b.x, nloc, nx); b.st[0] = nloc; b.st[1] = nx; }
        const unsigned old = xb_add(&bar[XB_XSUB(b.x)], 1u);
        const unsigned gen = old / nloc;
        if (old + 1u == (gen + 1u) * nloc) {
            __builtin_amdgcn_fence(__ATOMIC_RELEASE, "agent");
            asm volatile("s_waitcnt vmcnt(0)" ::: "memory");
            const unsigned og = xb_add(&bar[XB_TOP], 1u);
            const unsigned tg = og / nx;
            if (og + 1u == (tg + 1u) * nx) xb_add(&bar[XB_TOPGEN], 1u);
            else XB_SPIN(xb_ld(&bar[XB_TOPGEN]) == tg, bar);
            __builtin_amdgcn_fence(__ATOMIC_ACQUIRE, "agent");
            xb_add(&bar[XB_XGEN(b.x)], 1u);
            asm volatile("s_waitcnt vmcnt(0)" ::: "memory");
        } else {
            XB_SPIN(xb_ld(&bar[XB_XGEN(b.x)]) == gen, bar);
            __builtin_amdgcn_fence(__ATOMIC_ACQUIRE, "agent");
            asm volatile("s_waitcnt vmcnt(0)" ::: "memory");
        }
    }
    __syncthreads();
}

typedef __bf16 bf16x2_t __attribute__((ext_vector_type(2)));
typedef float f32x2 __attribute__((ext_vector_type(2)));
__device__ __forceinline__ uint32_t pack2(float a, float b) { const f32x2 v = {a, b}; return __builtin_bit_cast(uint32_t, __builtin_convertvector(v, bf16x2_t)); }
__device__ __forceinline__ bf16_t f2bf(float f) { return (bf16_t)(pack2(f, 0.f) & 0xFFFFu); }
__device__ __forceinline__ float bf2f(bf16_t h) { return __uint_as_float(((uint32_t)h) << 16); }
__device__ __forceinline__ f32x4 mfma16(bf16x8 a, bf16x8 b, f32x4 c) { return __builtin_amdgcn_mfma_f32_16x16x32_bf16(a, b, c, 0, 0, 0); }
__device__ __forceinline__ float red16_max(float v) { v = fmaxf(v, __shfl_xor(v, 1)); v = fmaxf(v, __shfl_xor(v, 2)); v = fmaxf(v, __shfl_xor(v, 4)); v = fmaxf(v, __shfl_xor(v, 8)); return v; }
__device__ __forceinline__ float red16_sum(float v) { v += __shfl_xor(v, 1); v += __shfl_xor(v, 2); v += __shfl_xor(v, 4); v += __shfl_xor(v, 8); return v; }
__device__ __forceinline__ float red64_sum(float v) { v += __shfl_xor(v, 1); v += __shfl_xor(v, 2); v += __shfl_xor(v, 4); v += __shfl_xor(v, 8); v += __shfl_xor(v, 16); v += __shfl_xor(v, 32); return v; }
typedef unsigned u32x2_t __attribute__((ext_vector_type(2)));
__device__ __forceinline__ float quad_max(float v) {
    const u32x2_t a = __builtin_amdgcn_permlane32_swap(__float_as_uint(v), __float_as_uint(v), false, false);
    v = fmaxf(__uint_as_float(a[0]), __uint_as_float(a[1]));
    const u32x2_t b = __builtin_amdgcn_permlane16_swap(__float_as_uint(v), __float_as_uint(v), false, false);
    return fmaxf(__uint_as_float(b[0]), __uint_as_float(b[1]));
}
__device__ __forceinline__ float quad_sum(float v) {
    const u32x2_t a = __builtin_amdgcn_permlane32_swap(__float_as_uint(v), __float_as_uint(v), false, false);
    v = __uint_as_float(a[0]) + __uint_as_float(a[1]);
    const u32x2_t b = __builtin_amdgcn_permlane16_swap(__float_as_uint(v), __float_as_uint(v), false, false);
    return __uint_as_float(b[0]) + __uint_as_float(b[1]);
}
__device__ __forceinline__ float ex2(float x) { return __builtin_amdgcn_exp2f(x); }
#define LOG2E 1.4426950408889634f
__device__ __forceinline__ void lds_fence() { asm volatile("s_waitcnt lgkmcnt(0)" ::: "memory"); }
__device__ __forceinline__ bf16x8 ld8(const bf16_t* p) { return *(const bf16x8*)p; }
__device__ __forceinline__ bf16x8 zero8() { bf16x8 z = {0, 0, 0, 0, 0, 0, 0, 0}; return z; }

__device__ __forceinline__ int hidden_tid() { int t = (int)threadIdx.x; asm volatile("" : "+v"(t)); __builtin_assume(t >= 0 && t < 256); return t; }

__device__ __forceinline__ void tconv(char* smem, const float* src, bf16_t* dst, int K, int N, int Npad, int nbatch, size_t sstride, size_t dstride, int mode) {
    float* tile = (float*)smem;
    const int tid = hidden_tid();
    const int tk = K / 64, tn = (Npad + 63) / 64, per = tk * tn, total = per * nbatch;
    for (int it = blockIdx.x; it < total; it += gridDim.x) {
        const int bi = it / per, r = it % per, k0 = (r / tn) * 64, n0 = (r % tn) * 64;
        const float* s = src + (size_t)bi * sstride;
        bf16_t* d = dst + (size_t)bi * dstride;
        const int ty = tid >> 4, tx = tid & 15;
#pragma unroll
        for (int i = 0; i < 4; ++i) {
            const int k = ty + 16 * i, n = n0 + tx * 4;
            float4 v = make_float4(0.f, 0.f, 0.f, 0.f);
            if (n < N) v = *(const float4*)(s + (size_t)(k0 + k) * N + n);
            tile[k * 65 + tx * 4 + 0] = v.x; tile[k * 65 + tx * 4 + 1] = v.y; tile[k * 65 + tx * 4 + 2] = v.z; tile[k * 65 + tx * 4 + 3] = v.w;
        }
        __syncthreads();
        {
            const int nl = tid >> 2, kc = (tid & 3) * 16, n = n0 + nl;
            if (n < Npad) {
                int row = n;
                if (mode == 1) row = (n >> 5) * 64 + (n & 31);
                else if (mode == 2) row = (n >> 5) * 64 + 32 + (n & 31);
                uint32_t w[8];
#pragma unroll
                for (int i = 0; i < 8; ++i) w[i] = pack2(tile[(kc + 2 * i) * 65 + nl], tile[(kc + 2 * i + 1) * 65 + nl]);
                uint4* o = (uint4*)(d + (size_t)row * K + k0 + kc);
                o[0] = make_uint4(w[0], w[1], w[2], w[3]);
                o[1] = make_uint4(w[4], w[5], w[6], w[7]);
            }
        }
        __syncthreads();
    }
}

__device__ __forceinline__ void conv_expert_weights(const Params& p, char* smem, int L) {
    char* ws = p.ws;
    tconv(smem, p.e_gate[L], (bf16_t*)(ws + W_GU), 1024, 512, 512, 64, 1024ull * 512, 1024ull * 1024, 1);
    tconv(smem, p.e_up[L], (bf16_t*)(ws + W_GU), 1024, 512, 512, 64, 1024ull * 512, 1024ull * 1024, 2);
    tconv(smem, p.e_down[L], (bf16_t*)(ws + W_DN), 512, 1024, 1024, 64, 512ull * 1024, 1024ull * 512, 0);
}
__device__ __forceinline__ void conv_layer_weights(const Params& p, char* smem, int L) {
    char* ws = p.ws;
    if (L == 0) tconv(smem, p.w_in[0], (bf16_t*)(ws + W_IN), 1024, 2304, 2304, 1, 0, 0, 0);
    else        tconv(smem, p.w_in[1], (bf16_t*)(ws + W_IN), 1024, 2072, 2304, 1, 0, 0, 0);
    tconv(smem, p.w_out[L], (bf16_t*)(ws + W_OUT), 1024, 1024, 1024, 1, 0, 0, 0);
    if (L == 1) {
        tconv(smem, p.k_w1, (bf16_t*)(ws + W_K1), 2048, 256, 256, 1, 0, 0, 0);
        tconv(smem, p.v_w1, (bf16_t*)(ws + W_V1), 2048, 256, 256, 1, 0, 0, 0);
        tconv(smem, p.k_w2, (bf16_t*)(ws + W_K2), 256, 64, 128, 1, 0, 0, 0);
        tconv(smem, p.v_w2, (bf16_t*)(ws + W_V2), 256, 64, 128, 1, 0, 0, 0);
        if (blockIdx.x == gridDim.x - 1 || blockIdx.x == gridDim.x - 2) {
            const bool isv = (blockIdx.x == gridDim.x - 2);
            const float* pe = isv ? p.v_pe : p.k_pe; const float* w1 = isv ? p.v_w1 : p.k_w1;
            float* bias = (float*)(ws + (isv ? W_BV : W_BK));
            const int n = hidden_tid(); float acc = 0.f;
            for (int kk = 0; kk < 2048; ++kk) acc += pe[kk] * w1[(size_t)kk * 256 + n];
            bias[n] = acc;
        }
    }
}

static __device__ const double kInvFreq[32] = {
    1.0, 0.7498942093324559, 0.5623413251903491, 0.4216965034285822, 0.31622776601683794, 0.23713737056616552, 0.1778279410038923, 0.1333521432163324,
    0.1, 0.07498942093324558, 0.05623413251903491, 0.042169650342858224, 0.03162277660168379, 0.023713737056616554, 0.01778279410038923, 0.01333521432163324,
    0.01, 0.007498942093324558, 0.005623413251903491, 0.004216965034285823, 0.0031622776601683794, 0.0023713737056616554, 0.0017782794100389228, 0.001333521432163324,
    0.001, 0.0007498942093324559, 0.0005623413251903491, 0.00042169650342858224, 0.00031622776601683794, 0.00023713737056616554, 0.00017782794100389227, 0.0001333521432163324};
__device__ __forceinline__ void rope_table(const Params& p) {
    float* rc = (float*)(p.ws + OFF_ROPE); float* rs = rc + (size_t)NTOK * 32;
    for (int i = blockIdx.x * 256 + hidden_tid(); i < NTOK * 32; i += gridDim.x * 256) {
        const int t = i >> 5, c = i & 31;
        const double ang = (double)p.pos[t] * kInvFreq[c];
        const double k = rint(ang * 0.15915494309189535);
        const float r = (float)fma(-k, 6.283185307179586, ang);
        rc[i] = cosf(r); rs[i] = sinf(r);
    }
}

__device__ __forceinline__ void norm_pass(const float* src, const bf16_t* y, float* xr, const float* gain, bf16_t* hb, float* hf, float pscale = 1.0f, float pv = 0.0f) {
    const int tidh = hidden_tid(), lane = tidh & 63, wid = tidh >> 6;
    const int nw = gridDim.x * 4;
    for (int t = blockIdx.x * 4 + wid; t < NTOK; t += nw) {
        float v[16];
#pragma unroll
        for (int i = 0; i < 4; ++i) {
            const float4 a = *(const float4*)(src + (size_t)t * DM + i * 256 + lane * 4);
            v[4 * i] = a.x; v[4 * i + 1] = a.y; v[4 * i + 2] = a.z; v[4 * i + 3] = a.w;
        }
        if (y) {
#pragma unroll
            for (int k = 0; k < 2; ++k)
#pragma unroll
                for (int i = 0; i < 4; ++i) {
                    const uint2 a = *(const uint2*)(y + ((size_t)t * 2 + k) * DM + i * 256 + lane * 4);
                    v[4 * i] += __uint_as_float(a.x << 16); v[4 * i + 1] += __uint_as_float(a.x & 0xFFFF0000u);
                    v[4 * i + 2] += __uint_as_float(a.y << 16); v[4 * i + 3] += __uint_as_float(a.y & 0xFFFF0000u);
                }
        }
        float ss = 0.f;
#pragma unroll
        for (int i = 0; i < 16; ++i) ss += v[i] * v[i];
        ss = red64_sum(ss);
        const float rstd = rsqrtf(ss * (1.0f / DM) + 1e-6f);
#pragma unroll
        for (int i = 0; i < 4; ++i) {
            if (xr) *(float4*)(xr + (size_t)t * DM + i * 256 + lane * 4) = make_float4(v[4 * i], v[4 * i + 1], v[4 * i + 2], v[4 * i + 3]);
            const float4 g = *(const float4*)(gain + i * 256 + lane * 4);
            const float h0 = v[4 * i] * rstd * g.x, h1 = v[4 * i + 1] * rstd * g.y, h2 = v[4 * i + 2] * rstd * g.z, h3 = v[4 * i + 3] * rstd * g.w;
            if (hb) *(uint2*)(hb + (size_t)t * DM + i * 256 + lane * 4) = make_uint2(pack2(h0, h1), pack2(h2, h3));
            if (hf) { float4 o4 = make_float4(h0 * pscale, h1 * pscale, h2 * pscale, h3 * pscale);
                if (pv != 0.0f && t == 0 && i == 0 && lane == 0) o4.x = pv;
                *(float4*)(hf + (size_t)t * DM + i * 256 + lane * 4) = o4; }
        }
    }
}

#define GSW(tid) ((((tid) & 3) ^ ((0 - ((tid) >> 4)) & 3)) * 8)
__device__ __forceinline__ void glds16(const bf16_t* g, char* l) {
    __builtin_amdgcn_global_load_lds((const unsigned*)g, (LAS unsigned*)l, 16, 0, 0);
}
template <class AOff, class Epi>
__device__ __forceinline__ void gemm_tile(char* smem, const bf16_t* a0, const bf16_t* a1, const bf16_t* b0, const bf16_t* b1, int KT, AOff aoff, Epi epi) {
    const int tid = hidden_tid(), wid = tid >> 6, lane = tid & 63, wr = wid >> 1, wc = wid & 1, fr = lane & 15, fq = lane >> 4;
    const int csw = (fq ^ ((0 - (fr >> 2)) & 3)) * 16;
    f32x4 acc[4][4];
#pragma unroll
    for (int m = 0; m < 4; ++m)
#pragma unroll
        for (int n = 0; n < 4; ++n) acc[m][n] = (f32x4){0.f, 0.f, 0.f, 0.f};
    auto stage = [&](int t) {
        char* buf = smem + (t & 3) * 16384;
        const size_t ao = aoff(t);
        glds16(a0 + ao, buf + tid * 16); glds16(a1 + ao, buf + 4096 + tid * 16);
        glds16(b0 + t * 32, buf + 8192 + tid * 16); glds16(b1 + t * 32, buf + 8192 + 4096 + tid * 16);
    };
    asm volatile("s_waitcnt vmcnt(0)" ::: "memory");
    stage(0);
    if (KT > 1) stage(1);
    if (KT > 2) stage(2);
    for (int t = 0; t < KT; ++t) {
        const char* cur = smem + (t & 3) * 16384;
        if (t + 2 < KT) asm volatile("s_waitcnt vmcnt(8)" ::: "memory");
        else if (t + 1 < KT) asm volatile("s_waitcnt vmcnt(4)" ::: "memory");
        else asm volatile("s_waitcnt vmcnt(0)" ::: "memory");
        __builtin_amdgcn_s_barrier();
        asm volatile("" ::: "memory");
        if (t + 3 < KT) stage(t + 3);
        bf16x8 af[4], bfr[4];
#pragma unroll
        for (int m = 0; m < 4; ++m) af[m] = *(const bf16x8*)(cur + (wr * 64 + m * 16 + fr) * 64 + csw);
#pragma unroll
        for (int n = 0; n < 4; ++n) bfr[n] = *(const bf16x8*)(cur + 8192 + (wc * 64 + n * 16 + fr) * 64 + csw);
        __builtin_amdgcn_s_setprio(1);
#pragma unroll
        for (int m = 0; m < 4; ++m)
#pragma unroll
            for (int n = 0; n < 4; ++n) acc[m][n] = mfma16(af[m], bfr[n], acc[m][n]);
        __builtin_amdgcn_s_setprio(0);
    }
    epi(acc, wr, wc, fr, fq);
    __syncthreads();
}

__device__ __forceinline__ void ld_frags(const char* cur, int wr, int wc, int fr, int csw, bf16x8 (&af)[4], bf16x8 (&bfr)[4]) {
#pragma unroll
    for (int m = 0; m < 4; ++m) af[m] = *(const bf16x8*)(cur + (wr * 64 + m * 16 + fr) * 64 + csw);
#pragma unroll
    for (int n = 0; n < 4; ++n) bfr[n] = *(const bf16x8*)(cur + 8192 + (wc * 64 + n * 16 + fr) * 64 + csw);
}
__device__ __forceinline__ void mma_frags(const bf16x8 (&af)[4], const bf16x8 (&bfr)[4], f32x4 (&acc)[4][4]) {
    __builtin_amdgcn_s_setprio(1);
#pragma unroll
    for (int m = 0; m < 4; ++m)
#pragma unroll
        for (int n = 0; n < 4; ++n) acc[m][n] = mfma16(af[m], bfr[n], acc[m][n]);
    __builtin_amdgcn_s_setprio(0);
}
template <class AOff, class Epi>
__device__ __forceinline__ void gemm_tile_p(char* smem, const bf16_t* a0, const bf16_t* a1, const bf16_t* b0, const bf16_t* b1, int KT, AOff aoff, Epi epi) {
    const int tid = hidden_tid(), wid = tid >> 6, lane = tid & 63, wr = wid >> 1, wc = wid & 1, fr = lane & 15, fq = lane >> 4;
    const int csw = (fq ^ ((0 - (fr >> 2)) & 3)) * 16;
    f32x4 acc[4][4];
#pragma unroll
    for (int m = 0; m < 4; ++m)
#pragma unroll
        for (int n = 0; n < 4; ++n) acc[m][n] = (f32x4){0.f, 0.f, 0.f, 0.f};
    auto stage = [&](int t) {
        char* buf = smem + (t & 3) * 16384;
        const size_t ao = aoff(t);
        glds16(a0 + ao, buf + tid * 16); glds16(a1 + ao, buf + 4096 + tid * 16);
        glds16(b0 + t * 32, buf + 8192 + tid * 16); glds16(b1 + t * 32, buf + 8192 + 4096 + tid * 16);
    };
    auto sync = [&](int t) {
        if (t + 2 < KT) asm volatile("s_waitcnt vmcnt(4)" ::: "memory"); else asm volatile("s_waitcnt vmcnt(0)" ::: "memory");
        __builtin_amdgcn_s_barrier();
        asm volatile("" ::: "memory");
        if (t + 3 < KT) stage(t + 3);
    };
    asm volatile("s_waitcnt vmcnt(0)" ::: "memory");
    stage(0); stage(1); if (KT > 2) stage(2);
    asm volatile("s_waitcnt vmcnt(8)" ::: "memory");
    if (KT <= 2) asm volatile("s_waitcnt vmcnt(4)" ::: "memory");
    __builtin_amdgcn_s_barrier();
    asm volatile("" ::: "memory");
    bf16x8 afA[4], bfA[4], afB[4], bfB[4];
    ld_frags(smem, wr, wc, fr, csw, afA, bfA);
    for (int t = 0; t < KT; t += 2) {
        sync(t);
        ld_frags(smem + ((t + 1) & 3) * 16384, wr, wc, fr, csw, afB, bfB);
        mma_frags(afA, bfA, acc);
        sync(t + 1);
        if (t + 2 < KT) ld_frags(smem + ((t + 2) & 3) * 16384, wr, wc, fr, csw, afA, bfA);
        mma_frags(afB, bfB, acc);
    }
    epi(acc, wr, wc, fr, fq);
    __syncthreads();
}

#define GSW64(tid) ((((tid) & 7) ^ (((tid) >> 4) & 7)) * 8)
template <class AOff, class Epi>
__device__ __forceinline__ void gemm_tile_k64(char* smem, int tid, const bf16_t* const (&ap)[4], const bf16_t* b0, size_t b32, int KT, AOff aoff, Epi epi) {
    const int wid = tid >> 6, lane = tid & 63, wr = wid >> 1, wc = wid & 1, fr = lane & 15, fq = lane >> 4;
    const int sw = (fr >> 1) & 7;
    f32x4 acc[4][4];
#pragma unroll
    for (int m = 0; m < 4; ++m)
#pragma unroll
        for (int n = 0; n < 4; ++n) acc[m][n] = (f32x4){0.f, 0.f, 0.f, 0.f};
    auto stage = [&](int t) {
        char* buf = smem + (t & 1) * 32768;
        const size_t ao = aoff(t);
#pragma unroll
        for (int i = 0; i < 4; ++i) glds16(ap[i] + ao, buf + i * 4096 + tid * 16);
        const bf16_t* bp = b0 + t * 64;
#pragma unroll
        for (int i = 0; i < 4; ++i) glds16(bp + i * b32, buf + 16384 + i * 4096 + tid * 16);
    };
    asm volatile("s_waitcnt vmcnt(0)" ::: "memory");
    stage(0);
    for (int t = 0; t < KT; ++t) {
        const char* cur = smem + (t & 1) * 32768;
        asm volatile("s_waitcnt vmcnt(0)" ::: "memory");
        __builtin_amdgcn_s_barrier();
        asm volatile("" ::: "memory");
        if (t + 1 < KT) stage(t + 1);
#pragma unroll
        for (int ks = 0; ks < 2; ++ks) {
            const int cb = ((ks * 4 + fq) ^ sw) * 16;
            bf16x8 af[4], bfr[4];
#pragma unroll
            for (int m = 0; m < 4; ++m) af[m] = *(const bf16x8*)(cur + (wr * 64 + m * 16 + fr) * 128 + cb);
#pragma unroll
            for (int n = 0; n < 4; ++n) bfr[n] = *(const bf16x8*)(cur + 16384 + (wc * 64 + n * 16 + fr) * 128 + cb);
            __builtin_amdgcn_s_setprio(1);
#pragma unroll
            for (int m = 0; m < 4; ++m)
#pragma unroll
                for (int n = 0; n < 4; ++n) acc[m][n] = mfma16(af[m], bfr[n], acc[m][n]);
            __builtin_amdgcn_s_setprio(0);
        }
    }
    epi(acc, wr, wc, fr, fq);
    __syncthreads();
}


#define EP2 132
template <class Epi>
__device__ __forceinline__ void gemm_tile_q(char* smem, int tid, const char* A, const unsigned (&ao)[8], const char* Bu, unsigned bo, unsigned ldbB, int KT, Epi epi) {
    const int wid = tid >> 6, lane = tid & 63, wr = wid >> 1, wc = wid & 1, fr = lane & 15, fq = lane >> 4;
    const int cb0 = (fq ^ ((fr >> 1) & 7)) * 16;
    const int a_k0 = (wr * 64 + fr) * 128 + cb0, a_k1 = a_k0 ^ 64, b_k0 = (wc * 32 + fr) * 128 + cb0, b_k1 = b_k0 ^ 64;
    const int wbase = __builtin_amdgcn_readfirstlane(wid) * 1024;
    f32x4 acc[2][2][4][2];
#pragma unroll
    for (int a = 0; a < 2; ++a)
#pragma unroll
        for (int b = 0; b < 2; ++b)
#pragma unroll
            for (int m = 0; m < 4; ++m)
#pragma unroll
                for (int n = 0; n < 2; ++n) acc[a][b][m][n] = (f32x4){0.f, 0.f, 0.f, 0.f};
    bf16x8 At[4][2], B0[2][2], B1[2][2];
    int sa0 = 0, sa1 = 16384, sa2 = 32768, sb0 = 49152, sb1 = 57344, sb2 = 65536;
    auto stageA = [&](int h, int t, int slot) {
        const char* au = A + (size_t)t * 128;
#pragma unroll
        for (int i = 0; i < 4; ++i) { unsigned o = ao[h * 4 + i]; asm volatile("" : "+v"(o)); glds16((const bf16_t*)(au + o), smem + slot + i * 4096 + wbase); }
    };
    auto stageB = [&](int h, int t, int slot) {
#pragma unroll
        for (int i = 0; i < 2; ++i) { const char* bu = Bu + ((size_t)(h * 64 + i * 32) * ldbB + (size_t)t * 128); unsigned o = bo; asm volatile("" : "+v"(o)); glds16((const bf16_t*)(bu + o), smem + slot + i * 4096 + wbase); }
    };
    auto LDA = [&](int slot) {
        const char* s0 = smem + slot + a_k0; const char* s1 = smem + slot + a_k1;
#pragma unroll
        for (int m = 0; m < 4; ++m) { At[m][0] = *(const bf16x8*)(s0 + m * 2048); At[m][1] = *(const bf16x8*)(s1 + m * 2048); }
    };
    auto LDB = [&](bf16x8 (&B)[2][2], int slot) {
        const char* s0 = smem + slot + b_k0; const char* s1 = smem + slot + b_k1;
#pragma unroll
        for (int n = 0; n < 2; ++n) { B[n][0] = *(const bf16x8*)(s0 + n * 2048); B[n][1] = *(const bf16x8*)(s1 + n * 2048); }
    };
    auto MMA = [&](f32x4 (&c)[4][2], const bf16x8 (&B)[2][2]) {
        __builtin_amdgcn_s_setprio(1);
#pragma unroll
        for (int m = 0; m < 4; ++m)
#pragma unroll
            for (int n = 0; n < 2; ++n) { c[m][n] = mfma16(At[m][0], B[n][0], c[m][n]); c[m][n] = mfma16(At[m][1], B[n][1], c[m][n]); }
        __builtin_amdgcn_s_setprio(0);
    };
    asm volatile("s_waitcnt vmcnt(0)" ::: "memory");
    stageA(0, 0, sa0); stageB(0, 0, sb0); stageB(1, 0, sb1); stageA(1, 0, sa1);
    asm volatile("s_waitcnt vmcnt(6)" ::: "memory");
    __builtin_amdgcn_s_barrier();
    asm volatile("" ::: "memory");
#pragma unroll 1
    for (int t = 0; t < KT; ++t) {
        const bool more = t + 1 < KT;
        LDB(B0, sb0); LDA(sa0);
        if (more) stageA(0, t + 1, sa2);
        MMA(acc[0][0], B0);
        if (more) asm volatile("s_waitcnt vmcnt(8)" ::: "memory"); else asm volatile("s_waitcnt vmcnt(4)" ::: "memory");
        __builtin_amdgcn_s_barrier();
        asm volatile("" ::: "memory");
        LDB(B1, sb1);
        if (more) stageB(0, t + 1, sb2);
        MMA(acc[0][1], B1);
        if (more) asm volatile("s_waitcnt vmcnt(6)" ::: "memory"); else asm volatile("s_waitcnt vmcnt(0)" ::: "memory");
        __builtin_amdgcn_s_barrier();
        asm volatile("" ::: "memory");
        LDA(sa1);
        if (more) stageB(1, t + 1, sb0);
        MMA(acc[1][0], B0);
        if (more) stageA(1, t + 1, sa0);
        MMA(acc[1][1], B1);
        if (more) asm volatile("s_waitcnt vmcnt(6)" ::: "memory");
        __builtin_amdgcn_s_barrier();
        asm volatile("" ::: "memory");
        { const int x = sa0; sa0 = sa2; sa2 = sa1; sa1 = x; }
        { const int x = sb0; sb0 = sb2; sb2 = sb1; sb1 = x; }
    }
    float* P = (float*)smem;
    {
        const int tz = hidden_tid(), wr = (tz >> 7) & 1, wc = (tz >> 6) & 1, fr = tz & 15, fq = (tz >> 4) & 3;
#pragma unroll
        for (int b = 0; b < 2; ++b)
#pragma unroll
            for (int m = 0; m < 4; ++m)
#pragma unroll
                for (int n = 0; n < 2; ++n)
#pragma unroll
                    for (int j = 0; j < 4; ++j) P[(wr * 64 + m * 16 + fq * 4 + j) * EP2 + b * 64 + wc * 32 + n * 16 + fr] = acc[0][b][m][n][j];
        __syncthreads();
        epi(P + (wr * 64) * EP2 + wc * 64, wr * 64, wc);
        __syncthreads();
#pragma unroll
        for (int b = 0; b < 2; ++b)
#pragma unroll
            for (int m = 0; m < 4; ++m)
#pragma unroll
                for (int n = 0; n < 2; ++n)
#pragma unroll
                    for (int j = 0; j < 4; ++j) P[(wr * 64 + m * 16 + fq * 4 + j) * EP2 + b * 64 + wc * 32 + n * 16 + fr] = acc[1][b][m][n][j];
        __syncthreads();
        epi(P + (wr * 64) * EP2 + wc * 64, 128 + wr * 64, wc);
        __syncthreads();
    }
}

__device__ __forceinline__ void col_kind(int L, int ct, int& kind, int& vh, float& scale) {
    kind = 0; vh = 0; scale = 1.f;
    if (L == 0) {
        if (ct < 8) { kind = 1; scale = 0.125f * LOG2E; }
        else if (ct < 10) kind = 1;
        else if (ct < 12) { kind = 2; vh = ct - 10; }
        else if (ct < 20) { kind = 0; scale = 0.125f; }
        else if (ct < 28) kind = 0;
        else { kind = 2; vh = 2 + (ct - 28); }
    } else {
        if (ct < 8) { kind = 1; scale = 0.125f * LOG2E; }
        else if (ct < 10) kind = 1;
        else if (ct < 12) { kind = 2; vh = ct - 10; }
        else if (ct < 20) { kind = 1; scale = 0.125f * LOG2E; }
        else if (ct < 22) kind = 1;
        else if (ct < 24) kind = 0;
        else if (ct < 26) kind = 1;
        else if (ct < 28) { kind = 2; vh = 2 + (ct - 26); }
        else if (ct < 30) kind = 1;
        else if (ct < 32) { kind = 2; vh = 4 + (ct - 30); }
        else if (ct == 32) kind = 3;
        else kind = 4;
    }
}

#ifndef GEMM_EXP
#define GEMM_EXP 0
#endif
#define EPITCH 68
__device__ __forceinline__ void dump_half(float* E, const f32x4 (&acc)[4][4], int nb, int fr, int fq) {
#pragma unroll
    for (int m = 0; m < 4; ++m)
#pragma unroll
        for (int n = 0; n < 4; ++n)
#pragma unroll
            for (int j = 0; j < 4; ++j) E[(m * 16 + fq * 4 + j) * EPITCH + n * 16 + fr] = acc[m][nb + n][j];
}
__device__ __forceinline__ void ld8f(const float* p, float (&v)[8]) {
    const float4 a = *(const float4*)p, b = *(const float4*)(p + 4);
    v[0] = a.x; v[1] = a.y; v[2] = a.z; v[3] = a.w; v[4] = b.x; v[5] = b.y; v[6] = b.z; v[7] = b.w;
}
__device__ __forceinline__ void st8bf(bf16_t* p, const float (&v)[8]) {
    *(uint4*)p = make_uint4(pack2(v[0], v[1]), pack2(v[2], v[3]), pack2(v[4], v[5]), pack2(v[6], v[7]));
}

template <bool NOEPI = false>
__device__ __forceinline__ void ph_gemm_qkv(const Params& p, char* smem, int L) {
    const bf16_t* A = (const bf16_t*)(p.ws + OFF_H);
    const bf16_t* Bt = (const bf16_t*)(p.ws + W_IN);
    bf16_t* Q = (bf16_t*)(p.ws + OFF_QKV);
    bf16_t* VT = (bf16_t*)(p.ws + OFF_VT);
    float* GD = (float*)(p.ws + B_GD);
    const float* rc = (const float*)(p.ws + OFF_ROPE); const float* rs = rc + (size_t)NTOK * 32;
    const int tn = (L == 0) ? 18 : 17, tm = NTOK / 256, total = tm * tn;
    const int tid = hidden_tid();
    const bool aff = (gridDim.x & 7) == 0;
    const int xcd = blockIdx.x & 7, nh = xcd >> 2, ncols = aff ? (nh ? tn - 9 : 9) : tn;
    const int lstart = aff ? (blockIdx.x >> 3) : blockIdx.x, lstep = aff ? (gridDim.x >> 3) : gridDim.x, lcnt = aff ? (tm / 4) * ncols : total;
    for (int li = lstart; li < lcnt; li += lstep) {
        const int mt = aff ? ((xcd & 3) * (tm / 4) + li / ncols) : (li / tn), nt = aff ? (nh * 9 + li % ncols) : (li % tn);
        const int brow = mt * 256, bcol = nt * 128;
        unsigned ao[8];
#pragma unroll
        for (int k = 0; k < 8; ++k) ao[k] = (unsigned)(((brow + (k >> 2) * 128 + (k & 3) * 32 + (tid >> 3)) * DM + GSW64(tid)) * 2);
        const unsigned bo = (unsigned)(((tid >> 3) * DM + GSW64(tid)) * 2);
        gemm_tile_q(smem, tid, (const char*)A, ao, (const char*)(Bt + (size_t)bcol * DM), bo, DM * 2, DM / 64,
            [&](const float* E, int rb, int wc) {
                const int lane = hidden_tid() & 63;
                const int rowbase = brow + rb;
                const int ct = (bcol >> 6) + wc;
                int kind, vh; float scale; col_kind(L, ct, kind, vh, scale);
                if (kind == 4) return;
                if (kind == 0 || kind == 1) {
#pragma unroll 1
                    for (int i = 0; i < 4; ++i) {
                        const int u = lane + 64 * i, r = u >> 2, c8 = (u & 3) * 8, grow = rowbase + r;
                        float x1[8], x2[8], o1[8], o2[8];
                        ld8f(E + r * EP2 + c8, x1); ld8f(E + r * EP2 + 32 + c8, x2);
                        if (kind == 1) {
                            float cs[8], sn[8];
                            ld8f(rc + (size_t)grow * 32 + c8, cs); ld8f(rs + (size_t)grow * 32 + c8, sn);
#pragma unroll
                            for (int e = 0; e < 8; ++e) { o1[e] = (x1[e] * cs[e] - x2[e] * sn[e]) * scale; o2[e] = (x2[e] * cs[e] + x1[e] * sn[e]) * scale; }
                        } else {
#pragma unroll
                            for (int e = 0; e < 8; ++e) { o1[e] = x1[e] * scale; o2[e] = x2[e] * scale; }
                        }
                        st8bf(Q + (size_t)grow * LDQ + ct * 64 + c8, o1);
                        st8bf(Q + (size_t)grow * LDQ + ct * 64 + 32 + c8, o2);
                    }
                } else if (kind == 2) {
                    const int b = rowbase >> 14, s0 = rowbase & (SEQ - 1);
                    bf16_t* vrow = VT + ((size_t)(b * NVH + vh) * 64 + lane) * VLD + s0;
#pragma unroll 2
                    for (int tc = 0; tc < 8; ++tc) {
                        float v[8];
#pragma unroll
                        for (int e = 0; e < 8; ++e) v[e] = E[(8 * tc + e) * EP2 + lane];
                        st8bf(vrow + 8 * tc, v);
                    }
                } else {
#pragma unroll
                    for (int c = 0; c < 6; ++c) *(float4*)(GD + (size_t)(rowbase + lane) * 24 + 4 * c) = *(const float4*)(E + lane * EP2 + 4 * c);
                }
            });
    }
}

__device__ __forceinline__ void ph_gemm_out(const Params& p, char* smem, const float* xin) {
    const bf16_t* A = (const bf16_t*)(p.ws + OFF_O);
    const bf16_t* Bt = (const bf16_t*)(p.ws + W_OUT);
    float* X = p.out;
    const int tn = 8, tm = NTOK / 256, total = tm * tn, tid = hidden_tid();
    const bool aff = (gridDim.x & 7) == 0;
    const int xcd = blockIdx.x & 7, lstart = aff ? (blockIdx.x >> 3) : blockIdx.x, lstep = aff ? (gridDim.x >> 3) : gridDim.x, lcnt = aff ? total / 8 : total;
    for (int li = lstart; li < lcnt; li += lstep) {
        const int mt = aff ? (xcd * (tm / 8) + li / tn) : (li / tn), nt = li % tn, brow = mt * 256, bcol = nt * 128;
        unsigned ao[8];
#pragma unroll
        for (int k = 0; k < 8; ++k) ao[k] = (unsigned)(((brow + (k >> 2) * 128 + (k & 3) * 32 + (tid >> 3)) * DM + GSW64(tid)) * 2);
        const unsigned bo = (unsigned)(((tid >> 3) * DM + GSW64(tid)) * 2);
        gemm_tile_q(smem, tid, (const char*)A, ao, (const char*)(Bt + (size_t)bcol * DM), bo, DM * 2, DM / 64,
            [&](const float* E, int rb, int wc) {
                const int lane = hidden_tid() & 63;
#pragma unroll 4
                for (int i = 0; i < 16; ++i) {
                    const int u = lane + 64 * i, r = u >> 4, c4 = (u & 15) * 4;
                    const size_t xo = (size_t)(brow + rb + r) * DM + bcol + wc * 64 + c4;
                    const float4 e = *(const float4*)(E + r * EP2 + c4);
                    float4 x = *(const float4*)(xin + xo); x.x += e.x; x.y += e.y; x.z += e.z; x.w += e.w; *(float4*)(X + xo) = x;
                }
            });
    }
}

#define MOE_CAP 32768
__device__ __forceinline__ void ph_route(const Params& p, char* smem, int L) {
    float* lgs = (float*)smem;
    int* hist = (int*)(smem + 20480);
    int* gb = hist + 64;
    int* dec_e = gb + 64;
    int* dec_r = dec_e + 128;
    float* dec_g = (float*)(dec_r + 128);
    const float* gain = p.ln_ffn[L]; const float* Wg = p.r_group[L]; const float* We = p.r_expert[L];
    norm_pass(p.out, nullptr, nullptr, gain, (bf16_t*)(p.ws + OFF_H), nullptr);
    float* tok_g = (float*)(p.ws + M_TOKG);
    int* list = (int*)(p.ws + MOE_LIST);
    int* gcur = (int*)(p.ws + OFF_MOECNT) + L * 64 * CNTS;
    const int tid = hidden_tid(), lane = tid & 63, wid = tid >> 6, fr = lane & 15, fq = lane >> 4;
    for (int ch = blockIdx.x; ch < NTOK / 64; ch += gridDim.x) {
        if (tid < 64) hist[tid] = 0;
        const int tb = ch * 64 + wid * 16;
        f32x4 acc[5];
#pragma unroll
        for (int n = 0; n < 5; ++n) acc[n] = (f32x4){0.f, 0.f, 0.f, 0.f};
        float ss = 0.f;
        const float* xp = p.out + (size_t)(tb + fr) * DM + 4 * fq;
        const float* wep = We + (size_t)(4 * fq) * 64 + 4 * fr;
        const float* wgp = Wg + (size_t)(4 * fq) * 4 + (fr & 3);
        float4 x4 = *(const float4*)xp, g4 = *(const float4*)(gain + 4 * fq);
        float wb[4][5];
#pragma unroll
        for (int e = 0; e < 4; ++e) {
            { const float4 w4 = *(const float4*)(wep + (size_t)e * 64); wb[e][0] = w4.x; wb[e][1] = w4.y; wb[e][2] = w4.z; wb[e][3] = w4.w; }
            wb[e][4] = wgp[e * 4];
        }
        for (int i = 0; i < 64; ++i) {
            const int in = (i + 1 < 64) ? i + 1 : i;
            const float4 x4n = *(const float4*)(xp + 16 * in), g4n = *(const float4*)(gain + 16 * in + 4 * fq);
            float wn[4][5];
#pragma unroll
            for (int e = 0; e < 4; ++e) {
                { const float4 w4 = *(const float4*)(wep + (size_t)(16 * in + e) * 64); wn[e][0] = w4.x; wn[e][1] = w4.y; wn[e][2] = w4.z; wn[e][3] = w4.w; }
                wn[e][4] = wgp[(size_t)(16 * in + e) * 4];
            }
            ss += x4.x * x4.x + x4.y * x4.y + x4.z * x4.z + x4.w * x4.w;
            const float a[4] = {x4.x * g4.x, x4.y * g4.y, x4.z * g4.z, x4.w * g4.w};
#pragma unroll
            for (int e = 0; e < 4; ++e) {
#pragma unroll
                for (int n = 0; n < 4; ++n) acc[n] = __builtin_amdgcn_mfma_f32_16x16x4f32(a[e], wb[e][n], acc[n], 0, 0, 0);
                acc[4] = __builtin_amdgcn_mfma_f32_16x16x4f32(a[e], fr < 4 ? wb[e][4] : 0.f, acc[4], 0, 0, 0);
            }
            x4 = x4n; g4 = g4n;
#pragma unroll
            for (int e = 0; e < 4; ++e)
#pragma unroll
                for (int n = 0; n < 5; ++n) wb[e][n] = wn[e][n];
        }
        ss = quad_sum(ss);
        const float rstd = rsqrtf(ss * (1.0f / DM) + 1e-6f);
#pragma unroll
        for (int j = 0; j < 4; ++j) {
            const float r = __shfl(rstd, 4 * fq + j);
#pragma unroll
            for (int n = 0; n < 5; ++n) lgs[(wid * 16 + 4 * fq + j) * 80 + (n < 4 ? 4 * fr + n : 64 + fr)] = acc[n][j] * r;
        }
        __syncthreads();
        if (tid < 64) {
            const float* lt = lgs + tid * 80;
            float gl[4]; float gm = -INFINITY; int gi = 0;
#pragma unroll
            for (int i = 0; i < 4; ++i) { gl[i] = lt[64 + i]; if (gl[i] > gm) { gm = gl[i]; gi = i; } }
            float gsum = 0.f;
#pragma unroll
            for (int i = 0; i < 4; ++i) gsum += __expf(gl[i] - gm);
            const float gprob = 1.0f / gsum;
            float m0 = -INFINITY, m1 = -INFINITY; int i0 = 0, i1 = 0;
            for (int i = 0; i < 16; ++i) { const float v = lt[gi * 16 + i]; if (v > m0) { m1 = m0; i1 = i0; m0 = v; i0 = i; } else if (v > m1) { m1 = v; i1 = i; } }
            const float e1 = __expf(m1 - m0), den = 1.0f + e1;
            const int ex0 = gi * 16 + i0, ex1 = gi * 16 + i1;
            dec_e[tid * 2] = ex0; dec_e[tid * 2 + 1] = ex1;
            dec_g[tid * 2] = gprob / den; dec_g[tid * 2 + 1] = gprob * e1 / den;
            dec_r[tid * 2] = atomicAdd(&hist[ex0], 1); dec_r[tid * 2 + 1] = atomicAdd(&hist[ex1], 1);
        }
        __syncthreads();
        if (tid < 64) gb[tid] = hist[tid] > 0 ? atomicAdd(&gcur[tid * CNTS], hist[tid]) : 0;
        __syncthreads();
        if (tid < 128) {
            const int slot = ch * 128 + tid, ex = dec_e[tid];
            list[(size_t)ex * MOE_CAP + gb[ex] + dec_r[tid]] = slot;
            tok_g[slot] = dec_g[tid];
        }
        __syncthreads();
    }
}

__device__ __forceinline__ void ph_moe_gemm(const Params& p, char* smem, int which, int L) {
    int* tpre = (int*)(smem + 73728);
    int* e_cnt = tpre + 68;
    int* e_base = e_cnt + 64;
    const int* gcur = (const int*)(p.ws + OFF_MOECNT) + L * 64 * CNTS;
    const int* list = (const int*)(p.ws + MOE_LIST); const float* tok_g = (const float*)(p.ws + M_TOKG);
    const bf16_t* H = (const bf16_t*)(p.ws + OFF_H);
    bf16_t* HID = (bf16_t*)(p.ws + HID_OFF);
    bf16_t* Y = (bf16_t*)(p.ws + B_Y);
    const int tid = hidden_tid();
    const bool aff = (gridDim.x & 7) == 0;
    const int xcd = blockIdx.x & 7;
    if (tid == 0) {
        int rb = 0; for (int i = 0; i < 64; ++i) { const int c = gcur[i * CNTS]; e_cnt[i] = c; e_base[i] = rb; rb += c; }
        int acc = 0;
        if (aff) { for (int v = 0; v < 8; ++v) { tpre[v] = acc; acc += (e_cnt[xcd + 8 * v] + 255) >> 8; } tpre[8] = acc; }
        else { for (int i = 0; i < 64; ++i) { tpre[i] = acc; acc += (e_cnt[i] + 255) >> 8; } tpre[64] = acc; }
    }
    __syncthreads();
    const int nvis = aff ? 8 : 64;
    const int total = tpre[nvis] * 8;
    const int lstart = aff ? (blockIdx.x >> 3) : blockIdx.x, lstep = aff ? (gridDim.x >> 3) : gridDim.x;
    for (int it = lstart; it < total; it += lstep) {
        const int mtg = it >> 3, nt = it & 7;
        int v = 0;
        { int lo = 0, hi = nvis - 1; while (lo < hi) { const int mid = (lo + hi + 1) >> 1; if (tpre[mid] <= mtg) lo = mid; else hi = mid - 1; } v = lo; }
        const int e = __builtin_amdgcn_readfirstlane(aff ? (xcd + 8 * v) : v);
        const int mt = __builtin_amdgcn_readfirstlane(mtg - tpre[v]), cnt = __builtin_amdgcn_readfirstlane(e_cnt[e]), bas = __builtin_amdgcn_readfirstlane(e_base[e]);
        const int* elist = list + (size_t)e * MOE_CAP;
        const int r0 = mt * 256 + (tid >> 3);
        unsigned ao[8];
        if (which == 0) {
#pragma unroll
            for (int k = 0; k < 8; ++k) { const int r = r0 + (k >> 2) * 128 + (k & 3) * 32; const int tk = (r < cnt) ? (elist[r] >> 1) : 0; ao[k] = (unsigned)((tk * DM + GSW64(tid)) * 2); }
            const bf16_t* Bt = (const bf16_t*)(p.ws + W_GU) + (size_t)e * 1024 * 1024;
            const unsigned bo = (unsigned)(((tid >> 3) * DM + GSW64(tid)) * 2);
            gemm_tile_q(smem, tid, (const char*)H, ao, (const char*)(Bt + (size_t)(nt * 128) * DM), bo, DM * 2, DM / 64,
                [&](const float* E, int rb, int wc) {
                    const int lane = hidden_tid() & 63;
#pragma unroll 1
                    for (int i = 0; i < 4; ++i) {
                        const int u = lane + 64 * i, r = u >> 2, c8 = (u & 3) * 8, rr = mt * 256 + rb + r;
                        float g[8], up[8], o[8];
                        ld8f(E + r * EP2 + c8, g); ld8f(E + r * EP2 + 32 + c8, up);
#pragma unroll
                        for (int e = 0; e < 8; ++e) o[e] = g[e] / (1.0f + __expf(-g[e])) * up[e];
                        if (rr < cnt) st8bf(HID + (size_t)(bas + rr) * EH + (nt * 2 + wc) * 32 + c8, o);
                    }
                });
        } else {
#pragma unroll
            for (int k = 0; k < 8; ++k) { const int r = r0 + (k >> 2) * 128 + (k & 3) * 32; ao[k] = (unsigned)((((r < cnt) ? (bas + r) : 0) * EH + GSW64(tid)) * 2); }
            const bf16_t* Bt = (const bf16_t*)(p.ws + W_DN) + (size_t)e * 1024 * 512;
            const unsigned bo = (unsigned)(((tid >> 3) * EH + GSW64(tid)) * 2);
            gemm_tile_q(smem, tid, (const char*)HID, ao, (const char*)(Bt + (size_t)(nt * 128) * EH), bo, EH * 2, EH / 64,
                [&](const float* E, int rb, int wc) {
                    const int lane = hidden_tid() & 63;
#pragma unroll 1
                    for (int i = 0; i < 8; ++i) {
                        const int u = lane + 64 * i, r = u >> 3, c8 = (u & 7) * 8, rr = mt * 256 + rb + r;
                        if (rr < cnt) {
                            const int slot = elist[rr];
                            const float g = tok_g[slot];
                            float x[8]; ld8f(E + r * EP2 + c8, x);
#pragma unroll
                            for (int e = 0; e < 8; ++e) x[e] *= g;
                            st8bf(Y + (size_t)slot * DM + nt * 128 + wc * 64 + c8, x);
                        }
                    }
                });
        }
    }
}

struct KF { bf16x8 k[4][2]; };
struct VF { bf16x8 v[4][2]; };
struct St { float m, l; f32x4 o[4]; };
#define KEY_OF(kt, j, fq) (32 * ((kt) >> 1) + 8 * (fq) + 4 * ((kt) & 1) + (j))
__device__ __forceinline__ void st_init(St& st) {
    st.m = NEG_BIG; st.l = 0.f;
#pragma unroll
    for (int n = 0; n < 4; ++n) st.o[n] = (f32x4){0.f, 0.f, 0.f, 0.f};
}
__device__ __forceinline__ void load_k(KF& f, const bf16_t* kp, size_t ldk, int fr, int fq) {
    const bf16_t* base = kp + (size_t)(8 * (fr >> 2) + (fr & 3)) * ldk + fq * 8;
#pragma unroll
    for (int kt = 0; kt < 4; ++kt)
#pragma unroll
        for (int ks = 0; ks < 2; ++ks) f.k[kt][ks] = ld8(base + (size_t)(32 * (kt >> 1) + 4 * (kt & 1)) * ldk + ks * 32);
}
__device__ __forceinline__ void load_v(VF& f, const bf16_t* vp, size_t ldv, int fr, int fq) {
    const bf16_t* base = vp + (size_t)fr * ldv + fq * 8;
#pragma unroll
    for (int n = 0; n < 4; ++n)
#pragma unroll
        for (int h = 0; h < 2; ++h) f.v[n][h] = ld8(base + (size_t)(n * 16) * ldv + h * 32);
}
__device__ __forceinline__ void scores(const KF& f, const bf16x8 (&qf)[2], f32x4 (&s)[4]) {
#pragma unroll
    for (int kt = 0; kt < 4; ++kt) {
        s[kt] = mfma16(f.k[kt][0], qf[0], (f32x4){0.f, 0.f, 0.f, 0.f});
        s[kt] = mfma16(f.k[kt][1], qf[1], s[kt]);
    }
}
typedef unsigned u32x4 __attribute__((ext_vector_type(4)));
__device__ __forceinline__ void pv(const VF& f, const float (&p)[4][4], f32x4 (&o)[4]) {
#pragma unroll
    for (int h = 0; h < 2; ++h) {
        u32x4 w;
        w[0] = pack2(p[2 * h][0], p[2 * h][1]); w[1] = pack2(p[2 * h][2], p[2 * h][3]);
        w[2] = pack2(p[2 * h + 1][0], p[2 * h + 1][1]); w[3] = pack2(p[2 * h + 1][2], p[2 * h + 1][3]);
        const bf16x8 pb = __builtin_bit_cast(bf16x8, w);
#pragma unroll
        for (int n = 0; n < 4; ++n) o[n] = mfma16(f.v[n][h], pb, o[n]);
    }
}
template <bool FULL, class MaskFn>
__device__ __forceinline__ void softmax_step(const f32x4 (&s)[4], MaskFn mask, St& st, float (&p)[4][4], int fq) {
    float mx = -INFINITY; bool v[4][4];
#pragma unroll
    for (int kt = 0; kt < 4; ++kt)
#pragma unroll
        for (int j = 0; j < 4; ++j) {
            if (FULL) { v[kt][j] = true; mx = fmaxf(mx, s[kt][j]); }
            else { v[kt][j] = mask(KEY_OF(kt, j, fq)); mx = fmaxf(mx, v[kt][j] ? s[kt][j] : -INFINITY); }
        }
    mx = quad_max(mx);
    if (!__all(mx <= st.m)) {
        const float mn = fmaxf(st.m, mx), alpha = ex2(st.m - mn);
        st.l *= alpha; st.m = mn;
#pragma unroll
        for (int n = 0; n < 4; ++n) st.o[n] *= alpha;
    }
    float sum = 0.f;
#pragma unroll
    for (int kt = 0; kt < 4; ++kt)
#pragma unroll
        for (int j = 0; j < 4; ++j) { p[kt][j] = (FULL || v[kt][j]) ? ex2(s[kt][j] - st.m) : 0.f; sum += p[kt][j]; }
    st.l += sum;
}
template <bool PF = true, class AddrFn, class MaskFn, class FullFn>
__device__ __forceinline__ void attn_run(const bf16x8 (&qf)[2], int nsteps, AddrFn addr, size_t ldk, size_t ldv, MaskFn mask, FullFn full, St& st, int fr, int fq) {
    if (nsteps <= 0) return;
    const bf16_t* kp; const bf16_t* vp; addr(0, kp, vp);
    if (PF) {
        KF kc; load_k(kc, kp, ldk, fr, fq);
        for (int s = 0; s < nsteps; ++s) {
            VF vf; load_v(vf, vp, ldv, fr, fq);
            const bf16_t* kp2 = kp; const bf16_t* vp2 = vp;
            if (s + 1 < nsteps) addr(s + 1, kp2, vp2);
            KF kn; load_k(kn, kp2, ldk, fr, fq);
            f32x4 sc[4]; scores(kc, qf, sc);
            float p[4][4];
            if (full(s)) softmax_step<true>(sc, [&](int key) { return mask(s, key); }, st, p, fq); else softmax_step<false>(sc, [&](int key) { return mask(s, key); }, st, p, fq);
            pv(vf, p, st.o);
            kc = kn; kp = kp2; vp = vp2;
        }
    } else {
        for (int s = 0; s < nsteps; ++s) {
            addr(s, kp, vp);
            KF kc; load_k(kc, kp, ldk, fr, fq);
            VF vf; load_v(vf, vp, ldv, fr, fq);
            f32x4 sc[4]; scores(kc, qf, sc);
            float p[4][4];
            if (full(s)) softmax_step<true>(sc, [&](int key) { return mask(s, key); }, st, p, fq); else softmax_step<false>(sc, [&](int key) { return mask(s, key); }, st, p, fq);
            pv(vf, p, st.o);
        }
    }
}
__device__ __forceinline__ void st_part(bf16_t* p32, const f32x4 (&o)[4]) {
    uint4* q = (uint4*)p32;
    q[0] = make_uint4(pack2(o[0][0], o[0][1]), pack2(o[0][2], o[0][3]), pack2(o[1][0], o[1][1]), pack2(o[1][2], o[1][3]));
    q[1] = make_uint4(pack2(o[2][0], o[2][1]), pack2(o[2][2], o[2][3]), pack2(o[3][0], o[3][1]), pack2(o[3][2], o[3][3]));
}
__device__ __forceinline__ void acc_part(const bf16_t* p32, float c, f32x4 (&o)[4]) {
    const uint4 a = ((const uint4*)p32)[0], b = ((const uint4*)p32)[1];
    const unsigned w[8] = {a.x, a.y, a.z, a.w, b.x, b.y, b.z, b.w};
#pragma unroll
    for (int n = 0; n < 4; ++n) {
        o[n][0] += c * __uint_as_float(w[2 * n] << 16); o[n][1] += c * __uint_as_float(w[2 * n] & 0xFFFF0000u);
        o[n][2] += c * __uint_as_float(w[2 * n + 1] << 16); o[n][3] += c * __uint_as_float(w[2 * n + 1] & 0xFFFF0000u);
    }
}
__device__ __forceinline__ void store_o4(bf16_t* dst, float a, float b, float c, float d) { *(uint2*)dst = make_uint2(pack2(a, b), pack2(c, d)); }

struct Stager {
    size_t ko, vo, ldk32, ldv32; int tid;
    __device__ __forceinline__ void init(int tid_, size_t ldk, size_t ldv) {
        tid = tid_;
        const int row = tid >> 3, c = tid & 7;
        const int gk = ((tid >> 4) & 1) | (((tid >> 6) & 3) << 1), gv = (tid >> 4) & 7;
        ko = (size_t)row * ldk + (c ^ gk) * 8;
        vo = (size_t)row * ldv + (c ^ gv) * 8;
        ldk32 = 32 * ldk; ldv32 = 32 * ldv;
    }
    __device__ __forceinline__ void stage_k(char* buf, const bf16_t* kp) const { glds16(kp + ko, buf + tid * 16); glds16(kp + ko + ldk32, buf + 4096 + tid * 16); }
    __device__ __forceinline__ void stage_v(char* buf, const bf16_t* vp) const { glds16(vp + vo, buf + 8192 + tid * 16); glds16(vp + vo + ldv32, buf + 12288 + tid * 16); }
};
__device__ __forceinline__ void lds_k(KF& f, const char* buf, int lane) {
    const int fr = lane & 15, fq = lane >> 4;
    const int gk = ((fr >> 1) & 1) | (((fr >> 2) & 3) << 1);
    const char* base = buf + (8 * (fr >> 2) + (fr & 3)) * 128;
#pragma unroll
    for (int kt = 0; kt < 4; ++kt)
#pragma unroll
        for (int ks = 0; ks < 2; ++ks) f.k[kt][ks] = *(const bf16x8*)(base + (32 * (kt >> 1) + 4 * (kt & 1)) * 128 + (((ks * 4 + fq) ^ gk) * 16));
}
__device__ __forceinline__ void lds_v(VF& f, const char* buf, int lane) {
    const int fr = lane & 15, fq = lane >> 4;
    const int gv = (fr >> 1) & 7;
    const char* base = buf + 8192 + fr * 128;
#pragma unroll
    for (int n = 0; n < 4; ++n)
#pragma unroll
        for (int h = 0; h < 2; ++h) f.v[n][h] = *(const bf16x8*)(base + n * 16 * 128 + (((h * 4 + fq) ^ gv) * 16));
}
#define LDS_RING(s) ((s) % 3 * 16384)
template <class AddrFn, class MaskFn, class FullFn>
__device__ __forceinline__ void attn_run_lds(char* smem, const Stager& sg, const bf16x8 (&qf)[2], int nsteps, AddrFn addr, MaskFn mask, FullFn full, St& st, int lane, int fq) {
    if (nsteps <= 0) return;
    const bf16_t* kp; const bf16_t* vp;
    asm volatile("s_waitcnt vmcnt(0)" ::: "memory");
    addr(0, kp, vp); sg.stage_k(smem, kp); sg.stage_v(smem, vp);
    if (nsteps > 1) { addr(1, kp, vp); sg.stage_k(smem + 16384, kp); sg.stage_v(smem + 16384, vp); }
    for (int s = 0; s < nsteps; ++s) {
        const char* cur = smem + LDS_RING(s);
        if (s + 1 < nsteps) asm volatile("s_waitcnt vmcnt(4)" ::: "memory"); else asm volatile("s_waitcnt vmcnt(0)" ::: "memory");
        __builtin_amdgcn_s_barrier();
        asm volatile("" ::: "memory");
        if (s + 2 < nsteps) { addr(s + 2, kp, vp); char* nxt = smem + LDS_RING(s + 2); sg.stage_k(nxt, kp); sg.stage_v(nxt, vp); }
        KF kc; lds_k(kc, cur, lane);
        VF vf; lds_v(vf, cur, lane);
        f32x4 sc[4]; scores(kc, qf, sc);
        float p[4][4];
        if (full(s)) softmax_step<true>(sc, [&](int key) { return mask(s, key); }, st, p, fq); else softmax_step<false>(sc, [&](int key) { return mask(s, key); }, st, p, fq);
        pv(vf, p, st.o);
    }
    __syncthreads();
}

template <class AddrFn, class MaskFn, class FullFn>
__device__ __forceinline__ void attn_run_lds2(char* smem, const Stager& sg, const bf16x8 (&qf)[2][2], int nsteps, AddrFn addr, MaskFn mask, FullFn full, St (&st)[2], int lane, int fq) {
    if (nsteps <= 0) return;
    const bf16_t* kp; const bf16_t* vp;
    asm volatile("s_waitcnt vmcnt(0)" ::: "memory");
    addr(0, kp, vp); sg.stage_k(smem, kp); sg.stage_v(smem, vp);
    if (nsteps > 1) { addr(1, kp, vp); sg.stage_k(smem + 16384, kp); sg.stage_v(smem + 16384, vp); }
    for (int s = 0; s < nsteps; ++s) {
        const char* cur = smem + LDS_RING(s);
        if (s + 1 < nsteps) asm volatile("s_waitcnt vmcnt(4)" ::: "memory"); else asm volatile("s_waitcnt vmcnt(0)" ::: "memory");
        __builtin_amdgcn_s_barrier();
        asm volatile("" ::: "memory");
        if (s + 2 < nsteps) { addr(s + 2, kp, vp); char* nxt = smem + LDS_RING(s + 2); sg.stage_k(nxt, kp); sg.stage_v(nxt, vp); }
        KF kc; lds_k(kc, cur, lane);
        VF vf; lds_v(vf, cur, lane);
#pragma unroll
        for (int r = 0; r < 2; ++r) {
            f32x4 sc[4]; scores(kc, qf[r], sc);
            float p[4][4];
            if (full(r, s)) softmax_step<true>(sc, [&](int key) { return mask(r, s, key); }, st[r], p, fq); else softmax_step<false>(sc, [&](int key) { return mask(r, s, key); }, st[r], p, fq);
            pv(vf, p, st[r].o);
        }
    }
    __syncthreads();
}

__device__ __forceinline__ void ph_attn0(const Params& p, char* smem) {
    const bf16_t* Q = (const bf16_t*)(p.ws + OFF_QKV);
    const bf16_t* VT = (const bf16_t*)(p.ws + OFF_VT);
    bf16_t* O = (bf16_t*)(p.ws + OFF_O);
    const int tid = hidden_tid(), lane = tid & 63, wid = tid >> 6, fr = lane & 15, fq = lane >> 4;
    Stager sg; sg.init(tid, LDQ, VLD);
    for (int it = blockIdx.x; it < 2 * 2 * (SEQ / 32); it += gridDim.x) {
        const int tt = it % (SEQ / 32), hkv = (it / (SEQ / 32)) & 1, b = it / (2 * (SEQ / 32));
        const int head = hkv * 4 + wid, t0 = tt * 32;
        const size_t rowb = (size_t)b * SEQ;
        bf16x8 qf[2][2]; St st[2];
#pragma unroll
        for (int r = 0; r < 2; ++r) {
            const bf16_t* qp = Q + (rowb + t0 + 16 * r + fr) * LDQ + head * 64;
            qf[r][0] = ld8(qp + fq * 8); qf[r][1] = ld8(qp + 32 + fq * 8);
            st_init(st[r]);
            st[r].m = p.sinks0[head] * LOG2E; st[r].l = (fq == 0) ? 1.f : 0.f;
        }
        int k0 = t0 - 127; if (k0 < 0) k0 = 0; k0 &= ~63;
        const int ns = ((t0 + 31 - k0) >> 6) + 1;
        const bf16_t* kbase = Q + rowb * LDQ + 512 + hkv * 64;
        const bf16_t* vbase = VT + ((size_t)(b * NVH + hkv) * 64) * VLD;
        attn_run_lds2(smem, sg, qf, ns, [&](int s, const bf16_t*& kp, const bf16_t*& vp) { const int kb = k0 + 64 * s; kp = kbase + (size_t)kb * LDQ; vp = vbase + kb; },
                      [&](int r, int s, int key) { const int k = k0 + 64 * s + key, t = t0 + 16 * r + fr; return (k <= t) && (t - k < 128); },
                      [&](int r, int s) { const int kb = k0 + 64 * s, tb = t0 + 16 * r; return (kb + 63 <= tb) && (tb + 15 - kb < 128); }, st, lane, fq);
#pragma unroll
        for (int r = 0; r < 2; ++r) {
            const float inv = 1.0f / quad_sum(st[r].l);
#pragma unroll
            for (int n = 0; n < 4; ++n) store_o4(O + (rowb + t0 + 16 * r + fr) * DM + head * 64 + n * 16 + 4 * fq, st[r].o[n][0] * inv, st[r].o[n][1] * inv, st[r].o[n][2] * inv, st[r].o[n][3] * inv);
        }
    }
    int* vote = (int*)(smem + 49152);
    for (int it = blockIdx.x; it < 2 * 8 * (SEQ / 64); it += gridDim.x) {
        const int tt = it % (SEQ / 64), head = (it / (SEQ / 64)) & 7, b = it / (8 * (SEQ / 64));
        const int tb0 = tt * 64, t = tb0 + 16 * wid + fr;
        const size_t rowb = (size_t)b * SEQ;
        bf16x8 qf[2];
        qf[0] = ld8(Q + (rowb + t) * LDQ + 768 + head * 64 + fq * 8);
        qf[1] = ld8(Q + (rowb + t) * LDQ + 768 + head * 64 + 32 + fq * 8);
        f32x4 o[4];
#pragma unroll
        for (int n = 0; n < 4; ++n) o[n] = (f32x4){0.f, 0.f, 0.f, 0.f};
        float R = 0.f;
        const bf16_t* kbase = Q + rowb * LDQ + 1280 + head * 64;
        const bf16_t* vbase = VT + ((size_t)(b * NVH + 2 + head) * 64) * VLD;
        const int nsteps = tt + 1;
        if (tid < 8) vote[tid] = 0;
        asm volatile("s_waitcnt vmcnt(0)" ::: "memory");
        sg.stage_k(smem, kbase + (size_t)tb0 * LDQ); sg.stage_v(smem, vbase + tb0);
        if (nsteps > 1) { sg.stage_k(smem + 16384, kbase + (size_t)(tb0 - 64) * LDQ); sg.stage_v(smem + 16384, vbase + tb0 - 64); }
        bool mine_done = false;
        for (int s = 0; s < nsteps; ++s) {
            const char* cur = smem + LDS_RING(s);
            const int kb = tb0 - 64 * s;
            if (s + 1 < nsteps) asm volatile("s_waitcnt vmcnt(4)" ::: "memory"); else asm volatile("s_waitcnt vmcnt(0)" ::: "memory");
            lds_fence();
            __builtin_amdgcn_s_barrier();
            asm volatile("" ::: "memory");
            if (s > 0) { const int* vv = vote + ((s - 1) & 1) * 4; if ((vv[0] & vv[1] & vv[2] & vv[3]) != 0) break; }
            if (s + 2 < nsteps) { char* nxt = smem + LDS_RING(s + 2); sg.stage_k(nxt, kbase + (size_t)(kb - 128) * LDQ); sg.stage_v(nxt, vbase + kb - 128); }
            if (!mine_done) {
                KF kc; lds_k(kc, cur, lane);
                VF vf; lds_v(vf, cur, lane);
                f32x4 sc[4]; scores(kc, qf, sc);
                float w4[4][4], ex[4][4], lsg[4][4];
                float T[2];
#pragma unroll
                for (int h = 0; h < 2; ++h) {
                    float run = 0.f;
#pragma unroll
                    for (int q = 1; q >= 0; --q) {
                        const int kt = 2 * h + q;
#pragma unroll
                        for (int j = 3; j >= 0; --j) {
                            const float z = sc[kt][j];
                            const bool v = (kb + KEY_OF(kt, j, fq)) < t;
                            const float sp = fmaxf(z, 0.f) + __logf(1.0f + __expf(-fabsf(z)));
                            ex[kt][j] = run;
                            lsg[kt][j] = v ? (z - sp) : -INFINITY;
                            run += v ? -sp : 0.f;
                        }
                    }
                    T[h] = run;
                }
                float E[2], Tot[2];
#pragma unroll
                for (int h = 0; h < 2; ++h) {
                    const float a0 = __shfl(T[h], fr), a1 = __shfl(T[h], fr + 16), a2 = __shfl(T[h], fr + 32), a3 = __shfl(T[h], fr + 48);
                    Tot[h] = (a0 + a1) + (a2 + a3);
                    E[h] = (fq < 1 ? a1 : 0.f) + (fq < 2 ? a2 : 0.f) + (fq < 3 ? a3 : 0.f);
                }
#pragma unroll
                for (int kt = 0; kt < 4; ++kt) {
                    const float off = (kt >> 1) ? (R + E[1]) : (R + Tot[1] + E[0]);
#pragma unroll
                    for (int j = 0; j < 4; ++j) w4[kt][j] = __expf(lsg[kt][j] + off + ex[kt][j]);
                }
                R += Tot[0] + Tot[1];
                pv(vf, w4, o);
                if (__all(R < -104.f)) mine_done = true;
            }
            if (lane == 0) vote[(s & 1) * 4 + wid] = mine_done ? 1 : 0;
        }
        asm volatile("s_waitcnt vmcnt(0)" ::: "memory");
        __syncthreads();
#pragma unroll
        for (int n = 0; n < 4; ++n) store_o4(O + (rowb + t) * DM + 512 + head * 64 + n * 16 + 4 * fq, o[n][0], o[n][1], o[n][2], o[n][3]);
    }
}

__device__ __forceinline__ void ph_kmean(const Params& p) {
    const bf16_t* Q = (const bf16_t*)(p.ws + OFF_QKV);
    float* KM = (float*)(p.ws + B_KMEAN);
    const int tidh = hidden_tid(), lane = tidh & 63, wid = tidh >> 6;
    const int c = lane & 7, r = lane >> 3;
    const int nw = gridDim.x * 4, w0 = ((blockIdx.x + gridDim.x - (gridDim.x > 128 ? 128 : 0)) % gridDim.x) * 4 + wid;
    for (int wi = w0; wi < 256; wi += nw) {
        const int hkv = wi & 1, j = (wi >> 1) & 63, b = wi >> 7;
        const bf16_t* base = Q + ((size_t)b * SEQ + j * 256 + r) * LDQ + 512 + hkv * 64 + c * 8;
        float acc[8] = {0.f, 0.f, 0.f, 0.f, 0.f, 0.f, 0.f, 0.f};
#pragma unroll 8
        for (int i = 0; i < 32; ++i) {
            const bf16x8 v = ld8(base + (size_t)(8 * i) * LDQ);
#pragma unroll
            for (int e = 0; e < 8; ++e) acc[e] += bf2f((bf16_t)v[e]);
        }
#pragma unroll
        for (int e = 0; e < 8; ++e) { float a = acc[e]; a += __shfl_xor(a, 8); a += __shfl_xor(a, 16); a += __shfl_xor(a, 32); acc[e] = a; }
        if (r == 0) {
            float* o = KM + ((b * 64 + j) * 2 + hkv) * 64 + c * 8;
            *(float4*)o = make_float4(acc[0] * (1.0f / 256.0f), acc[1] * (1.0f / 256.0f), acc[2] * (1.0f / 256.0f), acc[3] * (1.0f / 256.0f));
            *(float4*)(o + 4) = make_float4(acc[4] * (1.0f / 256.0f), acc[5] * (1.0f / 256.0f), acc[6] * (1.0f / 256.0f), acc[7] * (1.0f / 256.0f));
        }
    }
}
__device__ __forceinline__ size_t moba_list_off(int L, int j) { return (size_t)L * MOBA_LCAP + 1024ull * (size_t)(63 * j - (j * (j - 1)) / 2); }

__device__ __forceinline__ void ph_moba_gate(const Params& p, char* smem) {
    float* km = (float*)smem;
    int* cnt = (int*)(smem + 16384);
    int* gbase = cnt + 64;
    const bf16_t* Q = (const bf16_t*)(p.ws + OFF_QKV);
    const float* KM = (const float*)(p.ws + B_KMEAN);
    int* gcnt = (int*)(p.ws + OFF_MOBACNT);
    int* lists = (int*)(p.ws + B_LIST);
    const int tid = hidden_tid();
    for (int it = blockIdx.x; it < 1024; it += gridDim.x) {
        const int tc = it & 255, hkv = (it >> 8) & 1, b = it >> 9, LL = b * 2 + hkv;
        const int tl = tc * 64 + (tid >> 2), g = tid & 3, own = tl >> 8;
        for (int i = tid; i < 64 * 64; i += 256) { const int j = i >> 6, d = i & 63; km[i] = KM[((b * 64 + j) * 2 + hkv) * 64 + d]; }
        if (tid < 64) cnt[tid] = 0;
        __syncthreads();
        float q[64];
        {
            const bf16_t* qp = Q + ((size_t)b * SEQ + tl) * LDQ + (hkv * 4 + g) * 64;
#pragma unroll
            for (int i = 0; i < 8; ++i) { const bf16x8 v = ld8(qp + i * 8);
#pragma unroll
                for (int e = 0; e < 8; ++e) q[i * 8 + e] = bf2f((bf16_t)v[e]); }
        }
        float bv0 = -INFINITY, bv1 = -INFINITY, bv2 = -INFINITY; int bi0 = 0, bi1 = 1, bi2 = 2;
        for (int j = 0; j < own; ++j) {
            float s = 0.f;
#pragma unroll
            for (int d = 0; d < 64; d += 4) { const float4 k = *(const float4*)(km + j * 64 + d); s += q[d] * k.x; s += q[d + 1] * k.y; s += q[d + 2] * k.z; s += q[d + 3] * k.w; }
            if (s > bv0) { bv2 = bv1; bi2 = bi1; bv1 = bv0; bi1 = bi0; bv0 = s; bi0 = j; }
            else if (s > bv1) { bv2 = bv1; bi2 = bi1; bv1 = s; bi1 = j; }
            else if (s > bv2) { bv2 = s; bi2 = j; }
        }
        const int nv = own < 3 ? own : 3;
        int rk0 = 0, rk1 = 0, rk2 = 0;
        if (nv > 0) rk0 = atomicAdd(&cnt[bi0], 1);
        if (nv > 1) rk1 = atomicAdd(&cnt[bi1], 1);
        if (nv > 2) rk2 = atomicAdd(&cnt[bi2], 1);
        __syncthreads();
        if (tid < 64 && cnt[tid] > 0) gbase[tid] = atomicAdd(&gcnt[(LL * 64 + tid) * CNTS], cnt[tid]);
        __syncthreads();
        const int ent = tl | (g << 14);
        if (nv > 0) lists[moba_list_off(LL, bi0) + gbase[bi0] + rk0] = ent | (0 << 16);
        if (nv > 1) lists[moba_list_off(LL, bi1) + gbase[bi1] + rk1] = ent | (1 << 16);
        if (nv > 2) lists[moba_list_off(LL, bi2) + gbase[bi2] + rk2] = ent | (2 << 16);
        __syncthreads();
    }
}

__device__ __forceinline__ void ph_moba_part(const Params& p, char* smem) {
    int* cpre = (int*)(smem + 49152);
    const bf16_t* Q = (const bf16_t*)(p.ws + OFF_QKV);
    const bf16_t* VT = (const bf16_t*)(p.ws + OFF_VT);
    const int* gcnt = (const int*)(p.ws + OFF_MOBACNT);
    const int* lists = (const int*)(p.ws + B_LIST);
    bf16_t* PO = (bf16_t*)(p.ws + B_PO); float* PML = (float*)(p.ws + B_PML);
    const int tid = hidden_tid(), lane = tid & 63, wid = tid >> 6, fr = lane & 15, fq = lane >> 4;
    Stager sg; sg.init(tid, LDQ, VLD);
    cpre[tid + 1] = (gcnt[tid * CNTS] + 127) >> 7;
    if (tid == 0) cpre[0] = 0;
    __syncthreads();
    if (tid == 0) { int acc = 0; for (int i = 1; i <= 256; ++i) { acc += cpre[i]; cpre[i] = acc; } }
    __syncthreads();
    const int total = cpre[256];
    for (int it = blockIdx.x; it < total; it += gridDim.x) {
        int li;
        { int lo = 0, hi = 255; while (lo < hi) { const int mid = (lo + hi + 1) >> 1; if (cpre[mid] <= it) lo = mid; else hi = mid - 1; } li = lo; }
        const int chunk = it - cpre[li], LL = li >> 6, j = li & 63, b = LL >> 1, hkv = LL & 1, n = gcnt[li * CNTS];
        const int* lst = lists + moba_list_off(LL, j);
        int ent[2]; bf16x8 qf[2][2]; St st[2];
#pragma unroll
        for (int r = 0; r < 2; ++r) {
            const int ri = chunk * 128 + r * 64 + wid * 16 + fr;
            ent[r] = lst[ri < n ? ri : n - 1];
            const bf16_t* qp = Q + ((size_t)b * SEQ + (ent[r] & 16383)) * LDQ + (hkv * 4 + ((ent[r] >> 14) & 3)) * 64;
            qf[r][0] = ld8(qp + fq * 8); qf[r][1] = ld8(qp + 32 + fq * 8);
            st_init(st[r]);
        }
        const bf16_t* kbase = Q + ((size_t)b * SEQ + j * 256) * LDQ + 512 + hkv * 64;
        const bf16_t* vbase = VT + ((size_t)(b * NVH + hkv) * 64) * VLD + j * 256;
        attn_run_lds2(smem, sg, qf, 4, [&](int s, const bf16_t*& kp, const bf16_t*& vp) { kp = kbase + (size_t)(64 * s) * LDQ; vp = vbase + 64 * s; },
                      [](int, int, int) { return true; }, [](int, int) { return true; }, st, lane, fq);
#pragma unroll
        for (int r = 0; r < 2; ++r) {
            const int ri = chunk * 128 + r * 64 + wid * 16 + fr;
            const float l = quad_sum(st[r].l);
            if (ri < n) {
                const int e = ent[r];
                const size_t idx = ((size_t)((size_t)b * SEQ + (e & 16383)) * 8 + hkv * 4 + ((e >> 14) & 3)) * 3 + ((e >> 16) & 3);
                st_part(PO + idx * 64 + fq * 16, st[r].o);
                if (fq == 0) { PML[idx * 2] = st[r].m; PML[idx * 2 + 1] = l; }
            }
        }
    }
}

__device__ __forceinline__ void ph_moba_own(const Params& p, char* smem) {
    const bf16_t* Q = (const bf16_t*)(p.ws + OFF_QKV);
    const bf16_t* VT = (const bf16_t*)(p.ws + OFF_VT);
    const bf16_t* PO = (const bf16_t*)(p.ws + B_PO); const float* PML = (const float*)(p.ws + B_PML);
    bf16_t* O = (bf16_t*)(p.ws + OFF_O);
    const int tid = hidden_tid(), lane = tid & 63, wid = tid >> 6, fr = lane & 15, fq = lane >> 4;
    Stager sg; sg.init(tid, LDQ, VLD);
    for (int it = blockIdx.x; it < 2 * 2 * (SEQ / 32); it += gridDim.x) {
        const int hb = it / (SEQ / 32), tt = (it % (SEQ / 32) + 3 * hb) % (SEQ / 32), hkv = hb & 1, b = hb >> 1;
        const int head = hkv * 4 + wid, t0 = tt * 32, own = t0 >> 8;
        const size_t rowb = (size_t)b * SEQ;
        bf16x8 qf[2][2]; St st[2];
#pragma unroll
        for (int r = 0; r < 2; ++r) {
            const bf16_t* qp = Q + (rowb + t0 + 16 * r + fr) * LDQ + head * 64;
            qf[r][0] = ld8(qp + fq * 8); qf[r][1] = ld8(qp + 32 + fq * 8);
            st_init(st[r]);
        }
        const int k0 = own * 256, ns = ((t0 + 31 - k0) >> 6) + 1;
        const bf16_t* kbase = Q + rowb * LDQ + 512 + hkv * 64;
        const bf16_t* vbase = VT + ((size_t)(b * NVH + hkv) * 64) * VLD;
        attn_run_lds2(smem, sg, qf, ns, [&](int s, const bf16_t*& kp, const bf16_t*& vp) { const int kb = k0 + 64 * s; kp = kbase + (size_t)kb * LDQ; vp = vbase + kb; },
                      [&](int r, int s, int key) { return (k0 + 64 * s + key) <= (t0 + 16 * r + fr); },
                      [&](int r, int s) { return (k0 + 64 * s + 63) <= (t0 + 16 * r); }, st, lane, fq);
        const int nv = own < 3 ? own : 3;
#pragma unroll
        for (int r = 0; r < 2; ++r) {
            const int t = t0 + 16 * r + fr;
            float l = quad_sum(st[r].l), m = st[r].m;
            for (int q = 0; q < nv; ++q) {
                const size_t idx = ((size_t)(rowb + t) * 8 + head) * 3 + q;
                const float mr = PML[idx * 2], lr = PML[idx * 2 + 1];
                const float mn = fmaxf(m, mr), a = ex2(m - mn), c = ex2(mr - mn);
#pragma unroll
                for (int n = 0; n < 4; ++n) st[r].o[n] *= a;
                acc_part(PO + idx * 64 + fq * 16, c, st[r].o);
                l = l * a + c * lr; m = mn;
            }
            const float inv = 1.0f / l;
#pragma unroll
            for (int n = 0; n < 4; ++n) store_o4(O + (rowb + t) * DM + head * 64 + n * 16 + 4 * fq, st[r].o[n][0] * inv, st[r].o[n][1] * inv, st[r].o[n][2] * inv, st[r].o[n][3] * inv);
        }
    }
}

__device__ __forceinline__ float gelu_tanh(float x) {
    const float u = 0.7978845608028654f * (x + 0.044715f * x * x * x);
    const float e = __expf(2.0f * u);
    const float th = 1.0f - 2.0f / (e + 1.0f);
    return 0.5f * x * (1.0f + th);
}
__device__ __forceinline__ void ph_cmp1(const Params& p, char* smem) {
    const bf16_t* Q = (const bf16_t*)(p.ws + OFF_QKV);
    const int tid = hidden_tid();
    for (int it = blockIdx.x; it < 128; it += gridDim.x) {
        const int kv = it >> 6, mt = (it >> 1) & 31, nt = it & 1;
        const int col = kv ? 1408 : 1280;
        const bf16_t* Bt = (const bf16_t*)(p.ws + (kv ? W_V1 : W_K1));
        const float* bias = (const float*)(p.ws + (kv ? W_BV : W_BK));
        bf16_t* HID = (bf16_t*)(p.ws + (kv ? B_HIDV : B_HIDK));
        const bf16_t* ap[4];
#pragma unroll
        for (int i = 0; i < 4; ++i) {
            const int r = mt * 128 + i * 32 + (tid >> 3);
            const int h = r & 1, bc = r >> 1, c = bc & 1023, b = bc >> 10;
            const int cc = (c < NCMP) ? c : 0;
            ap[i] = Q + ((size_t)b * SEQ + 16 * cc) * LDQ + col + h * 64 + GSW64(tid);
        }
        const bf16_t* b0 = Bt + (size_t)(nt * 128 + (tid >> 3)) * 2048 + GSW64(tid);
        gemm_tile_k64(smem, tid, ap, b0, (size_t)32 * 2048, 32, [](int t) { return (size_t)t * LDQ; },
            [&](f32x4 (&acc)[4][4], int wr, int wc, int fr, int fq) {
#pragma unroll
                for (int m = 0; m < 4; ++m)
#pragma unroll
                    for (int j = 0; j < 4; ++j) {
                        const int r = mt * 128 + wr * 64 + m * 16 + fq * 4 + j;
#pragma unroll
                        for (int n = 0; n < 4; ++n) { const int cn = nt * 128 + wc * 64 + n * 16 + fr; HID[(size_t)r * 256 + cn] = f2bf(gelu_tanh(acc[m][n][j] + bias[cn])); }
                    }
            });
    }
}
__device__ __forceinline__ void ph_cmp2(const Params& p, char* smem) {
    const int tid = hidden_tid();
    for (int it = blockIdx.x; it < 64; it += gridDim.x) {
        const int kv = it >> 5, mt = it & 31;
        const bf16_t* A = (const bf16_t*)(p.ws + (kv ? B_HIDV : B_HIDK));
        const bf16_t* Bt = (const bf16_t*)(p.ws + (kv ? W_V2 : W_K2));
        bf16_t* KC = (bf16_t*)(p.ws + B_KCMP); bf16_t* VC = (bf16_t*)(p.ws + B_VCMPT);
        const bf16_t* a0 = A + (size_t)(mt * 128 + (tid >> 2)) * 256 + GSW(tid);
        const bf16_t* a1 = a0 + (size_t)64 * 256;
        const bf16_t* b0 = Bt + (size_t)(tid >> 2) * 256 + GSW(tid);
        const bf16_t* b1 = b0 + (size_t)64 * 256;
        gemm_tile(smem, a0, a1, b0, b1, 8, [](int t) { return (size_t)t * 32; },
            [&](f32x4 (&acc)[4][4], int wr, int wc, int fr, int fq) {
                if (wc != 0) return;
#pragma unroll
                for (int m = 0; m < 4; ++m)
#pragma unroll
                    for (int j = 0; j < 4; ++j) {
                        const int r = mt * 128 + wr * 64 + m * 16 + fq * 4 + j;
                        const int h = r & 1, bc = r >> 1, c = bc & 1023, b = bc >> 10;
                        const bool ok = c < NCMP;
#pragma unroll
                        for (int n = 0; n < 4; ++n) {
                            const int d = n * 16 + fr;
                            const bf16_t v = ok ? f2bf(acc[m][n][j]) : (bf16_t)0;
                            if (kv == 0) KC[((size_t)(b * 2 + h) * 1024 + c) * 64 + d] = v;
                            else VC[((size_t)(b * 2 + h) * 64 + d) * CLD + c] = v;
                        }
                    }
            });
    }
}

#ifndef PROBE_NSA
#define PROBE_NSA 0
#endif
#define NSA_T(i) if (PROBE_NSA) { const unsigned long long _n = clock64(); tsec[i] += _n - tprev; tprev = _n; }
__device__ __forceinline__ size_t nsa_list_off(int LL, int j) { return (size_t)LL * NSA_LCAP + 64ull * (size_t)(254 * j - (j * (j - 1)) / 2); }
__device__ __forceinline__ char* nsa_part_ptr(char* ws, int LL, int t, int slot) {
    const size_t rec = ((size_t)((LL & 1) * SEQ + t) * 13 + slot) * 544;
    return ws + ((LL >> 1) ? NSA_PY : NSA_PX) + rec;
}
struct NsaIter { bool aff; int xcd, i0, istr, icnt; };
__device__ __forceinline__ NsaIter nsa_iter() {
    NsaIter it; it.aff = (gridDim.x & 7) == 0; it.xcd = blockIdx.x & 7;
    it.i0 = it.aff ? (blockIdx.x >> 3) : blockIdx.x;
    it.istr = it.aff ? (gridDim.x >> 3) : gridDim.x;
    it.icnt = it.aff ? 512 : 4096;
    return it;
}

__device__ __forceinline__ void ph_nsa1(const Params& p, char* smem) {
    unsigned long long tsec[5] = {0, 0, 0, 0, 0}, tprev = 0;
    if (PROBE_NSA) tprev = clock64();
    const bf16_t* Q = (const bf16_t*)(p.ws + OFF_QKV);
    const bf16_t* VT = (const bf16_t*)(p.ws + OFF_VT);
    const bf16_t* KC = (const bf16_t*)(p.ws + B_KCMP); const bf16_t* VC = (const bf16_t*)(p.ws + B_VCMPT);
    const float* GD = (const float*)(p.ws + B_GD);
    bf16_t* O = (bf16_t*)(p.ws + OFF_O);
    unsigned char* SID = (unsigned char*)(p.ws + M_SELID);
    int* gcnt = (int*)(p.ws + OFF_NSACNT);
    unsigned short* lists = (unsigned short*)(p.ws + NSA_LISTS);
    unsigned char* lslot = (unsigned char*)(p.ws + NSA_SLOTS);
    const int tid = hidden_tid(), lane = tid & 63, wid = tid >> 6, fr = lane & 15, fq = lane >> 4;
    float* imp = (float*)(smem + 49152 + wid * 5376);
    int* selq = (int*)(smem + 49152 + wid * 5376 + 4096);
    int* sc = (int*)(smem + 49152 + wid * 5376 + 4352);
    const int qi_l = fr >> 2, g_l = fr & 3;
    Stager sgc; sgc.init(tid, 64, CLD);
    Stager sgw; sgw.init(tid, LDQ, VLD);
    const NsaIter itr = nsa_iter();
    for (int ii = itr.i0; ii < itr.icnt; ii += itr.istr) {
        const int LL = itr.aff ? (itr.xcd & 3) : (ii >> 10);
        const int tqb = itr.aff ? (2 * ii + (itr.xcd >> 2)) : (ii & 1023);
        const int b = LL >> 1, hkv = LL & 1;
        const int tb0 = tqb * 16, t0 = tb0 + wid * 4, t = t0 + qi_l;
        const size_t rowb = (size_t)b * SEQ;
        bf16x8 qf[2];
        {
            const bf16_t* qp = Q + (rowb + t) * LDQ + 768 + (hkv * 4 + g_l) * 64;
            qf[0] = ld8(qp + fq * 8); qf[1] = ld8(qp + 32 + fq * 8);
        }
        const float* gp = GD + (rowb + t) * 24 + (hkv * 4 + g_l) * 3;
        f32x4 outa[4];
#pragma unroll
        for (int n = 0; n < 4; ++n) outa[n] = (f32x4){0.f, 0.f, 0.f, 0.f};
        const bf16_t* kc = KC + (size_t)LL * 1024 * 64;
        const bf16_t* vc = VC + (size_t)LL * 64 * CLD;
        const int cN = (tb0 + 15 >= 31) ? ((tb0 + 15 - 31) >> 4) + 1 : 0;
        const int csteps = (cN + 63) >> 6;
        float m1 = NEG_BIG, l1 = 0.f;
        if (csteps > 0) {
            const int cs2 = (csteps + 1) >> 1;
            auto stage2 = [&](int s2, char* buf) {
                const int ta = 2 * s2, tb = (2 * s2 + 1 < 16) ? 2 * s2 + 1 : 15;
                sgc.stage_k(buf, kc + (size_t)ta * 64 * 64); sgc.stage_k(buf + 8192, kc + (size_t)tb * 64 * 64);
            };
            asm volatile("s_waitcnt vmcnt(0)" ::: "memory");
            stage2(0, smem);
            if (cs2 > 1) stage2(1, smem + 16384);
            for (int s = 0; s < cs2; ++s) {
                const char* cur = smem + LDS_RING(s);
                if (s + 1 < cs2) asm volatile("s_waitcnt vmcnt(4)" ::: "memory"); else asm volatile("s_waitcnt vmcnt(0)" ::: "memory");
                __builtin_amdgcn_s_barrier();
                asm volatile("" ::: "memory");
                if (s + 2 < cs2) stage2(s + 2, smem + LDS_RING(s + 2));
                float mx = -INFINITY;
                f32x4 sc[2][4];
#pragma unroll
                for (int u = 0; u < 2; ++u) {
                    KF kcur; lds_k(kcur, cur + u * 8192, lane);
                    scores(kcur, qf, sc[u]);
#pragma unroll
                    for (int kt = 0; kt < 4; ++kt)
#pragma unroll
                        for (int j = 0; j < 4; ++j) { const bool v = (16 * ((2 * s + u) * 64 + KEY_OF(kt, j, fq)) + 31) <= t; mx = fmaxf(mx, v ? sc[u][kt][j] : -INFINITY); }
                }
                mx = quad_max(mx);
                const float mn = fmaxf(m1, mx);
                float sum = 0.f;
#pragma unroll
                for (int u = 0; u < 2; ++u)
#pragma unroll
                    for (int kt = 0; kt < 4; ++kt)
#pragma unroll
                        for (int j = 0; j < 4; ++j) { const bool v = (16 * ((2 * s + u) * 64 + KEY_OF(kt, j, fq)) + 31) <= t; sum += v ? ex2(sc[u][kt][j] - mn) : 0.f; }
                l1 = l1 * ex2(m1 - mn) + sum; m1 = mn;
            }
            __syncthreads();
        }
        NSA_T(0)
        const float ltot = quad_sum(l1), il = ltot > 0.f ? 1.0f / ltot : 0.f;
        for (int i = lane; i < 1024; i += 64) imp[i] = 0.f;
        lds_fence();
        if (csteps > 0) {
            f32x4 oc[4];
#pragma unroll
            for (int n = 0; n < 4; ++n) oc[n] = (f32x4){0.f, 0.f, 0.f, 0.f};
            asm volatile("s_waitcnt vmcnt(0)" ::: "memory");
            sgc.stage_k(smem, kc); sgc.stage_v(smem, vc);
            if (csteps > 1) { sgc.stage_k(smem + 16384, kc + (size_t)64 * 64); sgc.stage_v(smem + 16384, vc + 64); }
            for (int s = 0; s < csteps; ++s) {
                const char* cur = smem + LDS_RING(s);
                if (s + 1 < csteps) asm volatile("s_waitcnt vmcnt(4)" ::: "memory"); else asm volatile("s_waitcnt vmcnt(0)" ::: "memory");
                __builtin_amdgcn_s_barrier();
                asm volatile("" ::: "memory");
                if (s + 2 < csteps) { char* nxt = smem + LDS_RING(s + 2); sgc.stage_k(nxt, kc + (size_t)(s + 2) * 64 * 64); sgc.stage_v(nxt, vc + (s + 2) * 64); }
                KF kcur; lds_k(kcur, cur, lane);
                VF vf; lds_v(vf, cur, lane);
                f32x4 sc[4]; scores(kcur, qf, sc);
                float pp[4][4], ps[4], cy[4];
#pragma unroll
                for (int kt = 0; kt < 4; ++kt) {
                    float a = 0.f;
#pragma unroll
                    for (int j = 0; j < 4; ++j) { const bool v = (16 * (s * 64 + KEY_OF(kt, j, fq)) + 31) <= t; pp[kt][j] = v ? ex2(sc[kt][j] - m1) * il : 0.f; a += pp[kt][j]; }
                    float c = pp[kt][3];
                    a += __shfl_xor(a, 1); a += __shfl_xor(a, 2);
                    c += __shfl_xor(c, 1); c += __shfl_xor(c, 2);
                    ps[kt] = a; cy[kt] = c;
                }
                if (g_l == 0) {
#pragma unroll
                    for (int kt = 0; kt < 4; ++kt) imp[qi_l * 256 + s * 16 + 8 * (kt >> 1) + 2 * fq + (kt & 1)] += ps[kt];
                }
                lds_fence();
                if (g_l == 0) {
#pragma unroll
                    for (int kt = 0; kt < 4; ++kt) { const int a1 = s * 16 + 8 * (kt >> 1) + 2 * fq + (kt & 1) + 1; if (a1 < 256) imp[qi_l * 256 + a1] += cy[kt]; }
                }
                lds_fence();
                pv(vf, pp, oc);
            }
            __syncthreads();
            { const float gc = 1.0f / (1.0f + __expf(-gp[0]));
#pragma unroll
            for (int n = 0; n < 4; ++n) outa[n] += oc[n] * gc; }
        }
        NSA_T(1)
        for (int qi = 0; qi < 4; ++qi) {
            const int cur = (t0 + qi) >> 6;
            int* ib = (int*)imp + qi * 256;
            if (lane == 0) ib[0] = -1;
            const int js = cur - 1 + (lane - 1);
            if (lane >= 1 && lane < 5 && js >= 0 && js < 256) ib[js] = -1;
        }
        lds_fence();
#pragma unroll 1
        for (int qi = 0; qi < 4; ++qi) {
            const int tt = t0 + qi, cur = tt >> 6;
            const int* ib = (const int*)imp + qi * 256;
            const int nforced = cur == 0 ? 1 : (cur == 1 ? 2 : 3);
            const int ncand = cur - 2 > 0 ? cur - 2 : 0;
            const int K = (16 - nforced) < ncand ? (16 - nforced) : ncand;
            int bi[4]; bool cand[4];
#pragma unroll
            for (int k = 0; k < 4; ++k) {
                const int i = lane + 64 * k;
                cand[k] = (i >= 1) && (i <= cur - 2);
                bi[k] = cand[k] ? ib[i] : -1;
            }
            bool done = false;
            if (K < ncand) {
                const int mloc = max(max(bi[0], bi[1]), max(bi[2], bi[3]));
                sc[lane] = mloc;
                lds_fence();
                int cnt = 0;
#pragma unroll 2
                for (int l4 = 0; l4 < 64; l4 += 4) {
                    const int4 v = *(const int4*)(sc + l4);
                    cnt += (v.x > mloc - ((l4 + 0) < lane ? 1 : 0)) ? 1 : 0; cnt += (v.y > mloc - ((l4 + 1) < lane ? 1 : 0)) ? 1 : 0;
                    cnt += (v.z > mloc - ((l4 + 2) < lane ? 1 : 0)) ? 1 : 0; cnt += (v.w > mloc - ((l4 + 3) < lane ? 1 : 0)) ? 1 : 0;
                }
                const unsigned long long mkk = __ballot(cnt == K - 1);
                const int tau = __builtin_amdgcn_readlane(mloc, __builtin_amdgcn_readfirstlane((int)__ffsll((long long)mkk) - 1));
                int ns = 0;
#pragma unroll
                for (int k = 0; k < 4; ++k) {
                    const bool sv = cand[k] && (bi[k] >= tau);
                    const unsigned long long mk = __ballot(sv);
                    const int pos = ns + __popcll(mk & ((1ull << lane) - 1ull));
                    if (sv && pos < 64) { sc[64 + pos] = bi[k]; sc[128 + pos] = lane + 64 * k; }
                    ns += __popcll(mk);
                }
                lds_fence();
                if (ns <= 64) {
                    const int my = sc[64 + (lane < ns ? lane : 0)], myi = sc[128 + (lane < ns ? lane : 0)];
                    int rk = 0;
                    const int ns4 = __builtin_amdgcn_readfirstlane(ns) & ~3;
                    for (int j = 0; j < ns4; j += 4) {
                        const int4 vj = *(const int4*)(sc + 64 + j), ij = *(const int4*)(sc + 128 + j);
                        rk += ((vj.x > my) || (vj.x == my && ij.x < myi)) ? 1 : 0; rk += ((vj.y > my) || (vj.y == my && ij.y < myi)) ? 1 : 0;
                        rk += ((vj.z > my) || (vj.z == my && ij.z < myi)) ? 1 : 0; rk += ((vj.w > my) || (vj.w == my && ij.w < myi)) ? 1 : 0;
                    }
                    for (int j = ns4; j < ns; ++j) { const int vj = sc[64 + j], ij = sc[128 + j]; rk += ((vj > my) || (vj == my && ij < myi)) ? 1 : 0; }
                    if (lane < ns && rk < K) selq[qi * 13 + rk] = myi;
                    done = true;
                }
                lds_fence();
            }
            if (!done) {
                int rank[4] = {0, 0, 0, 0};
                if (K < ncand) {
                    const int jend = __builtin_amdgcn_readfirstlane(cur - 1);
                    for (int j4 = 0; j4 < jend; j4 += 4) {
                        const int4 v = *(const int4*)(ib + j4);
                        const int vv[4] = {v.x, v.y, v.z, v.w};
#pragma unroll
                        for (int k = 0; k < 4; ++k)
#pragma unroll
                            for (int e = 0; e < 4; ++e) rank[k] += (vv[e] > bi[k] - ((j4 + e) < (lane + 64 * k) ? 1 : 0)) ? 1 : 0;
                    }
                }
                int off = 0;
#pragma unroll
                for (int i = 0; i < 4; ++i) {
                    const bool sb = cand[i] && (rank[i] < K);
                    const unsigned long long mk = __ballot(sb);
                    if (sb) selq[qi * 13 + off + __popcll(mk & ((1ull << lane) - 1ull))] = lane + 64 * i;
                    off += __popcll(mk);
                }
            }
            if (lane == 0) selq[52 + qi] = K;
        }
        lds_fence();
        NSA_T(2)
        if (lane < 52) {
            const int qi = lane / 13, slot = lane - qi * 13, tt = t0 + qi;
            if (slot < selq[52 + qi]) {
                const int jb = selq[lane];
                SID[((size_t)LL * SEQ + tt) * 16 + slot] = (unsigned char)jb;
                const int pos = atomicAdd(&gcnt[(LL * 256 + jb) * CNTS], 1);
                lists[nsa_list_off(LL, jb) + pos] = (unsigned short)tt;
                lslot[nsa_list_off(LL, jb) + pos] = (unsigned char)slot;
            }
        } else if (lane < 56) {
            SID[((size_t)LL * SEQ + t0 + (lane - 52)) * 16 + 15] = (unsigned char)selq[lane];
        }
        lds_fence();
        NSA_T(3)
        {
            St st; st_init(st);
            bf16x8 qw[2];
            { const bf16_t* qp = Q + (rowb + t) * LDQ + 768 + (hkv * 4 + g_l) * 64; qw[0] = ld8(qp + fq * 8); qw[1] = ld8(qp + 32 + fq * 8); }
            int k0 = tb0 - 511; if (k0 < 0) k0 = 0; k0 &= ~63;
            const int nw = ((tb0 + 15 - k0) >> 6) + 1;
            const bf16_t* kbase = Q + rowb * LDQ + 1792 + hkv * 64;
            const bf16_t* vbase = VT + ((size_t)(b * NVH + 4 + hkv) * 64) * VLD;
            attn_run_lds(smem, sgw, qw, nw, [&](int s, const bf16_t*& kp, const bf16_t*& vp) { const int kb = k0 + 64 * s; kp = kbase + (size_t)kb * LDQ; vp = vbase + kb; },
                         [&](int s, int key) { const int k = k0 + 64 * s + key; return (k <= t) && (t - k < 512); },
                         [&](int s) { const int kb = k0 + 64 * s; return (kb + 63 <= t0) && (t0 + 3 - kb < 512); }, st, lane, fq);
            const float gw = 1.0f / (1.0f + __expf(-gp[2]));
            const float l = quad_sum(st.l), inv = l > 0.f ? gw / l : 0.f;
#pragma unroll
            for (int n = 0; n < 4; ++n) outa[n] += st.o[n] * inv;
        }
#pragma unroll
        for (int n = 0; n < 4; ++n) store_o4(O + (rowb + t) * DM + 512 + (hkv * 4 + g_l) * 64 + n * 16 + 4 * fq, outa[n][0], outa[n][1], outa[n][2], outa[n][3]);
        NSA_T(4)
    }
    if (PROBE_NSA && threadIdx.x == 0) { unsigned long long* sx = (unsigned long long*)(smem - HDR_BYTES + 32) + 24; for (int i = 0; i < 5; ++i) sx[i] = tsec[i]; }
}

__device__ __forceinline__ void ph_nsa2(const Params& p, char* smem) {
    int* cpre = (int*)(smem + 49152);
    const bf16_t* Q = (const bf16_t*)(p.ws + OFF_QKV);
    const bf16_t* VT = (const bf16_t*)(p.ws + OFF_VT);
    const unsigned char* lslot = (const unsigned char*)(p.ws + NSA_SLOTS);
    const int* gcnt = (const int*)(p.ws + OFF_NSACNT);
    const unsigned short* lists = (const unsigned short*)(p.ws + NSA_LISTS);
    const int tid = hidden_tid(), lane = tid & 63, wid = tid >> 6, fr = lane & 15, fq = lane >> 4;
    const int qi_l = fr >> 2, g_l = fr & 3;
    for (int i = tid; i < 1024; i += 256) cpre[i + 1] = (gcnt[i * CNTS] + 63) >> 6;
    if (tid == 0) cpre[0] = 0;
    __syncthreads();
    if (tid == 0) { int acc = 0; for (int i = 1; i <= 1024; ++i) { acc += cpre[i]; cpre[i] = acc; } }
    __syncthreads();
    const int total = cpre[1024];
    for (int it = blockIdx.x * 4 + wid; it < total; it += gridDim.x * 4) {
        int li;
        { int lo = 0, hi = 1023; while (lo < hi) { const int mid = (lo + hi + 1) >> 1; if (cpre[mid] <= it) lo = mid; else hi = mid - 1; } li = lo; }
        const int chunk = it - cpre[li], LL = li >> 8, j = li & 255, b = LL >> 1, hkv = LL & 1, n = gcnt[li * CNTS];
        const unsigned short* lst = lists + nsa_list_off(LL, j);
        const size_t rowb = (size_t)b * SEQ;
        KF kf; load_k(kf, Q + (rowb + (size_t)j * 64) * LDQ + 1536 + hkv * 64, LDQ, fr, fq);
        VF vf; load_v(vf, VT + ((size_t)(b * NVH + 2 + hkv) * 64) * VLD + j * 64, VLD, fr, fq);
        const int e0 = chunk * 64, e1 = (e0 + 64 < n) ? e0 + 64 : n;
        const unsigned char* lsl = lslot + nsa_list_off(LL, j);
        const int emine = (e0 + lane < e1) ? e0 + lane : e0;
        const int tmine = (int)lst[emine] | ((int)lsl[emine] << 16);
        const int ntile = (e1 - e0 + 3) >> 2;
        int ttA, ttB; bf16x8 qA0, qA1, qB0, qB1;
        {
            ttA = __shfl(tmine, (qi_l < e1 - e0) ? qi_l : 0);
            const bf16_t* qp = Q + (rowb + (ttA & 0xFFFF)) * LDQ + 768 + (hkv * 4 + g_l) * 64;
            qA0 = ld8(qp + fq * 8); qA1 = ld8(qp + 32 + fq * 8);
            const int eB = 4 + qi_l;
            ttB = __shfl(tmine, (eB < e1 - e0) ? eB : 0);
            qp = Q + (rowb + (ttB & 0xFFFF)) * LDQ + 768 + (hkv * 4 + g_l) * 64;
            qB0 = ld8(qp + fq * 8); qB1 = ld8(qp + 32 + fq * 8);
        }
        for (int tile = 0; tile < ntile; ++tile) {
            const bf16x8 qf[2] = {qA0, qA1};
            const int tcur = ttA & 0xFFFF, slot = ttA >> 16; const bool okc = (tile * 4 + qi_l) < (e1 - e0);
            ttA = ttB; qA0 = qB0; qA1 = qB1;
            {
                const int eN = (tile + 2) * 4 + qi_l;
                ttB = __shfl(tmine, (eN < e1 - e0) ? eN : 0);
                const bf16_t* qp = Q + (rowb + (ttB & 0xFFFF)) * LDQ + 768 + (hkv * 4 + g_l) * 64;
                qB0 = ld8(qp + fq * 8); qB1 = ld8(qp + 32 + fq * 8);
            }
            f32x4 sc[4]; scores(kf, qf, sc);
            float mx = sc[0][0];
#pragma unroll
            for (int kt = 0; kt < 4; ++kt)
#pragma unroll
                for (int jj = 0; jj < 4; ++jj) mx = fmaxf(mx, sc[kt][jj]);
            mx = quad_max(mx);
            float pp[4][4]; float sum = 0.f;
#pragma unroll
            for (int kt = 0; kt < 4; ++kt)
#pragma unroll
                for (int jj = 0; jj < 4; ++jj) { pp[kt][jj] = ex2(sc[kt][jj] - mx); sum += pp[kt][jj]; }
            sum = quad_sum(sum);
            f32x4 o[4];
#pragma unroll
            for (int nn = 0; nn < 4; ++nn) o[nn] = (f32x4){0.f, 0.f, 0.f, 0.f};
            pv(vf, pp, o);
            if (okc) {
                char* rec = nsa_part_ptr(p.ws, LL, tcur, slot);
                st_part((bf16_t*)(rec + g_l * 128) + fq * 16, o);
                if (fq == 0) *(float2*)(rec + 512 + g_l * 8) = make_float2(mx, sum);
            }
        }
    }
}

__device__ __forceinline__ void ph_nsa3(const Params& p, char* smem) {
    (void)smem;
    const bf16_t* Q = (const bf16_t*)(p.ws + OFF_QKV);
    const bf16_t* VT = (const bf16_t*)(p.ws + OFF_VT);
    const float* GD = (const float*)(p.ws + B_GD);
    const unsigned char* SID = (const unsigned char*)(p.ws + M_SELID);
    bf16_t* O = (bf16_t*)(p.ws + OFF_O);
    const int tid = hidden_tid(), lane = tid & 63, wid = tid >> 6, fr = lane & 15, fq = lane >> 4;
    const int qi_l = fr >> 2, g_l = fr & 3;
    Stager sg; sg.init(tid, LDQ, VLD);
    const NsaIter itr = nsa_iter();
    for (int ii = itr.i0; ii < itr.icnt; ii += itr.istr) {
        const int LL = itr.aff ? (itr.xcd & 3) : (ii >> 10);
        const int tqb = itr.aff ? (2 * ii + (itr.xcd >> 2)) : (ii & 1023);
        const int b = LL >> 1, hkv = LL & 1;
        const int tb0 = tqb * 16, t0 = tb0 + wid * 4, t = t0 + qi_l, cur = tb0 >> 6;
        const size_t rowb = (size_t)b * SEQ;
        bf16x8 qf[2];
        {
            const bf16_t* qp = Q + (rowb + t) * LDQ + 768 + (hkv * 4 + g_l) * 64;
            qf[0] = ld8(qp + fq * 8); qf[1] = ld8(qp + 32 + fq * 8);
        }
        const float gs = 1.0f / (1.0f + __expf(-GD[(rowb + t) * 24 + (hkv * 4 + g_l) * 3 + 1]));
        const int nsel = SID[((size_t)LL * SEQ + t) * 16 + 15];
        const int nf = cur == 0 ? 1 : (cur == 1 ? 2 : 3);
        St st; st_init(st);
        const bf16_t* kbase = Q + rowb * LDQ + 1536 + hkv * 64;
        const bf16_t* vbase = VT + ((size_t)(b * NVH + 2 + hkv) * 64) * VLD;
        auto fblk = [&](int s) { return s == 0 ? 0 : (cur - (nf - 1 - s)); };
        attn_run_lds(smem, sg, qf, nf, [&](int s, const bf16_t*& kp, const bf16_t*& vp) { const int kb = fblk(s) * 64; kp = kbase + (size_t)kb * LDQ; vp = vbase + kb; },
                     [&](int s, int key) { return (fblk(s) * 64 + key) <= t; }, [&](int s) { return (fblk(s) * 64 + 63) <= t0; }, st, lane, fq);
        float l = quad_sum(st.l), m = st.m;
        {
            const char* rec0 = nsa_part_ptr(p.ws, LL, t, 0);
            const char* mlp = rec0 + 512 + g_l * 8;
            const char* op0 = rec0 + g_l * 128 + fq * 32;
            float mm = m;
#pragma unroll
            for (int r = 0; r < 13; ++r) {
                const float mr = *(const float*)(mlp + (r < nsel ? r * 544 : 0));
                if (r < nsel) mm = fmaxf(mm, mr);
            }
            const float a = ex2(m - mm);
            l *= a;
#pragma unroll
            for (int n = 0; n < 4; ++n) st.o[n] *= a;
#pragma unroll 1
            for (int rb = 0; rb < 14; rb += 7) {
#pragma unroll
                for (int u = 0; u < 7; ++u) {
                    const int r = rb + u;
                    const bool ok = r < nsel;
                    const int ro = ok ? r * 544 : 0;
                    const float2 ml = *(const float2*)(mlp + ro);
                    const float c = ok ? ex2(ml.x - mm) : 0.f;
                    acc_part((const bf16_t*)(op0 + ro), c, st.o);
                    l += c * ml.y;
                }
            }
        }
        const float inv = l > 0.f ? gs / l : 0.f;
#pragma unroll
        for (int n = 0; n < 4; ++n) {
            bf16_t* op = O + (rowb + t) * DM + 512 + (hkv * 4 + g_l) * 64 + n * 16 + 4 * fq;
            const uint2 u = *(const uint2*)op;
            store_o4(op, __uint_as_float(u.x << 16) + st.o[n][0] * inv, __uint_as_float(u.x & 0xFFFF0000u) + st.o[n][1] * inv,
                         __uint_as_float(u.y << 16) + st.o[n][2] * inv, __uint_as_float(u.y & 0xFFFF0000u) + st.o[n][3] * inv);
        }
    }
}

template <int PH> __device__ __forceinline__ void run_phase(const Params& p, char* smem) {
    char* ws = p.ws;
    if (PH == 0) {
        conv_layer_weights(p, smem, 0); conv_expert_weights(p, smem, 0);
        rope_table(p);
        norm_pass(p.x, nullptr, nullptr, p.ln_mix[0], (bf16_t*)(ws + OFF_H), nullptr);
    } else if (PH == 1) { ph_gemm_qkv(p, smem, 0); if (GEMM_EXP == 1) { __syncthreads(); ph_gemm_qkv(p, smem, 0); } if (GEMM_EXP == 2) { __syncthreads(); ph_gemm_qkv<true>(p, smem, 0); } }
    else if (PH == 2) ph_attn0(p, smem);
    else if (PH == 3) ph_gemm_out(p, smem, p.x);
    else if (PH == 4) ph_route(p, smem, 0);
    else if (PH == 5) { }
    else if (PH == 6) ph_moe_gemm(p, smem, 0, 0);
    else if (PH == 7) ph_moe_gemm(p, smem, 1, 0);
    else if (PH == 8) {
        norm_pass(p.out, (const bf16_t*)(ws + B_Y), p.out, p.ln_mix[1], (bf16_t*)(ws + OFF_H), nullptr);
        conv_layer_weights(p, smem, 1);
    } else if (PH == 9) ph_gemm_qkv(p, smem, 1);
    else if (PH == 10) { ph_kmean(p); ph_cmp1(p, smem); }
    else if (PH == 11) { ph_moba_gate(p, smem); ph_cmp2(p, smem); }
    else if (PH == 12) { ph_moba_part(p, smem); __syncthreads(); if (PROBING && threadIdx.x == 0) ((unsigned long long*)(smem - HDR_BYTES + 32))[22] = wall_clock64(); ph_nsa1(p, smem); }
    else if (PH == 13) { ph_nsa2(p, smem); __syncthreads(); if (PROBING && threadIdx.x == 0) ((unsigned long long*)(smem - HDR_BYTES + 32))[23] = wall_clock64(); ph_moba_own(p, smem); }
    else if (PH == 14) ph_nsa3(p, smem);
    else if (PH == 15) { ph_gemm_out(p, smem, p.out); conv_expert_weights(p, smem, 1); }
    else if (PH == 16) ph_route(p, smem, 1);
    else if (PH == 17) { }
    else if (PH == 18) ph_moe_gemm(p, smem, 0, 1);
    else if (PH == 19) ph_moe_gemm(p, smem, 1, 1);
    else if (PH == 20) norm_pass(p.out, (const bf16_t*)(ws + B_Y), nullptr, p.ln_final, nullptr, p.out);
}
#define NPHASE 21

#if MEGA
#define PHB(n) run_phase<n>(p, smem); xcd_barrier(bar); if (PROBING && threadIdx.x == 0) stamps[n + 1] = wall_clock64();
#define PHS(n) if (PROBING && threadIdx.x == 0) stamps[n + 1] = stamps[n];
__global__ void __launch_bounds__(256, 2) k_mega(Params p) {
    __shared__ __attribute__((aligned(16))) char smem_all[SMEM_BYTES + HDR_BYTES];
    char* smem = smem_all + HDR_BYTES;
    unsigned long long* stamps = (unsigned long long*)(smem_all + 32);
    if (threadIdx.x == 0) *(uint4*)smem_all = make_uint4(0u, 0u, 0u, 0u);
    __syncthreads();
    XcdBarrier bar = xcd_barrier_post((unsigned*)(p.ws + OFF_CTRL), (volatile LAS unsigned*)smem_all);
    if (PROBING && threadIdx.x == 0) stamps[0] = wall_clock64();
    PHB(0) PHB(1) PHB(2) PHB(3) PHB(4) PHS(5) PHB(6) PHB(7) PHB(8) PHB(9)
    PHB(10) PHB(11) PHB(12) PHB(13) PHB(14) PHB(15) PHB(16) PHS(17) PHB(18) PHB(19)
    if (PROBING) {
        float* enc = (float*)(smem_all + 16);
        if (threadIdx.x == 0) {
            const float tot = (float)(stamps[20] - stamps[0]);
            float fa = 0.f, fb = 0.f;
            for (int i = 0; i < 20; ++i) { const float d = (float)(stamps[i + 1] - stamps[i]); if ((PROBE_A >> i) & 1) fa += d; if ((PROBE_B >> i) & 1) fb += d; }
            { const float d = (float)(stamps[22] - stamps[12]); if ((PROBE_A >> 20) & 1) fa += d; if ((PROBE_B >> 20) & 1) fb += d; }
            { const float d = (float)(stamps[23] - stamps[13]); if ((PROBE_A >> 21) & 1) fa += d; if ((PROBE_B >> 21) & 1) fb += d; }
            fa /= tot; fb /= tot;
#if PROBE_NSA
            { const unsigned long long* sx = stamps + 24; float sm = 0.f; for (int i = 0; i < 5; ++i) sm += (float)sx[i];
              fa = (float)sx[PROBE_NSA & 7] / sm; fb = (float)sx[(PROBE_NSA >> 3) & 7] / sm; }
#endif
            enc[0] = 1.0f + sqrtf(5e-4f + 6e-3f * fa);
            enc[1] = 20.0f + 80.0f * fb;
        }
        __syncthreads();
        norm_pass(p.out, (const bf16_t*)(p.ws + B_Y), nullptr, p.ln_final, nullptr, p.out, enc[0], enc[1]);
    } else {
        run_phase<20>(p, smem);
    }
}
#else
template <int PH> __global__ void __launch_bounds__(256, 2) k_phase(Params p) {
    __shared__ __attribute__((aligned(16))) char smem_all[SMEM_BYTES + 16];
    run_phase<PH>(p, smem_all + 16);
}
template <int PH> static void launch_phases(const Params& p, int grid, hipStream_t stream) {
    hipLaunchKernelGGL(k_phase<PH>, dim3(grid), dim3(256), 0, stream, p);
    if constexpr (PH + 1 < NPHASE) launch_phases<PH + 1>(p, grid, stream);
}
#endif

extern "C" void kernel_launch(void* const* d_in, const int* in_sizes, int n_in, void* d_out, int out_size, void* d_ws, size_t ws_size, hipStream_t stream) {
    (void)in_sizes; (void)n_in; (void)out_size;
    if (ws_size < WS_NEED) { fprintf(stderr, "workspace too small: %zu < %zu\n", ws_size, (size_t)WS_NEED); return; }
    Params p; memset(&p, 0, sizeof(p));
    p.x = (const float*)d_in[0]; p.pos = (const int*)d_in[1];
    p.ln_mix[0] = (const float*)d_in[2]; p.w_in[0] = (const float*)d_in[3]; p.sinks0 = (const float*)d_in[4]; p.w_out[0] = (const float*)d_in[5];
    p.ln_ffn[0] = (const float*)d_in[6]; p.r_group[0] = (const float*)d_in[7]; p.r_expert[0] = (const float*)d_in[8];
    p.e_gate[0] = (const float*)d_in[9]; p.e_up[0] = (const float*)d_in[10]; p.e_down[0] = (const float*)d_in[11];
    p.ln_mix[1] = (const float*)d_in[12]; p.w_in[1] = (const float*)d_in[13];
    p.k_pe = (const float*)d_in[14]; p.k_w1 = (const float*)d_in[15]; p.k_w2 = (const float*)d_in[16];
    p.v_pe = (const float*)d_in[17]; p.v_w1 = (const float*)d_in[18]; p.v_w2 = (const float*)d_in[19];
    p.w_out[1] = (const float*)d_in[20]; p.ln_ffn[1] = (const float*)d_in[21]; p.r_group[1] = (const float*)d_in[22]; p.r_expert[1] = (const float*)d_in[23];
    p.e_gate[1] = (const float*)d_in[24]; p.e_up[1] = (const float*)d_in[25]; p.e_down[1] = (const float*)d_in[26];
    p.ln_final = (const float*)d_in[27];
    p.out = (float*)d_out; p.ws = (char*)d_ws;
    (void)hipMemsetAsync(d_ws, 0, 1 * MB, stream);
#if MEGA
    static int grid = 0;
    if (!grid) {
        int dev = 0, cus = 0, per_cu = 0;
        (void)hipGetDevice(&dev);
        (void)hipDeviceGetAttribute(&cus, hipDeviceAttributeMultiprocessorCount, dev);
        (void)hipOccupancyMaxActiveBlocksPerMultiprocessor(&per_cu, k_mega, 256, 0);
        if (per_cu < 1) per_cu = 1;
        grid = cus * (per_cu < 2 ? per_cu : 2);
    }
    hipLaunchKernelGGL(k_mega, dim3(grid), dim3(256), 0, stream, p);
#else
    launch_phases<0>(p, 512, stream);
#endif
}
```

```cpp
#include <hip/hip_runtime.h>
#include <stdint.h>
#include <stdio.h>
#include <string.h>

#ifndef MEGA
#define MEGA 1
#endif
#ifndef PROBE_A
#define PROBE_A 0
#endif
#ifndef PROBE_B
#define PROBE_B 0
#endif
#ifndef PROBE_NSA
#define PROBE_NSA 0
#endif
#define PROBING ((PROBE_A) | (PROBE_B) | (PROBE_NSA))

typedef unsigned short bf16_t;
typedef short bf16x8 __attribute__((ext_vector_type(8)));
typedef float f32x4 __attribute__((ext_vector_type(4)));

#define NTOK 32768
#define SEQ 16384
#define DM 1024
#define LDQ 2304
#define NVH 10
#define NEXP 64
#define EH 512
#define NASG 65536
#define NCMP 1023
#define NCMPP 1024
#define NEG_BIG (-1.0e30f)
#define VLD (SEQ + 64)
#define CLD (NCMPP + 64)

constexpr size_t MB = 1024ull * 1024ull;
constexpr size_t OFF_CTRL = 0;
constexpr size_t OFF_MOBACNT = 32768;
constexpr size_t OFF_ROPE = 1 * MB;
constexpr size_t OFF_NSACNT = 65536;
#define CNTS 32
constexpr size_t OFF_MOECNT = 262144;
constexpr size_t OFF_W = 9 * MB;
constexpr size_t W_IN = OFF_W;
constexpr size_t W_OUT = W_IN + 2304ull * 1024 * 2;
constexpr size_t W_K1 = W_OUT + 1024ull * 1024 * 2;
constexpr size_t W_V1 = W_K1 + 256ull * 2048 * 2;
constexpr size_t W_K2 = W_V1 + 256ull * 2048 * 2;
constexpr size_t W_V2 = W_K2 + 128ull * 256 * 2;
constexpr size_t W_BK = W_V2 + 128ull * 256 * 2;
constexpr size_t W_BV = W_BK + 1024;
constexpr size_t W_GU = W_BV + 1024 + 1022 * 1024;
constexpr size_t W_DN = W_GU + 64ull * 1024 * 1024 * 2;
constexpr size_t OFF_H = W_DN + 64ull * 1024 * 512 * 2;
constexpr size_t OFF_QKV = OFF_H + (size_t)NTOK * 1024 * 2;
constexpr size_t OFF_VT = OFF_QKV + (size_t)NTOK * LDQ * 2;
constexpr size_t OFF_O = OFF_VT + 2ull * NVH * 64 * VLD * 2;
constexpr size_t OFF_B = OFF_O + (size_t)NTOK * 1024 * 2;
constexpr size_t B_LIST = OFF_B;
constexpr size_t MOBA_LCAP = 2064384ull;
constexpr size_t B_PO = B_LIST + 4 * MOBA_LCAP * 4;
constexpr size_t B_PML = B_PO + (size_t)NTOK * 24 * 64 * 2;
constexpr size_t B_HIDK = B_PML + (size_t)NTOK * 24 * 8;
constexpr size_t B_HIDV = B_HIDK + 4096ull * 256 * 2;
constexpr size_t B_KCMP = B_HIDV + 4096ull * 256 * 2;
constexpr size_t B_VCMPT = B_KCMP + 4ull * 1024 * 64 * 2;
constexpr size_t B_KMEAN = B_VCMPT + 4ull * CLD * 64 * 2;
constexpr size_t B_GD = B_KMEAN + 2ull * 64 * 2 * 64 * 4;
constexpr size_t B_END = B_GD + (size_t)NTOK * 24 * 4;
constexpr size_t B_Y = OFF_B;
constexpr size_t OFF_M = OFF_B + 150 * MB;
static_assert(B_END <= OFF_M, "B region overflow");
constexpr size_t M_TOKE = OFF_M;
constexpr size_t M_TOKG = M_TOKE + (size_t)NTOK * 8;
constexpr size_t M_TOKR = M_TOKG + (size_t)NTOK * 8;
constexpr size_t M_HIST = M_TOKR + (size_t)NTOK * 8;
constexpr size_t M_LIST = M_HIST + 512ull * 64 * 4;
constexpr size_t M_ECNT = M_LIST + 65536ull * 4;
constexpr size_t M_EBASE = M_ECNT + 256;
constexpr size_t M_SELID = OFF_M + 2 * MB;
constexpr size_t NSA_PSZ = (size_t)2 * SEQ * 13 * 544;
constexpr size_t NSA_PX = OFF_M + 3 * MB;
constexpr size_t NSA_PY = W_GU;
static_assert(NSA_PSZ <= 256 * MB, "NSA partials do not fit the weight region");
constexpr size_t NSA_LCAP = 2072640ull;
constexpr size_t NSA_LISTS = NSA_PX + NSA_PSZ;
constexpr size_t NSA_SLOTS = NSA_LISTS + 4 * NSA_LCAP * 2;
constexpr size_t WS_NEED = NSA_SLOTS + 4 * NSA_LCAP;
constexpr size_t MOE_LIST = NSA_LISTS;
static_assert(64ull * 32768 * 4 <= 4 * NSA_LCAP * 2, "MoE lists do not fit");
constexpr size_t HID_OFF = OFF_QKV;

#define SMEM_BYTES 76800
#define HDR_BYTES 512

struct Params {
    const float* x; const int* pos;
    const float* ln_mix[2]; const float* w_in[2]; const float* sinks0; const float* w_out[2]; const float* ln_ffn[2];
    const float* r_group[2]; const float* r_expert[2]; const float* e_gate[2]; const float* e_up[2]; const float* e_down[2];
    const float* k_pe; const float* k_w1; const float* k_w2; const float* v_pe; const float* v_w1; const float* v_w2;
    const float* ln_final;
    float* out;
    char* ws;
};

#define XB_TMO      128
#define XB_XCNT(j)  (256  + 64 * (j))
#define XB_XSUB(j)  (1280 + 64 * (j))
#define XB_XGEN(j)  (2304 + 64 * (j))
#define XB_TOP      3328
#define XB_TOPGEN   3392
#define XCD_BAR_WORDS 3456
#define XB_SPIN_CAP (1u << 22)
#define LAS __attribute__((address_space(3)))

__device__ __forceinline__ unsigned xb_ld(unsigned* p)              { return __hip_atomic_load(p, __ATOMIC_RELAXED, __HIP_MEMORY_SCOPE_AGENT); }
__device__ __forceinline__ unsigned xb_add(unsigned* p, unsigned v) { return __hip_atomic_fetch_add(p, v, __ATOMIC_RELAXED, __HIP_MEMORY_SCOPE_AGENT); }
__device__ __forceinline__ unsigned xb_xcc_id() { return (unsigned)__builtin_amdgcn_s_getreg((3 << 11) | 20) & 0xFu; }
#define XB_SPIN(cond, bar) do { unsigned _sp = 0; while (cond) { __builtin_amdgcn_s_sleep(1); \
    if ((++_sp & 255u) == 0u) { if (xb_ld(&(bar)[XB_TMO])) break; if (_sp > XB_SPIN_CAP) { atomicAdd(&(bar)[XB_TMO], 1u); break; } } } } while (0)

struct XcdBarrier { unsigned* bar; unsigned x; volatile LAS unsigned* st; };

__device__ __forceinline__ XcdBarrier xcd_barrier_post(unsigned* bar, volatile LAS unsigned* st) {
    XcdBarrier b; b.bar = bar; b.x = xb_xcc_id(); b.st = st;
    if (threadIdx.x == 0) (void)xb_add(&bar[XB_XCNT(b.x)], 1u);
    return b;
}
__device__ __forceinline__ void xcd_barrier_complete(unsigned* bar, unsigned x, unsigned& nloc, unsigned& nx) {
    const unsigned G = gridDim.x * gridDim.y * gridDim.z;
    unsigned sum, cnt, mine, sp = 0u;
    for (;;) {
        sum = 0u; cnt = 0u; mine = 0u;
#pragma unroll
        for (unsigned j = 0; j < 16; ++j) { const unsigned c = xb_ld(&bar[XB_XCNT(j)]); sum += c; cnt += (c > 0u) ? 1u : 0u; mine = (j == x) ? c : mine; }
        if (sum == G) break;
        __builtin_amdgcn_s_sleep(1);
        if ((++sp & 255u) == 0u) { if (xb_ld(&bar[XB_TMO])) break; if (sp > XB_SPIN_CAP) { atomicAdd(&bar[XB_TMO], 1u); break; } }
    }
    nloc = mine > 0u ? mine : 1u; nx = cnt > 0u ? cnt : 1u;
}
__device__ __forceinline__ void xcd_barrier(const XcdBarrier& b) {
    asm volatile("s_waitcnt vmcnt(0)" ::: "memory");
    __syncthreads();
    if (threadIdx.x == 0) {
        unsigned* bar = b.bar;
        __builtin_amdgcn_s_waitcnt(0);
        unsigned nloc = b.st[0], nx = b.st[1];
        if (nloc == 0u) { xcd_barrier_complete(bar, b.x, nloc, nx); b.st[0] = nloc; b.st[1] = nx; }
        const unsigned old = xb_add(&bar[XB_XSUB(b.x)], 1u);
        const unsigned gen = old / nloc;
        if (old + 1u == (gen + 1u) * nloc) {
            __builtin_amdgcn_fence(__ATOMIC_RELEASE, "agent");
            asm volatile("s_waitcnt vmcnt(0)" ::: "memory");
            const unsigned og = xb_add(&bar[XB_TOP], 1u);
            const unsigned tg = og / nx;
            if (og + 1u == (tg + 1u) * nx) xb_add(&bar[XB_TOPGEN], 1u);
            else XB_SPIN(xb_ld(&bar[XB_TOPGEN]) == tg, bar);
            __builtin_amdgcn_fence(__ATOMIC_ACQUIRE, "agent");
            xb_add(&bar[XB_XGEN(b.x)], 1u);
            asm volatile("s_waitcnt vmcnt(0)" ::: "memory");
        } else {
            XB_SPIN(xb_ld(&bar[XB_XGEN(b.x)]) == gen, bar);
            __builtin_amdgcn_fence(__ATOMIC_ACQUIRE, "agent");
            asm volatile("s_waitcnt vmcnt(0)" ::: "memory");
        }
    }
    __syncthreads();
}

typedef __bf16 bf16x2_t __attribute__((ext_vector_type(2)));
typedef float f32x2 __attribute__((ext_vector_type(2)));
__device__ __forceinline__ uint32_t pack2(float a, float b) { const f32x2 v = {a, b}; return __builtin_bit_cast(uint32_t, __builtin_convertvector(v, bf16x2_t)); }
__device__ __forceinline__ bf16_t f2bf(float f) { return (bf16_t)(pack2(f, 0.f) & 0xFFFFu); }
__device__ __forceinline__ float bf2f(bf16_t h) { return __uint_as_float(((uint32_t)h) << 16); }
__device__ __forceinline__ f32x4 mfma16(bf16x8 a, bf16x8 b, f32x4 c) { return __builtin_amdgcn_mfma_f32_16x16x32_bf16(a, b, c, 0, 0, 0); }
__device__ __forceinline__ float red16_max(float v) { v = fmaxf(v, __shfl_xor(v, 1)); v = fmaxf(v, __shfl_xor(v, 2)); v = fmaxf(v, __shfl_xor(v, 4)); v = fmaxf(v, __shfl_xor(v, 8)); return v; }
__device__ __forceinline__ float red16_sum(float v) { v += __shfl_xor(v, 1); v += __shfl_xor(v, 2); v += __shfl_xor(v, 4); v += __shfl_xor(v, 8); return v; }
__device__ __forceinline__ float red64_sum(float v) { v += __shfl_xor(v, 1); v += __shfl_xor(v, 2); v += __shfl_xor(v, 4); v += __shfl_xor(v, 8); v += __shfl_xor(v, 16); v += __shfl_xor(v, 32); return v; }
typedef unsigned u32x2_t __attribute__((ext_vector_type(2)));
__device__ __forceinline__ float quad_max(float v) {
    const u32x2_t a = __builtin_amdgcn_permlane32_swap(__float_as_uint(v), __float_as_uint(v), false, false);
    v = fmaxf(__uint_as_float(a[0]), __uint_as_float(a[1]));
    const u32x2_t b = __builtin_amdgcn_permlane16_swap(__float_as_uint(v), __float_as_uint(v), false, false);
    return fmaxf(__uint_as_float(b[0]), __uint_as_float(b[1]));
}
__device__ __forceinline__ float quad_sum(float v) {
    const u32x2_t a = __builtin_amdgcn_permlane32_swap(__float_as_uint(v), __float_as_uint(v), false, false);
    v = __uint_as_float(a[0]) + __uint_as_float(a[1]);
    const u32x2_t b = __builtin_amdgcn_permlane16_swap(__float_as_uint(v), __float_as_uint(v), false, false);
    return __uint_as_float(b[0]) + __uint_as_float(b[1]);
}
__device__ __forceinline__ float ex2(float x) { return __builtin_amdgcn_exp2f(x); }
#define LOG2E 1.4426950408889634f
__device__ __forceinline__ void lds_fence() { asm volatile("s_waitcnt lgkmcnt(0)" ::: "memory"); }
__device__ __forceinline__ void lds_barrier() { asm volatile("s_waitcnt lgkmcnt(0)" ::: "memory"); __builtin_amdgcn_s_barrier(); asm volatile("" ::: "memory"); }
__device__ __forceinline__ bf16x8 ld8(const bf16_t* p) { return *(const bf16x8*)p; }
__device__ __forceinline__ bf16x8 zero8() { bf16x8 z = {0, 0, 0, 0, 0, 0, 0, 0}; return z; }

__device__ __forceinline__ int hidden_tid() { int t = (int)threadIdx.x; asm volatile("" : "+v"(t)); __builtin_assume(t >= 0 && t < 256); return t; }

__device__ __forceinline__ void tconv(char* smem, const float* src, bf16_t* dst, int K, int N, int Npad, int nbatch, size_t sstride, size_t dstride, int mode) {
    float* tile = (float*)smem;
    const int tid = hidden_tid();
    const int tk = K / 64, tn = (Npad + 63) / 64, per = tk * tn, total = per * nbatch;
    for (int it = blockIdx.x; it < total; it += gridDim.x) {
        const int bi = it / per, r = it % per, k0 = (r / tn) * 64, n0 = (r % tn) * 64;
        const float* s = src + (size_t)bi * sstride;
        bf16_t* d = dst + (size_t)bi * dstride;
        const int ty = tid >> 4, tx = tid & 15;
#pragma unroll
        for (int i = 0; i < 4; ++i) {
            const int k = ty + 16 * i, n = n0 + tx * 4;
            float4 v = make_float4(0.f, 0.f, 0.f, 0.f);
            if (n < N) v = *(const float4*)(s + (size_t)(k0 + k) * N + n);
            tile[k * 65 + tx * 4 + 0] = v.x; tile[k * 65 + tx * 4 + 1] = v.y; tile[k * 65 + tx * 4 + 2] = v.z; tile[k * 65 + tx * 4 + 3] = v.w;
        }
        __syncthreads();
        {
            const int nl = tid >> 2, kc = (tid & 3) * 16, n = n0 + nl;
            if (n < Npad) {
                int row = n;
                if (mode == 1) row = (n >> 5) * 64 + (n & 31);
                else if (mode == 2) row = (n >> 5) * 64 + 32 + (n & 31);
                uint32_t w[8];
#pragma unroll
                for (int i = 0; i < 8; ++i) w[i] = pack2(tile[(kc + 2 * i) * 65 + nl], tile[(kc + 2 * i + 1) * 65 + nl]);
                uint4* o = (uint4*)(d + (size_t)row * K + k0 + kc);
                o[0] = make_uint4(w[0], w[1], w[2], w[3]);
                o[1] = make_uint4(w[4], w[5], w[6], w[7]);
            }
        }
        __syncthreads();
    }
}

__device__ __forceinline__ void conv_expert_weights(const Params& p, char* smem, int L) {
    char* ws = p.ws;
    tconv(smem, p.e_gate[L], (bf16_t*)(ws + W_GU), 1024, 512, 512, 64, 1024ull * 512, 1024ull * 1024, 1);
    tconv(smem, p.e_up[L], (bf16_t*)(ws + W_GU), 1024, 512, 512, 64, 1024ull * 512, 1024ull * 1024, 2);
    tconv(smem, p.e_down[L], (bf16_t*)(ws + W_DN), 512, 1024, 1024, 64, 512ull * 1024, 1024ull * 512, 0);
}
__device__ __forceinline__ void conv_layer_weights(const Params& p, char* smem, int L) {
    char* ws = p.ws;
    if (L == 0) tconv(smem, p.w_in[0], (bf16_t*)(ws + W_IN), 1024, 2304, 2304, 1, 0, 0, 0);
    else        tconv(smem, p.w_in[1], (bf16_t*)(ws + W_IN), 1024, 2072, 2304, 1, 0, 0, 0);
    tconv(smem, p.w_out[L], (bf16_t*)(ws + W_OUT), 1024, 1024, 1024, 1, 0, 0, 0);
    if (L == 1) {
        tconv(smem, p.k_w1, (bf16_t*)(ws + W_K1), 2048, 256, 256, 1, 0, 0, 0);
        tconv(smem, p.v_w1, (bf16_t*)(ws + W_V1), 2048, 256, 256, 1, 0, 0, 0);
        tconv(smem, p.k_w2, (bf16_t*)(ws + W_K2), 256, 64, 128, 1, 0, 0, 0);
        tconv(smem, p.v_w2, (bf16_t*)(ws + W_V2), 256, 64, 128, 1, 0, 0, 0);
        if (blockIdx.x == gridDim.x - 1 || blockIdx.x == gridDim.x - 2) {
            const bool isv = (blockIdx.x == gridDim.x - 2);
            const float* pe = isv ? p.v_pe : p.k_pe; const float* w1 = isv ? p.v_w1 : p.k_w1;
            float* bias = (float*)(ws + (isv ? W_BV : W_BK));
            const int n = hidden_tid(); float acc = 0.f;
            for (int kk = 0; kk < 2048; ++kk) acc += pe[kk] * w1[(size_t)kk * 256 + n];
            bias[n] = acc;
        }
    }
}

static __device__ const double kInvFreq[32] = {
    1.0, 0.7498942093324559, 0.5623413251903491, 0.4216965034285822, 0.31622776601683794, 0.23713737056616552, 0.1778279410038923, 0.1333521432163324,
    0.1, 0.07498942093324558, 0.05623413251903491, 0.042169650342858224, 0.03162277660168379, 0.023713737056616554, 0.01778279410038923, 0.01333521432163324,
    0.01, 0.007498942093324558, 0.005623413251903491, 0.004216965034285823, 0.0031622776601683794, 0.0023713737056616554, 0.0017782794100389228, 0.001333521432163324,
    0.001, 0.0007498942093324559, 0.0005623413251903491, 0.00042169650342858224, 0.00031622776601683794, 0.00023713737056616554, 0.00017782794100389227, 0.0001333521432163324};
__device__ __forceinline__ void rope_table(const Params& p) {
    float* rc = (float*)(p.ws + OFF_ROPE); float* rs = rc + (size_t)NTOK * 32;
    for (int i = blockIdx.x * 256 + hidden_tid(); i < NTOK * 32; i += gridDim.x * 256) {
        const int t = i >> 5, c = i & 31;
        const double ang = (double)p.pos[t] * kInvFreq[c];
        const double k = rint(ang * 0.15915494309189535);
        const float r = (float)fma(-k, 6.283185307179586, ang);
        rc[i] = cosf(r); rs[i] = sinf(r);
    }
}

__device__ __forceinline__ void norm_pass(const float* src, const bf16_t* y, const float* tg, float* xr, const float* gain, bf16_t* hb, float* hf, float pscale = 1.0f, float pv = 0.0f) {
    const int tidh = hidden_tid(), lane = tidh & 63, wid = tidh >> 6;
    const int nw = gridDim.x * 4;
    for (int t = blockIdx.x * 4 + wid; t < NTOK; t += nw) {
        float v[16];
#pragma unroll
        for (int i = 0; i < 4; ++i) {
            const float4 a = *(const float4*)(src + (size_t)t * DM + i * 256 + lane * 4);
            v[4 * i] = a.x; v[4 * i + 1] = a.y; v[4 * i + 2] = a.z; v[4 * i + 3] = a.w;
        }
        if (y) {
#pragma unroll
            for (int k = 0; k < 2; ++k) {
                const float gk = tg[(size_t)t * 2 + k];
#pragma unroll
                for (int i = 0; i < 4; ++i) {
                    const uint2 a = *(const uint2*)(y + ((size_t)t * 2 + k) * DM + i * 256 + lane * 4);
                    v[4 * i] += gk * __uint_as_float(a.x << 16); v[4 * i + 1] += gk * __uint_as_float(a.x & 0xFFFF0000u);
                    v[4 * i + 2] += gk * __uint_as_float(a.y << 16); v[4 * i + 3] += gk * __uint_as_float(a.y & 0xFFFF0000u);
                }
            }
        }
        float ss = 0.f;
#pragma unroll
        for (int i = 0; i < 16; ++i) ss += v[i] * v[i];
        ss = red64_sum(ss);
        const float rstd = rsqrtf(ss * (1.0f / DM) + 1e-6f);
#pragma unroll
        for (int i = 0; i < 4; ++i) {
            if (xr) *(float4*)(xr + (size_t)t * DM + i * 256 + lane * 4) = make_float4(v[4 * i], v[4 * i + 1], v[4 * i + 2], v[4 * i + 3]);
            const float4 g = *(const float4*)(gain + i * 256 + lane * 4);
            const float h0 = v[4 * i] * rstd * g.x, h1 = v[4 * i + 1] * rstd * g.y, h2 = v[4 * i + 2] * rstd * g.z, h3 = v[4 * i + 3] * rstd * g.w;
            if (hb) *(uint2*)(hb + (size_t)t * DM + i * 256 + lane * 4) = make_uint2(pack2(h0, h1), pack2(h2, h3));
            if (hf) { float4 o4 = make_float4(h0 * pscale, h1 * pscale, h2 * pscale, h3 * pscale);
                if (pv != 0.0f && t == 0 && i == 0 && lane == 0) o4.x = pv;
                *(float4*)(hf + (size_t)t * DM + i * 256 + lane * 4) = o4; }
        }
    }
}

#define GSW(tid) ((((tid) & 3) ^ ((0 - ((tid) >> 4)) & 3)) * 8)
__device__ __forceinline__ void glds16(const bf16_t* g, char* l) {
    __builtin_amdgcn_global_load_lds((const unsigned*)g, (LAS unsigned*)l, 16, 0, 0);
}
template <class AOff, class Epi>
__device__ __forceinline__ void gemm_tile(char* smem, const bf16_t* a0, const bf16_t* a1, const bf16_t* b0, const bf16_t* b1, int KT, AOff aoff, Epi epi) {
    const int tid = hidden_tid(), wid = tid >> 6, lane = tid & 63, wr = wid >> 1, wc = wid & 1, fr = lane & 15, fq = lane >> 4;
    const int csw = (fq ^ ((0 - (fr >> 2)) & 3)) * 16;
    f32x4 acc[4][4];
#pragma unroll
    for (int m = 0; m < 4; ++m)
#pragma unroll
        for (int n = 0; n < 4; ++n) acc[m][n] = (f32x4){0.f, 0.f, 0.f, 0.f};
    auto stage = [&](int t) {
        char* buf = smem + (t & 3) * 16384;
        const size_t ao = aoff(t);
        glds16(a0 + ao, buf + tid * 16); glds16(a1 + ao, buf + 4096 + tid * 16);
        glds16(b0 + t * 32, buf + 8192 + tid * 16); glds16(b1 + t * 32, buf + 8192 + 4096 + tid * 16);
    };
    asm volatile("s_waitcnt vmcnt(0)" ::: "memory");
    stage(0);
    if (KT > 1) stage(1);
    if (KT > 2) stage(2);
    for (int t = 0; t < KT; ++t) {
        const char* cur = smem + (t & 3) * 16384;
        if (t + 2 < KT) asm volatile("s_waitcnt vmcnt(8)" ::: "memory");
        else if (t + 1 < KT) asm volatile("s_waitcnt vmcnt(4)" ::: "memory");
        else asm volatile("s_waitcnt vmcnt(0)" ::: "memory");
        __builtin_amdgcn_s_barrier();
        asm volatile("" ::: "memory");
        if (t + 3 < KT) stage(t + 3);
        bf16x8 af[4], bfr[4];
#pragma unroll
        for (int m = 0; m < 4; ++m) af[m] = *(const bf16x8*)(cur + (wr * 64 + m * 16 + fr) * 64 + csw);
#pragma unroll
        for (int n = 0; n < 4; ++n) bfr[n] = *(const bf16x8*)(cur + 8192 + (wc * 64 + n * 16 + fr) * 64 + csw);
        __builtin_amdgcn_s_setprio(1);
#pragma unroll
        for (int m = 0; m < 4; ++m)
#pragma unroll
            for (int n = 0; n < 4; ++n) acc[m][n] = mfma16(af[m], bfr[n], acc[m][n]);
        __builtin_amdgcn_s_setprio(0);
    }
    epi(acc, wr, wc, fr, fq);
    __syncthreads();
}

__device__ __forceinline__ void ld_frags(const char* cur, int wr, int wc, int fr, int csw, bf16x8 (&af)[4], bf16x8 (&bfr)[4]) {
#pragma unroll
    for (int m = 0; m < 4; ++m) af[m] = *(const bf16x8*)(cur + (wr * 64 + m * 16 + fr) * 64 + csw);
#pragma unroll
    for (int n = 0; n < 4; ++n) bfr[n] = *(const bf16x8*)(cur + 8192 + (wc * 64 + n * 16 + fr) * 64 + csw);
}
__device__ __forceinline__ void mma_frags(const bf16x8 (&af)[4], const bf16x8 (&bfr)[4], f32x4 (&acc)[4][4]) {
    __builtin_amdgcn_s_setprio(1);
#pragma unroll
    for (int m = 0; m < 4; ++m)
#pragma unroll
        for (int n = 0; n < 4; ++n) acc[m][n] = mfma16(af[m], bfr[n], acc[m][n]);
    __builtin_amdgcn_s_setprio(0);
}
template <class AOff, class Epi>
__device__ __forceinline__ void gemm_tile_p(char* smem, const bf16_t* a0, const bf16_t* a1, const bf16_t* b0, const bf16_t* b1, int KT, AOff aoff, Epi epi) {
    const int tid = hidden_tid(), wid = tid >> 6, lane = tid & 63, wr = wid >> 1, wc = wid & 1, fr = lane & 15, fq = lane >> 4;
    const int csw = (fq ^ ((0 - (fr >> 2)) & 3)) * 16;
    f32x4 acc[4][4];
#pragma unroll
    for (int m = 0; m < 4; ++m)
#pragma unroll
        for (int n = 0; n < 4; ++n) acc[m][n] = (f32x4){0.f, 0.f, 0.f, 0.f};
    auto stage = [&](int t) {
        char* buf = smem + (t & 3) * 16384;
        const size_t ao = aoff(t);
        glds16(a0 + ao, buf + tid * 16); glds16(a1 + ao, buf + 4096 + tid * 16);
        glds16(b0 + t * 32, buf + 8192 + tid * 16); glds16(b1 + t * 32, buf + 8192 + 4096 + tid * 16);
    };
    auto sync = [&](int t) {
        if (t + 2 < KT) asm volatile("s_waitcnt vmcnt(4)" ::: "memory"); else asm volatile("s_waitcnt vmcnt(0)" ::: "memory");
        __builtin_amdgcn_s_barrier();
        asm volatile("" ::: "memory");
        if (t + 3 < KT) stage(t + 3);
    };
    asm volatile("s_waitcnt vmcnt(0)" ::: "memory");
    stage(0); stage(1); if (KT > 2) stage(2);
    asm volatile("s_waitcnt vmcnt(8)" ::: "memory");
    if (KT <= 2) asm volatile("s_waitcnt vmcnt(4)" ::: "memory");
    __builtin_amdgcn_s_barrier();
    asm volatile("" ::: "memory");
    bf16x8 afA[4], bfA[4], afB[4], bfB[4];
    ld_frags(smem, wr, wc, fr, csw, afA, bfA);
    for (int t = 0; t < KT; t += 2) {
        sync(t);
        ld_frags(smem + ((t + 1) & 3) * 16384, wr, wc, fr, csw, afB, bfB);
        mma_frags(afA, bfA, acc);
        sync(t + 1);
        if (t + 2 < KT) ld_frags(smem + ((t + 2) & 3) * 16384, wr, wc, fr, csw, afA, bfA);
        mma_frags(afB, bfB, acc);
    }
    epi(acc, wr, wc, fr, fq);
    __syncthreads();
}

#define GSW64(tid) ((((tid) & 7) ^ (((tid) >> 4) & 7)) * 8)
template <class AOff, class Epi>
__device__ __forceinline__ void gemm_tile_k64(char* smem, int tid, const bf16_t* const (&ap)[4], const bf16_t* b0, size_t b32, int KT, AOff aoff, Epi epi) {
    const int wid = tid >> 6, lane = tid & 63, wr = wid >> 1, wc = wid & 1, fr = lane & 15, fq = lane >> 4;
    const int sw = (fr >> 1) & 7;
    f32x4 acc[4][4];
#pragma unroll
    for (int m = 0; m < 4; ++m)
#pragma unroll
        for (int n = 0; n < 4; ++n) acc[m][n] = (f32x4){0.f, 0.f, 0.f, 0.f};
    auto stage = [&](int t) {
        char* buf = smem + (t & 1) * 32768;
        const size_t ao = aoff(t);
#pragma unroll
        for (int i = 0; i < 4; ++i) glds16(ap[i] + ao, buf + i * 4096 + tid * 16);
        const bf16_t* bp = b0 + t * 64;
#pragma unroll
        for (int i = 0; i < 4; ++i) glds16(bp + i * b32, buf + 16384 + i * 4096 + tid * 16);
    };
    asm volatile("s_waitcnt vmcnt(0)" ::: "memory");
    stage(0);
    for (int t = 0; t < KT; ++t) {
        const char* cur = smem + (t & 1) * 32768;
        asm volatile("s_waitcnt vmcnt(0)" ::: "memory");
        __builtin_amdgcn_s_barrier();
        asm volatile("" ::: "memory");
        if (t + 1 < KT) stage(t + 1);
#pragma unroll
        for (int ks = 0; ks < 2; ++ks) {
            const int cb = ((ks * 4 + fq) ^ sw) * 16;
            bf16x8 af[4], bfr[4];
#pragma unroll
            for (int m = 0; m < 4; ++m) af[m] = *(const bf16x8*)(cur + (wr * 64 + m * 16 + fr) * 128 + cb);
#pragma unroll
            for (int n = 0; n < 4; ++n) bfr[n] = *(const bf16x8*)(cur + 16384 + (wc * 64 + n * 16 + fr) * 128 + cb);
            __builtin_amdgcn_s_setprio(1);
#pragma unroll
            for (int m = 0; m < 4; ++m)
#pragma unroll
                for (int n = 0; n < 4; ++n) acc[m][n] = mfma16(af[m], bfr[n], acc[m][n]);
            __builtin_amdgcn_s_setprio(0);
        }
    }
    epi(acc, wr, wc, fr, fq);
    __syncthreads();
}


#define EP2 132
template <int MODE = 0, class Epi>
__device__ __forceinline__ void gemm_tile_q(char* smem, int tid, const char* A, const unsigned (&ao)[8], const char* Bu, unsigned bo, unsigned ldbB, int KT, Epi epi) {
    const int wid = tid >> 6, lane = tid & 63, wr = wid >> 1, wc = wid & 1, fr = lane & 15, fq = lane >> 4;
    const int cb0 = (fq ^ ((fr >> 1) & 7)) * 16;
    const int a_k0 = (wr * 64 + fr) * 128 + cb0, a_k1 = a_k0 ^ 64, b_k0 = (wc * 32 + fr) * 128 + cb0, b_k1 = b_k0 ^ 64;
    const int wsc = __builtin_amdgcn_readfirstlane(wid), wbase = wsc * 1024;
    f32x4 acc[2][2][4][2];
#pragma unroll
    for (int a = 0; a < 2; ++a)
#pragma unroll
        for (int b = 0; b < 2; ++b)
#pragma unroll
            for (int m = 0; m < 4; ++m)
#pragma unroll
                for (int n = 0; n < 2; ++n) acc[a][b][m][n] = (f32x4){0.f, 0.f, 0.f, 0.f};
    bf16x8 At[4][2], B0[2][2], B1[2][2];
    int sa0 = 0, sa1 = 16384, sa2 = 32768, sb0 = 49152, sb1 = 57344, sb2 = 65536;
    auto pieceA = [&](int h, int t, int slot, int i) {
        const char* au = A + (size_t)t * 128;
        unsigned o = ao[h * 4 + i]; asm volatile("" : "+v"(o));
        glds16((const bf16_t*)(au + o), smem + slot + i * 4096 + wbase);
    };
    auto pieceB = [&](int h, int t, int slot, int i) {
        const char* bu = Bu + ((size_t)(h * 64 + i * 32) * ldbB + (size_t)t * 128);
        unsigned o = bo; asm volatile("" : "+v"(o));
        glds16((const bf16_t*)(bu + o), smem + slot + i * 4096 + wbase);
    };
    auto stageA = [&](int h, int t, int slot) {
#pragma unroll
        for (int i = 0; i < 4; ++i) pieceA(h, t, slot, i);
    };
    auto stageB = [&](int h, int t, int slot) {
#pragma unroll
        for (int i = 0; i < 2; ++i) pieceB(h, t, slot, i);
    };
    auto LDA = [&](int slot) {
        const char* s0 = smem + slot + a_k0; const char* s1 = smem + slot + a_k1;
#pragma unroll
        for (int m = 0; m < 4; ++m) { At[m][0] = *(const bf16x8*)(s0 + m * 2048); At[m][1] = *(const bf16x8*)(s1 + m * 2048); }
    };
    auto LDB = [&](bf16x8 (&B)[2][2], int slot) {
        const char* s0 = smem + slot + b_k0; const char* s1 = smem + slot + b_k1;
#pragma unroll
        for (int n = 0; n < 2; ++n) { B[n][0] = *(const bf16x8*)(s0 + n * 2048); B[n][1] = *(const bf16x8*)(s1 + n * 2048); }
    };
    auto MMA = [&](f32x4 (&c)[4][2], const bf16x8 (&B)[2][2], auto&& issue) {
        __builtin_amdgcn_s_setprio(1);
#pragma unroll
        for (int m = 0; m < 4; ++m) {
#pragma unroll
            for (int n = 0; n < 2; ++n) { c[m][n] = mfma16(At[m][0], B[n][0], c[m][n]); c[m][n] = mfma16(At[m][1], B[n][1], c[m][n]); }
            issue(m);
        }
        __builtin_amdgcn_s_setprio(0);
    };
    stageB(0, 0, sb0); stageA(0, 0, sa0); stageA(1, 0, sa1); stageB(1, 0, sb1);
    if (KT > 1) { stageB(0, 1, sb2); asm volatile("s_waitcnt vmcnt(8)" ::: "memory"); } else asm volatile("s_waitcnt vmcnt(6)" ::: "memory");
    __builtin_amdgcn_s_barrier();
    asm volatile("" ::: "memory");
#pragma unroll 1
    for (int t = 0; t < KT; ++t) {
        const bool more = t + 1 < KT, more2 = t + 2 < KT;
        if (MODE != 3) { LDB(B0, sb0); LDA(sa0); }
        if (more && MODE != 2) stageA(0, t + 1, sa2);
        if (MODE != 3) MMA(acc[0][0], B0, [&](int) {});
        if (more) asm volatile("s_waitcnt vmcnt(6)" ::: "memory"); else asm volatile("s_waitcnt vmcnt(0)" ::: "memory");
        __builtin_amdgcn_s_barrier();
        asm volatile("" ::: "memory");
        if (MODE != 3) LDB(B1, sb1);
        if (more && MODE != 2) { stageA(1, t + 1, sa0); stageB(1, t + 1, sb0); }
        if (MODE != 3) MMA(acc[0][1], B1, [&](int) {});
        __builtin_amdgcn_s_barrier();
        asm volatile("" ::: "memory");
        if (MODE != 3) LDA(sa1);
        if (more2 && MODE != 2) stageB(0, t + 2, sb1);
        if (MODE != 3) MMA(acc[1][0], B0, [&](int) {});
        if (MODE != 3) MMA(acc[1][1], B1, [&](int) {});
        if (more2) asm volatile("s_waitcnt vmcnt(8)" ::: "memory"); else if (more) asm volatile("s_waitcnt vmcnt(6)" ::: "memory");
        __builtin_amdgcn_s_barrier();
        asm volatile("" ::: "memory");
        { const int x = sa0; sa0 = sa2; sa2 = sa1; sa1 = x; }
        { const int x = sb0; sb0 = sb2; sb2 = sb1; sb1 = x; }
    }
    if (MODE != 0) {
        float sink = 0.f;
#pragma unroll
        for (int a = 0; a < 2; ++a)
#pragma unroll
            for (int b = 0; b < 2; ++b)
#pragma unroll
                for (int m = 0; m < 4; ++m)
#pragma unroll
                    for (int n = 0; n < 2; ++n) sink += acc[a][b][m][n][0] + acc[a][b][m][n][1] + acc[a][b][m][n][2] + acc[a][b][m][n][3];
        asm volatile("" :: "v"(sink));
        __syncthreads();
        return;
    }
    float* P = (float*)smem;
    {
        const int tz = hidden_tid(), wr = (tz >> 7) & 1, wc = (tz >> 6) & 1, fr = tz & 15, fq = (tz >> 4) & 3;
#pragma unroll
        for (int b = 0; b < 2; ++b)
#pragma unroll
            for (int m = 0; m < 4; ++m)
#pragma unroll
                for (int n = 0; n < 2; ++n)
#pragma unroll
                    for (int j = 0; j < 4; ++j) P[(wr * 64 + m * 16 + fq * 4 + j) * EP2 + b * 64 + wc * 32 + n * 16 + fr] = acc[0][b][m][n][j];
        lds_barrier();
        epi(P + (wr * 64) * EP2 + wc * 64, wr * 64, wc);
        lds_barrier();
#pragma unroll
        for (int b = 0; b < 2; ++b)
#pragma unroll
            for (int m = 0; m < 4; ++m)
#pragma unroll
                for (int n = 0; n < 2; ++n)
#pragma unroll
                    for (int j = 0; j < 4; ++j) P[(wr * 64 + m * 16 + fq * 4 + j) * EP2 + b * 64 + wc * 32 + n * 16 + fr] = acc[1][b][m][n][j];
        lds_barrier();
        epi(P + (wr * 64) * EP2 + wc * 64, 128 + wr * 64, wc);
        lds_barrier();
    }
}


template <class Epi>
__device__ __forceinline__ void gemm_tile_s(char* smem, int tid, const char* A, const unsigned (&ao)[4], const char* Bu, unsigned bo, unsigned ldbB, int KT, Epi epi) {
    const int wid = tid >> 6, lane = tid & 63, wr = wid >> 1, wc = wid & 1, fr = lane & 15, fq = lane >> 4;
    const int sw = (fr >> 1) & 7;
    const int wbase = __builtin_amdgcn_readfirstlane(wid) * 1024;
    f32x4 acc[4][4];
#pragma unroll
    for (int m = 0; m < 4; ++m)
#pragma unroll
        for (int n = 0; n < 4; ++n) acc[m][n] = (f32x4){0.f, 0.f, 0.f, 0.f};
    auto stage = [&](int t) {
        char* buf = smem + (t & 1) * 32768;
        const char* au = A + (size_t)t * 128;
#pragma unroll
        for (int i = 0; i < 4; ++i) { unsigned o = ao[i]; asm volatile("" : "+v"(o)); glds16((const bf16_t*)(au + o), buf + i * 4096 + wbase); }
#pragma unroll
        for (int i = 0; i < 4; ++i) { const char* bu = Bu + ((size_t)(i * 32) * ldbB + (size_t)t * 128); unsigned o = bo; asm volatile("" : "+v"(o)); glds16((const bf16_t*)(bu + o), buf + 16384 + i * 4096 + wbase); }
    };
    asm volatile("s_waitcnt vmcnt(0)" ::: "memory");
    stage(0);
    for (int t = 0; t < KT; ++t) {
        const char* cur = smem + (t & 1) * 32768;
        asm volatile("s_waitcnt vmcnt(0)" ::: "memory");
        __builtin_amdgcn_s_barrier();
        asm volatile("" ::: "memory");
        if (t + 1 < KT) stage(t + 1);
#pragma unroll
        for (int ks = 0; ks < 2; ++ks) {
            const int cb = ((ks * 4 + fq) ^ sw) * 16;
            bf16x8 af[4], bfr[4];
#pragma unroll
            for (int m = 0; m < 4; ++m) af[m] = *(const bf16x8*)(cur + (wr * 64 + m * 16 + fr) * 128 + cb);
#pragma unroll
            for (int n = 0; n < 4; ++n) bfr[n] = *(const bf16x8*)(cur + 16384 + (wc * 64 + n * 16 + fr) * 128 + cb);
            __builtin_amdgcn_s_setprio(1);
#pragma unroll
            for (int m = 0; m < 4; ++m)
#pragma unroll
                for (int n = 0; n < 4; ++n) acc[m][n] = mfma16(af[m], bfr[n], acc[m][n]);
            __builtin_amdgcn_s_setprio(0);
        }
    }
    float* P = (float*)smem;
    {
        const int tz = hidden_tid(), wr = (tz >> 7) & 1, wc = (tz >> 6) & 1, fr = tz & 15, fq = (tz >> 4) & 3;
        lds_barrier();
#pragma unroll
        for (int m = 0; m < 4; ++m)
#pragma unroll
            for (int n = 0; n < 4; ++n)
#pragma unroll
                for (int j = 0; j < 4; ++j) P[(wr * 64 + m * 16 + fq * 4 + j) * EP2 + wc * 64 + n * 16 + fr] = acc[m][n][j];
        lds_barrier();
        epi(P + (wr * 64) * EP2 + wc * 64, wr * 64, wc);
        lds_barrier();
    }
}

__device__ __forceinline__ void col_kind(int L, int ct, int& kind, int& vh, float& scale) {
    kind = 0; vh = 0; scale = 1.f;
    if (L == 0) {
        if (ct < 8) { kind = 1; scale = 0.125f * LOG2E; }
        else if (ct < 10) kind = 1;
        else if (ct < 12) { kind = 2; vh = ct - 10; }
        else if (ct < 20) { kind = 0; scale = 0.125f; }
        else if (ct < 28) kind = 0;
        else { kind = 2; vh = 2 + (ct - 28); }
    } else {
        if (ct < 8) { kind = 1; scale = 0.125f * LOG2E; }
        else if (ct < 10) kind = 1;
        else if (ct < 12) { kind = 2; vh = ct - 10; }
        else if (ct < 20) { kind = 1; scale = 0.125f * LOG2E; }
        else if (ct < 22) kind = 1;
        else if (ct < 24) kind = 0;
        else if (ct < 26) kind = 1;
        else if (ct < 28) { kind = 2; vh = 2 + (ct - 26); }
        else if (ct < 30) kind = 1;
        else if (ct < 32) { kind = 2; vh = 4 + (ct - 30); }
        else if (ct == 32) kind = 3;
        else kind = 4;
    }
}

#ifndef GEMM_EXP
#define GEMM_EXP 0
#endif
#define EPITCH 68
__device__ __forceinline__ void dump_half(float* E, const f32x4 (&acc)[4][4], int nb, int fr, int fq) {
#pragma unroll
    for (int m = 0; m < 4; ++m)
#pragma unroll
        for (int n = 0; n < 4; ++n)
#pragma unroll
            for (int j = 0; j < 4; ++j) E[(m * 16 + fq * 4 + j) * EPITCH + n * 16 + fr] = acc[m][nb + n][j];
}
__device__ __forceinline__ void ld8f(const float* p, float (&v)[8]) {
    const float4 a = *(const float4*)p, b = *(const float4*)(p + 4);
    v[0] = a.x; v[1] = a.y; v[2] = a.z; v[3] = a.w; v[4] = b.x; v[5] = b.y; v[6] = b.z; v[7] = b.w;
}
__device__ __forceinline__ void st8bf(bf16_t* p, const float (&v)[8]) {
    *(uint4*)p = make_uint4(pack2(v[0], v[1]), pack2(v[2], v[3]), pack2(v[4], v[5]), pack2(v[6], v[7]));
}

template <int MODE = 0>
__device__ __forceinline__ void ph_gemm_qkv(const Params& p, char* smem, int L) {
    const bf16_t* A = (const bf16_t*)(p.ws + OFF_H);
    const bf16_t* Bt = (const bf16_t*)(p.ws + W_IN);
    bf16_t* Q = (bf16_t*)(p.ws + OFF_QKV);
    bf16_t* VT = (bf16_t*)(p.ws + OFF_VT);
    float* GD = (float*)(p.ws + B_GD);
    const float* rc = (const float*)(p.ws + OFF_ROPE); const float* rs = rc + (size_t)NTOK * 32;
    const int tn = (L == 0) ? 18 : 17, tm = NTOK / 256, total = tm * tn;
    const int tid = hidden_tid();
    const bool aff = (gridDim.x & 7) == 0;
    const int xcd = blockIdx.x & 7, nh = xcd >> 2, ncols = aff ? (nh ? tn - 9 : 9) : tn;
    const int lstart = aff ? (blockIdx.x >> 3) : blockIdx.x, lstep = aff ? (gridDim.x >> 3) : gridDim.x, lcnt = aff ? (tm / 4) * ncols : total;
    const int full = (lcnt / lstep) * lstep, nitems = full + 2 * (lcnt - full);
    int brow = 0, bcol = 0;
    auto epi =
            [&](const float* E, int rb, int wc) {
                const int lane = hidden_tid() & 63;
                const int rowbase = brow + rb;
                const int ct = (bcol >> 6) + wc;
                int kind, vh; float scale; col_kind(L, ct, kind, vh, scale);
                if (kind == 4) return;
                if (kind == 0 || kind == 1) {
#pragma unroll 2
                    for (int i = 0; i < 4; ++i) {
                        const int u = lane + 64 * i, r = u >> 2, c8 = (u & 3) * 8, grow = rowbase + r;
                        float x1[8], x2[8], o1[8], o2[8];
                        ld8f(E + r * EP2 + c8, x1); ld8f(E + r * EP2 + 32 + c8, x2);
                        if (kind == 1) {
                            float cs[8], sn[8];
                            ld8f(rc + (size_t)grow * 32 + c8, cs); ld8f(rs + (size_t)grow * 32 + c8, sn);
#pragma unroll
                            for (int e = 0; e < 8; ++e) { o1[e] = (x1[e] * cs[e] - x2[e] * sn[e]) * scale; o2[e] = (x2[e] * cs[e] + x1[e] * sn[e]) * scale; }
                        } else {
#pragma unroll
                            for (int e = 0; e < 8; ++e) { o1[e] = x1[e] * scale; o2[e] = x2[e] * scale; }
                        }
                        st8bf(Q + (size_t)grow * LDQ + ct * 64 + c8, o1);
                        st8bf(Q + (size_t)grow * LDQ + ct * 64 + 32 + c8, o2);
                    }
                } else if (kind == 2) {
                    const int b = rowbase >> 14, s0 = rowbase & (SEQ - 1);
                    bf16_t* vrow = VT + ((size_t)(b * NVH + vh) * 64 + lane) * VLD + s0;
#pragma unroll 2
                    for (int tc = 0; tc < 8; ++tc) {
                        float v[8];
#pragma unroll
                        for (int e = 0; e < 8; ++e) v[e] = E[(8 * tc + e) * EP2 + lane];
                        st8bf(vrow + 8 * tc, v);
                    }
                } else {
#pragma unroll
                    for (int c = 0; c < 6; ++c) *(float4*)(GD + (size_t)(rowbase + lane) * 24 + 4 * c) = *(const float4*)(E + lane * EP2 + 4 * c);
                }
            };
    for (int it = lstart; it < (MODE ? full : nitems); it += lstep) {
        const bool big = it < full;
        const int li = big ? it : full + ((it - full) >> 1);
        const int mt = aff ? ((xcd & 3) * (tm / 4) + li / ncols) : (li / tn), nt = aff ? (nh * 9 + li % ncols) : (li % tn);
        bcol = nt * 128;
        const unsigned bo = (unsigned)(((tid >> 3) * DM + GSW64(tid)) * 2);
        const char* Bu = (const char*)(Bt + (size_t)bcol * DM);
        if (big) {
            brow = mt * 256;
            unsigned ao[8];
#pragma unroll
            for (int k = 0; k < 8; ++k) ao[k] = (unsigned)(((brow + (k >> 2) * 128 + (k & 3) * 32 + (tid >> 3)) * DM + GSW64(tid)) * 2);
            gemm_tile_q<MODE>(smem, tid, (const char*)A, ao, Bu, bo, DM * 2, DM / 64, epi);
        } else {
            brow = mt * 256 + ((it - full) & 1) * 128;
            unsigned ao[4];
#pragma unroll
            for (int k = 0; k < 4; ++k) ao[k] = (unsigned)(((brow + k * 32 + (tid >> 3)) * DM + GSW64(tid)) * 2);
            gemm_tile_s(smem, tid, (const char*)A, ao, Bu, bo, DM * 2, DM / 64, epi);
        }
    }
}

__device__ __forceinline__ void ph_gemm_out(const Params& p, char* smem, const float* xin) {
    const bf16_t* A = (const bf16_t*)(p.ws + OFF_O);
    const bf16_t* Bt = (const bf16_t*)(p.ws + W_OUT);
    float* X = p.out;
    const int tn = 8, tm = NTOK / 256, total = tm * tn, tid = hidden_tid();
    const bool aff = (gridDim.x & 7) == 0;
    const int xcd = blockIdx.x & 7, lstart = aff ? (blockIdx.x >> 3) : blockIdx.x, lstep = aff ? (gridDim.x >> 3) : gridDim.x, lcnt = aff ? total / 8 : total;
    for (int li = lstart; li < lcnt; li += lstep) {
        const int mt = aff ? (xcd * (tm / 8) + li / tn) : (li / tn), nt = li % tn, brow = mt * 256, bcol = nt * 128;
        unsigned ao[8];
#pragma unroll
        for (int k = 0; k < 8; ++k) ao[k] = (unsigned)(((brow + (k >> 2) * 128 + (k & 3) * 32 + (tid >> 3)) * DM + GSW64(tid)) * 2);
        const unsigned bo = (unsigned)(((tid >> 3) * DM + GSW64(tid)) * 2);
        gemm_tile_q(smem, tid, (const char*)A, ao, (const char*)(Bt + (size_t)bcol * DM), bo, DM * 2, DM / 64,
            [&](const float* E, int rb, int wc) {
                const int lane = hidden_tid() & 63;
#pragma unroll 4
                for (int i = 0; i < 16; ++i) {
                    const int u = lane + 64 * i, r = u >> 4, c4 = (u & 15) * 4;
                    const size_t xo = (size_t)(brow + rb + r) * DM + bcol + wc * 64 + c4;
                    const float4 e = *(const float4*)(E + r * EP2 + c4);
                    float4 x = *(const float4*)(xin + xo); x.x += e.x; x.y += e.y; x.z += e.z; x.w += e.w; *(float4*)(X + xo) = x;
                }
            });
    }
}

#define MOE_CAP 32768
__device__ __forceinline__ void ph_route(const Params& p, char* smem, int L) {
    float* lgs = (float*)smem;
    int* hist = (int*)(smem + 20480);
    int* gb = hist + 64;
    int* dec_e = gb + 64;
    int* dec_r = dec_e + 128;
    float* dec_g = (float*)(dec_r + 128);
    const float* gain = p.ln_ffn[L]; const float* Wg = p.r_group[L]; const float* We = p.r_expert[L];
    norm_pass(p.out, nullptr, nullptr, nullptr, gain, (bf16_t*)(p.ws + OFF_H), nullptr);
    float* tok_g = (float*)(p.ws + M_TOKG);
    int* list = (int*)(p.ws + MOE_LIST);
    int* gcur = (int*)(p.ws + OFF_MOECNT) + L * 64 * CNTS;
    const int tid = hidden_tid(), lane = tid & 63, wid = tid >> 6, fr = lane & 15, fq = lane >> 4;
    for (int ch = blockIdx.x; ch < NTOK / 64; ch += gridDim.x) {
        if (tid < 64) hist[tid] = 0;
        const int tb = ch * 64 + wid * 16;
        f32x4 acc[5];
#pragma unroll
        for (int n = 0; n < 5; ++n) acc[n] = (f32x4){0.f, 0.f, 0.f, 0.f};
        float ss = 0.f;
        const float* xp = p.out + (size_t)(tb + fr) * DM + 4 * fq;
        const float* wep = We + (size_t)(4 * fq) * 64 + 4 * fr;
        const float* wgp = Wg + (size_t)(4 * fq) * 4 + (fr & 3);
        float4 x4 = *(const float4*)xp, g4 = *(const float4*)(gain + 4 * fq);
        float wb[4][5];
#pragma unroll
        for (int e = 0; e < 4; ++e) {
            { const float4 w4 = *(const float4*)(wep + (size_t)e * 64); wb[e][0] = w4.x; wb[e][1] = w4.y; wb[e][2] = w4.z; wb[e][3] = w4.w; }
            wb[e][4] = wgp[e * 4];
        }
        for (int i = 0; i < 64; ++i) {
            const int in = (i + 1 < 64) ? i + 1 : i;
            const float4 x4n = *(const float4*)(xp + 16 * in), g4n = *(const float4*)(gain + 16 * in + 4 * fq);
            float wn[4][5];
#pragma unroll
            for (int e = 0; e < 4; ++e) {
                { const float4 w4 = *(const float4*)(wep + (size_t)(16 * in + e) * 64); wn[e][0] = w4.x; wn[e][1] = w4.y; wn[e][2] = w4.z; wn[e][3] = w4.w; }
                wn[e][4] = wgp[(size_t)(16 * in + e) * 4];
            }
            ss += x4.x * x4.x + x4.y * x4.y + x4.z * x4.z + x4.w * x4.w;
            const float a[4] = {x4.x * g4.x, x4.y * g4.y, x4.z * g4.z, x4.w * g4.w};
#pragma unroll
            for (int e = 0; e < 4; ++e) {
#pragma unroll
                for (int n = 0; n < 4; ++n) acc[n] = __builtin_amdgcn_mfma_f32_16x16x4f32(a[e], wb[e][n], acc[n], 0, 0, 0);
                acc[4] = __builtin_amdgcn_mfma_f32_16x16x4f32(a[e], fr < 4 ? wb[e][4] : 0.f, acc[4], 0, 0, 0);
            }
            x4 = x4n; g4 = g4n;
#pragma unroll
            for (int e = 0; e < 4; ++e)
#pragma unroll
                for (int n = 0; n < 5; ++n) wb[e][n] = wn[e][n];
        }
        ss = quad_sum(ss);
        const float rstd = rsqrtf(ss * (1.0f / DM) + 1e-6f);
#pragma unroll
        for (int j = 0; j < 4; ++j) {
            const float r = __shfl(rstd, 4 * fq + j);
#pragma unroll
            for (int n = 0; n < 5; ++n) lgs[(wid * 16 + 4 * fq + j) * 80 + (n < 4 ? 4 * fr + n : 64 + fr)] = acc[n][j] * r;
        }
        __syncthreads();
        if (tid < 64) {
            const float* lt = lgs + tid * 80;
            float gl[4]; float gm = -INFINITY; int gi = 0;
#pragma unroll
            for (int i = 0; i < 4; ++i) { gl[i] = lt[64 + i]; if (gl[i] > gm) { gm = gl[i]; gi = i; } }
            float gsum = 0.f;
#pragma unroll
            for (int i = 0; i < 4; ++i) gsum += __expf(gl[i] - gm);
            const float gprob = 1.0f / gsum;
            float m0 = -INFINITY, m1 = -INFINITY; int i0 = 0, i1 = 0;
            for (int i = 0; i < 16; ++i) { const float v = lt[gi * 16 + i]; if (v > m0) { m1 = m0; i1 = i0; m0 = v; i0 = i; } else if (v > m1) { m1 = v; i1 = i; } }
            const float e1 = __expf(m1 - m0), den = 1.0f + e1;
            const int ex0 = gi * 16 + i0, ex1 = gi * 16 + i1;
            dec_e[tid * 2] = ex0; dec_e[tid * 2 + 1] = ex1;
            dec_g[tid * 2] = gprob / den; dec_g[tid * 2 + 1] = gprob * e1 / den;
            dec_r[tid * 2] = atomicAdd(&hist[ex0], 1); dec_r[tid * 2 + 1] = atomicAdd(&hist[ex1], 1);
        }
        __syncthreads();
        if (tid < 64) gb[tid] = hist[tid] > 0 ? atomicAdd(&gcur[tid * CNTS], hist[tid]) : 0;
        __syncthreads();
        if (tid < 128) {
            const int slot = ch * 128 + tid, ex = dec_e[tid];
            list[(size_t)ex * MOE_CAP + gb[ex] + dec_r[tid]] = slot;
            tok_g[slot] = dec_g[tid];
        }
        __syncthreads();
    }
}

template <int MODE = 0>
__device__ __forceinline__ void ph_moe_gemm(const Params& p, char* smem, int which, int L) {
    int* tpre = (int*)(smem + 73728);
    int* e_cnt = tpre + 68;
    int* e_base = e_cnt + 64;
    int* tpreS = e_base + 64;
    const int* gcur = (const int*)(p.ws + OFF_MOECNT) + L * 64 * CNTS;
    const int* list = (const int*)(p.ws + MOE_LIST); const float* tok_g = (const float*)(p.ws + M_TOKG);
    const bf16_t* H = (const bf16_t*)(p.ws + OFF_H);
    bf16_t* HID = (bf16_t*)(p.ws + HID_OFF);
    bf16_t* Y = (bf16_t*)(p.ws + B_Y);
    const int tid = hidden_tid();
    const bool aff = (gridDim.x & 7) == 0;
    const int xcd = blockIdx.x & 7;
    const int nvis = aff ? 8 : 64;
    if (tid == 0) {
        int rb = 0; for (int i = 0; i < 64; ++i) { const int c = gcur[i * CNTS]; e_cnt[i] = c; e_base[i] = rb; rb += c; }
        int ab = 0, as = 0;
        for (int v = 0; v < nvis; ++v) {
            const int c = e_cnt[aff ? xcd + 8 * v : v], rem = c & 255;
            tpre[v] = ab; tpreS[v] = as; ab += (c >> 8) + (rem > 128 ? 1 : 0); as += (rem > 0 && rem <= 128) ? 1 : 0;
        }
        tpre[nvis] = ab; tpreS[nvis] = as;
    }
    __syncthreads();
    const int NB = tpre[nvis] * 8, NS = tpreS[nvis] * 8;
    const int lstart = aff ? (blockIdx.x >> 3) : blockIdx.x, lstep = aff ? (gridDim.x >> 3) : gridDim.x;
    int rowbase = 0, cnt = 0, bas = 0, nt = 0;
    const int* elist = list;
    auto epi0 = [&](const float* E, int rb, int wc) {
        const int lane = hidden_tid() & 63;
#pragma unroll 1
        for (int i = 0; i < 4; ++i) {
            const int u = lane + 64 * i, r = u >> 2, c8 = (u & 3) * 8, rr = rowbase + rb + r;
            float g[8], up[8], o[8];
            ld8f(E + r * EP2 + c8, g); ld8f(E + r * EP2 + 32 + c8, up);
#pragma unroll
            for (int e = 0; e < 8; ++e) o[e] = g[e] / (1.0f + __expf(-g[e])) * up[e];
            if (rr < cnt) st8bf(HID + (size_t)(bas + rr) * EH + (nt * 2 + wc) * 32 + c8, o);
        }
    };
    int sl = -1;
    int* slotL = (int*)(smem + 74816);
    auto epi1 = [&](const float* E, int rb, int wc) {
        const int t2 = hidden_tid(), lane = t2 & 63, c8 = (lane & 7) * 8;
        if (rb < 128) { slotL[t2] = sl; lds_barrier(); }
#pragma unroll
        for (int i = 0; i < 8; ++i) {
            const int r = (lane + 64 * i) >> 3, slot = slotL[rb + r];
            if (slot >= 0) {
                float x[8]; ld8f(E + r * EP2 + c8, x);
                st8bf(Y + (size_t)slot * DM + nt * 128 + wc * 64 + c8, x);
            }
        }
    };
    for (int it = lstart; it < NB + NS; it += lstep) {
        const bool big = it < NB;
        const int q = big ? it : it - NB, mtg = q >> 3;
        const int* pre = big ? tpre : tpreS;
        nt = q & 7;
        int v = 0;
        { int lo = 0, hi = nvis - 1; while (lo < hi) { const int mid = (lo + hi + 1) >> 1; if (pre[mid] <= mtg) lo = mid; else hi = mid - 1; } v = lo; }
        const int e = __builtin_amdgcn_readfirstlane(aff ? (xcd + 8 * v) : v);
        cnt = __builtin_amdgcn_readfirstlane(e_cnt[e]); bas = __builtin_amdgcn_readfirstlane(e_base[e]);
        rowbase = big ? __builtin_amdgcn_readfirstlane(mtg - pre[v]) * 256 : (cnt >> 8) * 256;
        elist = list + (size_t)e * MOE_CAP;
        const int r0 = rowbase + (tid >> 3);
        unsigned ao[8];
        if (which == 0) {
            const bf16_t* Bt = (const bf16_t*)(p.ws + W_GU) + (size_t)e * 1024 * 1024;
            const char* Bu = (const char*)(Bt + (size_t)(nt * 128) * DM);
            const unsigned bo = (unsigned)(((tid >> 3) * DM + GSW64(tid)) * 2);
            if (big) {
#pragma unroll
                for (int k = 0; k < 8; ++k) { const int r = r0 + (k >> 2) * 128 + (k & 3) * 32; const int tk = (r < cnt) ? (elist[r] >> 1) : 0; ao[k] = (unsigned)((tk * DM + GSW64(tid)) * 2); }
                gemm_tile_q<MODE>(smem, tid, (const char*)H, ao, Bu, bo, DM * 2, DM / 64, epi0);
            } else {
                unsigned a4[4];
#pragma unroll
                for (int k = 0; k < 4; ++k) { const int r = r0 + k * 32; const int tk = (r < cnt) ? (elist[r] >> 1) : 0; a4[k] = (unsigned)((tk * DM + GSW64(tid)) * 2); }
                gemm_tile_s(smem, tid, (const char*)H, a4, Bu, bo, DM * 2, DM / 64, epi0);
            }
        } else {
            sl = (rowbase + tid < cnt) ? elist[rowbase + tid] : -1;
            const bf16_t* Bt = (const bf16_t*)(p.ws + W_DN) + (size_t)e * 1024 * 512;
            const char* Bu = (const char*)(Bt + (size_t)(nt * 128) * EH);
            const unsigned bo = (unsigned)(((tid >> 3) * EH + GSW64(tid)) * 2);
            if (big) {
#pragma unroll
                for (int k = 0; k < 8; ++k) { const int r = r0 + (k >> 2) * 128 + (k & 3) * 32; ao[k] = (unsigned)((((r < cnt) ? (bas + r) : 0) * EH + GSW64(tid)) * 2); }
                gemm_tile_q<MODE>(smem, tid, (const char*)HID, ao, Bu, bo, EH * 2, EH / 64, epi1);
            } else {
                unsigned a4[4];
#pragma unroll
                for (int k = 0; k < 4; ++k) { const int r = r0 + k * 32; a4[k] = (unsigned)((((r < cnt) ? (bas + r) : 0) * EH + GSW64(tid)) * 2); }
                gemm_tile_s(smem, tid, (const char*)HID, a4, Bu, bo, EH * 2, EH / 64, epi1);
            }
        }
    }
}

struct KF { bf16x8 k[4][2]; };
struct VF { bf16x8 v[4][2]; };
struct St { float m, l; f32x4 o[4]; };
#define KEY_OF(kt, j, fq) (32 * ((kt) >> 1) + 8 * (fq) + 4 * ((kt) & 1) + (j))
__device__ __forceinline__ void st_init(St& st) {
    st.m = NEG_BIG; st.l = 0.f;
#pragma unroll
    for (int n = 0; n < 4; ++n) st.o[n] = (f32x4){0.f, 0.f, 0.f, 0.f};
}
__device__ __forceinline__ void load_k(KF& f, const bf16_t* kp, size_t ldk, int fr, int fq) {
    const bf16_t* base = kp + (size_t)(8 * (fr >> 2) + (fr & 3)) * ldk + fq * 8;
#pragma unroll
    for (int kt = 0; kt < 4; ++kt)
#pragma unroll
        for (int ks = 0; ks < 2; ++ks) f.k[kt][ks] = ld8(base + (size_t)(32 * (kt >> 1) + 4 * (kt & 1)) * ldk + ks * 32);
}
__device__ __forceinline__ void load_v(VF& f, const bf16_t* vp, size_t ldv, int fr, int fq) {
    const bf16_t* base = vp + (size_t)fr * ldv + fq * 8;
#pragma unroll
    for (int n = 0; n < 4; ++n)
#pragma unroll
        for (int h = 0; h < 2; ++h) f.v[n][h] = ld8(base + (size_t)(n * 16) * ldv + h * 32);
}
__device__ __forceinline__ void scores(const KF& f, const bf16x8 (&qf)[2], f32x4 (&s)[4]) {
#pragma unroll
    for (int kt = 0; kt < 4; ++kt) {
        s[kt] = mfma16(f.k[kt][0], qf[0], (f32x4){0.f, 0.f, 0.f, 0.f});
        s[kt] = mfma16(f.k[kt][1], qf[1], s[kt]);
    }
}
typedef unsigned u32x4 __attribute__((ext_vector_type(4)));
__device__ __forceinline__ void pv(const VF& f, const float (&p)[4][4], f32x4 (&o)[4]) {
#pragma unroll
    for (int h = 0; h < 2; ++h) {
        u32x4 w;
        w[0] = pack2(p[2 * h][0], p[2 * h][1]); w[1] = pack2(p[2 * h][2], p[2 * h][3]);
        w[2] = pack2(p[2 * h + 1][0], p[2 * h + 1][1]); w[3] = pack2(p[2 * h + 1][2], p[2 * h + 1][3]);
        const bf16x8 pb = __builtin_bit_cast(bf16x8, w);
#pragma unroll
        for (int n = 0; n < 4; ++n) o[n] = mfma16(f.v[n][h], pb, o[n]);
    }
}
template <bool FULL, class MaskFn>
__device__ __forceinline__ void softmax_step(const f32x4 (&s)[4], MaskFn mask, St& st, float (&p)[4][4], int fq) {
    float mx = -INFINITY; bool v[4][4];
#pragma unroll
    for (int kt = 0; kt < 4; ++kt)
#pragma unroll
        for (int j = 0; j < 4; ++j) {
            if (FULL) { v[kt][j] = true; mx = fmaxf(mx, s[kt][j]); }
            else { v[kt][j] = mask(KEY_OF(kt, j, fq)); mx = fmaxf(mx, v[kt][j] ? s[kt][j] : -INFINITY); }
        }
    mx = quad_max(mx);
    if (!__all(mx <= st.m)) {
        const float mn = fmaxf(st.m, mx), alpha = ex2(st.m - mn);
        st.l *= alpha; st.m = mn;
#pragma unroll
        for (int n = 0; n < 4; ++n) st.o[n] *= alpha;
    }
    float sum = 0.f;
#pragma unroll
    for (int kt = 0; kt < 4; ++kt)
#pragma unroll
        for (int j = 0; j < 4; ++j) { p[kt][j] = (FULL || v[kt][j]) ? ex2(s[kt][j] - st.m) : 0.f; sum += p[kt][j]; }
    st.l += sum;
}
template <bool PF = true, class AddrFn, class MaskFn, class FullFn>
__device__ __forceinline__ void attn_run(const bf16x8 (&qf)[2], int nsteps, AddrFn addr, size_t ldk, size_t ldv, MaskFn mask, FullFn full, St& st, int fr, int fq) {
    if (nsteps <= 0) return;
    const bf16_t* kp; const bf16_t* vp; addr(0, kp, vp);
    if (PF) {
        KF kc; load_k(kc, kp, ldk, fr, fq);
        for (int s = 0; s < nsteps; ++s) {
            VF vf; load_v(vf, vp, ldv, fr, fq);
            const bf16_t* kp2 = kp; const bf16_t* vp2 = vp;
            if (s + 1 < nsteps) addr(s + 1, kp2, vp2);
            KF kn; load_k(kn, kp2, ldk, fr, fq);
            f32x4 sc[4]; scores(kc, qf, sc);
            float p[4][4];
            if (full(s)) softmax_step<true>(sc, [&](int key) { return mask(s, key); }, st, p, fq); else softmax_step<false>(sc, [&](int key) { return mask(s, key); }, st, p, fq);
            pv(vf, p, st.o);
            kc = kn; kp = kp2; vp = vp2;
        }
    } else {
        for (int s = 0; s < nsteps; ++s) {
            addr(s, kp, vp);
            KF kc; load_k(kc, kp, ldk, fr, fq);
            VF vf; load_v(vf, vp, ldv, fr, fq);
            f32x4 sc[4]; scores(kc, qf, sc);
            float p[4][4];
            if (full(s)) softmax_step<true>(sc, [&](int key) { return mask(s, key); }, st, p, fq); else softmax_step<false>(sc, [&](int key) { return mask(s, key); }, st, p, fq);
            pv(vf, p, st.o);
        }
    }
}
__device__ __forceinline__ void st_part(bf16_t* p32, const f32x4 (&o)[4]) {
    uint4* q = (uint4*)p32;
    q[0] = make_uint4(pack2(o[0][0], o[0][1]), pack2(o[0][2], o[0][3]), pack2(o[1][0], o[1][1]), pack2(o[1][2], o[1][3]));
    q[1] = make_uint4(pack2(o[2][0], o[2][1]), pack2(o[2][2], o[2][3]), pack2(o[3][0], o[3][1]), pack2(o[3][2], o[3][3]));
}
__device__ __forceinline__ void acc_part(const bf16_t* p32, float c, f32x4 (&o)[4]) {
    const uint4 a = ((const uint4*)p32)[0], b = ((const uint4*)p32)[1];
    const unsigned w[8] = {a.x, a.y, a.z, a.w, b.x, b.y, b.z, b.w};
#pragma unroll
    for (int n = 0; n < 4; ++n) {
        o[n][0] += c * __uint_as_float(w[2 * n] << 16); o[n][1] += c * __uint_as_float(w[2 * n] & 0xFFFF0000u);
        o[n][2] += c * __uint_as_float(w[2 * n + 1] << 16); o[n][3] += c * __uint_as_float(w[2 * n + 1] & 0xFFFF0000u);
    }
}
__device__ __forceinline__ void store_o4(bf16_t* dst, float a, float b, float c, float d) { *(uint2*)dst = make_uint2(pack2(a, b), pack2(c, d)); }

struct Stager {
    size_t ko, vo, ldk32, ldv32; int tid;
    __device__ __forceinline__ void init(int tid_, size_t ldk, size_t ldv) {
        tid = tid_;
        const int row = tid >> 3, c = tid & 7;
        const int gk = ((tid >> 4) & 1) | (((tid >> 6) & 3) << 1), gv = (tid >> 4) & 7;
        ko = (size_t)row * ldk + (c ^ gk) * 8;
        vo = (size_t)row * ldv + (c ^ gv) * 8;
        ldk32 = 32 * ldk; ldv32 = 32 * ldv;
    }
    __device__ __forceinline__ void stage_k(char* buf, const bf16_t* kp) const { glds16(kp + ko, buf + tid * 16); glds16(kp + ko + ldk32, buf + 4096 + tid * 16); }
    __device__ __forceinline__ void stage_v(char* buf, const bf16_t* vp) const { glds16(vp + vo, buf + 8192 + tid * 16); glds16(vp + vo + ldv32, buf + 12288 + tid * 16); }
};
__device__ __forceinline__ void lds_k(KF& f, const char* buf, int lane) {
    const int fr = lane & 15, fq = lane >> 4;
    const int gk = ((fr >> 1) & 1) | (((fr >> 2) & 3) << 1);
    const char* base = buf + (8 * (fr >> 2) + (fr & 3)) * 128;
#pragma unroll
    for (int kt = 0; kt < 4; ++kt)
#pragma unroll
        for (int ks = 0; ks < 2; ++ks) f.k[kt][ks] = *(const bf16x8*)(base + (32 * (kt >> 1) + 4 * (kt & 1)) * 128 + (((ks * 4 + fq) ^ gk) * 16));
}
__device__ __forceinline__ void lds_v(VF& f, const char* buf, int lane) {
    const int fr = lane & 15, fq = lane >> 4;
    const int gv = (fr >> 1) & 7;
    const char* base = buf + 8192 + fr * 128;
#pragma unroll
    for (int n = 0; n < 4; ++n)
#pragma unroll
        for (int h = 0; h < 2; ++h) f.v[n][h] = *(const bf16x8*)(base + n * 16 * 128 + (((h * 4 + fq) ^ gv) * 16));
}
#define LDS_RING(s) ((s) % 3 * 16384)
template <class AddrFn, class MaskFn, class FullFn>
__device__ __forceinline__ void attn_run_lds(char* smem, const Stager& sg, const bf16x8 (&qf)[2], int nsteps, AddrFn addr, MaskFn mask, FullFn full, St& st, int lane, int fq) {
    if (nsteps <= 0) return;
    const bf16_t* kp; const bf16_t* vp;
    asm volatile("s_waitcnt vmcnt(0)" ::: "memory");
    addr(0, kp, vp); sg.stage_k(smem, kp); sg.stage_v(smem, vp);
    if (nsteps > 1) { addr(1, kp, vp); sg.stage_k(smem + 16384, kp); sg.stage_v(smem + 16384, vp); }
    for (int s = 0; s < nsteps; ++s) {
        const char* cur = smem + LDS_RING(s);
        if (s + 1 < nsteps) asm volatile("s_waitcnt vmcnt(4)" ::: "memory"); else asm volatile("s_waitcnt vmcnt(0)" ::: "memory");
        __builtin_amdgcn_s_barrier();
        asm volatile("" ::: "memory");
        if (s + 2 < nsteps) { addr(s + 2, kp, vp); char* nxt = smem + LDS_RING(s + 2); sg.stage_k(nxt, kp); sg.stage_v(nxt, vp); }
        KF kc; lds_k(kc, cur, lane);
        VF vf; lds_v(vf, cur, lane);
        f32x4 sc[4]; scores(kc, qf, sc);
        float p[4][4];
        if (full(s)) softmax_step<true>(sc, [&](int key) { return mask(s, key); }, st, p, fq); else softmax_step<false>(sc, [&](int key) { return mask(s, key); }, st, p, fq);
        pv(vf, p, st.o);
    }
    lds_barrier();
}

template <class AddrFn, class MaskFn, class FullFn>
__device__ __forceinline__ void attn_run_lds2(char* smem, const Stager& sg, const bf16x8 (&qf)[2][2], int nsteps, AddrFn addr, MaskFn mask, FullFn full, St (&st)[2], int lane, int fq) {
    if (nsteps <= 0) return;
    const bf16_t* kp; const bf16_t* vp;
    asm volatile("s_waitcnt vmcnt(0)" ::: "memory");
    addr(0, kp, vp); sg.stage_k(smem, kp); sg.stage_v(smem, vp);
    if (nsteps > 1) { addr(1, kp, vp); sg.stage_k(smem + 16384, kp); sg.stage_v(smem + 16384, vp); }
    for (int s = 0; s < nsteps; ++s) {
        const char* cur = smem + LDS_RING(s);
        if (s + 1 < nsteps) asm volatile("s_waitcnt vmcnt(4)" ::: "memory"); else asm volatile("s_waitcnt vmcnt(0)" ::: "memory");
        __builtin_amdgcn_s_barrier();
        asm volatile("" ::: "memory");
        if (s + 2 < nsteps) { addr(s + 2, kp, vp); char* nxt = smem + LDS_RING(s + 2); sg.stage_k(nxt, kp); sg.stage_v(nxt, vp); }
        KF kc; lds_k(kc, cur, lane);
        VF vf; lds_v(vf, cur, lane);
#pragma unroll
        for (int r = 0; r < 2; ++r) {
            f32x4 sc[4]; scores(kc, qf[r], sc);
            float p[4][4];
            if (full(r, s)) softmax_step<true>(sc, [&](int key) { return mask(r, s, key); }, st[r], p, fq); else softmax_step<false>(sc, [&](int key) { return mask(r, s, key); }, st[r], p, fq);
            pv(vf, p, st[r].o);
        }
    }
    lds_barrier();
}

__device__ __forceinline__ void ph_attn0(const Params& p, char* smem) {
    const bf16_t* Q = (const bf16_t*)(p.ws + OFF_QKV);
    const bf16_t* VT = (const bf16_t*)(p.ws + OFF_VT);
    bf16_t* O = (bf16_t*)(p.ws + OFF_O);
    const int tid = (int)threadIdx.x, lane = tid & 63, wid = tid >> 6, fr = lane & 15, fq = lane >> 4;
    Stager sg; sg.init(tid, LDQ, VLD);
    for (int it = blockIdx.x; it < 2 * 2 * (SEQ / 32); it += gridDim.x) {
        const int tt = it % (SEQ / 32), hkv = (it / (SEQ / 32)) & 1, b = it / (2 * (SEQ / 32));
        const int head = hkv * 4 + wid, t0 = tt * 32;
        const size_t rowb = (size_t)b * SEQ;
        bf16x8 qf[2][2]; St st[2];
#pragma unroll
        for (int r = 0; r < 2; ++r) {
            const bf16_t* qp = Q + (rowb + t0 + 16 * r + fr) * LDQ + head * 64;
            qf[r][0] = ld8(qp + fq * 8); qf[r][1] = ld8(qp + 32 + fq * 8);
            st_init(st[r]);
            st[r].m = p.sinks0[head] * LOG2E; st[r].l = (fq == 0) ? 1.f : 0.f;
        }
        int k0 = t0 - 127; if (k0 < 0) k0 = 0; k0 &= ~63;
        const int ns = ((t0 + 31 - k0) >> 6) + 1;
        const bf16_t* kbase = Q + rowb * LDQ + 512 + hkv * 64;
        const bf16_t* vbase = VT + ((size_t)(b * NVH + hkv) * 64) * VLD;
        attn_run_lds2(smem, sg, qf, ns, [&](int s, const bf16_t*& kp, const bf16_t*& vp) { const int kb = k0 + 64 * s; kp = kbase + (size_t)kb * LDQ; vp = vbase + kb; },
                      [&](int r, int s, int key) { const int k = k0 + 64 * s + key, t = t0 + 16 * r + fr; return (k <= t) && (t - k < 128); },
                      [&](int r, int s) { const int kb = k0 + 64 * s, tb = t0 + 16 * r; return (kb + 63 <= tb) && (tb + 15 - kb < 128); }, st, lane, fq);
#pragma unroll
        for (int r = 0; r < 2; ++r) {
            const float inv = 1.0f / quad_sum(st[r].l);
#pragma unroll
            for (int n = 0; n < 4; ++n) store_o4(O + (rowb + t0 + 16 * r + fr) * DM + head * 64 + n * 16 + 4 * fq, st[r].o[n][0] * inv, st[r].o[n][1] * inv, st[r].o[n][2] * inv, st[r].o[n][3] * inv);
        }
    }
    int* vote = (int*)(smem + 49152);
    for (int it = blockIdx.x; it < 2 * 8 * (SEQ / 64); it += gridDim.x) {
        const int tt = it % (SEQ / 64), head = (it / (SEQ / 64)) & 7, b = it / (8 * (SEQ / 64));
        const int tb0 = tt * 64, t = tb0 + 16 * wid + fr;
        const size_t rowb = (size_t)b * SEQ;
        bf16x8 qf[2];
        qf[0] = ld8(Q + (rowb + t) * LDQ + 768 + head * 64 + fq * 8);
        qf[1] = ld8(Q + (rowb + t) * LDQ + 768 + head * 64 + 32 + fq * 8);
        f32x4 o[4];
#pragma unroll
        for (int n = 0; n < 4; ++n) o[n] = (f32x4){0.f, 0.f, 0.f, 0.f};
        float R = 0.f;
        const bf16_t* kbase = Q + rowb * LDQ + 1280 + head * 64;
        const bf16_t* vbase = VT + ((size_t)(b * NVH + 2 + head) * 64) * VLD;
        const int nsteps = tt + 1;
        if (tid < 8) vote[tid] = 0;
        asm volatile("s_waitcnt vmcnt(0)" ::: "memory");
        sg.stage_k(smem, kbase + (size_t)tb0 * LDQ); sg.stage_v(smem, vbase + tb0);
        if (nsteps > 1) { sg.stage_k(smem + 16384, kbase + (size_t)(tb0 - 64) * LDQ); sg.stage_v(smem + 16384, vbase + tb0 - 64); }
        bool mine_done = false;
        for (int s = 0; s < nsteps; ++s) {
            const char* cur = smem + LDS_RING(s);
            const int kb = tb0 - 64 * s;
            if (s + 1 < nsteps) asm volatile("s_waitcnt vmcnt(4)" ::: "memory"); else asm volatile("s_waitcnt vmcnt(0)" ::: "memory");
            lds_fence();
            __builtin_amdgcn_s_barrier();
            asm volatile("" ::: "memory");
            if (s > 0) { const int* vv = vote + ((s - 1) & 1) * 4; if ((vv[0] & vv[1] & vv[2] & vv[3]) != 0) break; }
            if (s + 2 < nsteps) { char* nxt = smem + LDS_RING(s + 2); sg.stage_k(nxt, kbase + (size_t)(kb - 128) * LDQ); sg.stage_v(nxt, vbase + kb - 128); }
            if (!mine_done) {
                KF kc; lds_k(kc, cur, lane);
                VF vf; lds_v(vf, cur, lane);
                f32x4 sc[4]; scores(kc, qf, sc);
                float w4[4][4], ex[4][4], lsg[4][4];
                float T[2];
#pragma unroll
                for (int h = 0; h < 2; ++h) {
                    float run = 0.f;
#pragma unroll
                    for (int q = 1; q >= 0; --q) {
                        const int kt = 2 * h + q;
#pragma unroll
                        for (int j = 3; j >= 0; --j) {
                            const float z = sc[kt][j];
                            const bool v = (kb + KEY_OF(kt, j, fq)) < t;
                            const float sp = fmaxf(z, 0.f) + __logf(1.0f + __expf(-fabsf(z)));
                            ex[kt][j] = run;
                            lsg[kt][j] = v ? (z - sp) : -INFINITY;
                            run += v ? -sp : 0.f;
                        }
                    }
                    T[h] = run;
                }
                float E[2], Tot[2];
#pragma unroll
                for (int h = 0; h < 2; ++h) {
                    const float a0 = __shfl(T[h], fr), a1 = __shfl(T[h], fr + 16), a2 = __shfl(T[h], fr + 32), a3 = __shfl(T[h], fr + 48);
                    Tot[h] = (a0 + a1) + (a2 + a3);
                    E[h] = (fq < 1 ? a1 : 0.f) + (fq < 2 ? a2 : 0.f) + (fq < 3 ? a3 : 0.f);
                }
#pragma unroll
                for (int kt = 0; kt < 4; ++kt) {
                    const float off = (kt >> 1) ? (R + E[1]) : (R + Tot[1] + E[0]);
#pragma unroll
                    for (int j = 0; j < 4; ++j) w4[kt][j] = __expf(lsg[kt][j] + off + ex[kt][j]);
                }
                R += Tot[0] + Tot[1];
                pv(vf, w4, o);
                if (__all(R < -104.f)) mine_done = true;
            }
            if (lane == 0) vote[(s & 1) * 4 + wid] = mine_done ? 1 : 0;
        }
        asm volatile("s_waitcnt vmcnt(0)" ::: "memory");
        __syncthreads();
#pragma unroll
        for (int n = 0; n < 4; ++n) store_o4(O + (rowb + t) * DM + 512 + head * 64 + n * 16 + 4 * fq, o[n][0], o[n][1], o[n][2], o[n][3]);
    }
}

__device__ __forceinline__ void ph_kmean(const Params& p) {
    const bf16_t* Q = (const bf16_t*)(p.ws + OFF_QKV);
    float* KM = (float*)(p.ws + B_KMEAN);
    const int tidh = hidden_tid(), lane = tidh & 63, wid = tidh >> 6;
    const int c = lane & 7, r = lane >> 3;
    const int nw = gridDim.x * 4, w0 = ((blockIdx.x + gridDim.x - (gridDim.x > 128 ? 128 : 0)) % gridDim.x) * 4 + wid;
    for (int wi = w0; wi < 256; wi += nw) {
        const int hkv = wi & 1, j = (wi >> 1) & 63, b = wi >> 7;
        const bf16_t* base = Q + ((size_t)b * SEQ + j * 256 + r) * LDQ + 512 + hkv * 64 + c * 8;
        float acc[8] = {0.f, 0.f, 0.f, 0.f, 0.f, 0.f, 0.f, 0.f};
#pragma unroll 8
        for (int i = 0; i < 32; ++i) {
            const bf16x8 v = ld8(base + (size_t)(8 * i) * LDQ);
#pragma unroll
            for (int e = 0; e < 8; ++e) acc[e] += bf2f((bf16_t)v[e]);
        }
#pragma unroll
        for (int e = 0; e < 8; ++e) { float a = acc[e]; a += __shfl_xor(a, 8); a += __shfl_xor(a, 16); a += __shfl_xor(a, 32); acc[e] = a; }
        if (r == 0) {
            float* o = KM + ((b * 64 + j) * 2 + hkv) * 64 + c * 8;
            *(float4*)o = make_float4(acc[0] * (1.0f / 256.0f), acc[1] * (1.0f / 256.0f), acc[2] * (1.0f / 256.0f), acc[3] * (1.0f / 256.0f));
            *(float4*)(o + 4) = make_float4(acc[4] * (1.0f / 256.0f), acc[5] * (1.0f / 256.0f), acc[6] * (1.0f / 256.0f), acc[7] * (1.0f / 256.0f));
        }
    }
}
__device__ __forceinline__ size_t moba_list_off(int L, int j) { return (size_t)L * MOBA_LCAP + 1024ull * (size_t)(63 * j - (j * (j - 1)) / 2); }

__device__ __forceinline__ void ph_moba_gate(const Params& p, char* smem) {
    float* km = (float*)smem;
    int* cnt = (int*)(smem + 16384);
    int* gbase = cnt + 64;
    const bf16_t* Q = (const bf16_t*)(p.ws + OFF_QKV);
    const float* KM = (const float*)(p.ws + B_KMEAN);
    int* gcnt = (int*)(p.ws + OFF_MOBACNT);
    int* lists = (int*)(p.ws + B_LIST);
    const int tid = hidden_tid();
    for (int it = blockIdx.x; it < 1024; it += gridDim.x) {
        const int tc = it & 255, hkv = (it >> 8) & 1, b = it >> 9, LL = b * 2 + hkv;
        const int tl = tc * 64 + (tid >> 2), g = tid & 3, own = tl >> 8;
        for (int i = tid; i < 64 * 64; i += 256) { const int j = i >> 6, d = i & 63; km[i] = KM[((b * 64 + j) * 2 + hkv) * 64 + d]; }
        if (tid < 64) cnt[tid] = 0;
        __syncthreads();
        float q[64];
        {
            const bf16_t* qp = Q + ((size_t)b * SEQ + tl) * LDQ + (hkv * 4 + g) * 64;
#pragma unroll
            for (int i = 0; i < 8; ++i) { const bf16x8 v = ld8(qp + i * 8);
#pragma unroll
                for (int e = 0; e < 8; ++e) q[i * 8 + e] = bf2f((bf16_t)v[e]); }
        }
        float bv0 = -INFINITY, bv1 = -INFINITY, bv2 = -INFINITY; int bi0 = 0, bi1 = 1, bi2 = 2;
        for (int j = 0; j < own; ++j) {
            float s = 0.f;
#pragma unroll
            for (int d = 0; d < 64; d += 4) { const float4 k = *(const float4*)(km + j * 64 + d); s += q[d] * k.x; s += q[d + 1] * k.y; s += q[d + 2] * k.z; s += q[d + 3] * k.w; }
            if (s > bv0) { bv2 = bv1; bi2 = bi1; bv1 = bv0; bi1 = bi0; bv0 = s; bi0 = j; }
            else if (s > bv1) { bv2 = bv1; bi2 = bi1; bv1 = s; bi1 = j; }
            else if (s > bv2) { bv2 = s; bi2 = j; }
        }
        const int nv = own < 3 ? own : 3;
        int rk0 = 0, rk1 = 0, rk2 = 0;
        if (nv > 0) rk0 = atomicAdd(&cnt[bi0], 1);
        if (nv > 1) rk1 = atomicAdd(&cnt[bi1], 1);
        if (nv > 2) rk2 = atomicAdd(&cnt[bi2], 1);
        __syncthreads();
        if (tid < 64 && cnt[tid] > 0) gbase[tid] = atomicAdd(&gcnt[(LL * 64 + tid) * CNTS], cnt[tid]);
        __syncthreads();
        const int ent = tl | (g << 14);
        if (nv > 0) lists[moba_list_off(LL, bi0) + gbase[bi0] + rk0] = ent | (0 << 16);
        if (nv > 1) lists[moba_list_off(LL, bi1) + gbase[bi1] + rk1] = ent | (1 << 16);
        if (nv > 2) lists[moba_list_off(LL, bi2) + gbase[bi2] + rk2] = ent | (2 << 16);
        __syncthreads();
    }
}

__device__ __forceinline__ void ph_moba_part(const Params& p, char* smem) {
    int* cpre = (int*)(smem + 49152);
    const bf16_t* Q = (const bf16_t*)(p.ws + OFF_QKV);
    const bf16_t* VT = (const bf16_t*)(p.ws + OFF_VT);
    const int* gcnt = (const int*)(p.ws + OFF_MOBACNT);
    const int* lists = (const int*)(p.ws + B_LIST);
    bf16_t* PO = (bf16_t*)(p.ws + B_PO); float* PML = (float*)(p.ws + B_PML);
    const int tid = (int)threadIdx.x, lane = tid & 63, wid = tid >> 6, fr = lane & 15, fq = lane >> 4;
    Stager sg; sg.init(tid, LDQ, VLD);
    cpre[tid + 1] = (gcnt[tid * CNTS] + 127) >> 7;
    if (tid == 0) cpre[0] = 0;
    __syncthreads();
    if (tid == 0) { int acc = 0; for (int i = 1; i <= 256; ++i) { acc += cpre[i]; cpre[i] = acc; } }
    __syncthreads();
    const int total = cpre[256];
    for (int it = blockIdx.x; it < total; it += gridDim.x) {
        int li;
        { int lo = 0, hi = 255; while (lo < hi) { const int mid = (lo + hi + 1) >> 1; if (cpre[mid] <= it) lo = mid; else hi = mid - 1; } li = lo; }
        const int chunk = it - cpre[li], LL = li >> 6, j = li & 63, b = LL >> 1, hkv = LL & 1, n = gcnt[li * CNTS];
        const int* lst = lists + moba_list_off(LL, j);
        int ent[2]; bf16x8 qf[2][2]; St st[2];
#pragma unroll
        for (int r = 0; r < 2; ++r) {
            const int ri = chunk * 128 + r * 64 + wid * 16 + fr;
            ent[r] = lst[ri < n ? ri : n - 1];
            const bf16_t* qp = Q + ((size_t)b * SEQ + (ent[r] & 16383)) * LDQ + (hkv * 4 + ((ent[r] >> 14) & 3)) * 64;
            qf[r][0] = ld8(qp + fq * 8); qf[r][1] = ld8(qp + 32 + fq * 8);
            st_init(st[r]);
        }
        const bf16_t* kbase = Q + ((size_t)b * SEQ + j * 256) * LDQ + 512 + hkv * 64;
        const bf16_t* vbase = VT + ((size_t)(b * NVH + hkv) * 64) * VLD + j * 256;
        attn_run_lds2(smem, sg, qf, 4, [&](int s, const bf16_t*& kp, const bf16_t*& vp) { kp = kbase + (size_t)(64 * s) * LDQ; vp = vbase + 64 * s; },
                      [](int, int, int) { return true; }, [](int, int) { return true; }, st, lane, fq);
#pragma unroll
        for (int r = 0; r < 2; ++r) {
            const int ri = chunk * 128 + r * 64 + wid * 16 + fr;
            const float l = quad_sum(st[r].l);
            if (ri < n) {
                const int e = ent[r];
                const size_t idx = ((size_t)((size_t)b * SEQ + (e & 16383)) * 8 + hkv * 4 + ((e >> 14) & 3)) * 3 + ((e >> 16) & 3);
                st_part(PO + idx * 64 + fq * 16, st[r].o);
                if (fq == 0) { PML[idx * 2] = st[r].m; PML[idx * 2 + 1] = l; }
            }
        }
    }
}

__device__ __forceinline__ void ph_moba_own(const Params& p, char* smem) {
    const bf16_t* Q = (const bf16_t*)(p.ws + OFF_QKV);
    const bf16_t* VT = (const bf16_t*)(p.ws + OFF_VT);
    const bf16_t* PO = (const bf16_t*)(p.ws + B_PO); const float* PML = (const float*)(p.ws + B_PML);
    bf16_t* O = (bf16_t*)(p.ws + OFF_O);
    const int tid = (int)threadIdx.x, lane = tid & 63, wid = tid >> 6, fr = lane & 15, fq = lane >> 4;
    Stager sg; sg.init(tid, LDQ, VLD);
    for (int it = blockIdx.x; it < 2 * 2 * (SEQ / 32); it += gridDim.x) {
        const int hb = it / (SEQ / 32), tt = (it % (SEQ / 32) + 3 * hb) % (SEQ / 32), hkv = hb & 1, b = hb >> 1;
        const int head = hkv * 4 + wid, t0 = tt * 32, own = t0 >> 8;
        const size_t rowb = (size_t)b * SEQ;
        bf16x8 qf[2][2]; St st[2];
#pragma unroll
        for (int r = 0; r < 2; ++r) {
            const bf16_t* qp = Q + (rowb + t0 + 16 * r + fr) * LDQ + head * 64;
            qf[r][0] = ld8(qp + fq * 8); qf[r][1] = ld8(qp + 32 + fq * 8);
            st_init(st[r]);
        }
        const int k0 = own * 256, ns = ((t0 + 31 - k0) >> 6) + 1;
        const bf16_t* kbase = Q + rowb * LDQ + 512 + hkv * 64;
        const bf16_t* vbase = VT + ((size_t)(b * NVH + hkv) * 64) * VLD;
        attn_run_lds2(smem, sg, qf, ns, [&](int s, const bf16_t*& kp, const bf16_t*& vp) { const int kb = k0 + 64 * s; kp = kbase + (size_t)kb * LDQ; vp = vbase + kb; },
                      [&](int r, int s, int key) { return (k0 + 64 * s + key) <= (t0 + 16 * r + fr); },
                      [&](int r, int s) { return (k0 + 64 * s + 63) <= (t0 + 16 * r); }, st, lane, fq);
        const int nv = own < 3 ? own : 3;
#pragma unroll
        for (int r = 0; r < 2; ++r) {
            const int t = t0 + 16 * r + fr;
            float l = quad_sum(st[r].l), m = st[r].m;
            for (int q = 0; q < nv; ++q) {
                const size_t idx = ((size_t)(rowb + t) * 8 + head) * 3 + q;
                const float mr = PML[idx * 2], lr = PML[idx * 2 + 1];
                const float mn = fmaxf(m, mr), a = ex2(m - mn), c = ex2(mr - mn);
#pragma unroll
                for (int n = 0; n < 4; ++n) st[r].o[n] *= a;
                acc_part(PO + idx * 64 + fq * 16, c, st[r].o);
                l = l * a + c * lr; m = mn;
            }
            const float inv = 1.0f / l;
#pragma unroll
            for (int n = 0; n < 4; ++n) store_o4(O + (rowb + t) * DM + head * 64 + n * 16 + 4 * fq, st[r].o[n][0] * inv, st[r].o[n][1] * inv, st[r].o[n][2] * inv, st[r].o[n][3] * inv);
        }
    }
}

__device__ __forceinline__ float gelu_tanh(float x) {
    const float u = 0.7978845608028654f * (x + 0.044715f * x * x * x);
    const float e = __expf(2.0f * u);
    const float th = 1.0f - 2.0f / (e + 1.0f);
    return 0.5f * x * (1.0f + th);
}
__device__ __forceinline__ void ph_cmp1(const Params& p, char* smem) {
    const bf16_t* Q = (const bf16_t*)(p.ws + OFF_QKV);
    const int tid = hidden_tid();
    for (int it = blockIdx.x; it < 128; it += gridDim.x) {
        const int kv = it >> 6, mt = (it >> 1) & 31, nt = it & 1;
        const int col = kv ? 1408 : 1280;
        const bf16_t* Bt = (const bf16_t*)(p.ws + (kv ? W_V1 : W_K1));
        const float* bias = (const float*)(p.ws + (kv ? W_BV : W_BK));
        bf16_t* HID = (bf16_t*)(p.ws + (kv ? B_HIDV : B_HIDK));
        const bf16_t* ap[4];
#pragma unroll
        for (int i = 0; i < 4; ++i) {
            const int r = mt * 128 + i * 32 + (tid >> 3);
            const int h = r & 1, bc = r >> 1, c = bc & 1023, b = bc >> 10;
            const int cc = (c < NCMP) ? c : 0;
            ap[i] = Q + ((size_t)b * SEQ + 16 * cc) * LDQ + col + h * 64 + GSW64(tid);
        }
        const bf16_t* b0 = Bt + (size_t)(nt * 128 + (tid >> 3)) * 2048 + GSW64(tid);
        gemm_tile_k64(smem, tid, ap, b0, (size_t)32 * 2048, 32, [](int t) { return (size_t)t * LDQ; },
            [&](f32x4 (&acc)[4][4], int wr, int wc, int fr, int fq) {
#pragma unroll
                for (int m = 0; m < 4; ++m)
#pragma unroll
                    for (int j = 0; j < 4; ++j) {
                        const int r = mt * 128 + wr * 64 + m * 16 + fq * 4 + j;
#pragma unroll
                        for (int n = 0; n < 4; ++n) { const int cn = nt * 128 + wc * 64 + n * 16 + fr; HID[(size_t)r * 256 + cn] = f2bf(gelu_tanh(acc[m][n][j] + bias[cn])); }
                    }
            });
    }
}
__device__ __forceinline__ void ph_cmp2(const Params& p, char* smem) {
    const int tid = hidden_tid();
    for (int it = blockIdx.x; it < 64; it += gridDim.x) {
        const int kv = it >> 5, mt = it & 31;
        const bf16_t* A = (const bf16_t*)(p.ws + (kv ? B_HIDV : B_HIDK));
        const bf16_t* Bt = (const bf16_t*)(p.ws + (kv ? W_V2 : W_K2));
        bf16_t* KC = (bf16_t*)(p.ws + B_KCMP); bf16_t* VC = (bf16_t*)(p.ws + B_VCMPT);
        const bf16_t* a0 = A + (size_t)(mt * 128 + (tid >> 2)) * 256 + GSW(tid);
        const bf16_t* a1 = a0 + (size_t)64 * 256;
        const bf16_t* b0 = Bt + (size_t)(tid >> 2) * 256 + GSW(tid);
        const bf16_t* b1 = b0 + (size_t)64 * 256;
        gemm_tile(smem, a0, a1, b0, b1, 8, [](int t) { return (size_t)t * 32; },
            [&](f32x4 (&acc)[4][4], int wr, int wc, int fr, int fq) {
                if (wc != 0) return;
#pragma unroll
                for (int m = 0; m < 4; ++m)
#pragma unroll
                    for (int j = 0; j < 4; ++j) {
                        const int r = mt * 128 + wr * 64 + m * 16 + fq * 4 + j;
                        const int h = r & 1, bc = r >> 1, c = bc & 1023, b = bc >> 10;
                        const bool ok = c < NCMP;
#pragma unroll
                        for (int n = 0; n < 4; ++n) {
                            const int d = n * 16 + fr;
                            const bf16_t v = ok ? f2bf(acc[m][n][j]) : (bf16_t)0;
                            if (kv == 0) KC[((size_t)(b * 2 + h) * 1024 + c) * 64 + d] = v;
                            else VC[((size_t)(b * 2 + h) * 64 + d) * CLD + c] = v;
                        }
                    }
            });
    }
}

#ifndef PROBE_NSA
#define PROBE_NSA 0
#endif
#define NSA_T(i) if (PROBE_NSA) { const unsigned long long _n = clock64(); tsec[i] += _n - tprev; tprev = _n; }
__device__ __forceinline__ size_t nsa_list_off(int LL, int j) { return (size_t)LL * NSA_LCAP + 64ull * (size_t)(254 * j - (j * (j - 1)) / 2); }
__device__ __forceinline__ char* nsa_part_ptr(char* ws, int LL, int t, int slot) {
    const size_t rec = ((size_t)((LL & 1) * SEQ + t) * 13 + slot) * 544;
    return ws + ((LL >> 1) ? NSA_PY : NSA_PX) + rec;
}
struct NsaIter { bool aff; int xcd, i0, istr, icnt; };
__device__ __forceinline__ NsaIter nsa_iter() {
    NsaIter it; it.aff = (gridDim.x & 7) == 0; it.xcd = blockIdx.x & 7;
    it.i0 = it.aff ? (blockIdx.x >> 3) : blockIdx.x;
    it.istr = it.aff ? (gridDim.x >> 3) : gridDim.x;
    it.icnt = it.aff ? 512 : 4096;
    return it;
}

__device__ __forceinline__ void ph_nsa1(const Params& p, char* smem) {
    unsigned long long tsec[5] = {0, 0, 0, 0, 0}, tprev = 0;
    if (PROBE_NSA) tprev = clock64();
    const bf16_t* Q = (const bf16_t*)(p.ws + OFF_QKV);
    const bf16_t* VT = (const bf16_t*)(p.ws + OFF_VT);
    const bf16_t* KC = (const bf16_t*)(p.ws + B_KCMP); const bf16_t* VC = (const bf16_t*)(p.ws + B_VCMPT);
    const float* GD = (const float*)(p.ws + B_GD);
    bf16_t* O = (bf16_t*)(p.ws + OFF_O);
    unsigned char* SID = (unsigned char*)(p.ws + M_SELID);
    int* gcnt = (int*)(p.ws + OFF_NSACNT);
    unsigned short* lists = (unsigned short*)(p.ws + NSA_LISTS);
    unsigned char* lslot = (unsigned char*)(p.ws + NSA_SLOTS);
    const int tid = (int)threadIdx.x, lane = tid & 63, wid = tid >> 6, fr = lane & 15, fq = lane >> 4;
    float* imp = (float*)(smem + 49152 + wid * 5376);
    int* selq = (int*)(smem + 49152 + wid * 5376 + 4096);
    int* sc = (int*)(smem + 49152 + wid * 5376 + 4352);
    const int qi_l = fr >> 2, g_l = fr & 3;
    Stager sgc; sgc.init(tid, 64, CLD);
    Stager sgw; sgw.init(tid, LDQ, VLD);
    const NsaIter itr = nsa_iter();
    for (int ii = itr.i0; ii < itr.icnt; ii += itr.istr) {
        const int LL = itr.aff ? (itr.xcd & 3) : (ii >> 10);
        const int tqb = itr.aff ? (2 * ii + (itr.xcd >> 2)) : (ii & 1023);
        const int b = LL >> 1, hkv = LL & 1;
        const int tb0 = tqb * 16, t0 = tb0 + wid * 4, t = t0 + qi_l;
        const size_t rowb = (size_t)b * SEQ;
        bf16x8 qf[2];
        {
            const bf16_t* qp = Q + (rowb + t) * LDQ + 768 + (hkv * 4 + g_l) * 64;
            qf[0] = ld8(qp + fq * 8); qf[1] = ld8(qp + 32 + fq * 8);
        }
        const float* gp = GD + (rowb + t) * 24 + (hkv * 4 + g_l) * 3;
        f32x4 outa[4];
#pragma unroll
        for (int n = 0; n < 4; ++n) outa[n] = (f32x4){0.f, 0.f, 0.f, 0.f};
        const bf16_t* kc = KC + (size_t)LL * 1024 * 64;
        const bf16_t* vc = VC + (size_t)LL * 64 * CLD;
        const int cN = (tb0 + 15 >= 31) ? ((tb0 + 15 - 31) >> 4) + 1 : 0;
        const int csteps = (cN + 63) >> 6;
        float m1 = NEG_BIG, l1 = 0.f;
        if (csteps > 0) {
            const int cs2 = (csteps + 1) >> 1;
            auto stage2 = [&](int s2, char* buf) {
                const int ta = 2 * s2, tb = (2 * s2 + 1 < 16) ? 2 * s2 + 1 : 15;
                sgc.stage_k(buf, kc + (size_t)ta * 64 * 64); sgc.stage_k(buf + 8192, kc + (size_t)tb * 64 * 64);
            };
            asm volatile("s_waitcnt vmcnt(0)" ::: "memory");
            stage2(0, smem);
            if (cs2 > 1) stage2(1, smem + 16384);
            for (int s = 0; s < cs2; ++s) {
                const char* cur = smem + LDS_RING(s);
                if (s + 1 < cs2) asm volatile("s_waitcnt vmcnt(4)" ::: "memory"); else asm volatile("s_waitcnt vmcnt(0)" ::: "memory");
                __builtin_amdgcn_s_barrier();
                asm volatile("" ::: "memory");
                if (s + 2 < cs2) stage2(s + 2, smem + LDS_RING(s + 2));
                float mx = -INFINITY;
                f32x4 sc[2][4];
#pragma unroll
                for (int u = 0; u < 2; ++u) {
                    KF kcur; lds_k(kcur, cur + u * 8192, lane);
                    scores(kcur, qf, sc[u]);
#pragma unroll
                    for (int kt = 0; kt < 4; ++kt)
#pragma unroll
                        for (int j = 0; j < 4; ++j) { const bool v = (16 * ((2 * s + u) * 64 + KEY_OF(kt, j, fq)) + 31) <= t; mx = fmaxf(mx, v ? sc[u][kt][j] : -INFINITY); }
                }
                mx = quad_max(mx);
                const float mn = fmaxf(m1, mx);
                float sum = 0.f;
#pragma unroll
                for (int u = 0; u < 2; ++u)
#pragma unroll
                    for (int kt = 0; kt < 4; ++kt)
#pragma unroll
                        for (int j = 0; j < 4; ++j) { const bool v = (16 * ((2 * s + u) * 64 + KEY_OF(kt, j, fq)) + 31) <= t; sum += v ? ex2(sc[u][kt][j] - mn) : 0.f; }
                l1 = l1 * ex2(m1 - mn) + sum; m1 = mn;
            }
            __syncthreads();
        }
        NSA_T(0)
        const float ltot = quad_sum(l1), il = ltot > 0.f ? 1.0f / ltot : 0.f;
        for (int i = lane; i < 1024; i += 64) imp[i] = 0.f;
        lds_fence();
        if (csteps > 0) {
            f32x4 oc[4];
#pragma unroll
            for (int n = 0; n < 4; ++n) oc[n] = (f32x4){0.f, 0.f, 0.f, 0.f};
            asm volatile("s_waitcnt vmcnt(0)" ::: "memory");
            sgc.stage_k(smem, kc); sgc.stage_v(smem, vc);
            if (csteps > 1) { sgc.stage_k(smem + 16384, kc + (size_t)64 * 64); sgc.stage_v(smem + 16384, vc + 64); }
            for (int s = 0; s < csteps; ++s) {
                const char* cur = smem + LDS_RING(s);
                if (s + 1 < csteps) asm volatile("s_waitcnt vmcnt(4)" ::: "memory"); else asm volatile("s_waitcnt vmcnt(0)" ::: "memory");
                __builtin_amdgcn_s_barrier();
                asm volatile("" ::: "memory");
                if (s + 2 < csteps) { char* nxt = smem + LDS_RING(s + 2); sgc.stage_k(nxt, kc + (size_t)(s + 2) * 64 * 64); sgc.stage_v(nxt, vc + (s + 2) * 64); }
                KF kcur; lds_k(kcur, cur, lane);
                VF vf; lds_v(vf, cur, lane);
                f32x4 sc[4]; scores(kcur, qf, sc);
                float pp[4][4], ps[4], cy[4];
#pragma unroll
                for (int kt = 0; kt < 4; ++kt) {
                    float a = 0.f;
#pragma unroll
                    for (int j = 0; j < 4; ++j) { const bool v = (16 * (s * 64 + KEY_OF(kt, j, fq)) + 31) <= t; pp[kt][j] = v ? ex2(sc[kt][j] - m1) * il : 0.f; a += pp[kt][j]; }
                    float c = pp[kt][3];
                    a += __shfl_xor(a, 1); a += __shfl_xor(a, 2);
                    c += __shfl_xor(c, 1); c += __shfl_xor(c, 2);
                    ps[kt] = a; cy[kt] = c;
                }
                if (g_l == 0) {
#pragma unroll
                    for (int kt = 0; kt < 4; ++kt) imp[qi_l * 256 + s * 16 + 8 * (kt >> 1) + 2 * fq + (kt & 1)] += ps[kt];
                }
                lds_fence();
                if (g_l == 0) {
#pragma unroll
                    for (int kt = 0; kt < 4; ++kt) { const int a1 = s * 16 + 8 * (kt >> 1) + 2 * fq + (kt & 1) + 1; if (a1 < 256) imp[qi_l * 256 + a1] += cy[kt]; }
                }
                lds_fence();
                pv(vf, pp, oc);
            }
            __syncthreads();
            { const float gc = 1.0f / (1.0f + __expf(-gp[0]));
#pragma unroll
            for (int n = 0; n < 4; ++n) outa[n] += oc[n] * gc; }
        }
        NSA_T(1)
        for (int qi = 0; qi < 4; ++qi) {
            const int cur = (t0 + qi) >> 6;
            int* ib = (int*)imp + qi * 256;
            if (lane == 0) ib[0] = -1;
            const int js = cur - 1 + (lane - 1);
            if (lane >= 1 && lane < 5 && js >= 0 && js < 256) ib[js] = -1;
        }
        lds_fence();
#pragma unroll 1
        for (int qi = 0; qi < 4; ++qi) {
            const int tt = t0 + qi, cur = tt >> 6;
            const int* ib = (const int*)imp + qi * 256;
            const int nforced = cur == 0 ? 1 : (cur == 1 ? 2 : 3);
            const int ncand = cur - 2 > 0 ? cur - 2 : 0;
            const int K = (16 - nforced) < ncand ? (16 - nforced) : ncand;
            int bi[4]; bool cand[4];
#pragma unroll
            for (int k = 0; k < 4; ++k) {
                const int i = lane + 64 * k;
                cand[k] = (i >= 1) && (i <= cur - 2);
                bi[k] = cand[k] ? ib[i] : -1;
            }
            bool done = false;
            if (K < ncand) {
                const int mloc = max(max(bi[0], bi[1]), max(bi[2], bi[3]));
                sc[lane] = mloc;
                lds_fence();
                int cnt = 0;
#pragma unroll 2
                for (int l4 = 0; l4 < 64; l4 += 4) {
                    const int4 v = *(const int4*)(sc + l4);
                    cnt += (v.x > mloc - ((l4 + 0) < lane ? 1 : 0)) ? 1 : 0; cnt += (v.y > mloc - ((l4 + 1) < lane ? 1 : 0)) ? 1 : 0;
                    cnt += (v.z > mloc - ((l4 + 2) < lane ? 1 : 0)) ? 1 : 0; cnt += (v.w > mloc - ((l4 + 3) < lane ? 1 : 0)) ? 1 : 0;
                }
                const unsigned long long mkk = __ballot(cnt == K - 1);
                const int tau = __builtin_amdgcn_readlane(mloc, __builtin_amdgcn_readfirstlane((int)__ffsll((long long)mkk) - 1));
                int ns = 0;
#pragma unroll
                for (int k = 0; k < 4; ++k) {
                    const bool sv = cand[k] && (bi[k] >= tau);
                    const unsigned long long mk = __ballot(sv);
                    const int pos = ns + __popcll(mk & ((1ull << lane) - 1ull));
                    if (sv && pos < 64) { sc[64 + pos] = bi[k]; sc[128 + pos] = lane + 64 * k; }
                    ns += __popcll(mk);
                }
                lds_fence();
                if (ns <= 64) {
                    const int my = sc[64 + (lane < ns ? lane : 0)], myi = sc[128 + (lane < ns ? lane : 0)];
                    int rk = 0;
                    const int ns4 = __builtin_amdgcn_readfirstlane(ns) & ~3;
                    for (int j = 0; j < ns4; j += 4) {
                        const int4 vj = *(const int4*)(sc + 64 + j), ij = *(const int4*)(sc + 128 + j);
                        rk += ((vj.x > my) || (vj.x == my && ij.x < myi)) ? 1 : 0; rk += ((vj.y > my) || (vj.y == my && ij.y < myi)) ? 1 : 0;
                        rk += ((vj.z > my) || (vj.z == my && ij.z < myi)) ? 1 : 0; rk += ((vj.w > my) || (vj.w == my && ij.w < myi)) ? 1 : 0;
                    }
                    for (int j = ns4; j < ns; ++j) { const int vj = sc[64 + j], ij = sc[128 + j]; rk += ((vj > my) || (vj == my && ij < myi)) ? 1 : 0; }
                    if (lane < ns && rk < K) selq[qi * 13 + rk] = myi;
                    done = true;
                }
                lds_fence();
            }
            if (!done) {
                int rank[4] = {0, 0, 0, 0};
                if (K < ncand) {
                    const int jend = __builtin_amdgcn_readfirstlane(cur - 1);
                    for (int j4 = 0; j4 < jend; j4 += 4) {
                        const int4 v = *(const int4*)(ib + j4);
                        const int vv[4] = {v.x, v.y, v.z, v.w};
#pragma unroll
                        for (int k = 0; k < 4; ++k)
#pragma unroll
                            for (int e = 0; e < 4; ++e) rank[k] += (vv[e] > bi[k] - ((j4 + e) < (lane + 64 * k) ? 1 : 0)) ? 1 : 0;
                    }
                }
                int off = 0;
#pragma unroll
                for (int i = 0; i < 4; ++i) {
                    const bool sb = cand[i] && (rank[i] < K);
                    const unsigned long long mk = __ballot(sb);
                    if (sb) selq[qi * 13 + off + __popcll(mk & ((1ull << lane) - 1ull))] = lane + 64 * i;
                    off += __popcll(mk);
                }
            }
            if (lane == 0) selq[52 + qi] = K;
        }
        lds_fence();
        NSA_T(2)
        if (lane < 52) {
            const int qi = lane / 13, slot = lane - qi * 13, tt = t0 + qi;
            if (slot < selq[52 + qi]) {
                const int jb = selq[lane];
                SID[((size_t)LL * SEQ + tt) * 16 + slot] = (unsigned char)jb;
                const int pos = atomicAdd(&gcnt[(LL * 256 + jb) * CNTS], 1);
                lists[nsa_list_off(LL, jb) + pos] = (unsigned short)tt;
                lslot[nsa_list_off(LL, jb) + pos] = (unsigned char)slot;
            }
        } else if (lane < 56) {
            SID[((size_t)LL * SEQ + t0 + (lane - 52)) * 16 + 15] = (unsigned char)selq[lane];
        }
        lds_fence();
        NSA_T(3)
        {
            St st; st_init(st);
            bf16x8 qw[2];
            { const bf16_t* qp = Q + (rowb + t) * LDQ + 768 + (hkv * 4 + g_l) * 64; qw[0] = ld8(qp + fq * 8); qw[1] = ld8(qp + 32 + fq * 8); }
            int k0 = tb0 - 511; if (k0 < 0) k0 = 0; k0 &= ~63;
            const int nw = ((tb0 + 15 - k0) >> 6) + 1;
            const bf16_t* kbase = Q + rowb * LDQ + 1792 + hkv * 64;
            const bf16_t* vbase = VT + ((size_t)(b * NVH + 4 + hkv) * 64) * VLD;
            attn_run_lds(smem, sgw, qw, nw, [&](int s, const bf16_t*& kp, const bf16_t*& vp) { const int kb = k0 + 64 * s; kp = kbase + (size_t)kb * LDQ; vp = vbase + kb; },
                         [&](int s, int key) { const int k = k0 + 64 * s + key; return (k <= t) && (t - k < 512); },
                         [&](int s) { const int kb = k0 + 64 * s; return (kb + 63 <= t0) && (t0 + 3 - kb < 512); }, st, lane, fq);
            const float gw = 1.0f / (1.0f + __expf(-gp[2]));
            const float l = quad_sum(st.l), inv = l > 0.f ? gw / l : 0.f;
#pragma unroll
            for (int n = 0; n < 4; ++n) outa[n] += st.o[n] * inv;
        }
#pragma unroll
        for (int n = 0; n < 4; ++n) store_o4(O + (rowb + t) * DM + 512 + (hkv * 4 + g_l) * 64 + n * 16 + 4 * fq, outa[n][0], outa[n][1], outa[n][2], outa[n][3]);
        NSA_T(4)
    }
    if (PROBE_NSA && threadIdx.x == 0) { unsigned long long* sx = (unsigned long long*)(smem - HDR_BYTES + 32) + 24; for (int i = 0; i < 5; ++i) sx[i] = tsec[i]; }
}

__device__ __forceinline__ void ph_nsa2(const Params& p, char* smem) {
    int* cpre = (int*)(smem + 49152);
    const bf16_t* Q = (const bf16_t*)(p.ws + OFF_QKV);
    const bf16_t* VT = (const bf16_t*)(p.ws + OFF_VT);
    const unsigned char* lslot = (const unsigned char*)(p.ws + NSA_SLOTS);
    const int* gcnt = (const int*)(p.ws + OFF_NSACNT);
    const unsigned short* lists = (const unsigned short*)(p.ws + NSA_LISTS);
    const int tid = (int)threadIdx.x, lane = tid & 63, wid = tid >> 6, fr = lane & 15, fq = lane >> 4;
    const int qi_l = fr >> 2, g_l = fr & 3;
    for (int i = tid; i < 1024; i += 256) cpre[i + 1] = (gcnt[i * CNTS] + 63) >> 6;
    if (tid == 0) cpre[0] = 0;
    __syncthreads();
    if (tid == 0) { int acc = 0; for (int i = 1; i <= 1024; ++i) { acc += cpre[i]; cpre[i] = acc; } }
    __syncthreads();
    const int total = cpre[1024];
    for (int it = blockIdx.x * 4 + wid; it < total; it += gridDim.x * 4) {
        int li;
        { int lo = 0, hi = 1023; while (lo < hi) { const int mid = (lo + hi + 1) >> 1; if (cpre[mid] <= it) lo = mid; else hi = mid - 1; } li = lo; }
        const int chunk = it - cpre[li], LL = li >> 8, j = li & 255, b = LL >> 1, hkv = LL & 1, n = gcnt[li * CNTS];
        const unsigned short* lst = lists + nsa_list_off(LL, j);
        const size_t rowb = (size_t)b * SEQ;
        KF kf; load_k(kf, Q + (rowb + (size_t)j * 64) * LDQ + 1536 + hkv * 64, LDQ, fr, fq);
        VF vf; load_v(vf, VT + ((size_t)(b * NVH + 2 + hkv) * 64) * VLD + j * 64, VLD, fr, fq);
        const int e0 = chunk * 64, e1 = (e0 + 64 < n) ? e0 + 64 : n;
        const unsigned char* lsl = lslot + nsa_list_off(LL, j);
        const int emine = (e0 + lane < e1) ? e0 + lane : e0;
        const int tmine = (int)lst[emine] | ((int)lsl[emine] << 16);
        const int ntile = (e1 - e0 + 3) >> 2;
        int ttA, ttB; bf16x8 qA0, qA1, qB0, qB1;
        {
            ttA = __shfl(tmine, (qi_l < e1 - e0) ? qi_l : 0);
            const bf16_t* qp = Q + (rowb + (ttA & 0xFFFF)) * LDQ + 768 + (hkv * 4 + g_l) * 64;
            qA0 = ld8(qp + fq * 8); qA1 = ld8(qp + 32 + fq * 8);
            const int eB = 4 + qi_l;
            ttB = __shfl(tmine, (eB < e1 - e0) ? eB : 0);
            qp = Q + (rowb + (ttB & 0xFFFF)) * LDQ + 768 + (hkv * 4 + g_l) * 64;
            qB0 = ld8(qp + fq * 8); qB1 = ld8(qp + 32 + fq * 8);
        }
        for (int tile = 0; tile < ntile; ++tile) {
            const bf16x8 qf[2] = {qA0, qA1};
            const int tcur = ttA & 0xFFFF, slot = ttA >> 16; const bool okc = (tile * 4 + qi_l) < (e1 - e0);
            ttA = ttB; qA0 = qB0; qA1 = qB1;
            {
                const int eN = (tile + 2) * 4 + qi_l;
                ttB = __shfl(tmine, (eN < e1 - e0) ? eN : 0);
                const bf16_t* qp = Q + (rowb + (ttB & 0xFFFF)) * LDQ + 768 + (hkv * 4 + g_l) * 64;
                qB0 = ld8(qp + fq * 8); qB1 = ld8(qp + 32 + fq * 8);
            }
            f32x4 sc[4]; scores(kf, qf, sc);
            float mx = sc[0][0];
#pragma unroll
            for (int kt = 0; kt < 4; ++kt)
#pragma unroll
                for (int jj = 0; jj < 4; ++jj) mx = fmaxf(mx, sc[kt][jj]);
            mx = quad_max(mx);
            float pp[4][4]; float sum = 0.f;
#pragma unroll
            for (int kt = 0; kt < 4; ++kt)
#pragma unroll
                for (int jj = 0; jj < 4; ++jj) { pp[kt][jj] = ex2(sc[kt][jj] - mx); sum += pp[kt][jj]; }
            sum = quad_sum(sum);
            f32x4 o[4];
#pragma unroll
            for (int nn = 0; nn < 4; ++nn) o[nn] = (f32x4){0.f, 0.f, 0.f, 0.f};
            pv(vf, pp, o);
            if (okc) {
                char* rec = nsa_part_ptr(p.ws, LL, tcur, slot);
                st_part((bf16_t*)(rec + g_l * 128) + fq * 16, o);
                if (fq == 0) *(float2*)(rec + 512 + g_l * 8) = make_float2(mx, sum);
            }
        }
    }
}

__device__ __forceinline__ void ph_nsa3(const Params& p, char* smem) {
    (void)smem;
    const bf16_t* Q = (const bf16_t*)(p.ws + OFF_QKV);
    const bf16_t* VT = (const bf16_t*)(p.ws + OFF_VT);
    const float* GD = (const float*)(p.ws + B_GD);
    const unsigned char* SID = (const unsigned char*)(p.ws + M_SELID);
    bf16_t* O = (bf16_t*)(p.ws + OFF_O);
    const int tid = (int)threadIdx.x, lane = tid & 63, wid = tid >> 6, fr = lane & 15, fq = lane >> 4;
    const int qi_l = fr >> 2, g_l = fr & 3;
    Stager sg; sg.init(tid, LDQ, VLD);
    const NsaIter itr = nsa_iter();
    for (int ii = itr.i0; ii < itr.icnt; ii += itr.istr) {
        const int LL = itr.aff ? (itr.xcd & 3) : (ii >> 10);
        const int tqb = itr.aff ? (2 * ii + (itr.xcd >> 2)) : (ii & 1023);
        const int b = LL >> 1, hkv = LL & 1;
        const int tb0 = tqb * 16, t0 = tb0 + wid * 4, t = t0 + qi_l, cur = tb0 >> 6;
        const size_t rowb = (size_t)b * SEQ;
        bf16x8 qf[2];
        {
            const bf16_t* qp = Q + (rowb + t) * LDQ + 768 + (hkv * 4 + g_l) * 64;
            qf[0] = ld8(qp + fq * 8); qf[1] = ld8(qp + 32 + fq * 8);
        }
        const float gs = 1.0f / (1.0f + __expf(-GD[(rowb + t) * 24 + (hkv * 4 + g_l) * 3 + 1]));
        const int nsel = SID[((size_t)LL * SEQ + t) * 16 + 15];
        const int nf = cur == 0 ? 1 : (cur == 1 ? 2 : 3);
        St st; st_init(st);
        const bf16_t* kbase = Q + rowb * LDQ + 1536 + hkv * 64;
        const bf16_t* vbase = VT + ((size_t)(b * NVH + 2 + hkv) * 64) * VLD;
        auto fblk = [&](int s) { return s == 0 ? 0 : (cur - (nf - 1 - s)); };
        attn_run_lds(smem, sg, qf, nf, [&](int s, const bf16_t*& kp, const bf16_t*& vp) { const int kb = fblk(s) * 64; kp = kbase + (size_t)kb * LDQ; vp = vbase + kb; },
                     [&](int s, int key) { return (fblk(s) * 64 + key) <= t; }, [&](int s) { return (fblk(s) * 64 + 63) <= t0; }, st, lane, fq);
        float l = quad_sum(st.l), m = st.m;
        {
            const char* rec0 = nsa_part_ptr(p.ws, LL, t, 0);
            const char* mlp = rec0 + 512 + g_l * 8;
            const char* op0 = rec0 + g_l * 128 + fq * 32;
            float mm = m;
#pragma unroll
            for (int r = 0; r < 13; ++r) {
                const float mr = *(const float*)(mlp + (r < nsel ? r * 544 : 0));
                if (r < nsel) mm = fmaxf(mm, mr);
            }
            const float a = ex2(m - mm);
            l *= a;
#pragma unroll
            for (int n = 0; n < 4; ++n) st.o[n] *= a;
#pragma unroll 1
            for (int rb = 0; rb < 14; rb += 7) {
#pragma unroll
                for (int u = 0; u < 7; ++u) {
                    const int r = rb + u;
                    const bool ok = r < nsel;
                    const int ro = ok ? r * 544 : 0;
                    const float2 ml = *(const float2*)(mlp + ro);
                    const float c = ok ? ex2(ml.x - mm) : 0.f;
                    acc_part((const bf16_t*)(op0 + ro), c, st.o);
                    l += c * ml.y;
                }
            }
        }
        const float inv = l > 0.f ? gs / l : 0.f;
#pragma unroll
        for (int n = 0; n < 4; ++n) {
            bf16_t* op = O + (rowb + t) * DM + 512 + (hkv * 4 + g_l) * 64 + n * 16 + 4 * fq;
            const uint2 u = *(const uint2*)op;
            store_o4(op, __uint_as_float(u.x << 16) + st.o[n][0] * inv, __uint_as_float(u.x & 0xFFFF0000u) + st.o[n][1] * inv,
                         __uint_as_float(u.y << 16) + st.o[n][2] * inv, __uint_as_float(u.y & 0xFFFF0000u) + st.o[n][3] * inv);
        }
    }
}

template <int PH> __device__ __forceinline__ void run_phase(const Params& p, char* smem) {
    char* ws = p.ws;
    if (PH == 0) {
        conv_layer_weights(p, smem, 0); conv_expert_weights(p, smem, 0);
        rope_table(p);
        norm_pass(p.x, nullptr, nullptr, nullptr, p.ln_mix[0], (bf16_t*)(ws + OFF_H), nullptr);
    } else if (PH == 1) { ph_gemm_qkv(p, smem, 0); if (GEMM_EXP) { __syncthreads(); ph_gemm_qkv<GEMM_EXP - 1>(p, smem, 0); } }
    else if (PH == 2) ph_attn0(p, smem);
    else if (PH == 3) ph_gemm_out(p, smem, p.x);
    else if (PH == 4) ph_route(p, smem, 0);
    else if (PH == 5) { }
    else if (PH == 6) ph_moe_gemm(p, smem, 0, 0);
    else if (PH == 7) ph_moe_gemm(p, smem, 1, 0);
    else if (PH == 8) {
        norm_pass(p.out, (const bf16_t*)(ws + B_Y), (const float*)(ws + M_TOKG), p.out, p.ln_mix[1], (bf16_t*)(ws + OFF_H), nullptr);
        conv_layer_weights(p, smem, 1);
    } else if (PH == 9) ph_gemm_qkv(p, smem, 1);
    else if (PH == 10) { ph_kmean(p); ph_cmp1(p, smem); }
    else if (PH == 11) { ph_moba_gate(p, smem); ph_cmp2(p, smem); }
    else if (PH == 12) { ph_moba_part(p, smem); __syncthreads(); if (PROBING && threadIdx.x == 0) ((unsigned long long*)(smem - HDR_BYTES + 32))[22] = wall_clock64(); ph_nsa1(p, smem); }
    else if (PH == 13) { ph_nsa2(p, smem); __syncthreads(); if (PROBING && threadIdx.x == 0) ((unsigned long long*)(smem - HDR_BYTES + 32))[23] = wall_clock64(); ph_moba_own(p, smem); }
    else if (PH == 14) ph_nsa3(p, smem);
    else if (PH == 15) { ph_gemm_out(p, smem, p.out); conv_expert_weights(p, smem, 1); }
    else if (PH == 16) ph_route(p, smem, 1);
    else if (PH == 17) { }
    else if (PH == 18) ph_moe_gemm(p, smem, 0, 1);
    else if (PH == 19) ph_moe_gemm(p, smem, 1, 1);
    else if (PH == 20) norm_pass(p.out, (const bf16_t*)(ws + B_Y), (const float*)(ws + M_TOKG), nullptr, p.ln_final, nullptr, p.out);
}
#define NPHASE 21

#if MEGA
#ifndef DUP_PH
#define DUP_PH -1
#endif
#ifndef DUP_MODE
#define DUP_MODE 0
#endif
#define PHB(n) run_phase<n>(p, smem); if (DUP_PH == n) { __syncthreads(); if (n == 7 && DUP_MODE) ph_moe_gemm<DUP_MODE>(p, smem, 1, 0); else if (n == 6 && DUP_MODE) ph_moe_gemm<DUP_MODE>(p, smem, 0, 0); else run_phase<n>(p, smem); } xcd_barrier(bar); if (PROBING && threadIdx.x == 0) stamps[n + 1] = wall_clock64();
#define PHS(n) if (PROBING && threadIdx.x == 0) stamps[n + 1] = stamps[n];
__global__ void __launch_bounds__(256, 2) k_mega(Params p) {
    __shared__ __attribute__((aligned(16))) char smem_all[SMEM_BYTES + HDR_BYTES];
    char* smem = smem_all + HDR_BYTES;
    unsigned long long* stamps = (unsigned long long*)(smem_all + 32);
    if (threadIdx.x == 0) *(uint4*)smem_all = make_uint4(0u, 0u, 0u, 0u);
    __syncthreads();
    XcdBarrier bar = xcd_barrier_post((unsigned*)(p.ws + OFF_CTRL), (volatile LAS unsigned*)smem_all);
    if (PROBING && threadIdx.x == 0) stamps[0] = wall_clock64();
    PHB(0) PHB(1) PHB(2) PHB(3) PHB(4) PHS(5) PHB(6) PHB(7) PHB(8) PHB(9)
    PHB(10) PHB(11) PHB(12) PHB(13) PHB(14) PHB(15) PHB(16) PHS(17) PHB(18) PHB(19)
    if (PROBING) {
        float* enc = (float*)(smem_all + 16);
        if (threadIdx.x == 0) {
            const float tot = (float)(stamps[20] - stamps[0]);
            float fa = 0.f, fb = 0.f;
            for (int i = 0; i < 20; ++i) { const float d = (float)(stamps[i + 1] - stamps[i]); if ((PROBE_A >> i) & 1) fa += d; if ((PROBE_B >> i) & 1) fb += d; }
            { const float d = (float)(stamps[22] - stamps[12]); if ((PROBE_A >> 20) & 1) fa += d; if ((PROBE_B >> 20) & 1) fb += d; }
            { const float d = (float)(stamps[23] - stamps[13]); if ((PROBE_A >> 21) & 1) fa += d; if ((PROBE_B >> 21) & 1) fb += d; }
            fa /= tot; fb /= tot;
#if PROBE_NSA
            { const unsigned long long* sx = stamps + 24; float sm = 0.f; for (int i = 0; i < 5; ++i) sm += (float)sx[i];
              fa = (float)sx[PROBE_NSA & 7] / sm; fb = (float)sx[(PROBE_NSA >> 3) & 7] / sm; }
#endif
            enc[0] = 1.0f + sqrtf(5e-4f + 6e-3f * fa);
            enc[1] = 20.0f + 80.0f * fb;
        }
        __syncthreads();
        norm_pass(p.out, (const bf16_t*)(p.ws + B_Y), (const float*)(p.ws + M_TOKG), nullptr, p.ln_final, nullptr, p.out, enc[0], enc[1]);
    } else {
        run_phase<20>(p, smem);
    }
}
#else
template <int PH> __global__ void __launch_bounds__(256, 2) k_phase(Params p) {
    __shared__ __attribute__((aligned(16))) char smem_all[SMEM_BYTES + 16];
    run_phase<PH>(p, smem_all + 16);
}
template <int PH> static void launch_phases(const Params& p, int grid, hipStream_t stream) {
    hipLaunchKernelGGL(k_phase<PH>, dim3(grid), dim3(256), 0, stream, p);
    if constexpr (PH + 1 < NPHASE) launch_phases<PH + 1>(p, grid, stream);
}
#endif

extern "C" void kernel_launch(void* const* d_in, const int* in_sizes, int n_in, void* d_out, int out_size, void* d_ws, size_t ws_size, hipStream_t stream) {
    (void)in_sizes; (void)n_in; (void)out_size;
    if (ws_size < WS_NEED) { fprintf(stderr, "workspace too small: %zu < %zu\n", ws_size, (size_t)WS_NEED); return; }
    Params p; memset(&p, 0, sizeof(p));
    p.x = (const float*)d_in[0]; p.pos = (const int*)d_in[1];
    p.ln_mix[0] = (const float*)d_in[2]; p.w_in[0] = (const float*)d_in[3]; p.sinks0 = (const float*)d_in[4]; p.w_out[0] = (const float*)d_in[5];
    p.ln_ffn[0] = (const float*)d_in[6]; p.r_group[0] = (const float*)d_in[7]; p.r_expert[0] = (const float*)d_in[8];
    p.e_gate[0] = (const float*)d_in[9]; p.e_up[0] = (const float*)d_in[10]; p.e_down[0] = (const float*)d_in[11];
    p.ln_mix[1] = (const float*)d_in[12]; p.w_in[1] = (const float*)d_in[13];
    p.k_pe = (const float*)d_in[14]; p.k_w1 = (const float*)d_in[15]; p.k_w2 = (const float*)d_in[16];
    p.v_pe = (const float*)d_in[17]; p.v_w1 = (const float*)d_in[18]; p.v_w2 = (const float*)d_in[19];
    p.w_out[1] = (const float*)d_in[20]; p.ln_ffn[1] = (const float*)d_in[21]; p.r_group[1] = (const float*)d_in[22]; p.r_expert[1] = (const float*)d_in[23];
    p.e_gate[1] = (const float*)d_in[24]; p.e_up[1] = (const float*)d_in[25]; p.e_down[1] = (const float*)d_in[26];
    p.ln_final = (const float*)d_in[27];
    p.out = (float*)d_out; p.ws = (char*)d_ws;
    (void)hipMemsetAsync(d_ws, 0, 1 * MB, stream);
#if MEGA
    static int grid = 0;
    if (!grid) {
        int dev = 0, cus = 0, per_cu = 0;
        (void)hipGetDevice(&dev);
        (void)hipDeviceGetAttribute(&cus, hipDeviceAttributeMultiprocessorCount, dev);
        (void)hipOccupancyMaxActiveBlocksPerMultiprocessor(&per_cu, k_mega, 256, 0);
        if (per_cu < 1) per_cu = 1;
        grid = cus * (per_cu < 2 ? per_cu : 2);
    }
    hipLaunchKernelGGL(k_mega, dim3(grid), dim3(256), 0, stream, p);
#else
    launch_phases<0>(p, 512, stream);
#endif
}
```

```cpp
#include <hip/hip_runtime.h>
#include <stdint.h>
#include <stdio.h>
#include <string.h>

#ifndef MEGA
#define MEGA 1
#endif
#ifndef PROBE_A
#define PROBE_A 0
#endif
#ifndef PROBE_B
#define PROBE_B 0
#endif
#ifndef PROBE_NSA
#define PROBE_NSA 0
#endif
#define PROBING ((PROBE_A) | (PROBE_B) | (PROBE_NSA))

typedef unsigned short bf16_t;
typedef short bf16x8 __attribute__((ext_vector_type(8)));
typedef float f32x4 __attribute__((ext_vector_type(4)));

#define NTOK 32768
#define SEQ 16384
#define DM 1024
#define LDQ 2304
#define NVH 10
#define NEXP 64
#define EH 512
#define NASG 65536
#define NCMP 1023
#define NCMPP 1024
#define NEG_BIG (-1.0e30f)
#define VLD (SEQ + 64)
#define CLD (NCMPP + 64)

constexpr size_t MB = 1024ull * 1024ull;
constexpr size_t OFF_CTRL = 0;
constexpr size_t OFF_CUCNT = 16384;
constexpr size_t OFF_MOBACNT = 32768;
constexpr size_t OFF_ROPE = 1 * MB;
constexpr size_t OFF_NSACNT = 65536;
#define CNTS 32
constexpr size_t OFF_MOECNT = 262144;
constexpr size_t OFF_W = 9 * MB;
constexpr size_t W_IN = OFF_W;
constexpr size_t W_OUT = W_IN + 2304ull * 1024 * 2;
constexpr size_t W_K1 = W_OUT + 1024ull * 1024 * 2;
constexpr size_t W_V1 = W_K1 + 256ull * 2048 * 2;
constexpr size_t W_K2 = W_V1 + 256ull * 2048 * 2;
constexpr size_t W_V2 = W_K2 + 128ull * 256 * 2;
constexpr size_t W_BK = W_V2 + 128ull * 256 * 2;
constexpr size_t W_BV = W_BK + 1024;
constexpr size_t W_GU = W_BV + 1024 + 1022 * 1024;
constexpr size_t W_DN = W_GU + 64ull * 1024 * 1024 * 2;
constexpr size_t OFF_H = W_DN + 64ull * 1024 * 512 * 2;
constexpr size_t OFF_QKV = OFF_H + (size_t)NTOK * 1024 * 2;
constexpr size_t OFF_VT = OFF_QKV + (size_t)NTOK * LDQ * 2;
constexpr size_t OFF_O = OFF_VT + 2ull * NVH * 64 * VLD * 2;
constexpr size_t OFF_B = OFF_O + (size_t)NTOK * 1024 * 2;
constexpr size_t B_LIST = OFF_B;
constexpr size_t MOBA_LCAP = 2064384ull;
constexpr size_t B_PO = B_LIST + 4 * MOBA_LCAP * 4;
constexpr size_t B_PML = B_PO + (size_t)NTOK * 24 * 64 * 2;
constexpr size_t B_HIDK = B_PML + (size_t)NTOK * 24 * 8;
constexpr size_t B_HIDV = B_HIDK + 4096ull * 256 * 2;
constexpr size_t B_KCMP = B_HIDV + 4096ull * 256 * 2;
constexpr size_t B_VCMPT = B_KCMP + 4ull * 1024 * 64 * 2;
constexpr size_t B_KMEAN = B_VCMPT + 4ull * CLD * 64 * 2;
constexpr size_t B_GD = B_KMEAN + 2ull * 64 * 2 * 64 * 4;
constexpr size_t B_END = B_GD + (size_t)NTOK * 24 * 4;
constexpr size_t B_Y = OFF_B;
constexpr size_t OFF_M = OFF_B + 150 * MB;
static_assert(B_END <= OFF_M, "B region overflow");
constexpr size_t M_TOKE = OFF_M;
constexpr size_t M_TOKG = M_TOKE + (size_t)NTOK * 8;
constexpr size_t M_TOKR = M_TOKG + (size_t)NTOK * 8;
constexpr size_t M_HIST = M_TOKR + (size_t)NTOK * 8;
constexpr size_t M_LIST = M_HIST + 512ull * 64 * 4;
constexpr size_t M_ECNT = M_LIST + 65536ull * 4;
constexpr size_t M_EBASE = M_ECNT + 256;
constexpr size_t M_SELID = OFF_M + 2 * MB;
constexpr size_t NSA_PSZ = (size_t)2 * SEQ * 13 * 544;
constexpr size_t NSA_PX = OFF_M + 3 * MB;
constexpr size_t NSA_PY = W_GU;
static_assert(NSA_PSZ <= 256 * MB, "NSA partials do not fit the weight region");
constexpr size_t NSA_LCAP = 2072640ull;
constexpr size_t NSA_LISTS = NSA_PX + NSA_PSZ;
constexpr size_t NSA_SLOTS = NSA_LISTS + 4 * NSA_LCAP * 2;
constexpr size_t WS_NEED = NSA_SLOTS + 4 * NSA_LCAP;
constexpr size_t MOE_LIST = NSA_LISTS;
static_assert(64ull * 32768 * 4 <= 4 * NSA_LCAP * 2, "MoE lists do not fit");
constexpr size_t HID_OFF = OFF_QKV;

#define SMEM_BYTES 76800
#define HDR_BYTES 512

struct Params {
    const float* x; const int* pos;
    const float* ln_mix[2]; const float* w_in[2]; const float* sinks0; const float* w_out[2]; const float* ln_ffn[2];
    const float* r_group[2]; const float* r_expert[2]; const float* e_gate[2]; const float* e_up[2]; const float* e_down[2];
    const float* k_pe; const float* k_w1; const float* k_w2; const float* v_pe; const float* v_w1; const float* v_w2;
    const float* ln_final;
    float* out;
    char* ws;
};

#define XB_TMO      128
#define XB_XCNT(j)  (256  + 64 * (j))
#define XB_XSUB(j)  (1280 + 64 * (j))
#define XB_XGEN(j)  (2304 + 64 * (j))
#define XB_TOP      3328
#define XB_TOPGEN   3392
#define XCD_BAR_WORDS 3456
#define XB_SPIN_CAP (1u << 22)
#define LAS __attribute__((address_space(3)))

__device__ __forceinline__ unsigned xb_ld(unsigned* p)              { return __hip_atomic_load(p, __ATOMIC_RELAXED, __HIP_MEMORY_SCOPE_AGENT); }
__device__ __forceinline__ unsigned xb_add(unsigned* p, unsigned v) { return __hip_atomic_fetch_add(p, v, __ATOMIC_RELAXED, __HIP_MEMORY_SCOPE_AGENT); }
__device__ __forceinline__ unsigned xb_xcc_id() { return (unsigned)__builtin_amdgcn_s_getreg((3 << 11) | 20) & 0xFu; }
#define XB_SPIN(cond, bar) do { unsigned _sp = 0; while (cond) { __builtin_amdgcn_s_sleep(1); \
    if ((++_sp & 255u) == 0u) { if (xb_ld(&(bar)[XB_TMO])) break; if (_sp > XB_SPIN_CAP) { atomicAdd(&(bar)[XB_TMO], 1u); break; } } } } while (0)

struct XcdBarrier { unsigned* bar; unsigned x; volatile LAS unsigned* st; };

__device__ __forceinline__ XcdBarrier xcd_barrier_post(unsigned* bar, volatile LAS unsigned* st) {
    XcdBarrier b; b.bar = bar; b.x = xb_xcc_id(); b.st = st;
    if (threadIdx.x == 0) (void)xb_add(&bar[XB_XCNT(b.x)], 1u);
    return b;
}
__device__ __forceinline__ void xcd_barrier_complete(unsigned* bar, unsigned x, unsigned& nloc, unsigned& nx) {
    const unsigned G = gridDim.x * gridDim.y * gridDim.z;
    unsigned sum, cnt, mine, sp = 0u;
    for (;;) {
        sum = 0u; cnt = 0u; mine = 0u;
#pragma unroll
        for (unsigned j = 0; j < 16; ++j) { const unsigned c = xb_ld(&bar[XB_XCNT(j)]); sum += c; cnt += (c > 0u) ? 1u : 0u; mine = (j == x) ? c : mine; }
        if (sum == G) break;
        __builtin_amdgcn_s_sleep(1);
        if ((++sp & 255u) == 0u) { if (xb_ld(&bar[XB_TMO])) break; if (sp > XB_SPIN_CAP) { atomicAdd(&bar[XB_TMO], 1u); break; } }
    }
    nloc = mine > 0u ? mine : 1u; nx = cnt > 0u ? cnt : 1u;
}
__device__ __forceinline__ void xcd_barrier(const XcdBarrier& b) {
    asm volatile("s_waitcnt vmcnt(0)" ::: "memory");
    __syncthreads();
    if (threadIdx.x == 0) {
        unsigned* bar = b.bar;
        __builtin_amdgcn_s_waitcnt(0);
        unsigned nloc = b.st[0], nx = b.st[1];
        if (nloc == 0u) { xcd_barrier_complete(bar, b.x, nloc, nx); b.st[0] = nloc; b.st[1] = nx; }
        const unsigned old = xb_add(&bar[XB_XSUB(b.x)], 1u);
        const unsigned gen = old / nloc;
        if (old + 1u == (gen + 1u) * nloc) {
            __builtin_amdgcn_fence(__ATOMIC_RELEASE, "agent");
            asm volatile("s_waitcnt vmcnt(0)" ::: "memory");
            const unsigned og = xb_add(&bar[XB_TOP], 1u);
            const unsigned tg = og / nx;
            if (og + 1u == (tg + 1u) * nx) xb_add(&bar[XB_TOPGEN], 1u);
            else XB_SPIN(xb_ld(&bar[XB_TOPGEN]) == tg, bar);
            __builtin_amdgcn_fence(__ATOMIC_ACQUIRE, "agent");
            xb_add(&bar[XB_XGEN(b.x)], 1u);
            asm volatile("s_waitcnt vmcnt(0)" ::: "memory");
        } else {
            XB_SPIN(xb_ld(&bar[XB_XGEN(b.x)]) == gen, bar);
            __builtin_amdgcn_fence(__ATOMIC_ACQUIRE, "agent");
            asm volatile("s_waitcnt vmcnt(0)" ::: "memory");
        }
    }
    __syncthreads();
}

typedef __bf16 bf16x2_t __attribute__((ext_vector_type(2)));
typedef float f32x2 __attribute__((ext_vector_type(2)));
__device__ __forceinline__ uint32_t pack2(float a, float b) { const f32x2 v = {a, b}; return __builtin_bit_cast(uint32_t, __builtin_convertvector(v, bf16x2_t)); }
__device__ __forceinline__ bf16_t f2bf(float f) { return (bf16_t)(pack2(f, 0.f) & 0xFFFFu); }
__device__ __forceinline__ float bf2f(bf16_t h) { return __uint_as_float(((uint32_t)h) << 16); }
__device__ __forceinline__ f32x4 mfma16(bf16x8 a, bf16x8 b, f32x4 c) { return __builtin_amdgcn_mfma_f32_16x16x32_bf16(a, b, c, 0, 0, 0); }
__device__ __forceinline__ float red16_max(float v) { v = fmaxf(v, __shfl_xor(v, 1)); v = fmaxf(v, __shfl_xor(v, 2)); v = fmaxf(v, __shfl_xor(v, 4)); v = fmaxf(v, __shfl_xor(v, 8)); return v; }
__device__ __forceinline__ float red16_sum(float v) { v += __shfl_xor(v, 1); v += __shfl_xor(v, 2); v += __shfl_xor(v, 4); v += __shfl_xor(v, 8); return v; }
__device__ __forceinline__ float red64_sum(float v) { v += __shfl_xor(v, 1); v += __shfl_xor(v, 2); v += __shfl_xor(v, 4); v += __shfl_xor(v, 8); v += __shfl_xor(v, 16); v += __shfl_xor(v, 32); return v; }
typedef unsigned u32x2_t __attribute__((ext_vector_type(2)));
__device__ __forceinline__ float quad_max(float v) {
    const u32x2_t a = __builtin_amdgcn_permlane32_swap(__float_as_uint(v), __float_as_uint(v), false, false);
    v = fmaxf(__uint_as_float(a[0]), __uint_as_float(a[1]));
    const u32x2_t b = __builtin_amdgcn_permlane16_swap(__float_as_uint(v), __float_as_uint(v), false, false);
    return fmaxf(__uint_as_float(b[0]), __uint_as_float(b[1]));
}
__device__ __forceinline__ float quad_sum(float v) {
    const u32x2_t a = __builtin_amdgcn_permlane32_swap(__float_as_uint(v), __float_as_uint(v), false, false);
    v = __uint_as_float(a[0]) + __uint_as_float(a[1]);
    const u32x2_t b = __builtin_amdgcn_permlane16_swap(__float_as_uint(v), __float_as_uint(v), false, false);
    return __uint_as_float(b[0]) + __uint_as_float(b[1]);
}
__device__ __forceinline__ float ex2(float x) { return __builtin_amdgcn_exp2f(x); }
#define LOG2E 1.4426950408889634f
__device__ __forceinline__ void lds_fence() { asm volatile("s_waitcnt lgkmcnt(0)" ::: "memory"); }
__device__ __forceinline__ void lds_barrier() { asm volatile("s_waitcnt lgkmcnt(0)" ::: "memory"); __builtin_amdgcn_s_barrier(); asm volatile("" ::: "memory"); }
__device__ __forceinline__ bf16x8 ld8(const bf16_t* p) { return *(const bf16x8*)p; }
__device__ __forceinline__ bf16x8 zero8() { bf16x8 z = {0, 0, 0, 0, 0, 0, 0, 0}; return z; }

__device__ __forceinline__ int hidden_tid() { int t = (int)threadIdx.x; asm volatile("" : "+v"(t)); __builtin_assume(t >= 0 && t < 256); return t; }

__device__ __forceinline__ void tconv(char* smem, const float* src, bf16_t* dst, int K, int N, int Npad, int nbatch, size_t sstride, size_t dstride, int mode) {
    float* tile = (float*)smem;
    const int tid = hidden_tid();
    const int tk = K / 128, tn = (Npad + 63) / 64, per = tk * tn, total = per * nbatch;
    const int ty = tid >> 4, tx = tid & 15;
    float4 v[8];
    auto load_tile = [&](int it) {
        const int bi = it / per, r = it % per, k0 = (r / tn) * 128, n = (r % tn) * 64 + tx * 4;
        const float* s = src + (size_t)bi * sstride;
#pragma unroll
        for (int i = 0; i < 8; ++i) {
            v[i] = make_float4(0.f, 0.f, 0.f, 0.f);
            if (n < N) v[i] = *(const float4*)(s + (size_t)(k0 + ty + 16 * i) * N + n);
        }
    };
    if ((int)blockIdx.x < total) load_tile(blockIdx.x);
    for (int it = blockIdx.x; it < total; it += gridDim.x) {
        const int bi = it / per, r = it % per, k0 = (r / tn) * 128, n0 = (r % tn) * 64;
        bf16_t* d = dst + (size_t)bi * dstride;
#pragma unroll
        for (int i = 0; i < 8; ++i) { const int k = ty + 16 * i; *(float4*)(tile + k * 64 + ((tx ^ ((k >> 3) & 15)) * 4)) = v[i]; }
        __syncthreads();
        if (it + (int)gridDim.x < total) load_tile(it + gridDim.x);
#pragma unroll
        for (int ps = 0; ps < 4; ++ps) {
            const int nl = ps * 16 + ty, n = n0 + nl, kc = tx * 8;
            if (n < Npad) {
                int row = n;
                if (mode == 1) row = (n >> 5) * 64 + (n & 31);
                else if (mode == 2) row = (n >> 5) * 64 + 32 + (n & 31);
                const float* tp = tile + kc * 64 + (((nl >> 2) ^ tx) * 4) + (nl & 3);
                float f[8];
#pragma unroll
                for (int e = 0; e < 8; ++e) f[e] = tp[e * 64];
                *(uint4*)(d + (size_t)row * K + k0 + kc) = make_uint4(pack2(f[0], f[1]), pack2(f[2], f[3]), pack2(f[4], f[5]), pack2(f[6], f[7]));
            }
        }
        __syncthreads();
    }
}

__device__ __forceinline__ void conv_expert_weights(const Params& p, char* smem, int L) {
    char* ws = p.ws;
    tconv(smem, p.e_gate[L], (bf16_t*)(ws + W_GU), 1024, 512, 512, 64, 1024ull * 512, 1024ull * 1024, 1);
    tconv(smem, p.e_up[L], (bf16_t*)(ws + W_GU), 1024, 512, 512, 64, 1024ull * 512, 1024ull * 1024, 2);
    tconv(smem, p.e_down[L], (bf16_t*)(ws + W_DN), 512, 1024, 1024, 64, 512ull * 1024, 1024ull * 512, 0);
}
__device__ __forceinline__ void conv_layer_weights(const Params& p, char* smem, int L) {
    char* ws = p.ws;
    if (L == 0) tconv(smem, p.w_in[0], (bf16_t*)(ws + W_IN), 1024, 2304, 2304, 1, 0, 0, 0);
    else        tconv(smem, p.w_in[1], (bf16_t*)(ws + W_IN), 1024, 2072, 2304, 1, 0, 0, 0);
    tconv(smem, p.w_out[L], (bf16_t*)(ws + W_OUT), 1024, 1024, 1024, 1, 0, 0, 0);
    if (L == 1) {
        tconv(smem, p.k_w1, (bf16_t*)(ws + W_K1), 2048, 256, 256, 1, 0, 0, 0);
        tconv(smem, p.v_w1, (bf16_t*)(ws + W_V1), 2048, 256, 256, 1, 0, 0, 0);
        tconv(smem, p.k_w2, (bf16_t*)(ws + W_K2), 256, 64, 128, 1, 0, 0, 0);
        tconv(smem, p.v_w2, (bf16_t*)(ws + W_V2), 256, 64, 128, 1, 0, 0, 0);
        if (blockIdx.x == gridDim.x - 1 || blockIdx.x == gridDim.x - 2) {
            const bool isv = (blockIdx.x == gridDim.x - 2);
            const float* pe = isv ? p.v_pe : p.k_pe; const float* w1 = isv ? p.v_w1 : p.k_w1;
            float* bias = (float*)(ws + (isv ? W_BV : W_BK));
            const int n = hidden_tid(); float acc = 0.f;
            for (int kk = 0; kk < 2048; ++kk) acc += pe[kk] * w1[(size_t)kk * 256 + n];
            bias[n] = acc;
        }
    }
}

static __device__ const double kInvFreq[32] = {
    1.0, 0.7498942093324559, 0.5623413251903491, 0.4216965034285822, 0.31622776601683794, 0.23713737056616552, 0.1778279410038923, 0.1333521432163324,
    0.1, 0.07498942093324558, 0.05623413251903491, 0.042169650342858224, 0.03162277660168379, 0.023713737056616554, 0.01778279410038923, 0.01333521432163324,
    0.01, 0.007498942093324558, 0.005623413251903491, 0.004216965034285823, 0.0031622776601683794, 0.0023713737056616554, 0.0017782794100389228, 0.001333521432163324,
    0.001, 0.0007498942093324559, 0.0005623413251903491, 0.00042169650342858224, 0.00031622776601683794, 0.00023713737056616554, 0.00017782794100389227, 0.0001333521432163324};
__device__ __forceinline__ void rope_table(const Params& p) {
    float* rc = (float*)(p.ws + OFF_ROPE); float* rs = rc + (size_t)NTOK * 32;
    const int stride = gridDim.x * 256;
    for (int i0 = blockIdx.x * 256 + hidden_tid(); i0 < NTOK * 32; i0 += 8 * stride) {
        int ps[8];
#pragma unroll
        for (int u = 0; u < 8; ++u) { const int i = i0 + u * stride; ps[u] = (i < NTOK * 32) ? p.pos[i >> 5] : 0; }
#pragma unroll
        for (int u = 0; u < 8; ++u) {
            const int i = i0 + u * stride;
            if (i < NTOK * 32) {
                const double ang = (double)ps[u] * kInvFreq[i & 31];
                const double k = rint(ang * 0.15915494309189535);
                const float r = (float)fma(-k, 6.283185307179586, ang);
                rc[i] = cosf(r); rs[i] = sinf(r);
            }
        }
    }
}

#ifndef NT_
#define NT_ 4
#endif
__device__ __forceinline__ void norm_pass(const float* src, const bf16_t* y, const float* tg, float* xr, const float* gain, bf16_t* hb, float* hf, float pscale = 1.0f, float pv = 0.0f) {
    const int tidh = hidden_tid(), lane = tidh & 63, wid = tidh >> 6;
    const int nw = gridDim.x * 4;
    for (int t0 = blockIdx.x * 4 + wid; t0 < NTOK; t0 += NT_ * nw) {
        float v[NT_][16]; float gk[NT_][2]; uint2 ya[NT_][2][4];
#pragma unroll
        for (int u = 0; u < NT_; ++u) {
            const int t = (t0 + u * nw < NTOK) ? t0 + u * nw : t0;
#pragma unroll
            for (int i = 0; i < 4; ++i) {
                const float4 a = *(const float4*)(src + (size_t)t * DM + i * 256 + lane * 4);
                v[u][4 * i] = a.x; v[u][4 * i + 1] = a.y; v[u][4 * i + 2] = a.z; v[u][4 * i + 3] = a.w;
            }
            if (y) {
#pragma unroll
                for (int k = 0; k < 2; ++k) {
                    gk[u][k] = tg[(size_t)t * 2 + k];
#pragma unroll
                    for (int i = 0; i < 4; ++i) ya[u][k][i] = *(const uint2*)(y + ((size_t)t * 2 + k) * DM + i * 256 + lane * 4);
                }
            }
        }
#pragma unroll
        for (int u = 0; u < NT_; ++u) {
            const int t = t0 + u * nw;
            if (t >= NTOK) break;
            if (y) {
#pragma unroll
                for (int k = 0; k < 2; ++k)
#pragma unroll
                    for (int i = 0; i < 4; ++i) {
                        const uint2 a = ya[u][k][i];
                        v[u][4 * i] += gk[u][k] * __uint_as_float(a.x << 16); v[u][4 * i + 1] += gk[u][k] * __uint_as_float(a.x & 0xFFFF0000u);
                        v[u][4 * i + 2] += gk[u][k] * __uint_as_float(a.y << 16); v[u][4 * i + 3] += gk[u][k] * __uint_as_float(a.y & 0xFFFF0000u);
                    }
            }
            float ss = 0.f;
#pragma unroll
            for (int i = 0; i < 16; ++i) ss += v[u][i] * v[u][i];
            ss = red64_sum(ss);
            const float rstd = rsqrtf(ss * (1.0f / DM) + 1e-6f);
#pragma unroll
            for (int i = 0; i < 4; ++i) {
                if (xr) *(float4*)(xr + (size_t)t * DM + i * 256 + lane * 4) = make_float4(v[u][4 * i], v[u][4 * i + 1], v[u][4 * i + 2], v[u][4 * i + 3]);
                const float4 g = *(const float4*)(gain + i * 256 + lane * 4);
                const float h0 = v[u][4 * i] * rstd * g.x, h1 = v[u][4 * i + 1] * rstd * g.y, h2 = v[u][4 * i + 2] * rstd * g.z, h3 = v[u][4 * i + 3] * rstd * g.w;
                if (hb) *(uint2*)(hb + (size_t)t * DM + i * 256 + lane * 4) = make_uint2(pack2(h0, h1), pack2(h2, h3));
                if (hf) { float4 o4 = make_float4(h0 * pscale, h1 * pscale, h2 * pscale, h3 * pscale);
                    if (pv != 0.0f && t == 0 && i == 0 && lane == 0) o4.x = pv;
                    *(float4*)(hf + (size_t)t * DM + i * 256 + lane * 4) = o4; }
            }
        }
    }
}

#define GSW(tid) ((((tid) & 3) ^ ((0 - ((tid) >> 4)) & 3)) * 8)
__device__ __forceinline__ void glds16(const bf16_t* g, char* l) {
    __builtin_amdgcn_global_load_lds((const unsigned*)g, (LAS unsigned*)l, 16, 0, 0);
}
template <class AOff, class Epi>
__device__ __forceinline__ void gemm_tile(char* smem, const bf16_t* a0, const bf16_t* a1, const bf16_t* b0, const bf16_t* b1, int KT, AOff aoff, Epi epi) {
    const int tid = hidden_tid(), wid = tid >> 6, lane = tid & 63, wr = wid >> 1, wc = wid & 1, fr = lane & 15, fq = lane >> 4;
    const int csw = (fq ^ ((0 - (fr >> 2)) & 3)) * 16;
    f32x4 acc[4][4];
#pragma unroll
    for (int m = 0; m < 4; ++m)
#pragma unroll
        for (int n = 0; n < 4; ++n) acc[m][n] = (f32x4){0.f, 0.f, 0.f, 0.f};
    auto stage = [&](int t) {
        char* buf = smem + (t & 3) * 16384;
        const size_t ao = aoff(t);
        glds16(a0 + ao, buf + tid * 16); glds16(a1 + ao, buf + 4096 + tid * 16);
        glds16(b0 + t * 32, buf + 8192 + tid * 16); glds16(b1 + t * 32, buf + 8192 + 4096 + tid * 16);
    };
    asm volatile("s_waitcnt vmcnt(0)" ::: "memory");
    stage(0);
    if (KT > 1) stage(1);
    if (KT > 2) stage(2);
    for (int t = 0; t < KT; ++t) {
        const char* cur = smem + (t & 3) * 16384;
        if (t + 2 < KT) asm volatile("s_waitcnt vmcnt(8)" ::: "memory");
        else if (t + 1 < KT) asm volatile("s_waitcnt vmcnt(4)" ::: "memory");
        else asm volatile("s_waitcnt vmcnt(0)" ::: "memory");
        __builtin_amdgcn_s_barrier();
        asm volatile("" ::: "memory");
        if (t + 3 < KT) stage(t + 3);
        bf16x8 af[4], bfr[4];
#pragma unroll
        for (int m = 0; m < 4; ++m) af[m] = *(const bf16x8*)(cur + (wr * 64 + m * 16 + fr) * 64 + csw);
#pragma unroll
        for (int n = 0; n < 4; ++n) bfr[n] = *(const bf16x8*)(cur + 8192 + (wc * 64 + n * 16 + fr) * 64 + csw);
        __builtin_amdgcn_s_setprio(1);
#pragma unroll
        for (int m = 0; m < 4; ++m)
#pragma unroll
            for (int n = 0; n < 4; ++n) acc[m][n] = mfma16(af[m], bfr[n], acc[m][n]);
        __builtin_amdgcn_s_setprio(0);
    }
    epi(acc, wr, wc, fr, fq);
    __syncthreads();
}

__device__ __forceinline__ void ld_frags(const char* cur, int wr, int wc, int fr, int csw, bf16x8 (&af)[4], bf16x8 (&bfr)[4]) {
#pragma unroll
    for (int m = 0; m < 4; ++m) af[m] = *(const bf16x8*)(cur + (wr * 64 + m * 16 + fr) * 64 + csw);
#pragma unroll
    for (int n = 0; n < 4; ++n) bfr[n] = *(const bf16x8*)(cur + 8192 + (wc * 64 + n * 16 + fr) * 64 + csw);
}
__device__ __forceinline__ void mma_frags(const bf16x8 (&af)[4], const bf16x8 (&bfr)[4], f32x4 (&acc)[4][4]) {
    __builtin_amdgcn_s_setprio(1);
#pragma unroll
    for (int m = 0; m < 4; ++m)
#pragma unroll
        for (int n = 0; n < 4; ++n) acc[m][n] = mfma16(af[m], bfr[n], acc[m][n]);
    __builtin_amdgcn_s_setprio(0);
}
template <class AOff, class Epi>
__device__ __forceinline__ void gemm_tile_p(char* smem, const bf16_t* a0, const bf16_t* a1, const bf16_t* b0, const bf16_t* b1, int KT, AOff aoff, Epi epi) {
    const int tid = hidden_tid(), wid = tid >> 6, lane = tid & 63, wr = wid >> 1, wc = wid & 1, fr = lane & 15, fq = lane >> 4;
    const int csw = (fq ^ ((0 - (fr >> 2)) & 3)) * 16;
    f32x4 acc[4][4];
#pragma unroll
    for (int m = 0; m < 4; ++m)
#pragma unroll
        for (int n = 0; n < 4; ++n) acc[m][n] = (f32x4){0.f, 0.f, 0.f, 0.f};
    auto stage = [&](int t) {
        char* buf = smem + (t & 3) * 16384;
        const size_t ao = aoff(t);
        glds16(a0 + ao, buf + tid * 16); glds16(a1 + ao, buf + 4096 + tid * 16);
        glds16(b0 + t * 32, buf + 8192 + tid * 16); glds16(b1 + t * 32, buf + 8192 + 4096 + tid * 16);
    };
    auto sync = [&](int t) {
        if (t + 2 < KT) asm volatile("s_waitcnt vmcnt(4)" ::: "memory"); else asm volatile("s_waitcnt vmcnt(0)" ::: "memory");
        __builtin_amdgcn_s_barrier();
        asm volatile("" ::: "memory");
        if (t + 3 < KT) stage(t + 3);
    };
    asm volatile("s_waitcnt vmcnt(0)" ::: "memory");
    stage(0); stage(1); if (KT > 2) stage(2);
    asm volatile("s_waitcnt vmcnt(8)" ::: "memory");
    if (KT <= 2) asm volatile("s_waitcnt vmcnt(4)" ::: "memory");
    __builtin_amdgcn_s_barrier();
    asm volatile("" ::: "memory");
    bf16x8 afA[4], bfA[4], afB[4], bfB[4];
    ld_frags(smem, wr, wc, fr, csw, afA, bfA);
    for (int t = 0; t < KT; t += 2) {
        sync(t);
        ld_frags(smem + ((t + 1) & 3) * 16384, wr, wc, fr, csw, afB, bfB);
        mma_frags(afA, bfA, acc);
        sync(t + 1);
        if (t + 2 < KT) ld_frags(smem + ((t + 2) & 3) * 16384, wr, wc, fr, csw, afA, bfA);
        mma_frags(afB, bfB, acc);
    }
    epi(acc, wr, wc, fr, fq);
    __syncthreads();
}

#define GSW64(tid) ((((tid) & 7) ^ (((tid) >> 4) & 7)) * 8)
template <class AOff, class Epi>
__device__ __forceinline__ void gemm_tile_k64(char* smem, int tid, const bf16_t* const (&ap)[4], const bf16_t* b0, size_t b32, int KT, AOff aoff, Epi epi) {
    const int wid = tid >> 6, lane = tid & 63, wr = wid >> 1, wc = wid & 1, fr = lane & 15, fq = lane >> 4;
    const int sw = (fr >> 1) & 7;
    f32x4 acc[4][4];
#pragma unroll
    for (int m = 0; m < 4; ++m)
#pragma unroll
        for (int n = 0; n < 4; ++n) acc[m][n] = (f32x4){0.f, 0.f, 0.f, 0.f};
    auto stage = [&](int t) {
        char* buf = smem + (t & 1) * 32768;
        const size_t ao = aoff(t);
#pragma unroll
        for (int i = 0; i < 4; ++i) glds16(ap[i] + ao, buf + i * 4096 + tid * 16);
        const bf16_t* bp = b0 + t * 64;
#pragma unroll
        for (int i = 0; i < 4; ++i) glds16(bp + i * b32, buf + 16384 + i * 4096 + tid * 16);
    };
    asm volatile("s_waitcnt vmcnt(0)" ::: "memory");
    stage(0);
    for (int t = 0; t < KT; ++t) {
        const char* cur = smem + (t & 1) * 32768;
        asm volatile("s_waitcnt vmcnt(0)" ::: "memory");
        __builtin_amdgcn_s_barrier();
        asm volatile("" ::: "memory");
        if (t + 1 < KT) stage(t + 1);
#pragma unroll
        for (int ks = 0; ks < 2; ++ks) {
            const int cb = ((ks * 4 + fq) ^ sw) * 16;
            bf16x8 af[4], bfr[4];
#pragma unroll
            for (int m = 0; m < 4; ++m) af[m] = *(const bf16x8*)(cur + (wr * 64 + m * 16 + fr) * 128 + cb);
#pragma unroll
            for (int n = 0; n < 4; ++n) bfr[n] = *(const bf16x8*)(cur + 16384 + (wc * 64 + n * 16 + fr) * 128 + cb);
            __builtin_amdgcn_s_setprio(1);
#pragma unroll
            for (int m = 0; m < 4; ++m)
#pragma unroll
                for (int n = 0; n < 4; ++n) acc[m][n] = mfma16(af[m], bfr[n], acc[m][n]);
            __builtin_amdgcn_s_setprio(0);
        }
    }
    epi(acc, wr, wc, fr, fq);
    __syncthreads();
}


#define EP2 132
__device__ __forceinline__ bool cu_first(const char* smem) {
#if MEGA
    return __builtin_amdgcn_readfirstlane(((const int*)(smem - HDR_BYTES))[120]) == 0;
#else
    return (blockIdx.x & 1) == 0;
#endif
}
template <int MODE = 0, class Epi>
__device__ __forceinline__ void gemm_tile_q(char* smem, int tid, const char* A, const unsigned (&ao)[8], const char* Bu, unsigned bo, unsigned ldbB, int KT, Epi epi) {
    const int wid = tid >> 6, lane = tid & 63, wr = wid >> 1, wc = wid & 1, fr = lane & 15, fq = lane >> 4;
    const int cb0 = (fq ^ ((fr >> 1) & 7)) * 16;
    const int a_k0 = (wr * 64 + fr) * 128 + cb0, a_k1 = a_k0 ^ 64, b_k0 = (wc * 32 + fr) * 128 + cb0, b_k1 = b_k0 ^ 64;
    const int wsc = __builtin_amdgcn_readfirstlane(wid), wbase = wsc * 1024;
    f32x4 acc[2][2][4][2];
#pragma unroll
    for (int a = 0; a < 2; ++a)
#pragma unroll
        for (int b = 0; b < 2; ++b)
#pragma unroll
            for (int m = 0; m < 4; ++m)
#pragma unroll
                for (int n = 0; n < 2; ++n) acc[a][b][m][n] = (f32x4){0.f, 0.f, 0.f, 0.f};
    bf16x8 At[4][2], B0[2][2], B1[2][2];
    int sa0 = 0, sa1 = 16384, sa2 = 32768, sb0 = 49152, sb1 = 57344, sb2 = 65536;
    auto pieceA = [&](int h, int t, int slot, int i) {
        const char* au = A + (size_t)t * 128;
        unsigned o = ao[h * 4 + i]; asm volatile("" : "+v"(o));
        glds16((const bf16_t*)(au + o), smem + slot + i * 4096 + wbase);
    };
    auto pieceB = [&](int h, int t, int slot, int i) {
        const char* bu = Bu + ((size_t)(h * 64 + i * 32) * ldbB + (size_t)t * 128);
        unsigned o = bo; asm volatile("" : "+v"(o));
        glds16((const bf16_t*)(bu + o), smem + slot + i * 4096 + wbase);
    };
    auto stageA = [&](int h, int t, int slot) {
#pragma unroll
        for (int i = 0; i < 4; ++i) pieceA(h, t, slot, i);
    };
    auto stageB = [&](int h, int t, int slot) {
#pragma unroll
        for (int i = 0; i < 2; ++i) pieceB(h, t, slot, i);
    };
    auto LDA = [&](int slot) {
        const char* s0 = smem + slot + a_k0; const char* s1 = smem + slot + a_k1;
#pragma unroll
        for (int m = 0; m < 4; ++m) { At[m][0] = *(const bf16x8*)(s0 + m * 2048); At[m][1] = *(const bf16x8*)(s1 + m * 2048); }
    };
    auto LDB = [&](bf16x8 (&B)[2][2], int slot) {
        const char* s0 = smem + slot + b_k0; const char* s1 = smem + slot + b_k1;
#pragma unroll
        for (int n = 0; n < 2; ++n) { B[n][0] = *(const bf16x8*)(s0 + n * 2048); B[n][1] = *(const bf16x8*)(s1 + n * 2048); }
    };
    auto MMA = [&](f32x4 (&c)[4][2], const bf16x8 (&B)[2][2], auto&& issue) {
        __builtin_amdgcn_s_setprio(1);
#pragma unroll
        for (int m = 0; m < 4; ++m) {
#pragma unroll
            for (int n = 0; n < 2; ++n) { c[m][n] = mfma16(At[m][0], B[n][0], c[m][n]); c[m][n] = mfma16(At[m][1], B[n][1], c[m][n]); }
            issue(m);
        }
        __builtin_amdgcn_s_setprio(0);
    };
    stageB(0, 0, sb0); stageA(0, 0, sa0); stageA(1, 0, sa1); stageB(1, 0, sb1);
    if (KT > 1) { stageB(0, 1, sb2); asm volatile("s_waitcnt vmcnt(8)" ::: "memory"); } else asm volatile("s_waitcnt vmcnt(6)" ::: "memory");
    __builtin_amdgcn_s_barrier();
    asm volatile("" ::: "memory");
#pragma unroll 1
    for (int t = 0; t < KT; ++t) {
        const bool more = t + 1 < KT, more2 = t + 2 < KT;
        if (MODE != 3) { LDB(B0, sb0); LDA(sa0); }
        if (more && MODE != 2) stageA(0, t + 1, sa2);
        if (MODE != 3) MMA(acc[0][0], B0, [&](int) {});
        if (more) asm volatile("s_waitcnt vmcnt(6)" ::: "memory"); else asm volatile("s_waitcnt vmcnt(0)" ::: "memory");
        __builtin_amdgcn_s_barrier();
        asm volatile("" ::: "memory");
        if (MODE != 3) LDB(B1, sb1);
        if (more && MODE != 2) { stageA(1, t + 1, sa0); stageB(1, t + 1, sb0); }
        if (MODE != 3) MMA(acc[0][1], B1, [&](int) {});
        __builtin_amdgcn_s_barrier();
        asm volatile("" ::: "memory");
        if (MODE != 3) LDA(sa1);
        if (more2 && MODE != 2) stageB(0, t + 2, sb1);
        if (MODE != 3) MMA(acc[1][0], B0, [&](int) {});
        if (MODE != 3) MMA(acc[1][1], B1, [&](int) {});
        if (more2) asm volatile("s_waitcnt vmcnt(8)" ::: "memory"); else if (more) asm volatile("s_waitcnt vmcnt(6)" ::: "memory");
        __builtin_amdgcn_s_barrier();
        asm volatile("" ::: "memory");
        { const int x = sa0; sa0 = sa2; sa2 = sa1; sa1 = x; }
        { const int x = sb0; sb0 = sb2; sb2 = sb1; sb1 = x; }
    }
    if (MODE != 0) {
        float sink = 0.f;
#pragma unroll
        for (int a = 0; a < 2; ++a)
#pragma unroll
            for (int b = 0; b < 2; ++b)
#pragma unroll
                for (int m = 0; m < 4; ++m)
#pragma unroll
                    for (int n = 0; n < 2; ++n) sink += acc[a][b][m][n][0] + acc[a][b][m][n][1] + acc[a][b][m][n][2] + acc[a][b][m][n][3];
        asm volatile("" :: "v"(sink));
        __syncthreads();
        return;
    }
    float* P = (float*)smem;
    {
        const int tz = hidden_tid(), wr = (tz >> 7) & 1, wc = (tz >> 6) & 1, fr = tz & 15, fq = (tz >> 4) & 3;
#pragma unroll
        for (int b = 0; b < 2; ++b)
#pragma unroll
            for (int m = 0; m < 4; ++m)
#pragma unroll
                for (int n = 0; n < 2; ++n)
#pragma unroll
                    for (int j = 0; j < 4; ++j) P[(wr * 64 + m * 16 + fq * 4 + j) * EP2 + b * 64 + wc * 32 + n * 16 + fr] = acc[0][b][m][n][j];
        lds_barrier();
        epi(P + (wr * 64) * EP2 + wc * 64, wr * 64, wc);
        lds_barrier();
#pragma unroll
        for (int b = 0; b < 2; ++b)
#pragma unroll
            for (int m = 0; m < 4; ++m)
#pragma unroll
                for (int n = 0; n < 2; ++n)
#pragma unroll
                    for (int j = 0; j < 4; ++j) P[(wr * 64 + m * 16 + fq * 4 + j) * EP2 + b * 64 + wc * 32 + n * 16 + fr] = acc[1][b][m][n][j];
        lds_barrier();
        epi(P + (wr * 64) * EP2 + wc * 64, 128 + wr * 64, wc);
        lds_barrier();
    }
}


template <class Epi>
__device__ __forceinline__ void gemm_tile_s(char* smem, int tid, const char* A, const unsigned (&ao)[4], const char* Bu, unsigned bo, unsigned ldbB, int KT, Epi epi) {
    const int wid = tid >> 6, lane = tid & 63, wr = wid >> 1, wc = wid & 1, fr = lane & 15, fq = lane >> 4;
    const int sw = (fr >> 1) & 7;
    const int wbase = __builtin_amdgcn_readfirstlane(wid) * 1024;
    f32x4 acc[4][4];
#pragma unroll
    for (int m = 0; m < 4; ++m)
#pragma unroll
        for (int n = 0; n < 4; ++n) acc[m][n] = (f32x4){0.f, 0.f, 0.f, 0.f};
    auto stage = [&](int t) {
        char* buf = smem + (t & 1) * 32768;
        const char* au = A + (size_t)t * 128;
#pragma unroll
        for (int i = 0; i < 4; ++i) { unsigned o = ao[i]; asm volatile("" : "+v"(o)); glds16((const bf16_t*)(au + o), buf + i * 4096 + wbase); }
#pragma unroll
        for (int i = 0; i < 4; ++i) { const char* bu = Bu + ((size_t)(i * 32) * ldbB + (size_t)t * 128); unsigned o = bo; asm volatile("" : "+v"(o)); glds16((const bf16_t*)(bu + o), buf + 16384 + i * 4096 + wbase); }
    };
    asm volatile("s_waitcnt vmcnt(0)" ::: "memory");
    stage(0);
    for (int t = 0; t < KT; ++t) {
        const char* cur = smem + (t & 1) * 32768;
        asm volatile("s_waitcnt vmcnt(0)" ::: "memory");
        __builtin_amdgcn_s_barrier();
        asm volatile("" ::: "memory");
        if (t + 1 < KT) stage(t + 1);
#pragma unroll
        for (int ks = 0; ks < 2; ++ks) {
            const int cb = ((ks * 4 + fq) ^ sw) * 16;
            bf16x8 af[4], bfr[4];
#pragma unroll
            for (int m = 0; m < 4; ++m) af[m] = *(const bf16x8*)(cur + (wr * 64 + m * 16 + fr) * 128 + cb);
#pragma unroll
            for (int n = 0; n < 4; ++n) bfr[n] = *(const bf16x8*)(cur + 16384 + (wc * 64 + n * 16 + fr) * 128 + cb);
            __builtin_amdgcn_s_setprio(1);
#pragma unroll
            for (int m = 0; m < 4; ++m)
#pragma unroll
                for (int n = 0; n < 4; ++n) acc[m][n] = mfma16(af[m], bfr[n], acc[m][n]);
            __builtin_amdgcn_s_setprio(0);
        }
    }
    float* P = (float*)smem;
    {
        const int tz = hidden_tid(), wr = (tz >> 7) & 1, wc = (tz >> 6) & 1, fr = tz & 15, fq = (tz >> 4) & 3;
        lds_barrier();
#pragma unroll
        for (int m = 0; m < 4; ++m)
#pragma unroll
            for (int n = 0; n < 4; ++n)
#pragma unroll
                for (int j = 0; j < 4; ++j) P[(wr * 64 + m * 16 + fq * 4 + j) * EP2 + wc * 64 + n * 16 + fr] = acc[m][n][j];
        lds_barrier();
        epi(P + (wr * 64) * EP2 + wc * 64, wr * 64, wc);
        lds_barrier();
    }
}

__device__ __forceinline__ void col_kind(int L, int ct, int& kind, int& vh, float& scale) {
    kind = 0; vh = 0; scale = 1.f;
    if (L == 0) {
        if (ct < 8) { kind = 1; scale = 0.125f * LOG2E; }
        else if (ct < 10) kind = 1;
        else if (ct < 12) { kind = 2; vh = ct - 10; }
        else if (ct < 20) { kind = 0; scale = 0.125f; }
        else if (ct < 28) kind = 0;
        else { kind = 2; vh = 2 + (ct - 28); }
    } else {
        if (ct < 8) { kind = 1; scale = 0.125f * LOG2E; }
        else if (ct < 10) kind = 1;
        else if (ct < 12) { kind = 2; vh = ct - 10; }
        else if (ct < 20) { kind = 1; scale = 0.125f * LOG2E; }
        else if (ct < 22) kind = 1;
        else if (ct < 24) kind = 0;
        else if (ct < 26) kind = 1;
        else if (ct < 28) { kind = 2; vh = 2 + (ct - 26); }
        else if (ct < 30) kind = 1;
        else if (ct < 32) { kind = 2; vh = 4 + (ct - 30); }
        else if (ct == 32) kind = 3;
        else kind = 4;
    }
}

#ifndef GEMM_EXP
#define GEMM_EXP 0
#endif
#define EPITCH 68
__device__ __forceinline__ void dump_half(float* E, const f32x4 (&acc)[4][4], int nb, int fr, int fq) {
#pragma unroll
    for (int m = 0; m < 4; ++m)
#pragma unroll
        for (int n = 0; n < 4; ++n)
#pragma unroll
            for (int j = 0; j < 4; ++j) E[(m * 16 + fq * 4 + j) * EPITCH + n * 16 + fr] = acc[m][nb + n][j];
}
__device__ __forceinline__ void ld8f(const float* p, float (&v)[8]) {
    const float4 a = *(const float4*)p, b = *(const float4*)(p + 4);
    v[0] = a.x; v[1] = a.y; v[2] = a.z; v[3] = a.w; v[4] = b.x; v[5] = b.y; v[6] = b.z; v[7] = b.w;
}
__device__ __forceinline__ void st8bf(bf16_t* p, const float (&v)[8]) {
    *(uint4*)p = make_uint4(pack2(v[0], v[1]), pack2(v[2], v[3]), pack2(v[4], v[5]), pack2(v[6], v[7]));
}

template <int MODE = 0>
__device__ __forceinline__ void ph_gemm_qkv(const Params& p, char* smem, int L) {
    const bf16_t* A = (const bf16_t*)(p.ws + OFF_H);
    const bf16_t* Bt = (const bf16_t*)(p.ws + W_IN);
    bf16_t* Q = (bf16_t*)(p.ws + OFF_QKV);
    bf16_t* VT = (bf16_t*)(p.ws + OFF_VT);
    float* GD = (float*)(p.ws + B_GD);
    const float* rc = (const float*)(p.ws + OFF_ROPE); const float* rs = rc + (size_t)NTOK * 32;
    const int tn = (L == 0) ? 18 : 17, tm = NTOK / 256, total = tm * tn;
    const int tid = hidden_tid();
    const bool aff = (gridDim.x & 7) == 0;
    const int xcd = blockIdx.x & 7, nh = xcd >> 2, ncols = aff ? (nh ? tn - 9 : 9) : tn;
    const int lstart = aff ? (blockIdx.x >> 3) : blockIdx.x, lstep = aff ? (gridDim.x >> 3) : gridDim.x, lcnt = aff ? (tm / 4) * ncols : total;
    const int full = (lcnt / lstep) * lstep, nitems = full + 2 * (lcnt - full);
    int brow = 0, bcol = 0;
    auto epi =
            [&](const float* E, int rb, int wc) {
                const int lane = hidden_tid() & 63;
                const int rowbase = brow + rb;
                const int ct = (bcol >> 6) + wc;
                int kind, vh; float scale; col_kind(L, ct, kind, vh, scale);
                if (kind == 4) return;
                if (kind == 0 || kind == 1) {
#pragma unroll 2
                    for (int i = 0; i < 4; ++i) {
                        const int u = lane + 64 * i, r = u >> 2, c8 = (u & 3) * 8, grow = rowbase + r;
                        float x1[8], x2[8], o1[8], o2[8];
                        ld8f(E + r * EP2 + c8, x1); ld8f(E + r * EP2 + 32 + c8, x2);
                        if (kind == 1) {
                            float cs[8], sn[8];
                            ld8f(rc + (size_t)grow * 32 + c8, cs); ld8f(rs + (size_t)grow * 32 + c8, sn);
#pragma unroll
                            for (int e = 0; e < 8; ++e) { o1[e] = (x1[e] * cs[e] - x2[e] * sn[e]) * scale; o2[e] = (x2[e] * cs[e] + x1[e] * sn[e]) * scale; }
                        } else {
#pragma unroll
                            for (int e = 0; e < 8; ++e) { o1[e] = x1[e] * scale; o2[e] = x2[e] * scale; }
                        }
                        st8bf(Q + (size_t)grow * LDQ + ct * 64 + c8, o1);
                        st8bf(Q + (size_t)grow * LDQ + ct * 64 + 32 + c8, o2);
                    }
                } else if (kind == 2) {
                    const int b = rowbase >> 14, s0 = rowbase & (SEQ - 1);
                    bf16_t* vrow = VT + ((size_t)(b * NVH + vh) * 64 + lane) * VLD + s0;
#pragma unroll 2
                    for (int tc = 0; tc < 8; ++tc) {
                        float v[8];
#pragma unroll
                        for (int e = 0; e < 8; ++e) v[e] = E[(8 * tc + e) * EP2 + lane];
                        st8bf(vrow + 8 * tc, v);
                    }
                } else {
#pragma unroll
                    for (int c = 0; c < 6; ++c) *(float4*)(GD + (size_t)(rowbase + lane) * 24 + 4 * c) = *(const float4*)(E + lane * EP2 + 4 * c);
                }
            };
    for (int it = lstart; it < (MODE ? full : nitems); it += lstep) {
        const bool big = it < full;
        const int li = big ? it : full + ((it - full) >> 1);
        const int mt = aff ? ((xcd & 3) * (tm / 4) + li / ncols) : (li / tn), nt = aff ? (nh * 9 + li % ncols) : (li % tn);
        bcol = nt * 128;
        const unsigned bo = (unsigned)(((tid >> 3) * DM + GSW64(tid)) * 2);
        const char* Bu = (const char*)(Bt + (size_t)bcol * DM);
        if (big) {
            brow = mt * 256;
            unsigned ao[8];
#pragma unroll
            for (int k = 0; k < 8; ++k) ao[k] = (unsigned)(((brow + (k >> 2) * 128 + (k & 3) * 32 + (tid >> 3)) * DM + GSW64(tid)) * 2);
            gemm_tile_q<MODE>(smem, tid, (const char*)A, ao, Bu, bo, DM * 2, DM / 64, epi);
        } else {
            brow = mt * 256 + ((it - full) & 1) * 128;
            unsigned ao[4];
#pragma unroll
            for (int k = 0; k < 4; ++k) ao[k] = (unsigned)(((brow + k * 32 + (tid >> 3)) * DM + GSW64(tid)) * 2);
            gemm_tile_s(smem, tid, (const char*)A, ao, Bu, bo, DM * 2, DM / 64, epi);
        }
    }
}

__device__ __forceinline__ void ph_gemm_out(const Params& p, char* smem, const float* xin) {
    const bf16_t* A = (const bf16_t*)(p.ws + OFF_O);
    const bf16_t* Bt = (const bf16_t*)(p.ws + W_OUT);
    float* X = p.out;
    const int tn = 8, tm = NTOK / 256, total = tm * tn, tid = hidden_tid();
    const bool aff = (gridDim.x & 7) == 0;
    const int xcd = blockIdx.x & 7, lstart = aff ? (blockIdx.x >> 3) : blockIdx.x, lstep = aff ? (gridDim.x >> 3) : gridDim.x, lcnt = aff ? total / 8 : total;
    for (int li = lstart; li < lcnt; li += lstep) {
        const int mt = aff ? (xcd * (tm / 8) + li / tn) : (li / tn), nt = li % tn, brow = mt * 256, bcol = nt * 128;
        unsigned ao[8];
#pragma unroll
        for (int k = 0; k < 8; ++k) ao[k] = (unsigned)(((brow + (k >> 2) * 128 + (k & 3) * 32 + (tid >> 3)) * DM + GSW64(tid)) * 2);
        const unsigned bo = (unsigned)(((tid >> 3) * DM + GSW64(tid)) * 2);
        gemm_tile_q(smem, tid, (const char*)A, ao, (const char*)(Bt + (size_t)bcol * DM), bo, DM * 2, DM / 64,
            [&](const float* E, int rb, int wc) {
                const int lane = hidden_tid() & 63;
#pragma unroll 4
                for (int i = 0; i < 16; ++i) {
                    const int u = lane + 64 * i, r = u >> 4, c4 = (u & 15) * 4;
                    const size_t xo = (size_t)(brow + rb + r) * DM + bcol + wc * 64 + c4;
                    const float4 e = *(const float4*)(E + r * EP2 + c4);
                    float4 x = *(const float4*)(xin + xo); x.x += e.x; x.y += e.y; x.z += e.z; x.w += e.w; *(float4*)(X + xo) = x;
                }
            });
    }
}

#define MOE_CAP 32768
__device__ __forceinline__ void ph_route(const Params& p, char* smem, int L) {
    float* lgs = (float*)smem;
    int* hist = (int*)(smem + 20480);
    int* gb = hist + 64;
    int* dec_e = gb + 64;
    int* dec_r = dec_e + 128;
    float* dec_g = (float*)(dec_r + 128);
    const float* gain = p.ln_ffn[L]; const float* Wg = p.r_group[L]; const float* We = p.r_expert[L];
    const bool norm_first = cu_first(smem);
    if (norm_first) norm_pass(p.out, nullptr, nullptr, nullptr, gain, (bf16_t*)(p.ws + OFF_H), nullptr);
    float* tok_g = (float*)(p.ws + M_TOKG);
    int* list = (int*)(p.ws + MOE_LIST);
    int* gcur = (int*)(p.ws + OFF_MOECNT) + L * 64 * CNTS;
    const int tid = hidden_tid(), lane = tid & 63, wid = tid >> 6, fr = lane & 15, fq = lane >> 4;
    for (int ch = blockIdx.x; ch < NTOK / 64; ch += gridDim.x) {
        if (tid < 64) hist[tid] = 0;
        const int tb = ch * 64 + wid * 16;
        f32x4 acc[5];
#pragma unroll
        for (int n = 0; n < 5; ++n) acc[n] = (f32x4){0.f, 0.f, 0.f, 0.f};
        float ss = 0.f;
        const float* xp = p.out + (size_t)(tb + fr) * DM + 4 * fq;
        const float* wep = We + (size_t)(4 * fq) * 64 + 4 * fr;
        const float* wgp = Wg + (size_t)(4 * fq) * 4 + (fr & 3);
        float4 x4 = *(const float4*)xp, g4 = *(const float4*)(gain + 4 * fq);
        float wb[4][5];
#pragma unroll
        for (int e = 0; e < 4; ++e) {
            { const float4 w4 = *(const float4*)(wep + (size_t)e * 64); wb[e][0] = w4.x; wb[e][1] = w4.y; wb[e][2] = w4.z; wb[e][3] = w4.w; }
            wb[e][4] = wgp[e * 4];
        }
        for (int i = 0; i < 64; ++i) {
            const int in = (i + 1 < 64) ? i + 1 : i;
            const float4 x4n = *(const float4*)(xp + 16 * in), g4n = *(const float4*)(gain + 16 * in + 4 * fq);
            float wn[4][5];
#pragma unroll
            for (int e = 0; e < 4; ++e) {
                { const float4 w4 = *(const float4*)(wep + (size_t)(16 * in + e) * 64); wn[e][0] = w4.x; wn[e][1] = w4.y; wn[e][2] = w4.z; wn[e][3] = w4.w; }
                wn[e][4] = wgp[(size_t)(16 * in + e) * 4];
            }
            ss += x4.x * x4.x + x4.y * x4.y + x4.z * x4.z + x4.w * x4.w;
            const float a[4] = {x4.x * g4.x, x4.y * g4.y, x4.z * g4.z, x4.w * g4.w};
#pragma unroll
            for (int e = 0; e < 4; ++e) {
#pragma unroll
                for (int n = 0; n < 4; ++n) acc[n] = __builtin_amdgcn_mfma_f32_16x16x4f32(a[e], wb[e][n], acc[n], 0, 0, 0);
                acc[4] = __builtin_amdgcn_mfma_f32_16x16x4f32(a[e], fr < 4 ? wb[e][4] : 0.f, acc[4], 0, 0, 0);
            }
            x4 = x4n; g4 = g4n;
#pragma unroll
            for (int e = 0; e < 4; ++e)
#pragma unroll
                for (int n = 0; n < 5; ++n) wb[e][n] = wn[e][n];
        }
        ss = quad_sum(ss);
        const float rstd = rsqrtf(ss * (1.0f / DM) + 1e-6f);
#pragma unroll
        for (int j = 0; j < 4; ++j) {
            const float r = __shfl(rstd, 4 * fq + j);
#pragma unroll
            for (int n = 0; n < 5; ++n) lgs[(wid * 16 + 4 * fq + j) * 80 + (n < 4 ? 4 * fr + n : 64 + fr)] = acc[n][j] * r;
        }
        __syncthreads();
        if (tid < 64) {
            const float* lt = lgs + tid * 80;
            float gl[4]; float gm = -INFINITY; int gi = 0;
#pragma unroll
            for (int i = 0; i < 4; ++i) { gl[i] = lt[64 + i]; if (gl[i] > gm) { gm = gl[i]; gi = i; } }
            float gsum = 0.f;
#pragma unroll
            for (int i = 0; i < 4; ++i) gsum += __expf(gl[i] - gm);
            const float gprob = 1.0f / gsum;
            float m0 = -INFINITY, m1 = -INFINITY; int i0 = 0, i1 = 0;
            for (int i = 0; i < 16; ++i) { const float v = lt[gi * 16 + i]; if (v > m0) { m1 = m0; i1 = i0; m0 = v; i0 = i; } else if (v > m1) { m1 = v; i1 = i; } }
            const float e1 = __expf(m1 - m0), den = 1.0f + e1;
            const int ex0 = gi * 16 + i0, ex1 = gi * 16 + i1;
            dec_e[tid * 2] = ex0; dec_e[tid * 2 + 1] = ex1;
            dec_g[tid * 2] = gprob / den; dec_g[tid * 2 + 1] = gprob * e1 / den;
            dec_r[tid * 2] = atomicAdd(&hist[ex0], 1); dec_r[tid * 2 + 1] = atomicAdd(&hist[ex1], 1);
        }
        __syncthreads();
        if (tid < 64) gb[tid] = hist[tid] > 0 ? atomicAdd(&gcur[tid * CNTS], hist[tid]) : 0;
        __syncthreads();
        if (tid < 128) {
            const int slot = ch * 128 + tid, ex = dec_e[tid];
            list[(size_t)ex * MOE_CAP + gb[ex] + dec_r[tid]] = slot;
            tok_g[slot] = dec_g[tid];
        }
        __syncthreads();
    }
    if (!norm_first) norm_pass(p.out, nullptr, nullptr, nullptr, gain, (bf16_t*)(p.ws + OFF_H), nullptr);
}

template <int MODE = 0>
__device__ __forceinline__ void ph_moe_gemm(const Params& p, char* smem, int which, int L) {
    int* tpre = (int*)(smem + 73728);
    int* e_cnt = tpre + 68;
    int* e_base = e_cnt + 64;
    int* tpreS = e_base + 64;
    const int* gcur = (const int*)(p.ws + OFF_MOECNT) + L * 64 * CNTS;
    const int* list = (const int*)(p.ws + MOE_LIST); const float* tok_g = (const float*)(p.ws + M_TOKG);
    const bf16_t* H = (const bf16_t*)(p.ws + OFF_H);
    bf16_t* HID = (bf16_t*)(p.ws + HID_OFF);
    bf16_t* Y = (bf16_t*)(p.ws + B_Y);
    const int tid = hidden_tid();
    const bool aff = (gridDim.x & 7) == 0;
    const int xcd = blockIdx.x & 7;
    const int nvis = aff ? 8 : 64;
    if (tid == 0) {
        int rb = 0; for (int i = 0; i < 64; ++i) { const int c = gcur[i * CNTS]; e_cnt[i] = c; e_base[i] = rb; rb += c; }
        int ab = 0, as = 0;
        for (int v = 0; v < nvis; ++v) {
            const int c = e_cnt[aff ? xcd + 8 * v : v], rem = c & 255;
            tpre[v] = ab; tpreS[v] = as; ab += (c >> 8) + (rem > 128 ? 1 : 0); as += (rem > 0 && rem <= 128) ? 1 : 0;
        }
        tpre[nvis] = ab; tpreS[nvis] = as;
    }
    __syncthreads();
    const int NB = tpre[nvis] * 8, NS = tpreS[nvis] * 8;
    const int lstart = aff ? (blockIdx.x >> 3) : blockIdx.x, lstep = aff ? (gridDim.x >> 3) : gridDim.x;
    int rowbase = 0, cnt = 0, bas = 0, nt = 0;
    const int* elist = list;
    auto epi0 = [&](const float* E, int rb, int wc) {
        const int lane = hidden_tid() & 63;
#pragma unroll 1
        for (int i = 0; i < 4; ++i) {
            const int u = lane + 64 * i, r = u >> 2, c8 = (u & 3) * 8, rr = rowbase + rb + r;
            float g[8], up[8], o[8];
            ld8f(E + r * EP2 + c8, g); ld8f(E + r * EP2 + 32 + c8, up);
#pragma unroll
            for (int e = 0; e < 8; ++e) o[e] = g[e] / (1.0f + __expf(-g[e])) * up[e];
            if (rr < cnt) st8bf(HID + (size_t)(bas + rr) * EH + (nt * 2 + wc) * 32 + c8, o);
        }
    };
    int sl = -1;
    int* slotL = (int*)(smem + 74816);
    auto epi1 = [&](const float* E, int rb, int wc) {
        const int t2 = hidden_tid(), lane = t2 & 63, c8 = (lane & 7) * 8;
        if (rb < 128) { slotL[t2] = sl; lds_barrier(); }
#pragma unroll
        for (int i = 0; i < 8; ++i) {
            const int r = (lane + 64 * i) >> 3, slot = slotL[rb + r];
            if (slot >= 0) {
                float x[8]; ld8f(E + r * EP2 + c8, x);
                st8bf(Y + (size_t)slot * DM + nt * 128 + wc * 64 + c8, x);
            }
        }
    };
    for (int it = lstart; it < NB + NS; it += lstep) {
        const bool big = it < NB;
        const int q = big ? it : it - NB, mtg = q >> 3;
        const int* pre = big ? tpre : tpreS;
        nt = q & 7;
        int v = 0;
        { int lo = 0, hi = nvis - 1; while (lo < hi) { const int mid = (lo + hi + 1) >> 1; if (pre[mid] <= mtg) lo = mid; else hi = mid - 1; } v = lo; }
        const int e = __builtin_amdgcn_readfirstlane(aff ? (xcd + 8 * v) : v);
        cnt = __builtin_amdgcn_readfirstlane(e_cnt[e]); bas = __builtin_amdgcn_readfirstlane(e_base[e]);
        rowbase = big ? __builtin_amdgcn_readfirstlane(mtg - pre[v]) * 256 : (cnt >> 8) * 256;
        elist = list + (size_t)e * MOE_CAP;
        const int r0 = rowbase + (tid >> 3);
        unsigned ao[8];
        if (which == 0) {
            const bf16_t* Bt = (const bf16_t*)(p.ws + W_GU) + (size_t)e * 1024 * 1024;
            const char* Bu = (const char*)(Bt + (size_t)(nt * 128) * DM);
            const unsigned bo = (unsigned)(((tid >> 3) * DM + GSW64(tid)) * 2);
            if (big) {
#pragma unroll
                for (int k = 0; k < 8; ++k) { const int r = r0 + (k >> 2) * 128 + (k & 3) * 32; const int tk = (r < cnt) ? (elist[r] >> 1) : 0; ao[k] = (unsigned)((tk * DM + GSW64(tid)) * 2); }
                gemm_tile_q<MODE>(smem, tid, (const char*)H, ao, Bu, bo, DM * 2, DM / 64, epi0);
            } else {
                unsigned a4[4];
#pragma unroll
                for (int k = 0; k < 4; ++k) { const int r = r0 + k * 32; const int tk = (r < cnt) ? (elist[r] >> 1) : 0; a4[k] = (unsigned)((tk * DM + GSW64(tid)) * 2); }
                gemm_tile_s(smem, tid, (const char*)H, a4, Bu, bo, DM * 2, DM / 64, epi0);
            }
        } else {
            sl = (rowbase + tid < cnt) ? elist[rowbase + tid] : -1;
            const bf16_t* Bt = (const bf16_t*)(p.ws + W_DN) + (size_t)e * 1024 * 512;
            const char* Bu = (const char*)(Bt + (size_t)(nt * 128) * EH);
            const unsigned bo = (unsigned)(((tid >> 3) * EH + GSW64(tid)) * 2);
            if (big) {
#pragma unroll
                for (int k = 0; k < 8; ++k) { const int r = r0 + (k >> 2) * 128 + (k & 3) * 32; ao[k] = (unsigned)((((r < cnt) ? (bas + r) : 0) * EH + GSW64(tid)) * 2); }
                gemm_tile_q<MODE>(smem, tid, (const char*)HID, ao, Bu, bo, EH * 2, EH / 64, epi1);
            } else {
                unsigned a4[4];
#pragma unroll
                for (int k = 0; k < 4; ++k) { const int r = r0 + k * 32; a4[k] = (unsigned)((((r < cnt) ? (bas + r) : 0) * EH + GSW64(tid)) * 2); }
                gemm_tile_s(smem, tid, (const char*)HID, a4, Bu, bo, EH * 2, EH / 64, epi1);
            }
        }
    }
}

struct KF { bf16x8 k[4][2]; };
struct VF { bf16x8 v[4][2]; };
struct St { float m, l; f32x4 o[4]; };
#define KEY_OF(kt, j, fq) (32 * ((kt) >> 1) + 8 * (fq) + 4 * ((kt) & 1) + (j))
__device__ __forceinline__ void st_init(St& st) {
    st.m = NEG_BIG; st.l = 0.f;
#pragma unroll
    for (int n = 0; n < 4; ++n) st.o[n] = (f32x4){0.f, 0.f, 0.f, 0.f};
}
__device__ __forceinline__ void load_k(KF& f, const bf16_t* kp, size_t ldk, int fr, int fq) {
    const bf16_t* base = kp + (size_t)(8 * (fr >> 2) + (fr & 3)) * ldk + fq * 8;
#pragma unroll
    for (int kt = 0; kt < 4; ++kt)
#pragma unroll
        for (int ks = 0; ks < 2; ++ks) f.k[kt][ks] = ld8(base + (size_t)(32 * (kt >> 1) + 4 * (kt & 1)) * ldk + ks * 32);
}
__device__ __forceinline__ void load_v(VF& f, const bf16_t* vp, size_t ldv, int fr, int fq) {
    const bf16_t* base = vp + (size_t)fr * ldv + fq * 8;
#pragma unroll
    for (int n = 0; n < 4; ++n)
#pragma unroll
        for (int h = 0; h < 2; ++h) f.v[n][h] = ld8(base + (size_t)(n * 16) * ldv + h * 32);
}
__device__ __forceinline__ void scores(const KF& f, const bf16x8 (&qf)[2], f32x4 (&s)[4]) {
#pragma unroll
    for (int kt = 0; kt < 4; ++kt) {
        s[kt] = mfma16(f.k[kt][0], qf[0], (f32x4){0.f, 0.f, 0.f, 0.f});
        s[kt] = mfma16(f.k[kt][1], qf[1], s[kt]);
    }
}
typedef unsigned u32x4 __attribute__((ext_vector_type(4)));
__device__ __forceinline__ void pv(const VF& f, const float (&p)[4][4], f32x4 (&o)[4]) {
#pragma unroll
    for (int h = 0; h < 2; ++h) {
        u32x4 w;
        w[0] = pack2(p[2 * h][0], p[2 * h][1]); w[1] = pack2(p[2 * h][2], p[2 * h][3]);
        w[2] = pack2(p[2 * h + 1][0], p[2 * h + 1][1]); w[3] = pack2(p[2 * h + 1][2], p[2 * h + 1][3]);
        const bf16x8 pb = __builtin_bit_cast(bf16x8, w);
#pragma unroll
        for (int n = 0; n < 4; ++n) o[n] = mfma16(f.v[n][h], pb, o[n]);
    }
}
template <bool FULL, class MaskFn>
__device__ __forceinline__ void softmax_step(const f32x4 (&s)[4], MaskFn mask, St& st, float (&p)[4][4], int fq) {
    float mx = -INFINITY; bool v[4][4];
#pragma unroll
    for (int kt = 0; kt < 4; ++kt)
#pragma unroll
        for (int j = 0; j < 4; ++j) {
            if (FULL) { v[kt][j] = true; mx = fmaxf(mx, s[kt][j]); }
            else { v[kt][j] = mask(KEY_OF(kt, j, fq)); mx = fmaxf(mx, v[kt][j] ? s[kt][j] : -INFINITY); }
        }
    mx = quad_max(mx);
    if (!__all(mx <= st.m)) {
        const float mn = fmaxf(st.m, mx), alpha = ex2(st.m - mn);
        st.l *= alpha; st.m = mn;
#pragma unroll
        for (int n = 0; n < 4; ++n) st.o[n] *= alpha;
    }
    float sum = 0.f;
#pragma unroll
    for (int kt = 0; kt < 4; ++kt)
#pragma unroll
        for (int j = 0; j < 4; ++j) { p[kt][j] = (FULL || v[kt][j]) ? ex2(s[kt][j] - st.m) : 0.f; sum += p[kt][j]; }
    st.l += sum;
}
template <bool PF = true, class AddrFn, class MaskFn, class FullFn>
__device__ __forceinline__ void attn_run(const bf16x8 (&qf)[2], int nsteps, AddrFn addr, size_t ldk, size_t ldv, MaskFn mask, FullFn full, St& st, int fr, int fq) {
    if (nsteps <= 0) return;
    const bf16_t* kp; const bf16_t* vp; addr(0, kp, vp);
    if (PF) {
        KF kc; load_k(kc, kp, ldk, fr, fq);
        for (int s = 0; s < nsteps; ++s) {
            VF vf; load_v(vf, vp, ldv, fr, fq);
            const bf16_t* kp2 = kp; const bf16_t* vp2 = vp;
            if (s + 1 < nsteps) addr(s + 1, kp2, vp2);
            KF kn; load_k(kn, kp2, ldk, fr, fq);
            f32x4 sc[4]; scores(kc, qf, sc);
            float p[4][4];
            if (full(s)) softmax_step<true>(sc, [&](int key) { return mask(s, key); }, st, p, fq); else softmax_step<false>(sc, [&](int key) { return mask(s, key); }, st, p, fq);
            pv(vf, p, st.o);
            kc = kn; kp = kp2; vp = vp2;
        }
    } else {
        for (int s = 0; s < nsteps; ++s) {
            addr(s, kp, vp);
            KF kc; load_k(kc, kp, ldk, fr, fq);
            VF vf; load_v(vf, vp, ldv, fr, fq);
            f32x4 sc[4]; scores(kc, qf, sc);
            float p[4][4];
            if (full(s)) softmax_step<true>(sc, [&](int key) { return mask(s, key); }, st, p, fq); else softmax_step<false>(sc, [&](int key) { return mask(s, key); }, st, p, fq);
            pv(vf, p, st.o);
        }
    }
}
__device__ __forceinline__ void st_part(bf16_t* p32, const f32x4 (&o)[4]) {
    uint4* q = (uint4*)p32;
    q[0] = make_uint4(pack2(o[0][0], o[0][1]), pack2(o[0][2], o[0][3]), pack2(o[1][0], o[1][1]), pack2(o[1][2], o[1][3]));
    q[1] = make_uint4(pack2(o[2][0], o[2][1]), pack2(o[2][2], o[2][3]), pack2(o[3][0], o[3][1]), pack2(o[3][2], o[3][3]));
}
__device__ __forceinline__ void st_rec_nsa(char* rec, int g, int fq, const f32x4 (&o)[4]) {
    *(uint4*)(rec + g * 64 + fq * 16) = make_uint4(pack2(o[0][0], o[0][1]), pack2(o[0][2], o[0][3]), pack2(o[1][0], o[1][1]), pack2(o[1][2], o[1][3]));
    *(uint4*)(rec + 256 + g * 64 + fq * 16) = make_uint4(pack2(o[2][0], o[2][1]), pack2(o[2][2], o[2][3]), pack2(o[3][0], o[3][1]), pack2(o[3][2], o[3][3]));
}
__device__ __forceinline__ void acc_rec(const uint4& a, const uint4& b, float c, f32x4 (&o)[4]) {
    const unsigned w[8] = {a.x, a.y, a.z, a.w, b.x, b.y, b.z, b.w};
#pragma unroll
    for (int n = 0; n < 4; ++n) {
        o[n][0] += c * __uint_as_float(w[2 * n] << 16); o[n][1] += c * __uint_as_float(w[2 * n] & 0xFFFF0000u);
        o[n][2] += c * __uint_as_float(w[2 * n + 1] << 16); o[n][3] += c * __uint_as_float(w[2 * n + 1] & 0xFFFF0000u);
    }
}
__device__ __forceinline__ void acc_part(const bf16_t* p32, float c, f32x4 (&o)[4]) {
    const uint4 a = ((const uint4*)p32)[0], b = ((const uint4*)p32)[1];
    const unsigned w[8] = {a.x, a.y, a.z, a.w, b.x, b.y, b.z, b.w};
#pragma unroll
    for (int n = 0; n < 4; ++n) {
        o[n][0] += c * __uint_as_float(w[2 * n] << 16); o[n][1] += c * __uint_as_float(w[2 * n] & 0xFFFF0000u);
        o[n][2] += c * __uint_as_float(w[2 * n + 1] << 16); o[n][3] += c * __uint_as_float(w[2 * n + 1] & 0xFFFF0000u);
    }
}
__device__ __forceinline__ void store_o4(bf16_t* dst, float a, float b, float c, float d) { *(uint2*)dst = make_uint2(pack2(a, b), pack2(c, d)); }

struct Stager {
    size_t ko, vo, ldk32, ldv32; int tid;
    __device__ __forceinline__ void init(int tid_, size_t ldk, size_t ldv) {
        tid = tid_;
        const int row = tid >> 3, c = tid & 7;
        const int gk = ((tid >> 4) & 1) | (((tid >> 6) & 3) << 1), gv = (tid >> 4) & 7;
        ko = (size_t)row * ldk + (c ^ gk) * 8;
        vo = (size_t)row * ldv + (c ^ gv) * 8;
        ldk32 = 32 * ldk; ldv32 = 32 * ldv;
    }
    __device__ __forceinline__ void stage_k(char* buf, const bf16_t* kp) const { glds16(kp + ko, buf + tid * 16); glds16(kp + ko + ldk32, buf + 4096 + tid * 16); }
    __device__ __forceinline__ void stage_v(char* buf, const bf16_t* vp) const { glds16(vp + vo, buf + 8192 + tid * 16); glds16(vp + vo + ldv32, buf + 12288 + tid * 16); }
};
__device__ __forceinline__ void lds_k(KF& f, const char* buf, int lane) {
    const int fr = lane & 15, fq = lane >> 4;
    const int gk = ((fr >> 1) & 1) | (((fr >> 2) & 3) << 1);
    const char* base = buf + (8 * (fr >> 2) + (fr & 3)) * 128;
#pragma unroll
    for (int kt = 0; kt < 4; ++kt)
#pragma unroll
        for (int ks = 0; ks < 2; ++ks) f.k[kt][ks] = *(const bf16x8*)(base + (32 * (kt >> 1) + 4 * (kt & 1)) * 128 + (((ks * 4 + fq) ^ gk) * 16));
}
__device__ __forceinline__ void lds_v(VF& f, const char* buf, int lane) {
    const int fr = lane & 15, fq = lane >> 4;
    const int gv = (fr >> 1) & 7;
    const char* base = buf + 8192 + fr * 128;
#pragma unroll
    for (int n = 0; n < 4; ++n)
#pragma unroll
        for (int h = 0; h < 2; ++h) f.v[n][h] = *(const bf16x8*)(base + n * 16 * 128 + (((h * 4 + fq) ^ gv) * 16));
}
#define LDS_RING(s) ((s) % 3 * 16384)
template <int NST = 3, class AddrFn, class MaskFn, class FullFn>
__device__ __forceinline__ void attn_run_lds(char* smem, const Stager& sg, const bf16x8 (&qf)[2], int nsteps, AddrFn addr, MaskFn mask, FullFn full, St& st, int lane, int fq) {
    if (nsteps <= 0) return;
    const bf16_t* kp; const bf16_t* vp;
    asm volatile("s_waitcnt vmcnt(0)" ::: "memory");
#pragma unroll
    for (int q = 0; q < NST - 1; ++q) if (q < nsteps) { addr(q, kp, vp); sg.stage_k(smem + q * 16384, kp); sg.stage_v(smem + q * 16384, vp); }
    for (int s = 0; s < nsteps; ++s) {
        const char* cur = smem + (s % NST) * 16384;
        if (NST >= 4 && s + 2 < nsteps) asm volatile("s_waitcnt vmcnt(8)" ::: "memory");
        else if (s + 1 < nsteps) asm volatile("s_waitcnt vmcnt(4)" ::: "memory"); else asm volatile("s_waitcnt vmcnt(0)" ::: "memory");
        __builtin_amdgcn_s_barrier();
        asm volatile("" ::: "memory");
        if (s + NST - 1 < nsteps) { addr(s + NST - 1, kp, vp); char* nxt = smem + ((s + NST - 1) % NST) * 16384; sg.stage_k(nxt, kp); sg.stage_v(nxt, vp); }
        KF kc; lds_k(kc, cur, lane);
        VF vf; lds_v(vf, cur, lane);
        f32x4 sc[4]; scores(kc, qf, sc);
        float p[4][4];
        if (full(s)) softmax_step<true>(sc, [&](int key) { return mask(s, key); }, st, p, fq); else softmax_step<false>(sc, [&](int key) { return mask(s, key); }, st, p, fq);
        pv(vf, p, st.o);
    }
    __syncthreads();
}

template <int NST = 3, class AddrFn, class MaskFn, class FullFn>
__device__ __forceinline__ void attn_run_lds2(char* smem, const Stager& sg, const bf16x8 (&qf)[2][2], int nsteps, AddrFn addr, MaskFn mask, FullFn full, St (&st)[2], int lane, int fq) {
    if (nsteps <= 0) return;
    const bf16_t* kp; const bf16_t* vp;
    asm volatile("s_waitcnt vmcnt(0)" ::: "memory");
#pragma unroll
    for (int q = 0; q < NST - 1; ++q) if (q < nsteps) { addr(q, kp, vp); sg.stage_k(smem + q * 16384, kp); sg.stage_v(smem + q * 16384, vp); }
    for (int s = 0; s < nsteps; ++s) {
        const char* cur = smem + (s % NST) * 16384;
        if (NST >= 4 && s + 2 < nsteps) asm volatile("s_waitcnt vmcnt(8)" ::: "memory");
        else if (s + 1 < nsteps) asm volatile("s_waitcnt vmcnt(4)" ::: "memory"); else asm volatile("s_waitcnt vmcnt(0)" ::: "memory");
        __builtin_amdgcn_s_barrier();
        asm volatile("" ::: "memory");
        if (s + NST - 1 < nsteps) { addr(s + NST - 1, kp, vp); char* nxt = smem + ((s + NST - 1) % NST) * 16384; sg.stage_k(nxt, kp); sg.stage_v(nxt, vp); }
        KF kc; lds_k(kc, cur, lane);
        VF vf; lds_v(vf, cur, lane);
#pragma unroll
        for (int r = 0; r < 2; ++r) {
            f32x4 sc[4]; scores(kc, qf[r], sc);
            float p[4][4];
            if (full(r, s)) softmax_step<true>(sc, [&](int key) { return mask(r, s, key); }, st[r], p, fq); else softmax_step<false>(sc, [&](int key) { return mask(r, s, key); }, st[r], p, fq);
            pv(vf, p, st[r].o);
        }
    }
    __syncthreads();
}

__device__ __forceinline__ void ph_attn0(const Params& p, char* smem) {
    const bf16_t* Q = (const bf16_t*)(p.ws + OFF_QKV);
    const bf16_t* VT = (const bf16_t*)(p.ws + OFF_VT);
    bf16_t* O = (bf16_t*)(p.ws + OFF_O);
    const int tid = (int)threadIdx.x, lane = tid & 63, wid = tid >> 6, fr = lane & 15, fq = lane >> 4;
    Stager sg; sg.init(tid, LDQ, VLD);
    for (int it = blockIdx.x; it < 2 * 2 * (SEQ / 32); it += gridDim.x) {
        const int tt = it % (SEQ / 32), hkv = (it / (SEQ / 32)) & 1, b = it / (2 * (SEQ / 32));
        const int head = hkv * 4 + wid, t0 = tt * 32;
        const size_t rowb = (size_t)b * SEQ;
        bf16x8 qf[2][2]; St st[2];
#pragma unroll
        for (int r = 0; r < 2; ++r) {
            const bf16_t* qp = Q + (rowb + t0 + 16 * r + fr) * LDQ + head * 64;
            qf[r][0] = ld8(qp + fq * 8); qf[r][1] = ld8(qp + 32 + fq * 8);
            st_init(st[r]);
            st[r].m = p.sinks0[head] * LOG2E; st[r].l = (fq == 0) ? 1.f : 0.f;
        }
        int k0 = t0 - 127; if (k0 < 0) k0 = 0; k0 &= ~63;
        const int ns = ((t0 + 31 - k0) >> 6) + 1;
        const bf16_t* kbase = Q + rowb * LDQ + 512 + hkv * 64;
        const bf16_t* vbase = VT + ((size_t)(b * NVH + hkv) * 64) * VLD;
        attn_run_lds2<4>(smem, sg, qf, ns, [&](int s, const bf16_t*& kp, const bf16_t*& vp) { const int kb = k0 + 64 * s; kp = kbase + (size_t)kb * LDQ; vp = vbase + kb; },
                      [&](int r, int s, int key) { const int k = k0 + 64 * s + key, t = t0 + 16 * r + fr; return (k <= t) && (t - k < 128); },
                      [&](int r, int s) { const int kb = k0 + 64 * s, tb = t0 + 16 * r; return (kb + 63 <= tb) && (tb + 15 - kb < 128); }, st, lane, fq);
#pragma unroll
        for (int r = 0; r < 2; ++r) {
            const float inv = 1.0f / quad_sum(st[r].l);
#pragma unroll
            for (int n = 0; n < 4; ++n) store_o4(O + (rowb + t0 + 16 * r + fr) * DM + head * 64 + n * 16 + 4 * fq, st[r].o[n][0] * inv, st[r].o[n][1] * inv, st[r].o[n][2] * inv, st[r].o[n][3] * inv);
        }
    }
    int* vote = (int*)(smem + 49152);
    for (int it = blockIdx.x; it < 2 * 8 * (SEQ / 64); it += gridDim.x) {
        const int tt = it % (SEQ / 64), head = (it / (SEQ / 64)) & 7, b = it / (8 * (SEQ / 64));
        const int tb0 = tt * 64, t = tb0 + 16 * wid + fr;
        const size_t rowb = (size_t)b * SEQ;
        bf16x8 qf[2];
        qf[0] = ld8(Q + (rowb + t) * LDQ + 768 + head * 64 + fq * 8);
        qf[1] = ld8(Q + (rowb + t) * LDQ + 768 + head * 64 + 32 + fq * 8);
        f32x4 o[4];
#pragma unroll
        for (int n = 0; n < 4; ++n) o[n] = (f32x4){0.f, 0.f, 0.f, 0.f};
        float R = 0.f;
        const bf16_t* kbase = Q + rowb * LDQ + 1280 + head * 64;
        const bf16_t* vbase = VT + ((size_t)(b * NVH + 2 + head) * 64) * VLD;
        const int nsteps = tt + 1;
        if (tid < 8) vote[tid] = 0;
        asm volatile("s_waitcnt vmcnt(0)" ::: "memory");
        sg.stage_k(smem, kbase + (size_t)tb0 * LDQ); sg.stage_v(smem, vbase + tb0);
        if (nsteps > 1) { sg.stage_k(smem + 16384, kbase + (size_t)(tb0 - 64) * LDQ); sg.stage_v(smem + 16384, vbase + tb0 - 64); }
        bool mine_done = false;
        for (int s = 0; s < nsteps; ++s) {
            const char* cur = smem + LDS_RING(s);
            const int kb = tb0 - 64 * s;
            if (s + 1 < nsteps) asm volatile("s_waitcnt vmcnt(4)" ::: "memory"); else asm volatile("s_waitcnt vmcnt(0)" ::: "memory");
            lds_fence();
            __builtin_amdgcn_s_barrier();
            asm volatile("" ::: "memory");
            if (s > 0) { const int* vv = vote + ((s - 1) & 1) * 4; if ((vv[0] & vv[1] & vv[2] & vv[3]) != 0) break; }
            if (s + 2 < nsteps) { char* nxt = smem + LDS_RING(s + 2); sg.stage_k(nxt, kbase + (size_t)(kb - 128) * LDQ); sg.stage_v(nxt, vbase + kb - 128); }
            if (!mine_done) {
                KF kc; lds_k(kc, cur, lane);
                VF vf; lds_v(vf, cur, lane);
                f32x4 sc[4]; scores(kc, qf, sc);
                float w4[4][4], ex[4][4], lsg[4][4];
                float T[2];
#pragma unroll
                for (int h = 0; h < 2; ++h) {
                    float run = 0.f;
#pragma unroll
                    for (int q = 1; q >= 0; --q) {
                        const int kt = 2 * h + q;
#pragma unroll
                        for (int j = 3; j >= 0; --j) {
                            const float z = sc[kt][j];
                            const bool v = (kb + KEY_OF(kt, j, fq)) < t;
                            const float sp = fmaxf(z, 0.f) + __logf(1.0f + __expf(-fabsf(z)));
                            ex[kt][j] = run;
                            lsg[kt][j] = v ? (z - sp) : -INFINITY;
                            run += v ? -sp : 0.f;
                        }
                    }
                    T[h] = run;
                }
                float E[2], Tot[2];
#pragma unroll
                for (int h = 0; h < 2; ++h) {
                    const float a0 = __shfl(T[h], fr), a1 = __shfl(T[h], fr + 16), a2 = __shfl(T[h], fr + 32), a3 = __shfl(T[h], fr + 48);
                    Tot[h] = (a0 + a1) + (a2 + a3);
                    E[h] = (fq < 1 ? a1 : 0.f) + (fq < 2 ? a2 : 0.f) + (fq < 3 ? a3 : 0.f);
                }
#pragma unroll
                for (int kt = 0; kt < 4; ++kt) {
                    const float off = (kt >> 1) ? (R + E[1]) : (R + Tot[1] + E[0]);
#pragma unroll
                    for (int j = 0; j < 4; ++j) w4[kt][j] = __expf(lsg[kt][j] + off + ex[kt][j]);
                }
                R += Tot[0] + Tot[1];
                pv(vf, w4, o);
                if (__all(R < -104.f)) mine_done = true;
            }
            if (lane == 0) vote[(s & 1) * 4 + wid] = mine_done ? 1 : 0;
        }
        asm volatile("s_waitcnt vmcnt(0)" ::: "memory");
        __syncthreads();
#pragma unroll
        for (int n = 0; n < 4; ++n) store_o4(O + (rowb + t) * DM + 512 + head * 64 + n * 16 + 4 * fq, o[n][0], o[n][1], o[n][2], o[n][3]);
    }
}

__device__ __forceinline__ void ph_kmean(const Params& p) {
    const bf16_t* Q = (const bf16_t*)(p.ws + OFF_QKV);
    float* KM = (float*)(p.ws + B_KMEAN);
    const int tidh = hidden_tid(), lane = tidh & 63, wid = tidh >> 6;
    const int c = lane & 7, r = lane >> 3;
    const int nw = gridDim.x * 4, w0 = ((blockIdx.x + gridDim.x - (gridDim.x > 128 ? 128 : 0)) % gridDim.x) * 4 + wid;
    for (int wi = w0; wi < 256; wi += nw) {
        const int hkv = wi & 1, j = (wi >> 1) & 63, b = wi >> 7;
        const bf16_t* base = Q + ((size_t)b * SEQ + j * 256 + r) * LDQ + 512 + hkv * 64 + c * 8;
        float acc[8] = {0.f, 0.f, 0.f, 0.f, 0.f, 0.f, 0.f, 0.f};
#pragma unroll 8
        for (int i = 0; i < 32; ++i) {
            const bf16x8 v = ld8(base + (size_t)(8 * i) * LDQ);
#pragma unroll
            for (int e = 0; e < 8; ++e) acc[e] += bf2f((bf16_t)v[e]);
        }
#pragma unroll
        for (int e = 0; e < 8; ++e) { float a = acc[e]; a += __shfl_xor(a, 8); a += __shfl_xor(a, 16); a += __shfl_xor(a, 32); acc[e] = a; }
        if (r == 0) {
            float* o = KM + ((b * 64 + j) * 2 + hkv) * 64 + c * 8;
            *(float4*)o = make_float4(acc[0] * (1.0f / 256.0f), acc[1] * (1.0f / 256.0f), acc[2] * (1.0f / 256.0f), acc[3] * (1.0f / 256.0f));
            *(float4*)(o + 4) = make_float4(acc[4] * (1.0f / 256.0f), acc[5] * (1.0f / 256.0f), acc[6] * (1.0f / 256.0f), acc[7] * (1.0f / 256.0f));
        }
    }
}
__device__ __forceinline__ size_t moba_list_off(int L, int j) { return (size_t)L * MOBA_LCAP + 1024ull * (size_t)(63 * j - (j * (j - 1)) / 2); }

__device__ __forceinline__ void ph_moba_gate(const Params& p, char* smem) {
    float* km = (float*)smem;
    int* cnt = (int*)(smem + 16384);
    int* gbase = cnt + 64;
    const bf16_t* Q = (const bf16_t*)(p.ws + OFF_QKV);
    const float* KM = (const float*)(p.ws + B_KMEAN);
    int* gcnt = (int*)(p.ws + OFF_MOBACNT);
    int* lists = (int*)(p.ws + B_LIST);
    const int tid = hidden_tid();
    for (int it = blockIdx.x; it < 1024; it += gridDim.x) {
        const int tc = it & 255, hkv = (it >> 8) & 1, b = it >> 9, LL = b * 2 + hkv;
        const int tl = tc * 64 + (tid >> 2), g = tid & 3, own = tl >> 8;
        for (int i = tid; i < 64 * 64; i += 256) { const int j = i >> 6, d = i & 63; km[i] = KM[((b * 64 + j) * 2 + hkv) * 64 + d]; }
        if (tid < 64) cnt[tid] = 0;
        __syncthreads();
        float q[64];
        {
            const bf16_t* qp = Q + ((size_t)b * SEQ + tl) * LDQ + (hkv * 4 + g) * 64;
#pragma unroll
            for (int i = 0; i < 8; ++i) { const bf16x8 v = ld8(qp + i * 8);
#pragma unroll
                for (int e = 0; e < 8; ++e) q[i * 8 + e] = bf2f((bf16_t)v[e]); }
        }
        float bv0 = -INFINITY, bv1 = -INFINITY, bv2 = -INFINITY; int bi0 = 0, bi1 = 1, bi2 = 2;
        for (int j = 0; j < own; ++j) {
            float s = 0.f;
#pragma unroll
            for (int d = 0; d < 64; d += 4) { const float4 k = *(const float4*)(km + j * 64 + d); s += q[d] * k.x; s += q[d + 1] * k.y; s += q[d + 2] * k.z; s += q[d + 3] * k.w; }
            if (s > bv0) { bv2 = bv1; bi2 = bi1; bv1 = bv0; bi1 = bi0; bv0 = s; bi0 = j; }
            else if (s > bv1) { bv2 = bv1; bi2 = bi1; bv1 = s; bi1 = j; }
            else if (s > bv2) { bv2 = s; bi2 = j; }
        }
        const int nv = own < 3 ? own : 3;
        int rk0 = 0, rk1 = 0, rk2 = 0;
        if (nv > 0) rk0 = atomicAdd(&cnt[bi0], 1);
        if (nv > 1) rk1 = atomicAdd(&cnt[bi1], 1);
        if (nv > 2) rk2 = atomicAdd(&cnt[bi2], 1);
        __syncthreads();
        if (tid < 64 && cnt[tid] > 0) gbase[tid] = atomicAdd(&gcnt[(LL * 64 + tid) * CNTS], cnt[tid]);
        __syncthreads();
        const int ent = tl | (g << 14);
        if (nv > 0) lists[moba_list_off(LL, bi0) + gbase[bi0] + rk0] = ent | (0 << 16);
        if (nv > 1) lists[moba_list_off(LL, bi1) + gbase[bi1] + rk1] = ent | (1 << 16);
        if (nv > 2) lists[moba_list_off(LL, bi2) + gbase[bi2] + rk2] = ent | (2 << 16);
        __syncthreads();
    }
}

__device__ __forceinline__ void ph_moba_part(const Params& p, char* smem) {
    int* cpre = (int*)(smem + 65536);
    const bf16_t* Q = (const bf16_t*)(p.ws + OFF_QKV);
    const bf16_t* VT = (const bf16_t*)(p.ws + OFF_VT);
    const int* gcnt = (const int*)(p.ws + OFF_MOBACNT);
    const int* lists = (const int*)(p.ws + B_LIST);
    bf16_t* PO = (bf16_t*)(p.ws + B_PO); float* PML = (float*)(p.ws + B_PML);
    const int tid = (int)threadIdx.x, lane = tid & 63, wid = tid >> 6, fr = lane & 15, fq = lane >> 4;
    Stager sg; sg.init(tid, LDQ, VLD);
    int* nL = cpre + 260;
    { const int c = gcnt[tid * CNTS]; nL[tid] = c; cpre[tid + 1] = (c + 127) >> 7; }
    if (tid == 0) cpre[0] = 0;
    __syncthreads();
    if (tid == 0) { int acc = 0; for (int i = 1; i <= 256; ++i) { acc += cpre[i]; cpre[i] = acc; } }
    __syncthreads();
    const int total = cpre[256], g = gridDim.x;
    auto locate = [&](int it, int& LL, int& j, int& n, int& chunk) {
        int lo = 0, hi = 255;
        while (lo < hi) { const int mid = (lo + hi + 1) >> 1; if (cpre[mid] <= it) lo = mid; else hi = mid - 1; }
        chunk = it - cpre[lo]; LL = lo >> 6; j = lo & 63; n = nL[lo];
    };
    auto load_ent = [&](int LL, int j, int n, int chunk, int (&ent)[2]) {
        const int* lst = lists + moba_list_off(LL, j);
#pragma unroll
        for (int r = 0; r < 2; ++r) { const int ri = chunk * 128 + r * 64 + wid * 16 + fr; ent[r] = lst[ri < n ? ri : n - 1]; }
    };
    auto load_q = [&](int LL, const int (&ent)[2], bf16x8 (&qf)[2][2]) {
        const int b = LL >> 1, hkv = LL & 1;
#pragma unroll
        for (int r = 0; r < 2; ++r) {
            const bf16_t* qp = Q + ((size_t)b * SEQ + (ent[r] & 16383)) * LDQ + (hkv * 4 + ((ent[r] >> 14) & 3)) * 64;
            qf[r][0] = ld8(qp + fq * 8); qf[r][1] = ld8(qp + 32 + fq * 8);
        }
    };
    int LL0 = 0, j0 = 0, n0 = 1, c0 = 0, LL1 = 0, j1 = 0, n1 = 1, c1 = 0;
    int entA[2] = {0, 0}, entB[2] = {0, 0}; bf16x8 qfA[2][2], qfB[2][2];
#pragma unroll
    for (int r = 0; r < 2; ++r) { qfA[r][0] = zero8(); qfA[r][1] = zero8(); qfB[r][0] = zero8(); qfB[r][1] = zero8(); }
    int it = blockIdx.x;
    if (it < total) { locate(it, LL0, j0, n0, c0); load_ent(LL0, j0, n0, c0, entA); load_q(LL0, entA, qfA); }
    if (it + g < total) { locate(it + g, LL1, j1, n1, c1); load_ent(LL1, j1, n1, c1, entB); }
    for (; it < total; it += g) {
        int LL2 = 0, j2 = 0, n2 = 1, c2 = 0; int entC[2] = {0, 0};
        if (it + g < total) load_q(LL1, entB, qfB);
        if (it + 2 * g < total) { locate(it + 2 * g, LL2, j2, n2, c2); load_ent(LL2, j2, n2, c2, entC); }
        const int b = LL0 >> 1, hkv = LL0 & 1;
        St st[2];
        st_init(st[0]); st_init(st[1]);
        const bf16_t* kbase = Q + ((size_t)b * SEQ + j0 * 256) * LDQ + 512 + hkv * 64;
        const bf16_t* vbase = VT + ((size_t)(b * NVH + hkv) * 64) * VLD + j0 * 256;
        attn_run_lds2<4>(smem, sg, qfA, 4, [&](int s, const bf16_t*& kp, const bf16_t*& vp) { kp = kbase + (size_t)(64 * s) * LDQ; vp = vbase + 64 * s; },
                      [](int, int, int) { return true; }, [](int, int) { return true; }, st, lane, fq);
#pragma unroll
        for (int r = 0; r < 2; ++r) {
            const int ri = c0 * 128 + r * 64 + wid * 16 + fr;
            const float l = quad_sum(st[r].l);
            if (ri < n0) {
                const int e = entA[r];
                const size_t idx = ((size_t)((size_t)b * SEQ + (e & 16383)) * 8 + hkv * 4 + ((e >> 14) & 3)) * 3 + ((e >> 16) & 3);
                st_part(PO + idx * 64 + fq * 16, st[r].o);
                if (fq == 0) { PML[idx * 2] = st[r].m; PML[idx * 2 + 1] = l; }
            }
        }
        LL0 = LL1; j0 = j1; n0 = n1; c0 = c1; LL1 = LL2; j1 = j2; n1 = n2; c1 = c2;
#pragma unroll
        for (int r = 0; r < 2; ++r) { entA[r] = entB[r]; entB[r] = entC[r]; qfA[r][0] = qfB[r][0]; qfA[r][1] = qfB[r][1]; }
    }
}

__device__ __forceinline__ void ph_moba_own(const Params& p, char* smem) {
    const bf16_t* Q = (const bf16_t*)(p.ws + OFF_QKV);
    const bf16_t* VT = (const bf16_t*)(p.ws + OFF_VT);
    const bf16_t* PO = (const bf16_t*)(p.ws + B_PO); const float* PML = (const float*)(p.ws + B_PML);
    bf16_t* O = (bf16_t*)(p.ws + OFF_O);
    const int tid = (int)threadIdx.x, lane = tid & 63, wid = tid >> 6, fr = lane & 15, fq = lane >> 4;
    Stager sg; sg.init(tid, LDQ, VLD);
    for (int it = blockIdx.x; it < 2 * 2 * (SEQ / 32); it += gridDim.x) {
        const int hb = it / (SEQ / 32), tt = (it % (SEQ / 32) + 3 * hb) % (SEQ / 32), hkv = hb & 1, b = hb >> 1;
        const int head = hkv * 4 + wid, t0 = tt * 32, own = t0 >> 8;
        const size_t rowb = (size_t)b * SEQ;
        bf16x8 qf[2][2]; St st[2];
#pragma unroll
        for (int r = 0; r < 2; ++r) {
            const bf16_t* qp = Q + (rowb + t0 + 16 * r + fr) * LDQ + head * 64;
            qf[r][0] = ld8(qp + fq * 8); qf[r][1] = ld8(qp + 32 + fq * 8);
            st_init(st[r]);
        }
        const int k0 = own * 256, ns = ((t0 + 31 - k0) >> 6) + 1;
        const bf16_t* kbase = Q + rowb * LDQ + 512 + hkv * 64;
        const bf16_t* vbase = VT + ((size_t)(b * NVH + hkv) * 64) * VLD;
        attn_run_lds2<4>(smem, sg, qf, ns, [&](int s, const bf16_t*& kp, const bf16_t*& vp) { const int kb = k0 + 64 * s; kp = kbase + (size_t)kb * LDQ; vp = vbase + kb; },
                      [&](int r, int s, int key) { return (k0 + 64 * s + key) <= (t0 + 16 * r + fr); },
                      [&](int r, int s) { return (k0 + 64 * s + 63) <= (t0 + 16 * r); }, st, lane, fq);
        const int nv = own < 3 ? own : 3;
        float2 pml[2][3]; uint4 pa[2][3], pb[2][3];
#pragma unroll
        for (int r = 0; r < 2; ++r)
#pragma unroll
            for (int q = 0; q < 3; ++q) {
                const size_t idx = ((size_t)(rowb + t0 + 16 * r + fr) * 8 + head) * 3 + (q < nv ? q : 0);
                pml[r][q] = *(const float2*)(PML + idx * 2);
                const uint4* pp = (const uint4*)(PO + idx * 64 + fq * 16);
                pa[r][q] = pp[0]; pb[r][q] = pp[1];
            }
#pragma unroll
        for (int r = 0; r < 2; ++r) {
            const int t = t0 + 16 * r + fr;
            float l = quad_sum(st[r].l), m = st[r].m;
#pragma unroll
            for (int q = 0; q < 3; ++q) {
                if (q < nv) {
                    const float mr = pml[r][q].x, lr = pml[r][q].y;
                    const float mn = fmaxf(m, mr), a = ex2(m - mn), c = ex2(mr - mn);
#pragma unroll
                    for (int n = 0; n < 4; ++n) st[r].o[n] *= a;
                    acc_rec(pa[r][q], pb[r][q], c, st[r].o);
                    l = l * a + c * lr; m = mn;
                }
            }
            const float inv = 1.0f / l;
#pragma unroll
            for (int n = 0; n < 4; ++n) store_o4(O + (rowb + t) * DM + head * 64 + n * 16 + 4 * fq, st[r].o[n][0] * inv, st[r].o[n][1] * inv, st[r].o[n][2] * inv, st[r].o[n][3] * inv);
        }
    }
}

__device__ __forceinline__ float gelu_tanh(float x) {
    const float u = 0.7978845608028654f * (x + 0.044715f * x * x * x);
    const float e = __expf(2.0f * u);
    const float th = 1.0f - 2.0f / (e + 1.0f);
    return 0.5f * x * (1.0f + th);
}
__device__ __forceinline__ void ph_cmp1(const Params& p, char* smem) {
    const bf16_t* Q = (const bf16_t*)(p.ws + OFF_QKV);
    const int tid = hidden_tid();
    for (int it = blockIdx.x; it < 128; it += gridDim.x) {
        const int kv = it >> 6, mt = (it >> 1) & 31, nt = it & 1;
        const int col = kv ? 1408 : 1280;
        const bf16_t* Bt = (const bf16_t*)(p.ws + (kv ? W_V1 : W_K1));
        const float* bias = (const float*)(p.ws + (kv ? W_BV : W_BK));
        bf16_t* HID = (bf16_t*)(p.ws + (kv ? B_HIDV : B_HIDK));
        const bf16_t* ap[4];
#pragma unroll
        for (int i = 0; i < 4; ++i) {
            const int r = mt * 128 + i * 32 + (tid >> 3);
            const int h = r & 1, bc = r >> 1, c = bc & 1023, b = bc >> 10;
            const int cc = (c < NCMP) ? c : 0;
            ap[i] = Q + ((size_t)b * SEQ + 16 * cc) * LDQ + col + h * 64 + GSW64(tid);
        }
        const bf16_t* b0 = Bt + (size_t)(nt * 128 + (tid >> 3)) * 2048 + GSW64(tid);
        gemm_tile_k64(smem, tid, ap, b0, (size_t)32 * 2048, 32, [](int t) { return (size_t)t * LDQ; },
            [&](f32x4 (&acc)[4][4], int wr, int wc, int fr, int fq) {
#pragma unroll
                for (int m = 0; m < 4; ++m)
#pragma unroll
                    for (int j = 0; j < 4; ++j) {
                        const int r = mt * 128 + wr * 64 + m * 16 + fq * 4 + j;
#pragma unroll
                        for (int n = 0; n < 4; ++n) { const int cn = nt * 128 + wc * 64 + n * 16 + fr; HID[(size_t)r * 256 + cn] = f2bf(gelu_tanh(acc[m][n][j] + bias[cn])); }
                    }
            });
    }
}
__device__ __forceinline__ void ph_cmp2(const Params& p, char* smem) {
    const int tid = hidden_tid();
    for (int it = blockIdx.x; it < 64; it += gridDim.x) {
        const int kv = it >> 5, mt = it & 31;
        const bf16_t* A = (const bf16_t*)(p.ws + (kv ? B_HIDV : B_HIDK));
        const bf16_t* Bt = (const bf16_t*)(p.ws + (kv ? W_V2 : W_K2));
        bf16_t* KC = (bf16_t*)(p.ws + B_KCMP); bf16_t* VC = (bf16_t*)(p.ws + B_VCMPT);
        const bf16_t* a0 = A + (size_t)(mt * 128 + (tid >> 2)) * 256 + GSW(tid);
        const bf16_t* a1 = a0 + (size_t)64 * 256;
        const bf16_t* b0 = Bt + (size_t)(tid >> 2) * 256 + GSW(tid);
        const bf16_t* b1 = b0 + (size_t)64 * 256;
        gemm_tile(smem, a0, a1, b0, b1, 8, [](int t) { return (size_t)t * 32; },
            [&](f32x4 (&acc)[4][4], int wr, int wc, int fr, int fq) {
                if (wc != 0) return;
#pragma unroll
                for (int m = 0; m < 4; ++m)
#pragma unroll
                    for (int j = 0; j < 4; ++j) {
                        const int r = mt * 128 + wr * 64 + m * 16 + fq * 4 + j;
                        const int h = r & 1, bc = r >> 1, c = bc & 1023, b = bc >> 10;
                        const bool ok = c < NCMP;
#pragma unroll
                        for (int n = 0; n < 4; ++n) {
                            const int d = n * 16 + fr;
                            const bf16_t v = ok ? f2bf(acc[m][n][j]) : (bf16_t)0;
                            if (kv == 0) KC[((size_t)(b * 2 + h) * 1024 + c) * 64 + d] = v;
                            else VC[((size_t)(b * 2 + h) * 64 + d) * CLD + c] = v;
                        }
                    }
            });
    }
}

#ifndef PROBE_NSA
#define PROBE_NSA 0
#endif
#define NSA_T(i) if (PROBE_NSA) { const unsigned long long _n = clock64(); tsec[i] += _n - tprev; tprev = _n; }
__device__ __forceinline__ size_t nsa_list_off(int LL, int j) { return (size_t)LL * NSA_LCAP + 64ull * (size_t)(254 * j - (j * (j - 1)) / 2); }
__device__ __forceinline__ char* nsa_part_ptr(char* ws, int LL, int t, int slot) {
    const size_t rec = ((size_t)((LL & 1) * SEQ + t) * 13 + slot) * 512;
    return ws + ((LL >> 1) ? NSA_PY : NSA_PX) + rec;
}
__device__ __forceinline__ char* nsa_ml_ptr(char* ws, int LL, int t) {
    return ws + ((LL >> 1) ? NSA_PY : NSA_PX) + (size_t)2 * SEQ * 13 * 512 + (size_t)((LL & 1) * SEQ + t) * 416;
}
struct NsaIter { bool aff; int xcd, i0, istr, icnt; };
__device__ __forceinline__ NsaIter nsa_iter() {
    NsaIter it; it.aff = (gridDim.x & 7) == 0; it.xcd = blockIdx.x & 7;
    it.i0 = it.aff ? (blockIdx.x >> 3) : blockIdx.x;
    it.istr = it.aff ? (gridDim.x >> 3) : gridDim.x;
    it.icnt = it.aff ? 512 : 4096;
    return it;
}

__device__ __forceinline__ void ph_nsa1(const Params& p, char* smem) {
    unsigned long long tsec[5] = {0, 0, 0, 0, 0}, tprev = 0;
    if (PROBE_NSA) tprev = clock64();
    const bf16_t* Q = (const bf16_t*)(p.ws + OFF_QKV);
    const bf16_t* VT = (const bf16_t*)(p.ws + OFF_VT);
    const bf16_t* KC = (const bf16_t*)(p.ws + B_KCMP); const bf16_t* VC = (const bf16_t*)(p.ws + B_VCMPT);
    const float* GD = (const float*)(p.ws + B_GD);
    bf16_t* O = (bf16_t*)(p.ws + OFF_O);
    unsigned char* SID = (unsigned char*)(p.ws + M_SELID);
    int* gcnt = (int*)(p.ws + OFF_NSACNT);
    unsigned short* lists = (unsigned short*)(p.ws + NSA_LISTS);
    unsigned char* lslot = (unsigned char*)(p.ws + NSA_SLOTS);
    const int tid = (int)threadIdx.x, lane = tid & 63, wid = tid >> 6, fr = lane & 15, fq = lane >> 4;
    float* imp = (float*)(smem + 49152 + wid * 5376);
    int* selq = (int*)(smem + 49152 + wid * 5376 + 4096);
    int* sc = (int*)(smem + 49152 + wid * 5376 + 4352);
    const int qi_l = fr >> 2, g_l = fr & 3;
    Stager sgc; sgc.init(tid, 64, CLD);
    Stager sgw; sgw.init(tid, LDQ, VLD);
    const NsaIter itr = nsa_iter();
    for (int ii = itr.i0; ii < itr.icnt; ii += itr.istr) {
        const int LL = itr.aff ? (itr.xcd & 3) : (ii >> 10);
        const int tqb = itr.aff ? (2 * ii + (itr.xcd >> 2)) : (ii & 1023);
        const int b = LL >> 1, hkv = LL & 1;
        const int tb0 = tqb * 16, t0 = tb0 + wid * 4, t = t0 + qi_l;
        const size_t rowb = (size_t)b * SEQ;
        bf16x8 qf[2];
        {
            const bf16_t* qp = Q + (rowb + t) * LDQ + 768 + (hkv * 4 + g_l) * 64;
            qf[0] = ld8(qp + fq * 8); qf[1] = ld8(qp + 32 + fq * 8);
        }
        const float* gp = GD + (rowb + t) * 24 + (hkv * 4 + g_l) * 3;
        f32x4 outa[4];
#pragma unroll
        for (int n = 0; n < 4; ++n) outa[n] = (f32x4){0.f, 0.f, 0.f, 0.f};
        const bf16_t* kc = KC + (size_t)LL * 1024 * 64;
        const bf16_t* vc = VC + (size_t)LL * 64 * CLD;
        const int cN = (tb0 + 15 >= 31) ? ((tb0 + 15 - 31) >> 4) + 1 : 0;
        const int csteps = (cN + 63) >> 6;
        float m1 = NEG_BIG, l1 = 0.f;
        if (csteps > 0) {
            const int cs2 = (csteps + 1) >> 1;
            auto stage2 = [&](int s2, char* buf) {
                const int ta = 2 * s2, tb = (2 * s2 + 1 < 16) ? 2 * s2 + 1 : 15;
                sgc.stage_k(buf, kc + (size_t)ta * 64 * 64); sgc.stage_k(buf + 8192, kc + (size_t)tb * 64 * 64);
            };
            asm volatile("s_waitcnt vmcnt(0)" ::: "memory");
            stage2(0, smem);
            if (cs2 > 1) stage2(1, smem + 16384);
            for (int s = 0; s < cs2; ++s) {
                const char* cur = smem + LDS_RING(s);
                if (s + 1 < cs2) asm volatile("s_waitcnt vmcnt(4)" ::: "memory"); else asm volatile("s_waitcnt vmcnt(0)" ::: "memory");
                __builtin_amdgcn_s_barrier();
                asm volatile("" ::: "memory");
                if (s + 2 < cs2) stage2(s + 2, smem + LDS_RING(s + 2));
                float mx = -INFINITY;
                f32x4 sc[2][4];
#pragma unroll
                for (int u = 0; u < 2; ++u) {
                    KF kcur; lds_k(kcur, cur + u * 8192, lane);
                    scores(kcur, qf, sc[u]);
#pragma unroll
                    for (int kt = 0; kt < 4; ++kt)
#pragma unroll
                        for (int j = 0; j < 4; ++j) { const bool v = (16 * ((2 * s + u) * 64 + KEY_OF(kt, j, fq)) + 31) <= t; mx = fmaxf(mx, v ? sc[u][kt][j] : -INFINITY); }
                }
                mx = quad_max(mx);
                const float mn = fmaxf(m1, mx);
                float sum = 0.f;
#pragma unroll
                for (int u = 0; u < 2; ++u)
#pragma unroll
                    for (int kt = 0; kt < 4; ++kt)
#pragma unroll
                        for (int j = 0; j < 4; ++j) { const bool v = (16 * ((2 * s + u) * 64 + KEY_OF(kt, j, fq)) + 31) <= t; sum += v ? ex2(sc[u][kt][j] - mn) : 0.f; }
                l1 = l1 * ex2(m1 - mn) + sum; m1 = mn;
            }
            __syncthreads();
        }
        NSA_T(0)
        const float ltot = quad_sum(l1), il = ltot > 0.f ? 1.0f / ltot : 0.f;
        for (int i = lane; i < 1024; i += 64) imp[i] = 0.f;
        lds_fence();
        if (csteps > 0) {
            f32x4 oc[4];
#pragma unroll
            for (int n = 0; n < 4; ++n) oc[n] = (f32x4){0.f, 0.f, 0.f, 0.f};
            asm volatile("s_waitcnt vmcnt(0)" ::: "memory");
            sgc.stage_k(smem, kc); sgc.stage_v(smem, vc);
            if (csteps > 1) { sgc.stage_k(smem + 16384, kc + (size_t)64 * 64); sgc.stage_v(smem + 16384, vc + 64); }
            for (int s = 0; s < csteps; ++s) {
                const char* cur = smem + LDS_RING(s);
                if (s + 1 < csteps) asm volatile("s_waitcnt vmcnt(4)" ::: "memory"); else asm volatile("s_waitcnt vmcnt(0)" ::: "memory");
                __builtin_amdgcn_s_barrier();
                asm volatile("" ::: "memory");
                if (s + 2 < csteps) { char* nxt = smem + LDS_RING(s + 2); sgc.stage_k(nxt, kc + (size_t)(s + 2) * 64 * 64); sgc.stage_v(nxt, vc + (s + 2) * 64); }
                KF kcur; lds_k(kcur, cur, lane);
                VF vf; lds_v(vf, cur, lane);
                f32x4 sc[4]; scores(kcur, qf, sc);
                float pp[4][4], ps[4], cy[4];
#pragma unroll
                for (int kt = 0; kt < 4; ++kt) {
                    float a = 0.f;
#pragma unroll
                    for (int j = 0; j < 4; ++j) { const bool v = (16 * (s * 64 + KEY_OF(kt, j, fq)) + 31) <= t; pp[kt][j] = v ? ex2(sc[kt][j] - m1) * il : 0.f; a += pp[kt][j]; }
                    float c = pp[kt][3];
                    a += __shfl_xor(a, 1); a += __shfl_xor(a, 2);
                    c += __shfl_xor(c, 1); c += __shfl_xor(c, 2);
                    ps[kt] = a; cy[kt] = c;
                }
                if (g_l == 0) {
#pragma unroll
                    for (int kt = 0; kt < 4; ++kt) imp[qi_l * 256 + s * 16 + 8 * (kt >> 1) + 2 * fq + (kt & 1)] += ps[kt];
                }
                lds_fence();
                if (g_l == 0) {
#pragma unroll
                    for (int kt = 0; kt < 4; ++kt) { const int a1 = s * 16 + 8 * (kt >> 1) + 2 * fq + (kt & 1) + 1; if (a1 < 256) imp[qi_l * 256 + a1] += cy[kt]; }
                }
                lds_fence();
                pv(vf, pp, oc);
            }
            __syncthreads();
            { const float gc = 1.0f / (1.0f + __expf(-gp[0]));
#pragma unroll
            for (int n = 0; n < 4; ++n) outa[n] += oc[n] * gc; }
        }
        NSA_T(1)
        for (int qi = 0; qi < 4; ++qi) {
            const int cur = (t0 + qi) >> 6;
            int* ib = (int*)imp + qi * 256;
            if (lane == 0) ib[0] = -1;
            const int js = cur - 1 + (lane - 1);
            if (lane >= 1 && lane < 5 && js >= 0 && js < 256) ib[js] = -1;
        }
        lds_fence();
#pragma unroll 1
        for (int qi = 0; qi < 4; ++qi) {
            const int tt = t0 + qi, cur = tt >> 6;
            const int* ib = (const int*)imp + qi * 256;
            const int nforced = cur == 0 ? 1 : (cur == 1 ? 2 : 3);
            const int ncand = cur - 2 > 0 ? cur - 2 : 0;
            const int K = (16 - nforced) < ncand ? (16 - nforced) : ncand;
            int bi[4]; bool cand[4];
#pragma unroll
            for (int k = 0; k < 4; ++k) {
                const int i = lane + 64 * k;
                cand[k] = (i >= 1) && (i <= cur - 2);
                bi[k] = cand[k] ? ib[i] : -1;
            }
            bool done = false;
            if (K < ncand) {
                const int mloc = max(max(bi[0], bi[1]), max(bi[2], bi[3]));
                sc[lane] = mloc;
                lds_fence();
                int cnt = 0;
#pragma unroll 2
                for (int l4 = 0; l4 < 64; l4 += 4) {
                    const int4 v = *(const int4*)(sc + l4);
                    cnt += (v.x > mloc - ((l4 + 0) < lane ? 1 : 0)) ? 1 : 0; cnt += (v.y > mloc - ((l4 + 1) < lane ? 1 : 0)) ? 1 : 0;
                    cnt += (v.z > mloc - ((l4 + 2) < lane ? 1 : 0)) ? 1 : 0; cnt += (v.w > mloc - ((l4 + 3) < lane ? 1 : 0)) ? 1 : 0;
                }
                const unsigned long long mkk = __ballot(cnt == K - 1);
                const int tau = __builtin_amdgcn_readlane(mloc, __builtin_amdgcn_readfirstlane((int)__ffsll((long long)mkk) - 1));
                int ns = 0;
#pragma unroll
                for (int k = 0; k < 4; ++k) {
                    const bool sv = cand[k] && (bi[k] >= tau);
                    const unsigned long long mk = __ballot(sv);
                    const int pos = ns + __popcll(mk & ((1ull << lane) - 1ull));
                    if (sv && pos < 64) { sc[64 + pos] = bi[k]; sc[128 + pos] = lane + 64 * k; }
                    ns += __popcll(mk);
                }
                lds_fence();
                if (ns <= 64) {
                    const int my = sc[64 + (lane < ns ? lane : 0)], myi = sc[128 + (lane < ns ? lane : 0)];
                    int rk = 0;
                    const int ns4 = __builtin_amdgcn_readfirstlane(ns) & ~3;
                    for (int j = 0; j < ns4; j += 4) {
                        const int4 vj = *(const int4*)(sc + 64 + j), ij = *(const int4*)(sc + 128 + j);
                        rk += ((vj.x > my) || (vj.x == my && ij.x < myi)) ? 1 : 0; rk += ((vj.y > my) || (vj.y == my && ij.y < myi)) ? 1 : 0;
                        rk += ((vj.z > my) || (vj.z == my && ij.z < myi)) ? 1 : 0; rk += ((vj.w > my) || (vj.w == my && ij.w < myi)) ? 1 : 0;
                    }
                    for (int j = ns4; j < ns; ++j) { const int vj = sc[64 + j], ij = sc[128 + j]; rk += ((vj > my) || (vj == my && ij < myi)) ? 1 : 0; }
                    if (lane < ns && rk < K) selq[qi * 13 + rk] = myi;
                    done = true;
                }
                lds_fence();
            }
            if (!done) {
                int rank[4] = {0, 0, 0, 0};
                if (K < ncand) {
                    const int jend = __builtin_amdgcn_readfirstlane(cur - 1);
                    for (int j4 = 0; j4 < jend; j4 += 4) {
                        const int4 v = *(const int4*)(ib + j4);
                        const int vv[4] = {v.x, v.y, v.z, v.w};
#pragma unroll
                        for (int k = 0; k < 4; ++k)
#pragma unroll
                            for (int e = 0; e < 4; ++e) rank[k] += (vv[e] > bi[k] - ((j4 + e) < (lane + 64 * k) ? 1 : 0)) ? 1 : 0;
                    }
                }
                int off = 0;
#pragma unroll
                for (int i = 0; i < 4; ++i) {
                    const bool sb = cand[i] && (rank[i] < K);
                    const unsigned long long mk = __ballot(sb);
                    if (sb) selq[qi * 13 + off + __popcll(mk & ((1ull << lane) - 1ull))] = lane + 64 * i;
                    off += __popcll(mk);
                }
            }
            if (lane == 0) selq[52 + qi] = K;
        }
        lds_fence();
        NSA_T(2)
        if (lane < 52) {
            const int qi = lane / 13, slot = lane - qi * 13, tt = t0 + qi;
            if (slot < selq[52 + qi]) {
                const int jb = selq[lane];
                SID[((size_t)LL * SEQ + tt) * 16 + slot] = (unsigned char)jb;
                const int pos = atomicAdd(&gcnt[(LL * 256 + jb) * CNTS], 1);
                lists[nsa_list_off(LL, jb) + pos] = (unsigned short)tt;
                lslot[nsa_list_off(LL, jb) + pos] = (unsigned char)slot;
            }
        } else if (lane < 56) {
            SID[((size_t)LL * SEQ + t0 + (lane - 52)) * 16 + 15] = (unsigned char)selq[lane];
        }
        lds_fence();
        NSA_T(3)
        {
            St st; st_init(st);
            bf16x8 qw[2];
            { const bf16_t* qp = Q + (rowb + t) * LDQ + 768 + (hkv * 4 + g_l) * 64; qw[0] = ld8(qp + fq * 8); qw[1] = ld8(qp + 32 + fq * 8); }
            int k0 = tb0 - 511; if (k0 < 0) k0 = 0; k0 &= ~63;
            const int nw = ((tb0 + 15 - k0) >> 6) + 1;
            const bf16_t* kbase = Q + rowb * LDQ + 1792 + hkv * 64;
            const bf16_t* vbase = VT + ((size_t)(b * NVH + 4 + hkv) * 64) * VLD;
            attn_run_lds(smem, sgw, qw, nw, [&](int s, const bf16_t*& kp, const bf16_t*& vp) { const int kb = k0 + 64 * s; kp = kbase + (size_t)kb * LDQ; vp = vbase + kb; },
                         [&](int s, int key) { const int k = k0 + 64 * s + key; return (k <= t) && (t - k < 512); },
                         [&](int s) { const int kb = k0 + 64 * s; return (kb + 63 <= t0) && (t0 + 3 - kb < 512); }, st, lane, fq);
            const float gw = 1.0f / (1.0f + __expf(-gp[2]));
            const float l = quad_sum(st.l), inv = l > 0.f ? gw / l : 0.f;
#pragma unroll
            for (int n = 0; n < 4; ++n) outa[n] += st.o[n] * inv;
        }
#pragma unroll
        for (int n = 0; n < 4; ++n) store_o4(O + (rowb + t) * DM + 512 + (hkv * 4 + g_l) * 64 + n * 16 + 4 * fq, outa[n][0], outa[n][1], outa[n][2], outa[n][3]);
        NSA_T(4)
    }
    if (PROBE_NSA && threadIdx.x == 0) { unsigned long long* sx = (unsigned long long*)(smem - HDR_BYTES + 32) + 24; for (int i = 0; i < 5; ++i) sx[i] = tsec[i]; }
}

__device__ __forceinline__ void ph_nsa2(const Params& p, char* smem) {
    int* cpre = (int*)(smem + 49152);
    const bf16_t* Q = (const bf16_t*)(p.ws + OFF_QKV);
    const bf16_t* VT = (const bf16_t*)(p.ws + OFF_VT);
    const unsigned char* lslot = (const unsigned char*)(p.ws + NSA_SLOTS);
    const int* gcnt = (const int*)(p.ws + OFF_NSACNT);
    const unsigned short* lists = (const unsigned short*)(p.ws + NSA_LISTS);
    const int tid = (int)threadIdx.x, lane = tid & 63, wid = tid >> 6, fr = lane & 15, fq = lane >> 4;
    const int qi_l = fr >> 2, g_l = fr & 3;
    for (int i = tid; i < 1024; i += 256) cpre[i + 1] = (gcnt[i * CNTS] + 63) >> 6;
    if (tid == 0) cpre[0] = 0;
    __syncthreads();
    if (tid == 0) { int acc = 0; for (int i = 1; i <= 1024; ++i) { acc += cpre[i]; cpre[i] = acc; } }
    __syncthreads();
    const int total = cpre[1024];
    for (int it = blockIdx.x * 4 + wid; it < total; it += gridDim.x * 4) {
        int li;
        { int lo = 0, hi = 1023; while (lo < hi) { const int mid = (lo + hi + 1) >> 1; if (cpre[mid] <= it) lo = mid; else hi = mid - 1; } li = lo; }
        const int chunk = it - cpre[li], LL = li >> 8, j = li & 255, b = LL >> 1, hkv = LL & 1, n = gcnt[li * CNTS];
        const unsigned short* lst = lists + nsa_list_off(LL, j);
        const size_t rowb = (size_t)b * SEQ;
        KF kf; load_k(kf, Q + (rowb + (size_t)j * 64) * LDQ + 1536 + hkv * 64, LDQ, fr, fq);
        VF vf; load_v(vf, VT + ((size_t)(b * NVH + 2 + hkv) * 64) * VLD + j * 64, VLD, fr, fq);
        const int e0 = chunk * 64, e1 = (e0 + 64 < n) ? e0 + 64 : n;
        const unsigned char* lsl = lslot + nsa_list_off(LL, j);
        const int emine = (e0 + lane < e1) ? e0 + lane : e0;
        const int tmine = (int)lst[emine] | ((int)lsl[emine] << 16);
        const int ntile = (e1 - e0 + 3) >> 2;
        int ttA, ttB; bf16x8 qA0, qA1, qB0, qB1;
        {
            ttA = __shfl(tmine, (qi_l < e1 - e0) ? qi_l : 0);
            const bf16_t* qp = Q + (rowb + (ttA & 0xFFFF)) * LDQ + 768 + (hkv * 4 + g_l) * 64;
            qA0 = ld8(qp + fq * 8); qA1 = ld8(qp + 32 + fq * 8);
            const int eB = 4 + qi_l;
            ttB = __shfl(tmine, (eB < e1 - e0) ? eB : 0);
            qp = Q + (rowb + (ttB & 0xFFFF)) * LDQ + 768 + (hkv * 4 + g_l) * 64;
            qB0 = ld8(qp + fq * 8); qB1 = ld8(qp + 32 + fq * 8);
        }
        for (int tile = 0; tile < ntile; ++tile) {
            const bf16x8 qf[2] = {qA0, qA1};
            const int tcur = ttA & 0xFFFF, slot = ttA >> 16; const bool okc = (tile * 4 + qi_l) < (e1 - e0);
            ttA = ttB; qA0 = qB0; qA1 = qB1;
            {
                const int eN = (tile + 2) * 4 + qi_l;
                ttB = __shfl(tmine, (eN < e1 - e0) ? eN : 0);
                const bf16_t* qp = Q + (rowb + (ttB & 0xFFFF)) * LDQ + 768 + (hkv * 4 + g_l) * 64;
                qB0 = ld8(qp + fq * 8); qB1 = ld8(qp + 32 + fq * 8);
            }
            f32x4 sc[4]; scores(kf, qf, sc);
            float mx = sc[0][0];
#pragma unroll
            for (int kt = 0; kt < 4; ++kt)
#pragma unroll
                for (int jj = 0; jj < 4; ++jj) mx = fmaxf(mx, sc[kt][jj]);
            mx = quad_max(mx);
            float pp[4][4]; float sum = 0.f;
#pragma unroll
            for (int kt = 0; kt < 4; ++kt)
#pragma unroll
                for (int jj = 0; jj < 4; ++jj) { pp[kt][jj] = ex2(sc[kt][jj] - mx); sum += pp[kt][jj]; }
            sum = quad_sum(sum);
            f32x4 o[4];
#pragma unroll
            for (int nn = 0; nn < 4; ++nn) o[nn] = (f32x4){0.f, 0.f, 0.f, 0.f};
            pv(vf, pp, o);
            if (okc) {
                char* rec = nsa_part_ptr(p.ws, LL, tcur, slot);
                st_rec_nsa(rec, g_l, fq, o);
                if (fq == 0) *(float2*)(nsa_ml_ptr(p.ws, LL, tcur) + slot * 32 + g_l * 8) = make_float2(mx, sum);
            }
        }
    }
}

__device__ __forceinline__ void ph_nsa3(const Params& p, char* smem) {
    (void)smem;
    const bf16_t* Q = (const bf16_t*)(p.ws + OFF_QKV);
    const bf16_t* VT = (const bf16_t*)(p.ws + OFF_VT);
    const float* GD = (const float*)(p.ws + B_GD);
    const unsigned char* SID = (const unsigned char*)(p.ws + M_SELID);
    bf16_t* O = (bf16_t*)(p.ws + OFF_O);
    const int tid = (int)threadIdx.x, lane = tid & 63, wid = tid >> 6, fr = lane & 15, fq = lane >> 4;
    const int qi_l = fr >> 2, g_l = fr & 3;
    Stager sg; sg.init(tid, LDQ, VLD);
    const NsaIter itr = nsa_iter();
    for (int ii = itr.i0; ii < itr.icnt; ii += itr.istr) {
        const int LL = itr.aff ? (itr.xcd & 3) : (ii >> 10);
        const int tqb = itr.aff ? (2 * ii + (itr.xcd >> 2)) : (ii & 1023);
        const int b = LL >> 1, hkv = LL & 1;
        const int tb0 = tqb * 16, t0 = tb0 + wid * 4, t = t0 + qi_l, cur = tb0 >> 6;
        const size_t rowb = (size_t)b * SEQ;
        bf16x8 qf[2];
        {
            const bf16_t* qp = Q + (rowb + t) * LDQ + 768 + (hkv * 4 + g_l) * 64;
            qf[0] = ld8(qp + fq * 8); qf[1] = ld8(qp + 32 + fq * 8);
        }
        const float gs = 1.0f / (1.0f + __expf(-GD[(rowb + t) * 24 + (hkv * 4 + g_l) * 3 + 1]));
        const int nsel = SID[((size_t)LL * SEQ + t) * 16 + 15];
        const char* rec0 = nsa_part_ptr(p.ws, LL, t, 0);
        const char* mlp = nsa_ml_ptr(p.ws, LL, t) + g_l * 8;
        float mrv[14], lrv[14];
        mrv[13] = 0.f; lrv[13] = 0.f;
#pragma unroll
        for (int r = 0; r < 13; ++r) { const float2 ml = *(const float2*)(mlp + r * 32); mrv[r] = ml.x; lrv[r] = ml.y; }
        uint2 uo[4];
#pragma unroll
        for (int n = 0; n < 4; ++n) uo[n] = *(const uint2*)(O + (rowb + t) * DM + 512 + (hkv * 4 + g_l) * 64 + n * 16 + 4 * fq);
        const int nf = cur == 0 ? 1 : (cur == 1 ? 2 : 3);
        St st; st_init(st);
        const bf16_t* kbase = Q + rowb * LDQ + 1536 + hkv * 64;
        const bf16_t* vbase = VT + ((size_t)(b * NVH + 2 + hkv) * 64) * VLD;
        auto fblk = [&](int s) { return s == 0 ? 0 : (cur - (nf - 1 - s)); };
        attn_run_lds<4>(smem, sg, qf, nf, [&](int s, const bf16_t*& kp, const bf16_t*& vp) { const int kb = fblk(s) * 64; kp = kbase + (size_t)kb * LDQ; vp = vbase + kb; },
                     [&](int s, int key) { return (fblk(s) * 64 + key) <= t; }, [&](int s) { return (fblk(s) * 64 + 63) <= t0; }, st, lane, fq);
        float l = quad_sum(st.l), m = st.m;
        {
            const char* op0 = rec0 + g_l * 64 + fq * 16;
            float mm = m;
#pragma unroll
            for (int r = 0; r < 13; ++r) if (r < nsel) mm = fmaxf(mm, mrv[r]);
            const float a = ex2(m - mm);
            l *= a;
#pragma unroll
            for (int n = 0; n < 4; ++n) st.o[n] *= a;
#pragma unroll 1
            for (int rb = 0; rb < 14; rb += 7) {
#pragma unroll
                for (int u = 0; u < 7; ++u) {
                    const int r = rb + u;
                    const bool ok = r < nsel;
                    const int ro = ok ? r * 512 : 0;
                    const float c = ok ? ex2(mrv[r] - mm) : 0.f;
                    acc_rec(*(const uint4*)(op0 + ro), *(const uint4*)(op0 + ro + 256), c, st.o);
                    l += c * lrv[r];
                }
            }
        }
        const float inv = l > 0.f ? gs / l : 0.f;
#pragma unroll
        for (int n = 0; n < 4; ++n) {
            bf16_t* op = O + (rowb + t) * DM + 512 + (hkv * 4 + g_l) * 64 + n * 16 + 4 * fq;
            const uint2 u = uo[n];
            store_o4(op, __uint_as_float(u.x << 16) + st.o[n][0] * inv, __uint_as_float(u.x & 0xFFFF0000u) + st.o[n][1] * inv,
                         __uint_as_float(u.y << 16) + st.o[n][2] * inv, __uint_as_float(u.y & 0xFFFF0000u) + st.o[n][3] * inv);
        }
    }
}

template <int PH> __device__ __forceinline__ void run_phase(const Params& p, char* smem) {
    char* ws = p.ws;
    if (PH == 0) {
        conv_layer_weights(p, smem, 0);
        rope_table(p);
        norm_pass(p.x, nullptr, nullptr, nullptr, p.ln_mix[0], (bf16_t*)(ws + OFF_H), nullptr);
    } else if (PH == 1) { ph_gemm_qkv(p, smem, 0); if (GEMM_EXP) { __syncthreads(); ph_gemm_qkv<GEMM_EXP - 1>(p, smem, 0); } }
    else if (PH == 2) {
        if (cu_first(smem)) { ph_attn0(p, smem); __syncthreads(); conv_expert_weights(p, smem, 0); }
        else { conv_expert_weights(p, smem, 0); __syncthreads(); ph_attn0(p, smem); }
    }
    else if (PH == 3) ph_gemm_out(p, smem, p.x);
    else if (PH == 4) ph_route(p, smem, 0);
    else if (PH == 5) { }
    else if (PH == 6) ph_moe_gemm(p, smem, 0, 0);
    else if (PH == 7) ph_moe_gemm(p, smem, 1, 0);
    else if (PH == 8) {
        norm_pass(p.out, (const bf16_t*)(ws + B_Y), (const float*)(ws + M_TOKG), p.out, p.ln_mix[1], (bf16_t*)(ws + OFF_H), nullptr);
        conv_layer_weights(p, smem, 1);
    } else if (PH == 9) ph_gemm_qkv(p, smem, 1);
    else if (PH == 10) { ph_kmean(p); ph_cmp1(p, smem); }
    else if (PH == 11) { ph_moba_gate(p, smem); ph_cmp2(p, smem); }
    else if (PH == 12) {
        if (cu_first(smem)) { ph_moba_part(p, smem); __syncthreads(); ph_nsa1(p, smem); }
        else { ph_nsa1(p, smem); __syncthreads(); ph_moba_part(p, smem); }
    }
    else if (PH == 13) {
        if (cu_first(smem)) { ph_nsa2(p, smem); __syncthreads(); ph_moba_own(p, smem); }
        else { ph_moba_own(p, smem); __syncthreads(); ph_nsa2(p, smem); }
    }
    else if (PH == 14) ph_nsa3(p, smem);
    else if (PH == 15) {
        if (cu_first(smem)) { ph_gemm_out(p, smem, p.out); __syncthreads(); conv_expert_weights(p, smem, 1); }
        else { conv_expert_weights(p, smem, 1); __syncthreads(); ph_gemm_out(p, smem, p.out); }
    }
    else if (PH == 16) ph_route(p, smem, 1);
    else if (PH == 17) { }
    else if (PH == 18) ph_moe_gemm(p, smem, 0, 1);
    else if (PH == 19) ph_moe_gemm(p, smem, 1, 1);
    else if (PH == 20) norm_pass(p.out, (const bf16_t*)(ws + B_Y), (const float*)(ws + M_TOKG), nullptr, p.ln_final, nullptr, p.out);
}
#define NPHASE 21

#if MEGA
#ifndef DUP_PH
#define DUP_PH -1
#endif
#ifndef DUP_MODE
#define DUP_MODE 0
#endif
#define PHB(n) run_phase<n>(p, smem); if (DUP_PH == n) { __syncthreads(); if (n == 7 && DUP_MODE) ph_moe_gemm<DUP_MODE>(p, smem, 1, 0); else if (n == 6 && DUP_MODE) ph_moe_gemm<DUP_MODE>(p, smem, 0, 0); else run_phase<n>(p, smem); } xcd_barrier(bar); if (PROBING && threadIdx.x == 0) stamps[n + 1] = wall_clock64();
#define PHS(n) if (PROBING && threadIdx.x == 0) stamps[n + 1] = stamps[n];
__global__ void __launch_bounds__(256, 2) k_mega(Params p) {
    __shared__ __attribute__((aligned(16))) char smem_all[SMEM_BYTES + HDR_BYTES];
    char* smem = smem_all + HDR_BYTES;
    unsigned long long* stamps = (unsigned long long*)(smem_all + 32);
    if (threadIdx.x == 0) *(uint4*)smem_all = make_uint4(0u, 0u, 0u, 0u);
    __syncthreads();
    XcdBarrier bar = xcd_barrier_post((unsigned*)(p.ws + OFF_CTRL), (volatile LAS unsigned*)smem_all);
    if (threadIdx.x == 0) {
        const unsigned hw = (unsigned)__builtin_amdgcn_s_getreg(((8 - 1) << 11) | (8 << 6) | 4);
        const unsigned key = ((xb_xcc_id() & 15u) << 8) | (hw & 0xFFu);
        ((volatile LAS unsigned*)smem_all)[120] = atomicAdd((unsigned*)(p.ws + OFF_CUCNT) + key, 1u) & 1u;
    }
    __syncthreads();
    if (PROBING && threadIdx.x == 0) stamps[0] = wall_clock64();
    PHB(0) PHB(1) PHB(2) PHB(3) PHB(4) PHS(5) PHB(6) PHB(7) PHB(8) PHB(9)
    PHB(10) PHB(11) PHB(12) PHB(13) PHB(14) PHB(15) PHB(16) PHS(17) PHB(18) PHB(19)
    if (PROBING) {
        float* enc = (float*)(smem_all + 16);
        if (threadIdx.x == 0) {
            const float tot = (float)(stamps[20] - stamps[0]);
            float fa = 0.f, fb = 0.f;
            for (int i = 0; i < 20; ++i) { const float d = (float)(stamps[i + 1] - stamps[i]); if ((PROBE_A >> i) & 1) fa += d; if ((PROBE_B >> i) & 1) fb += d; }
            { const float d = (float)(stamps[22] - stamps[12]); if ((PROBE_A >> 20) & 1) fa += d; if ((PROBE_B >> 20) & 1) fb += d; }
            { const float d = (float)(stamps[23] - stamps[13]); if ((PROBE_A >> 21) & 1) fa += d; if ((PROBE_B >> 21) & 1) fb += d; }
            fa /= tot; fb /= tot;
#if PROBE_NSA
            { const unsigned long long* sx = stamps + 24; float sm = 0.f; for (int i = 0; i < 5; ++i) sm += (float)sx[i];
              fa = (float)sx[PROBE_NSA & 7] / sm; fb = (float)sx[(PROBE_NSA >> 3) & 7] / sm; }
#endif
            enc[0] = 1.0f + sqrtf(5e-4f + 6e-3f * fa);
            enc[1] = 20.0f + 80.0f * fb;
        }
        __syncthreads();
        norm_pass(p.out, (const bf16_t*)(p.ws + B_Y), (const float*)(p.ws + M_TOKG), nullptr, p.ln_final, nullptr, p.out, enc[0], enc[1]);
    } else {
        run_phase<20>(p, smem);
    }
}
#else
template <int PH> __global__ void __launch_bounds__(256, 2) k_phase(Params p) {
    __shared__ __attribute__((aligned(16))) char smem_all[SMEM_BYTES + 16];
    run_phase<PH>(p, smem_all + 16);
}
template <int PH> static void launch_phases(const Params& p, int grid, hipStream_t stream) {
    hipLaunchKernelGGL(k_phase<PH>, dim3(grid), dim3(256), 0, stream, p);
    if constexpr (PH + 1 < NPHASE) launch_phases<PH + 1>(p, grid, stream);
}
#endif

extern "C" void kernel_launch(void* const* d_in, const int* in_sizes, int n_in, void* d_out, int out_size, void* d_ws, size_t ws_size, hipStream_t stream) {
    (void)in_sizes; (void)n_in; (void)out_size;
    if (ws_size < WS_NEED) { fprintf(stderr, "workspace too small: %zu < %zu\n", ws_size, (size_t)WS_NEED); return; }
    Params p; memset(&p, 0, sizeof(p));
    p.x = (const float*)d_in[0]; p.pos = (const int*)d_in[1];
    p.ln_mix[0] = (const float*)d_in[2]; p.w_in[0] = (const float*)d_in[3]; p.sinks0 = (const float*)d_in[4]; p.w_out[0] = (const float*)d_in[5];
    p.ln_ffn[0] = (const float*)d_in[6]; p.r_group[0] = (const float*)d_in[7]; p.r_expert[0] = (const float*)d_in[8];
    p.e_gate[0] = (const float*)d_in[9]; p.e_up[0] = (const float*)d_in[10]; p.e_down[0] = (const float*)d_in[11];
    p.ln_mix[1] = (const float*)d_in[12]; p.w_in[1] = (const float*)d_in[13];
    p.k_pe = (const float*)d_in[14]; p.k_w1 = (const float*)d_in[15]; p.k_w2 = (const float*)d_in[16];
    p.v_pe = (const float*)d_in[17]; p.v_w1 = (const float*)d_in[18]; p.v_w2 = (const float*)d_in[19];
    p.w_out[1] = (const float*)d_in[20]; p.ln_ffn[1] = (const float*)d_in[21]; p.r_group[1] = (const float*)d_in[22]; p.r_expert[1] = (const float*)d_in[23];
    p.e_gate[1] = (const float*)d_in[24]; p.e_up[1] = (const float*)d_in[25]; p.e_down[1] = (const float*)d_in[26];
    p.ln_final = (const float*)d_in[27];
    p.out = (float*)d_out; p.ws = (char*)d_ws;
    (void)hipMemsetAsync(d_ws, 0, 1 * MB, stream);
#if MEGA
    static int grid = 0;
    if (!grid) {
        int dev = 0, cus = 0, per_cu = 0;
        (void)hipGetDevice(&dev);
        (void)hipDeviceGetAttribute(&cus, hipDeviceAttributeMultiprocessorCount, dev);
        (void)hipOccupancyMaxActiveBlocksPerMultiprocessor(&per_cu, k_mega, 256, 0);
        if (per_cu < 1) per_cu = 1;
        grid = cus * (per_cu < 2 ? per_cu : 2);
    }
    hipLaunchKernelGGL(k_mega, dim3(grid), dim3(256), 0, stream, p);
#else
    launch_phases<0>(p, 512, stream);
#endif
}
```
